# Optimizing an MI355X kernel written in HIP

```python
import jax
import jax.numpy as jnp
from jax import lax
import numpy as np


D_MODEL = 1024
BATCH = 8
SEQ = 4096
DEPTH = 2

CHUNK = 64
NORM_EPS = 1e-6
GLA_HEADS = 4
GLA_DK = 64
GLA_DV = 128
GLA_GATE_RANK = 16
GLA_GATE_TAU = 16.0
GDN_HEADS = 4
GDN_DK = 128
GDN_DV = 128
GDN_CONV = 4
SSD_HEADS = 8
SSD_HEAD_DIM = 64
SSD_GROUPS = 2
SSD_STATE = 64
SSD_CONV = 4
SSD_INNER = SSD_HEADS * SSD_HEAD_DIM
N_BRANCH = 3
BRANCH_WIDTH = 512
N_EXPERTS = 32
TOP_K = 4
D_FF_EXPERT = D_MODEL
SWIGLU_LIMIT = 7.0
SWIGLU_ALPHA = 1.702
MOE_BLOCK = 256

IN_SPLITS = (
    GLA_HEADS * GLA_DK,
    GLA_HEADS * GLA_DK,
    GLA_HEADS * GLA_DV,
    GLA_GATE_RANK,
    GLA_HEADS * GLA_DV,
    GDN_HEADS * (2 * GDN_DK + GDN_DV),
    GDN_HEADS,
    GDN_HEADS,
    GDN_HEADS * GDN_DV,
    SSD_INNER,
    SSD_INNER + 2 * SSD_GROUPS * SSD_STATE,
    SSD_HEADS,
    N_BRANCH * D_MODEL,
)
IN_COLS = sum(IN_SPLITS)

kernel_name = 'hybrid_gla_gdn_ssd_moe_adaln'


def _split_points():
    pts, acc = [], 0
    for s in IN_SPLITS[:-1]:
        acc += s
        pts.append(acc)
    return pts


def _rms(x):
    xf = x.astype(jnp.float32)
    return xf * lax.rsqrt(jnp.mean(xf * xf, axis=-1, keepdims=True) + NORM_EPS)


def rmsnorm(x, g):
    return (_rms(x) * g.astype(jnp.float32)).astype(x.dtype)


def l2norm(x):
    return x * lax.rsqrt(jnp.sum(x * x, axis=-1, keepdims=True) + 1e-6)


def causal_dwconv(u, w, b=None):
    k = w.shape[0]
    ch = u.shape[-1]
    out = lax.conv_general_dilated(
        u, w.astype(u.dtype)[:, None, :], window_strides=(1,), padding=[(k - 1, 0)],
        dimension_numbers=('NWC', 'WIO', 'NWC'), feature_group_count=ch)
    if b is not None:
        out = out + b.astype(u.dtype)
    return out


def to_heads(u, n_heads):
    bsz, seq, width = u.shape
    return u.reshape(bsz, seq // CHUNK, CHUNK, n_heads, width // n_heads).transpose(0, 3, 1, 2, 4)


def heads_scalar(u):
    bsz, seq, nh = u.shape
    return u.reshape(bsz, seq // CHUNK, CHUNK, nh).transpose(0, 3, 1, 2)


def from_heads(o):
    bsz, nh, nc, cl, d = o.shape
    return o.transpose(0, 2, 3, 1, 4).reshape(bsz, nc * cl, nh * d)


def chunk_masks():
    ones = jnp.ones((CHUNK, CHUNK), dtype=bool)
    return jnp.tril(ones), jnp.tril(ones, k=-1)


def masked_decay(cum, mask):
    diff = cum[..., :, None] - cum[..., None, :]
    return jnp.where(mask, jnp.exp(jnp.where(mask, diff, 0.0)), 0.0)


def inter_chunk_scan(decay, update, axis):
    d = jnp.moveaxis(decay, axis, 0)
    u = jnp.moveaxis(update, axis, 0)

    def step(s, du):
        dn, un = du
        return dn * s + un, s

    _, s_in = lax.scan(step, jnp.zeros_like(u[0]), (d, u))
    return jnp.moveaxis(s_in, 0, axis)


def gla_mixer(q, k, v, lr, r, w_gate2, b_gate2, norm_g):
    incl, _ = chunk_masks()
    gk = jax.nn.log_sigmoid(lr @ w_gate2.astype(jnp.float32) + b_gate2.astype(jnp.float32)) / GLA_GATE_TAU
    q = to_heads(q, GLA_HEADS) * (GLA_DK ** -0.5)
    k = to_heads(k, GLA_HEADS)
    v = to_heads(v, GLA_HEADS)
    gk = to_heads(gk, GLA_HEADS)
    b = jnp.cumsum(gk, axis=3)
    b_last = b[..., -1:, :]
    q_dec = q * jnp.exp(b)
    att = jnp.einsum('bhnld,bhnmd->bhnlm', q_dec, k * jnp.exp(-b))
    o = jnp.einsum('bhnlm,bhnme->bhnle', jnp.where(incl, att, 0.0), v)
    upd = jnp.einsum('bhnld,bhnle->bhnde', k * jnp.exp(b_last - b), v)
    s_in = inter_chunk_scan(jnp.exp(b_last[..., 0, :])[..., None], upd, axis=2)
    o = o + jnp.einsum('bhnld,bhnde->bhnle', q_dec, s_in)
    o = _rms(o) * norm_g.astype(jnp.float32)
    return from_heads(o) * jax.nn.silu(r)


def gdn_mixer(qkv, a_raw, b_raw, g_raw, conv_w, a_log, dt_bias, norm_g):
    incl, strict = chunk_masks()
    qkv = jax.nn.silu(causal_dwconv(qkv, conv_w))
    q, k, v = jnp.split(qkv, [GDN_HEADS * GDN_DK, 2 * GDN_HEADS * GDN_DK], axis=-1)
    q = l2norm(to_heads(q, GDN_HEADS)) * (GDN_DK ** -0.5)
    k = l2norm(to_heads(k, GDN_HEADS))
    v = to_heads(v, GDN_HEADS)
    beta = heads_scalar(jax.nn.sigmoid(b_raw))
    g = heads_scalar(-jnp.exp(a_log.astype(jnp.float32)) * jax.nn.softplus(a_raw + dt_bias.astype(jnp.float32)))
    cum = jnp.cumsum(g, axis=-1)
    gam = masked_decay(cum, incl)
    a_mat = jnp.where(strict, beta[..., None] * jnp.einsum('bhnld,bhnmd->bhnlm', k, k) * gam, 0.0)
    rhs = jnp.concatenate([beta[..., None] * v, (beta * jnp.exp(cum))[..., None] * k], axis=-1)
    sol = lax.linalg.triangular_solve(a_mat + jnp.eye(CHUNK, dtype=jnp.float32), rhs,
                                      left_side=True, lower=True, unit_diagonal=True)
    u_pre, w_mix = sol[..., :GDN_DV], sol[..., GDN_DV:]
    p_mat = jnp.einsum('bhnld,bhnmd->bhnlm', q, k) * gam
    q_dec = q * jnp.exp(cum)[..., None]
    k_dec = k * jnp.exp(cum[..., -1:] - cum)[..., None]
    chunk_decay = jnp.exp(cum[..., -1])

    def step(m, inp):
        u_pre_n, w_n, p_n, q_n, k_n, d_n = inp
        u_n = u_pre_n - jnp.einsum('bhld,bhde->bhle', w_n, m)
        o_n = jnp.einsum('bhld,bhde->bhle', q_n, m) + jnp.einsum('bhlm,bhme->bhle', p_n, u_n)
        m = d_n[..., None, None] * m + jnp.einsum('bhld,bhle->bhde', k_n, u_n)
        return m, o_n

    xs = tuple(jnp.moveaxis(t, 2, 0) for t in (u_pre, w_mix, p_mat, q_dec, k_dec, chunk_decay))
    m0 = jnp.zeros((qkv.shape[0], GDN_HEADS, GDN_DK, GDN_DV), jnp.float32)
    _, o = lax.scan(step, m0, xs)
    o = jnp.moveaxis(o, 0, 2)
    o = _rms(o) * norm_g.astype(jnp.float32)
    return from_heads(o) * jax.nn.silu(g_raw)


def ssd_mixer(z, xbc, dt_raw, conv_w, conv_b, a_log, dt_bias, d_skip, norm_g):
    incl, _ = chunk_masks()
    bsz, seq, _ = z.shape
    nc = seq // CHUNK
    hg = SSD_HEADS // SSD_GROUPS
    xbc = jax.nn.silu(causal_dwconv(xbc, conv_w, conv_b))
    xs, bm, cm = jnp.split(xbc, [SSD_INNER, SSD_INNER + SSD_GROUPS * SSD_STATE], axis=-1)
    x = xs.reshape(bsz, nc, CHUNK, SSD_GROUPS, hg, SSD_HEAD_DIM)
    bm = bm.reshape(bsz, nc, CHUNK, SSD_GROUPS, SSD_STATE)
    cm = cm.reshape(bsz, nc, CHUNK, SSD_GROUPS, SSD_STATE)
    dt = jax.nn.softplus(dt_raw + dt_bias.astype(jnp.float32)).reshape(bsz, nc, CHUNK, SSD_GROUPS, hg)
    a_head = -jnp.exp(a_log.astype(jnp.float32)).reshape(SSD_GROUPS, hg)
    cum = jnp.cumsum((dt * a_head).transpose(0, 1, 3, 4, 2), axis=-1)
    seg = masked_decay(cum, incl)
    xdt = x * dt[..., None]
    cb = jnp.einsum('bclgn,bcsgn->bcgls', cm, bm)
    y = jnp.einsum('bcgls,bcghls,bcsghp->bclghp', cb, seg, xdt)
    states = jnp.einsum('bcsgn,bcghs,bcsghp->bcghnp', bm, jnp.exp(cum[..., -1:] - cum), xdt)
    s_in = inter_chunk_scan(jnp.exp(cum[..., -1])[..., None, None], states, axis=1)
    y = y + jnp.einsum('bclgn,bcghnp,bcghl->bclghp', cm, s_in, jnp.exp(cum))
    y = y + d_skip.astype(jnp.float32).reshape(SSD_GROUPS, hg)[:, :, None] * x
    y = y.reshape(bsz, seq, SSD_INNER) * jax.nn.silu(z)
    y = _rms(y.reshape(bsz, seq, SSD_GROUPS, SSD_INNER // SSD_GROUPS)).reshape(bsz, seq, SSD_INNER)
    return y * norm_g.astype(jnp.float32)


def hybrid_mixer(h, w_in, gla_w_gate2, gla_b_gate2, gla_norm, gdn_conv_w, gdn_a_log, gdn_dt_bias, gdn_norm,
                 ssd_conv_w, ssd_conv_b, ssd_a_log, ssd_dt_bias, ssd_d, ssd_norm,
                 w_branch_gla, w_branch_gdn, w_branch_ssd, b_merge, w_out):
    proj = (h @ w_in).astype(jnp.float32)
    (gla_q, gla_k, gla_v, gla_lr, gla_r, gdn_qkv, gdn_a, gdn_b, gdn_g,
     ssd_z, ssd_xbc, ssd_dt, merge_raw) = jnp.split(proj, _split_points(), axis=-1)
    y_gla = gla_mixer(gla_q, gla_k, gla_v, gla_lr, gla_r, gla_w_gate2, gla_b_gate2, gla_norm).astype(h.dtype) @ w_branch_gla
    y_gdn = gdn_mixer(gdn_qkv, gdn_a, gdn_b, gdn_g, gdn_conv_w, gdn_a_log, gdn_dt_bias, gdn_norm).astype(h.dtype) @ w_branch_gdn
    y_ssd = ssd_mixer(ssd_z, ssd_xbc, ssd_dt, ssd_conv_w, ssd_conv_b, ssd_a_log, ssd_dt_bias, ssd_d, ssd_norm).astype(h.dtype) @ w_branch_ssd
    g_gla, g_gdn, g_ssd = jnp.split(jax.nn.sigmoid(merge_raw + b_merge.astype(jnp.float32)), N_BRANCH, axis=-1)
    merged = g_gla * y_gla + g_gdn * y_gdn + g_ssd * y_ssd
    return merged.astype(h.dtype) @ w_out


def moe_ffn(h, w_router, b_router, w_gate_up, b_gate_up, w_down, b_down):
    bsz, seq, dm = h.shape
    t = h.reshape(-1, dm)
    n_tok = t.shape[0]
    logits = (t @ w_router).astype(jnp.float32) + b_router.astype(jnp.float32)
    top_val, top_idx = lax.top_k(logits, TOP_K)
    gates = jax.nn.softmax(top_val, axis=-1)
    n_assign = n_tok * TOP_K
    flat_e = top_idx.reshape(-1)
    flat_tok = jnp.arange(n_assign, dtype=jnp.int32) // TOP_K
    order = jnp.argsort(flat_e)
    se = flat_e[order]
    counts = jnp.bincount(flat_e, length=N_EXPERTS)
    padded = ((counts + MOE_BLOCK - 1) // MOE_BLOCK) * MOE_BLOCK
    pad_end = jnp.cumsum(padded)
    pad_start = pad_end - padded
    start = jnp.cumsum(counts) - counts
    pos = jnp.arange(n_assign, dtype=jnp.int32) - start[se] + pad_start[se]
    n_blocks = -(-n_assign // MOE_BLOCK) + N_EXPERTS
    n_rows = n_blocks * MOE_BLOCK
    row_tok = jnp.zeros((n_rows,), jnp.int32).at[pos].set(flat_tok[order])
    row_gate = jnp.zeros((n_rows,), jnp.float32).at[pos].set(gates.reshape(-1)[order])
    block_e = jnp.minimum(jnp.searchsorted(pad_end, jnp.arange(n_blocks) * MOE_BLOCK, side='right'), N_EXPERTS - 1)
    xs = t[row_tok].reshape(n_blocks, MOE_BLOCK, dm)

    def expert_block(args):
        xb, e = args
        gu = xb @ w_gate_up[e] + b_gate_up[e]
        gate = jnp.minimum(gu[..., 0::2], SWIGLU_LIMIT)
        up = jnp.clip(gu[..., 1::2], -SWIGLU_LIMIT, SWIGLU_LIMIT)
        act = (up + 1.0) * gate * jax.nn.sigmoid(SWIGLU_ALPHA * gate)
        return act @ w_down[e] + b_down[e]

    ys = lax.map(expert_block, (xs, block_e)).reshape(n_rows, dm)
    y = jax.ops.segment_sum(ys.astype(jnp.float32) * row_gate[:, None], row_tok, num_segments=n_tok)
    return y.reshape(bsz, seq, dm).astype(h.dtype)


def setup_inputs(seed: int = 0) -> dict:
    key = jax.random.key(seed)
    keys = iter(jax.random.split(key, 48))

    def nrm(shape, scale):
        return jax.random.normal(next(keys), shape, jnp.float32) * scale

    def gain(shape):
        return 1.0 + nrm(shape, 0.02)

    def dt_bias_init(n):
        lo, hi = np.log(1e-3), np.log(1e-1)
        dt = jnp.exp(jax.random.uniform(next(keys), (DEPTH, n), jnp.float32, minval=lo, maxval=hi))
        return dt + jnp.log(-jnp.expm1(-dt))

    def a_log_init(n):
        return jnp.log(jax.random.uniform(next(keys), (DEPTH, n), jnp.float32, minval=1.0, maxval=16.0))

    gdn_ch = GDN_HEADS * (2 * GDN_DK + GDN_DV)
    ssd_ch = SSD_INNER + 2 * SSD_GROUPS * SSD_STATE
    return {
        'x': nrm((BATCH, SEQ, D_MODEL), 1.0),
        'c': nrm((BATCH, D_MODEL), 1.0),
        'w_mod': nrm((DEPTH, D_MODEL, 6 * D_MODEL), 0.5 * D_MODEL ** -0.5),
        'b_mod': nrm((DEPTH, 6 * D_MODEL), 0.01),
        'norm_mix': gain((DEPTH, D_MODEL)),
        'norm_ffn': gain((DEPTH, D_MODEL)),
        'norm_final': gain((D_MODEL,)),
        'w_in': nrm((DEPTH, D_MODEL, IN_COLS), D_MODEL ** -0.5),
        'gla_w_gate2': nrm((DEPTH, GLA_GATE_RANK, GLA_HEADS * GLA_DK), GLA_GATE_RANK ** -0.5),
        'gla_b_gate2': nrm((DEPTH, GLA_HEADS * GLA_DK), 0.1),
        'gla_norm': gain((DEPTH, GLA_DV)),
        'gdn_conv_w': nrm((DEPTH, GDN_CONV, gdn_ch), GDN_CONV ** -0.5),
        'gdn_a_log': a_log_init(GDN_HEADS),
        'gdn_dt_bias': dt_bias_init(GDN_HEADS),
        'gdn_norm': gain((DEPTH, GDN_DV)),
        'ssd_conv_w': nrm((DEPTH, SSD_CONV, ssd_ch), SSD_CONV ** -0.5),
        'ssd_conv_b': nrm((DEPTH, ssd_ch), 0.01),
        'ssd_a_log': a_log_init(SSD_HEADS),
        'ssd_dt_bias': dt_bias_init(SSD_HEADS),
        'ssd_d': 1.0 + nrm((DEPTH, SSD_HEADS), 0.1),
        'ssd_norm': gain((DEPTH, SSD_INNER)),
        'w_branch_gla': nrm((DEPTH, GLA_HEADS * GLA_DV, D_MODEL), (GLA_HEADS * GLA_DV) ** -0.5),
        'w_branch_gdn': nrm((DEPTH, GDN_HEADS * GDN_DV, D_MODEL), (GDN_HEADS * GDN_DV) ** -0.5),
        'w_branch_ssd': nrm((DEPTH, SSD_INNER, D_MODEL), SSD_INNER ** -0.5),
        'b_merge': nrm((DEPTH, N_BRANCH * D_MODEL), 0.01),
        'w_out': nrm((DEPTH, D_MODEL, D_MODEL), D_MODEL ** -0.5),
        'w_router': nrm((DEPTH, D_MODEL, N_EXPERTS), D_MODEL ** -0.5),
        'b_router': nrm((DEPTH, N_EXPERTS), 0.01),
        'w_gate_up': nrm((DEPTH, N_EXPERTS, D_MODEL, 2 * D_FF_EXPERT), D_MODEL ** -0.5),
        'b_gate_up': nrm((DEPTH, N_EXPERTS, 2 * D_FF_EXPERT), 0.01),
        'w_down': nrm((DEPTH, N_EXPERTS, D_FF_EXPERT, D_MODEL), D_FF_EXPERT ** -0.5),
        'b_down': nrm((DEPTH, N_EXPERTS, D_MODEL), 0.01),
    }


def reference(x, c, w_mod, b_mod, norm_mix, norm_ffn, norm_final, w_in, gla_w_gate2, gla_b_gate2, gla_norm,
              gdn_conv_w, gdn_a_log, gdn_dt_bias, gdn_norm, ssd_conv_w, ssd_conv_b, ssd_a_log, ssd_dt_bias,
              ssd_d, ssd_norm, w_branch_gla, w_branch_gdn, w_branch_ssd, b_merge, w_out,
              w_router, b_router, w_gate_up, b_gate_up, w_down, b_down):
    c_act = jax.nn.silu(c)
    for l in range(DEPTH):
        mod = (c_act @ w_mod[l] + b_mod[l])[:, None, :]
        sh_m, sc_m, g_m, sh_f, sc_f, g_f = jnp.split(mod, 6, axis=-1)
        h = rmsnorm(x, norm_mix[l]) * (1.0 + sc_m) + sh_m
        mix = hybrid_mixer(h, w_in[l], gla_w_gate2[l], gla_b_gate2[l], gla_norm[l],
                           gdn_conv_w[l], gdn_a_log[l], gdn_dt_bias[l], gdn_norm[l],
                           ssd_conv_w[l], ssd_conv_b[l], ssd_a_log[l], ssd_dt_bias[l], ssd_d[l], ssd_norm[l],
                           w_branch_gla[l], w_branch_gdn[l], w_branch_ssd[l], b_merge[l], w_out[l])
        x = x + (g_m * mix).astype(x.dtype)
        h = rmsnorm(x, norm_ffn[l]) * (1.0 + sc_f) + sh_f
        ffn = moe_ffn(h, w_router[l], b_router[l], w_gate_up[l], b_gate_up[l], w_down[l], b_down[l])
        x = x + (g_f * ffn).astype(x.dtype)
    return rmsnorm(x, norm_final)
```

```cpp
#include <hip/hip_runtime.h>
#include <cstdio>
#include <cstdint>
#define DI __device__ __forceinline__
#define LAS __attribute__((address_space(3)))
typedef unsigned short bf16_t;
typedef short bf16x8 __attribute__((ext_vector_type(8)));
typedef float f32x4 __attribute__((ext_vector_type(4)));
typedef float f32x2 __attribute__((ext_vector_type(2)));
typedef float f32x16 __attribute__((ext_vector_type(16)));
typedef unsigned u32x4 __attribute__((ext_vector_type(4)));
typedef unsigned u32x2 __attribute__((ext_vector_type(2)));
typedef __bf16 hbf16x2 __attribute__((ext_vector_type(2)));

DI int ltid() { int t = threadIdx.x; asm volatile("" : "+v"(t)); return t; }
DI int lbid() { int t = blockIdx.x; asm volatile("" : "+s"(t)); return t; }
DI int lgrid() { int t = gridDim.x; asm volatile("" : "+s"(t)); return t; }
DI unsigned pk2(float a, float b) { f32x2 v = {a, b}; hbf16x2 r = __builtin_convertvector(v, hbf16x2); return __builtin_bit_cast(unsigned, r); }
DI float bflo(unsigned w) { return __uint_as_float(w << 16); }
DI float bfhi(unsigned w) { return __uint_as_float(w & 0xffff0000u); }
DI float bf2f(bf16_t v) { return __uint_as_float(((unsigned)v) << 16); }
DI bf16_t f2bf(float a) { return (bf16_t)(pk2(a, 0.f) & 0xffffu); }
DI float sigmoid_(float x) { return 1.f / (1.f + __expf(-x)); }
DI float silu_(float x) { return x / (1.f + __expf(-x)); }
DI float softplus_(float x) { return fmaxf(x, 0.f) + log1pf(__expf(-fabsf(x))); }

namespace pg8 {
constexpr int BM = 256, BK = 64, HALF = 128, HTB = HALF * BK * 2, STAGE_BYTES = 8 * HTB, NXCD = 8, WGM = 8;
__host__ __device__ __forceinline__ int lds_byte(int r, int c) { const int st = (r >> 4) * 2 + (c >> 5), rr = r & 15, cc = c & 31, ob = rr * 64 + cc * 2; return st * 1024 + (ob ^ (((ob >> 9) & 1) << 5)); }
__host__ __device__ __forceinline__ void stage_rc(int b, int& R, int& C) { const int st = b / 1024, sb = b % 1024, swz = sb ^ (((sb >> 9) & 1) << 5); R = (st >> 1) * 16 + swz / 64; C = (st & 1) * 32 + (swz % 64) / 2; }
__host__ __device__ __forceinline__ int perm32(int rho) { const int n = rho >> 4, i = rho & 15; return 8 * (i >> 2) + 4 * n + (i & 3); }

struct Unit { int pm, pn, e, cnt; };

struct StaticOrder {
    static constexpr bool GATHER = false;
    int nM, nN, nwg, G, c;
    const char* A; const char* Bt; size_t a_tstep, b_tstep, a_pnstride; int pn_per_a;
    DI void init(int M, int N, int K, int G_, int c_, const void* A_, const void* Bt_) { nM = M / BM; nN = N / BM; nwg = nM * nN; G = G_; c = c_; A = (const char*)A_; Bt = (const char*)Bt_; a_tstep = (size_t)BM * K * 2; b_tstep = (size_t)BM * K * 2; a_pnstride = 0; pn_per_a = 1 << 30; }
    DI bool next(int i, Unit& u) const {
        const long L = (long)i * G + c; if (L >= nwg) return false;
        int wgid = (int)L; { const int q = nwg / NXCD, r = nwg % NXCD, xcd = wgid % NXCD, off = wgid / NXCD; wgid = (xcd < r ? xcd * (q + 1) : r * (q + 1) + (xcd - r) * q) + off; }
        const int nig = WGM * nN, gid = wgid / nig, fm = gid * WGM, gsz = (nM - fm) < WGM ? (nM - fm) : WGM;
        u.pm = fm + ((wgid % nig) % gsz); u.pn = (wgid % nig) / gsz; u.e = 0; u.cnt = 256; return true;
    }
    DI const char* a_ptr(const Unit& u) const { return A + (size_t)(u.pn / pn_per_a) * a_pnstride + (size_t)u.pm * a_tstep; }
    DI const char* b_ptr(const Unit& u) const { return Bt + (size_t)u.pn * b_tstep; }
    DI int a_row(const Unit&, int) const { return 0; }
};

template <class Epi, class Sched, bool ALIGN_EPI = true>
DI void gemm_phase(LAS unsigned char* lds, const int K, const Sched& S, const Epi& E) {
    constexpr bool GATHER = Sched::GATHER;
    const int tid = ltid(), wid = __builtin_amdgcn_readfirstlane(tid >> 6), lane = tid & 63, wr = wid >> 2, wc = wid & 3, fr = lane & 15, fq = lane >> 4;
    const int nt = K / BK;
    unsigned voffA[2], voffB[2]; int RA[2], CA[2];
#pragma unroll
    for (int i = 0; i < 2; ++i) { int R, C; stage_rc(tid * 16 + i * 8192, R, C); const int Rb = Epi::PERM ? ((R & ~31) + perm32(R & 31)) : R; RA[i] = R; CA[i] = C;
        voffA[i] = (unsigned)(R * K + C) * 2u; voffB[i] = (unsigned)(Rb * K + C) * 2u; }
    const size_t kstep = (size_t)(BK * 2);
    const size_t hstepB = (size_t)HALF * K * 2;
    const size_t hstepA = GATHER ? 0 : hstepB;
    const unsigned ldsw = (unsigned)wid * 1024u;
    const int aoff = lds_byte(wr * 64 + fr, fq * 8), boff = lds_byte(wc * 32 + fr, fq * 8);
#define PG8_SA(b, h) (((b) * 2 + (h)) * HTB)
#define PG8_SB(b, h) ((4 + (b) * 2 + (h)) * HTB)
#define PG8_STAGE(bufoff, gbase, voff) do { _Pragma("unroll") for (int _i = 0; _i < 2; ++_i) \
        __builtin_amdgcn_global_load_lds((const unsigned*)((const char*)(gbase) + (voff)[_i]), (LAS unsigned*)(lds + (bufoff) + ldsw + _i * 8192), 16, 0, 0); } while (0)
#define PG8_LDA(dst, b, h) do { _Pragma("unroll") for (int m = 0; m < 4; ++m) _Pragma("unroll") for (int k = 0; k < 2; ++k) dst[m][k] = *(const LAS bf16x8*)(lds + PG8_SA(b, h) + aoff + m * 2048 + k * 1024); } while (0)
#define PG8_LDB(dst, b, h) do { _Pragma("unroll") for (int n = 0; n < 2; ++n) _Pragma("unroll") for (int k = 0; k < 2; ++k) dst[n][k] = *(const LAS bf16x8*)(lds + PG8_SB(b, h) + boff + n * 2048 + k * 1024); } while (0)
#define PG8_MMA(ai, bj, At, Bt) do { __builtin_amdgcn_s_setprio(1); _Pragma("unroll") for (int m = 0; m < 4; ++m) _Pragma("unroll") for (int n = 0; n < 2; ++n) _Pragma("unroll") for (int k = 0; k < 2; ++k) \
        acc[ai][bj][m][n] = __builtin_amdgcn_mfma_f32_16x16x32_bf16(Bt[n][k], At[m][k], acc[ai][bj][m][n], 0, 0, 0); __builtin_amdgcn_s_setprio(0); } while (0)
#define PG8_WAIT_V(n) asm volatile("s_waitcnt vmcnt(" #n ")" ::: "memory")
#define PG8_WAIT_L(n) asm volatile("s_waitcnt lgkmcnt(" #n ")" ::: "memory")
#define PG8_BAR __builtin_amdgcn_s_barrier()
#define PG8_SCHED __builtin_amdgcn_sched_barrier(0)
    Unit cur, nxt; int ui = 0;
    if (!S.next(0, cur)) return;
    f32x4 acc[2][2][4][2];
#pragma unroll
    for (int a = 0; a < 2; ++a)
#pragma unroll
        for (int b = 0; b < 2; ++b)
#pragma unroll
            for (int m = 0; m < 4; ++m)
#pragma unroll
                for (int n = 0; n < 2; ++n) acc[a][b][m][n] = (f32x4){0.f, 0.f, 0.f, 0.f};
    bf16x8 At[4][2], B0[2][2], B1[2][2];
    const char* cA = S.a_ptr(cur); const char* cB = S.b_ptr(cur);
    unsigned vC0[2], vC1[2], vN0[2], vN1[2];
    if constexpr (GATHER) {
#pragma unroll
        for (int i = 0; i < 2; ++i) { vC0[i] = (unsigned)(S.a_row(cur, RA[i]) * K + CA[i]) * 2u; vC1[i] = (unsigned)(S.a_row(cur, HALF + RA[i]) * K + CA[i]) * 2u; vN0[i] = vC0[i]; vN1[i] = vC1[i]; }
    } else {
#pragma unroll
        for (int i = 0; i < 2; ++i) { vC0[i] = voffA[i]; vC1[i] = voffA[i]; vN0[i] = voffA[i]; vN1[i] = voffA[i]; }
    }
    PG8_STAGE(PG8_SB(0, 0), cB, voffB); PG8_STAGE(PG8_SB(0, 1), cB + hstepB, voffB); PG8_STAGE(PG8_SA(0, 0), cA, vC0); PG8_STAGE(PG8_SA(0, 1), cA + hstepA, vC1);
    if (wr == 1) PG8_BAR;
    PG8_WAIT_V(2); PG8_BAR;
    PG8_STAGE(PG8_SB(1, 0), cB + kstep, voffB); PG8_STAGE(PG8_SA(1, 0), cA + kstep, vC0); PG8_STAGE(PG8_SB(1, 1), cB + hstepB + kstep, voffB);
    PG8_WAIT_V(6); PG8_BAR;
    for (;;) {
        const bool has_next = S.next(ui + 1, nxt);
        const char* nA = has_next ? S.a_ptr(nxt) : cA; const char* nB = has_next ? S.b_ptr(nxt) : cB;
        if constexpr (GATHER) { if (has_next) {
#pragma unroll
            for (int i = 0; i < 2; ++i) { vN0[i] = (unsigned)(S.a_row(nxt, RA[i]) * K + CA[i]) * 2u; vN1[i] = (unsigned)(S.a_row(nxt, HALF + RA[i]) * K + CA[i]) * 2u; } } }
        for (int t = 0; t < nt; t += 2) {
            const bool last = (t == nt - 2);
            const char* a1 = cA + (size_t)(t + 1) * kstep;
            const char* a2 = last ? nA : cA + (size_t)(t + 2) * kstep; const char* b2 = last ? nB : cB + (size_t)(t + 2) * kstep;
            const char* a3 = a2 + kstep; const char* b3 = b2 + kstep;
            unsigned w0[2], w1[2];
            if constexpr (GATHER) { w0[0] = last ? vN0[0] : vC0[0]; w0[1] = last ? vN0[1] : vC0[1]; w1[0] = last ? vN1[0] : vC1[0]; w1[1] = last ? vN1[1] : vC1[1]; }
            else { w0[0] = voffA[0]; w0[1] = voffA[1]; w1[0] = voffA[0]; w1[1] = voffA[1]; }
            PG8_LDB(B0, 0, 0); PG8_LDB(B1, 0, 1); PG8_SCHED; PG8_LDA(At, 0, 0); PG8_STAGE(PG8_SA(1, 1), a1 + hstepA, vC1);
            PG8_WAIT_V(8); PG8_WAIT_L(0); PG8_BAR; PG8_MMA(0, 0, At, B0); PG8_MMA(0, 1, At, B1); PG8_BAR; PG8_SCHED;
            PG8_LDA(At, 0, 1); PG8_STAGE(PG8_SB(0, 0), b2, voffB); PG8_STAGE(PG8_SB(0, 1), b2 + hstepB, voffB); PG8_STAGE(PG8_SA(0, 0), a2, w0);
            PG8_WAIT_V(8); PG8_WAIT_L(0); PG8_BAR; PG8_MMA(1, 0, At, B0); PG8_MMA(1, 1, At, B1); PG8_BAR; PG8_SCHED;
            PG8_LDB(B0, 1, 0); PG8_LDB(B1, 1, 1); PG8_SCHED; PG8_LDA(At, 1, 0); PG8_STAGE(PG8_SA(0, 1), a2 + hstepA, w1);
            PG8_WAIT_V(8); PG8_WAIT_L(0); PG8_BAR; PG8_MMA(0, 0, At, B0); PG8_MMA(0, 1, At, B1); PG8_BAR; PG8_SCHED;
            PG8_LDA(At, 1, 1); PG8_STAGE(PG8_SB(1, 0), b3, voffB); PG8_STAGE(PG8_SB(1, 1), b3 + hstepB, voffB); PG8_STAGE(PG8_SA(1, 0), a3, w0);
            PG8_WAIT_V(8); PG8_WAIT_L(0); PG8_BAR; PG8_MMA(1, 0, At, B0); PG8_MMA(1, 1, At, B1); PG8_BAR; PG8_SCHED;
        }
        if constexpr (ALIGN_EPI) { if (wr == 0) PG8_BAR; }
        E(acc, cur, wr, wc, fr, fq);
        if (!has_next) break;
#pragma unroll
        for (int a = 0; a < 2; ++a)
#pragma unroll
            for (int b = 0; b < 2; ++b)
#pragma unroll
                for (int m = 0; m < 4; ++m)
#pragma unroll
                    for (int n = 0; n < 2; ++n) acc[a][b][m][n] = (f32x4){0.f, 0.f, 0.f, 0.f};
        cur = nxt; cA = nA; cB = nB; ++ui;
        if constexpr (GATHER) { vC0[0] = vN0[0]; vC0[1] = vN0[1]; vC1[0] = vN1[0]; vC1[1] = vN1[1]; }
        if constexpr (ALIGN_EPI) { if (wr == 1) PG8_BAR; }
    }
    PG8_WAIT_V(0);
    if constexpr (!ALIGN_EPI) { if (wr == 0) PG8_BAR; }
    PG8_BAR;
#undef PG8_SA
#undef PG8_SB
#undef PG8_STAGE
#undef PG8_LDA
#undef PG8_LDB
#undef PG8_MMA
#undef PG8_WAIT_V
#undef PG8_WAIT_L
#undef PG8_BAR
#undef PG8_SCHED
}
}
using pg8::Unit;

#define XB_TMO      128
#define XB_XCNT(j)  (256  + 64 * (j))
#define XB_XSUB(j)  (1280 + 64 * (j))
#define XB_XGEN(j)  (2304 + 64 * (j))
#define XB_TOP      3328
#define XB_TOPGEN   3392
#define XCD_BAR_WORDS 3456
#define XB_SPIN_CAP (1u << 18)
DI unsigned xb_ld(unsigned* p)              { return __hip_atomic_load(p, __ATOMIC_RELAXED, __HIP_MEMORY_SCOPE_AGENT); }
DI unsigned xb_add(unsigned* p, unsigned v) { return __hip_atomic_fetch_add(p, v, __ATOMIC_RELAXED, __HIP_MEMORY_SCOPE_AGENT); }
DI unsigned xb_xcc_id() { return (unsigned)__builtin_amdgcn_s_getreg((3 << 11) | 20) & 0xFu; }
#define XB_SPIN(cond, bar) do { unsigned _sp = 0; while (cond) { __builtin_amdgcn_s_sleep(1); \
    if ((++_sp & 255u) == 0u) { if (xb_ld(&(bar)[XB_TMO])) break; if (_sp > XB_SPIN_CAP) { atomicAdd(&(bar)[XB_TMO], 1u); break; } } } } while (0)
struct XcdBarrier { unsigned* bar; unsigned x; volatile LAS unsigned* st; };
DI XcdBarrier xcd_barrier_post(unsigned* bar, volatile LAS unsigned* st) {
    XcdBarrier b; b.bar = bar; b.x = xb_xcc_id(); b.st = st;
    if (threadIdx.x == 0) (void)xb_add(&bar[XB_XCNT(b.x)], 1u);
    return b;
}
DI void xcd_barrier_complete(unsigned* bar, unsigned x, unsigned& nloc, unsigned& nx) {
    const unsigned G = gridDim.x * gridDim.y * gridDim.z;
    unsigned sum, cnt, mine, sp = 0u;
    for (;;) {
        sum = 0u; cnt = 0u; mine = 0u;
#pragma unroll
        for (unsigned j = 0; j < 16; ++j) { const unsigned c = xb_ld(&bar[XB_XCNT(j)]); sum += c; cnt += (c > 0u) ? 1u : 0u; mine = (j == x) ? c : mine; }
        if (sum == G) break;
        __builtin_amdgcn_s_sleep(1);
        if ((++sp & 255u) == 0u) { if (xb_ld(&bar[XB_TMO])) break; if (sp > XB_SPIN_CAP) { atomicAdd(&bar[XB_TMO], 1u); break; } }
    }
    nloc = mine > 0u ? mine : 1u; nx = cnt > 0u ? cnt : 1u;
}
DI void xcd_barrier(const XcdBarrier& b) {
    asm volatile("s_waitcnt vmcnt(0)" ::: "memory");
    __syncthreads();
    if (threadIdx.x == 0) {
        unsigned* bar = b.bar;
        __builtin_amdgcn_s_waitcnt(0);
        unsigned nloc = b.st[0], nx = b.st[1];
        if (nloc == 0u) { xcd_barrier_complete(bar, b.x, nloc, nx); b.st[0] = nloc; b.st[1] = nx; }
        const unsigned old = xb_add(&bar[XB_XSUB(b.x)], 1u);
        const unsigned gen = old / nloc;
        if (old + 1u == (gen + 1u) * nloc) {
            __builtin_amdgcn_fence(__ATOMIC_RELEASE, "agent");
            asm volatile("s_waitcnt vmcnt(0)" ::: "memory");
            const unsigned og = xb_add(&bar[XB_TOP], 1u);
            const unsigned tg = og / nx;
            if (og + 1u == (tg + 1u) * nx) xb_add(&bar[XB_TOPGEN], 1u);
            else XB_SPIN(xb_ld(&bar[XB_TOPGEN]) == tg, bar);
            __builtin_amdgcn_fence(__ATOMIC_ACQUIRE, "agent");
            xb_add(&bar[XB_XGEN(b.x)], 1u);
            asm volatile("s_waitcnt vmcnt(0)" ::: "memory");
        } else {
            XB_SPIN(xb_ld(&bar[XB_XGEN(b.x)]) == gen, bar);
            __builtin_amdgcn_fence(__ATOMIC_ACQUIRE, "agent");
            asm volatile("s_waitcnt vmcnt(0)" ::: "memory");
        }
    }
    __syncthreads();
}
constexpr int DM = 1024, NB = 8, SEQ = 4096, NTOK = NB * SEQ, NCHUNK = 64, NP = 8192, NEXP = 32;
constexpr int PC_GLA_Q = 0, PC_GLA_K = 256, PC_GLA_V = 512, PC_GLA_R = 1024, PC_GDN_QKV = 1536, PC_GDN_G = 3072, PC_SSD_Z = 3584, PC_SSD_XBC = 4096, PC_MERGE = 4864, PC_SMALL = 7936;
constexpr int IN_COLS = 7968;
constexpr int NTHREADS = 512;
constexpr int LDS_BYTES = 155648;
constexpr int LDS_CTRL = LDS_BYTES - 1024;
constexpr int GLA_UNIT = 41216, GDN_UNIT = 74240, SSD_UNIT = 33024;
constexpr int GLA_OQ = 0, GLA_OP = 8192, GLA_OK = 16384, GLA_OU = 24576, GLA_OD = 40960;
constexpr int GDN_OQ = 0, GDN_OW = 16384, GDN_OP = 32768, GDN_OK = 40960, GDN_OU = 57344, GDN_OD = 73728;
constexpr int SSD_OQ = 0, SSD_OP = 8192, SSD_OK = 16384, SSD_OU = 24576, SSD_OD = 32768;
constexpr size_t WS_CTL = 0, WS_CNT = 16384, WS_MOD = 65536;
constexpr size_t WS_WIN = 458752, WS_WBR = WS_WIN + 33554432ull, WS_WOUT = WS_WBR + 6291456ull, WS_WGU = WS_WOUT + 12582912ull, WS_WDN = WS_WGU + 268435456ull;
constexpr size_t WS_H = WS_WDN + 134217728ull, WS_SMALL = WS_H + 67108864ull, WS_XA = WS_SMALL + 4194304ull, WS_XB = WS_XA + 134217728ull;
constexpr size_t WS_ROWTOK = WS_XB + 134217728ull, WS_TOKSLOT = WS_ROWTOK + 4194304ull, WS_GATES = WS_TOKSLOT + 524288ull, WS_TSCR = WS_GATES + 524288ull, WS_R1 = WS_TSCR + 16777216ull;
constexpr size_t R1_PROJ = 0, R1_SGLA = 536870912ull, R1_SGDN = R1_SGLA + 2048ull * GLA_UNIT, R1_SSSD = R1_SGDN + 2048ull * GDN_UNIT, R1_OBUF = R1_SSSD + 4096ull * SSD_UNIT;
constexpr size_t R1_YMIX = R1_OBUF + 100663296ull, R1_END = R1_YMIX + 100663296ull, R1_GATED = R1_SGLA, R1_ACT = 0, R1_YS = 285212672ull;
constexpr size_t WS_END = WS_R1 + R1_END;
constexpr size_t OB_GLA = 0, OB_GDN = 33554432ull, OB_SSD = 67108864ull;

struct Args {
    const float *x, *c, *w_mod, *b_mod, *norm_mix, *norm_ffn, *norm_final, *w_in, *gla_w2, *gla_b2, *gla_norm, *gdn_conv_w, *gdn_a_log, *gdn_dt_bias, *gdn_norm,
        *ssd_conv_w, *ssd_conv_b, *ssd_a_log, *ssd_dt_bias, *ssd_d, *ssd_norm, *w_br_gla, *w_br_gdn, *w_br_ssd, *b_merge, *w_out, *w_router, *b_router, *w_gu, *b_gu, *w_dn, *b_dn;
    float* out; char* ws;
};
typedef const Args __attribute__((address_space(4))) CArgs;

DI void phase_mod(CArgs& a, LAS unsigned char* lds) {
    LAS float* cact = (LAS float*)lds;
    LAS float* red = (LAS float*)(lds + 32768);
    const int tid = ltid();
    for (int i = tid; i < 8192; i += NTHREADS) cact[i] = silu_(a.c[i]);
    __syncthreads();
    float* mod = (float*)(a.ws + WS_MOD);
    for (int blk = lbid(); blk < 256; blk += lgrid()) {
        const int jj = tid & 63, ks = tid >> 6, col = blk * 48 + jj;
        float s[8];
#pragma unroll
        for (int b = 0; b < 8; ++b) s[b] = 0.f;
        if (jj < 48) {
            const int l = col / 6144, j = col % 6144;
            const float* w = a.w_mod + (size_t)l * DM * 6144 + j;
            for (int k = ks * 128; k < ks * 128 + 128; ++k) { const float wv = w[(size_t)k * 6144];
#pragma unroll
                for (int b = 0; b < 8; ++b) s[b] += cact[b * 1024 + k] * wv; }
        }
#pragma unroll
        for (int b = 0; b < 8; ++b) red[(ks * 64 + jj) * 8 + b] = s[b];
        __syncthreads();
        if (tid < 48 * 8) { const int j2 = tid >> 3, b = tid & 7, col2 = blk * 48 + j2, l = col2 / 6144, j = col2 % 6144; float t = 0.f;
#pragma unroll
            for (int k2 = 0; k2 < 8; ++k2) t += red[(k2 * 64 + j2) * 8 + b];
            mod[((size_t)l * 8 + b) * 6144 + j] = t + a.b_mod[l * 6144 + j]; }
        __syncthreads();
    }
}
DI int win_dst(int c) {
    if (c < 1024) return c;
    if (c < 1040) return PC_SMALL + (c - 1024);
    if (c < 1552) return PC_GLA_R + (c - 1040);
    if (c < 3088) return PC_GDN_QKV + (c - 1552);
    if (c < 3092) return PC_SMALL + 16 + (c - 3088);
    if (c < 3096) return PC_SMALL + 20 + (c - 3092);
    if (c < 3608) return PC_GDN_G + (c - 3096);
    if (c < 4120) return PC_SSD_Z + (c - 3608);
    if (c < 4888) return PC_SSD_XBC + (c - 4120);
    if (c < 4896) return PC_SMALL + 24 + (c - 4888);
    return PC_MERGE + (c - 4896);
}
template <int KIND> DI void cvt_tile(const float* src, int ld_src, int ncols, int k0, int n0, bf16_t* dst, int ld_dst, int kd0, LAS float* T) {
    const int tid = ltid();
    { const int jj = tid & 127, kk = tid >> 7; const bool ok = (n0 + jj) < ncols;
#pragma unroll
      for (int i = 0; i < 16; ++i) { const int k = kk + 4 * i; T[k * 129 + jj] = ok ? src[(size_t)(k0 + k) * ld_src + n0 + jj] : 0.f; } }
    __syncthreads();
    { const int j = tid >> 2, kq = tid & 3, c = n0 + j;
      if (c < ncols) {
        int drow;
        if (KIND == 0) drow = c; else if (KIND == 1) drow = (c & ~255) + (c & 1) * 128 + ((c & 255) >> 1); else drow = win_dst(c);
        u32x4 w0, w1; float v[16];
#pragma unroll
        for (int i = 0; i < 16; ++i) v[i] = T[(kq * 16 + i) * 129 + j];
        w0.x = pk2(v[0], v[1]); w0.y = pk2(v[2], v[3]); w0.z = pk2(v[4], v[5]); w0.w = pk2(v[6], v[7]);
        w1.x = pk2(v[8], v[9]); w1.y = pk2(v[10], v[11]); w1.z = pk2(v[12], v[13]); w1.w = pk2(v[14], v[15]);
        bf16_t* d = dst + (size_t)drow * ld_dst + kd0 + k0 + kq * 16;
        *(u32x4*)d = w0; *(u32x4*)(d + 8) = w1; } }
    __syncthreads();
}
DI void phase_cvt(CArgs& a, LAS unsigned char* lds) {
    LAS float* T = (LAS float*)lds;
    constexpr int T_IN = 16 * 63, T_BR = 3 * 8 * 8, T_OUT = 3 * 16 * 8, T_GU = 32 * 16 * 16, T_DN = 32 * 16 * 8, T_L = T_IN + T_BR + T_OUT + T_GU + T_DN;
    for (int g = lbid(); g < 2 * T_L; g += lgrid()) {
        const int l = g / T_L; int r = g % T_L;
        if (r < T_IN) { const int kt = r % 16, ntile = r / 16;
            cvt_tile<2>(a.w_in + (size_t)l * DM * IN_COLS, IN_COLS, IN_COLS, kt * 64, ntile * 128, (bf16_t*)(a.ws + WS_WIN) + (size_t)l * NP * DM, DM, 0, T); continue; }
        r -= T_IN;
        if (r < T_BR) { const int br = r / 64, kt = (r % 64) % 8, ntile = (r % 64) / 8; const float* src = (br == 0 ? a.w_br_gla : br == 1 ? a.w_br_gdn : a.w_br_ssd) + (size_t)l * 512 * DM;
            cvt_tile<0>(src, DM, DM, kt * 64, ntile * 128, (bf16_t*)(a.ws + WS_WBR) + ((size_t)l * 3 + br) * DM * 512, 512, 0, T); continue; }
        r -= T_BR;
        if (r < T_OUT) { const int cp = r / 128, kt = (r % 128) % 16, ntile = (r % 128) / 16;
            cvt_tile<0>(a.w_out + (size_t)l * DM * DM, DM, DM, kt * 64, ntile * 128, (bf16_t*)(a.ws + WS_WOUT) + (size_t)l * DM * 3072, 3072, cp * 1024, T); continue; }
        r -= T_OUT;
        if (r < T_GU) { const int e = r / 256, kt = (r % 256) % 16, ntile = (r % 256) / 16;
            cvt_tile<1>(a.w_gu + ((size_t)l * NEXP + e) * DM * 2048, 2048, 2048, kt * 64, ntile * 128, (bf16_t*)(a.ws + WS_WGU) + ((size_t)l * NEXP + e) * 2048 * DM, DM, 0, T); continue; }
        r -= T_GU;
        { const int e = r / 128, kt = (r % 128) % 16, ntile = (r % 128) / 16;
            cvt_tile<0>(a.w_dn + ((size_t)l * NEXP + e) * DM * DM, DM, DM, kt * 64, ntile * 128, (bf16_t*)(a.ws + WS_WDN) + ((size_t)l * NEXP + e) * DM * DM, DM, 0, T); }
    }
    for (size_t i = (size_t)lbid() * NTHREADS + ltid(); i < 2ull * 224 * DM / 8; i += (size_t)lgrid() * NTHREADS) {
        const size_t l = i / (224 * DM / 8), rr = i % (224 * DM / 8);
        *(u32x4*)((bf16_t*)(a.ws + WS_WIN) + (l * NP + IN_COLS) * DM + rr * 8) = (u32x4){0u, 0u, 0u, 0u}; }
}

DI float wave_sum(float v) {
#pragma unroll
    for (int o = 32; o > 0; o >>= 1) v += __shfl_xor(v, o);
    return v;
}
DI void phase_norm0(CArgs& a) {
    const int lane = ltid() & 63, gw = lbid() * 8 + (ltid() >> 6), nw = lgrid() * 8;
    const float* mod = (const float*)(a.ws + WS_MOD);
    bf16_t* H = (bf16_t*)(a.ws + WS_H);
    for (int row = gw; row < NTOK; row += nw) {
        const int b = row >> 12; const float* xr = a.x + (size_t)row * DM; const float* mb = mod + (size_t)b * 6144;
        f32x4 v[4]; float ss = 0.f;
#pragma unroll
        for (int i = 0; i < 2; ++i) { v[2 * i] = *(const f32x4*)(xr + lane * 8 + 512 * i); v[2 * i + 1] = *(const f32x4*)(xr + lane * 8 + 512 * i + 4); }
#pragma unroll
        for (int i = 0; i < 4; ++i) ss += v[i][0] * v[i][0] + v[i][1] * v[i][1] + v[i][2] * v[i][2] + v[i][3] * v[i][3];
        ss = wave_sum(ss); const float rs = rsqrtf(ss * (1.f / 1024.f) + 1e-6f);
#pragma unroll
        for (int i = 0; i < 2; ++i) { const int c0 = lane * 8 + 512 * i; float o[8];
#pragma unroll
            for (int j = 0; j < 8; ++j) { const float xv = v[2 * i + (j >> 2)][j & 3]; o[j] = xv * rs * a.norm_mix[c0 + j] * (1.f + mb[1024 + c0 + j]) + mb[c0 + j]; }
            u32x4 w; w.x = pk2(o[0], o[1]); w.y = pk2(o[2], o[3]); w.z = pk2(o[4], o[5]); w.w = pk2(o[6], o[7]);
            *(u32x4*)(H + (size_t)row * DM + c0) = w; }
    }
}

struct EpiProj { static constexpr bool PERM = true; bf16_t* P; float* small;
    DI void operator()(const f32x4 (&acc)[2][2][4][2], const Unit& u, int wr, int wc, int fr, int fq) const {
        const int row0 = u.pm * 256 + wr * 64 + fr, col0 = u.pn * 256 + wc * 32 + 8 * fq;
#pragma unroll
        for (int ai = 0; ai < 2; ++ai)
#pragma unroll
            for (int m = 0; m < 4; ++m) { const int row = row0 + ai * 128 + m * 16; bf16_t* rowp = P + (size_t)row * NP + col0;
#pragma unroll
                for (int bj = 0; bj < 2; ++bj) { const f32x4 v0 = acc[ai][bj][m][0], v1 = acc[ai][bj][m][1];
                    u32x4 w; w.x = pk2(v0[0], v0[1]); w.y = pk2(v0[2], v0[3]); w.z = pk2(v1[0], v1[1]); w.w = pk2(v1[2], v1[3]);
                    *(u32x4*)(rowp + bj * 128) = w; }
                if (u.pn == 31 && wc == 0) { float* sp = small + (size_t)row * 32 + 8 * fq; *(f32x4*)sp = acc[ai][0][m][0]; *(f32x4*)(sp + 4) = acc[ai][0][m][1]; } }
    } };
struct EpiGate { static constexpr bool PERM = true; const bf16_t* P; const float* bmerge; bf16_t* G;
    DI void operator()(const f32x4 (&acc)[2][2][4][2], const Unit& u, int wr, int wc, int fr, int fq) const {
        const int row0 = u.pm * 256 + wr * 64 + fr, col0 = u.pn * 256 + wc * 32 + 8 * fq;
        f32x4 bv[2][2];
#pragma unroll
        for (int bj = 0; bj < 2; ++bj) { bv[bj][0] = *(const f32x4*)(bmerge + col0 + bj * 128); bv[bj][1] = *(const f32x4*)(bmerge + col0 + bj * 128 + 4); }
#pragma unroll
        for (int ai = 0; ai < 2; ++ai)
#pragma unroll
            for (int m = 0; m < 4; ++m) { const size_t row = row0 + ai * 128 + m * 16;
#pragma unroll
                for (int bj = 0; bj < 2; ++bj) { const u32x4 mr = *(const u32x4*)(P + row * NP + PC_MERGE + col0 + bj * 128); const f32x4 v0 = acc[ai][bj][m][0], v1 = acc[ai][bj][m][1];
                    float o[8];
                    o[0] = v0[0] * sigmoid_(bflo(mr.x) + bv[bj][0][0]); o[1] = v0[1] * sigmoid_(bfhi(mr.x) + bv[bj][0][1]); o[2] = v0[2] * sigmoid_(bflo(mr.y) + bv[bj][0][2]); o[3] = v0[3] * sigmoid_(bfhi(mr.y) + bv[bj][0][3]);
                    o[4] = v1[0] * sigmoid_(bflo(mr.z) + bv[bj][1][0]); o[5] = v1[1] * sigmoid_(bfhi(mr.z) + bv[bj][1][1]); o[6] = v1[2] * sigmoid_(bflo(mr.w) + bv[bj][1][2]); o[7] = v1[3] * sigmoid_(bfhi(mr.w) + bv[bj][1][3]);
                    u32x4 w; w.x = pk2(o[0], o[1]); w.y = pk2(o[2], o[3]); w.z = pk2(o[4], o[5]); w.w = pk2(o[6], o[7]);
                    *(u32x4*)(G + row * 3072 + col0 + bj * 128) = w; } }
    } };
struct EpiResid { static constexpr bool PERM = false; const float* xin; float* xout; const float* gm;
    DI void operator()(const f32x4 (&acc)[2][2][4][2], const Unit& u, int wr, int wc, int fr, int fq) const {
        const int row0 = u.pm * 256 + wr * 64 + fr, col0 = u.pn * 256 + wc * 32 + 4 * fq; const int b = (u.pm * 256) >> 12;
        f32x4 gv[2][2];
#pragma unroll
        for (int bj = 0; bj < 2; ++bj)
#pragma unroll
            for (int n = 0; n < 2; ++n) gv[bj][n] = *(const f32x4*)(gm + (size_t)b * 6144 + col0 + bj * 128 + n * 16);
#pragma unroll
        for (int ai = 0; ai < 2; ++ai)
#pragma unroll
            for (int m = 0; m < 4; ++m) { const size_t off = (size_t)(row0 + ai * 128 + m * 16) * DM + col0;
#pragma unroll
                for (int bj = 0; bj < 2; ++bj)
#pragma unroll
                    for (int n = 0; n < 2; ++n) { const f32x4 xi = *(const f32x4*)(xin + off + bj * 128 + n * 16); *(f32x4*)(xout + off + bj * 128 + n * 16) = xi + gv[bj][n] * acc[ai][bj][m][n]; } }
    } };
struct EpiSwiglu { static constexpr bool PERM = true; bf16_t* act; const float* bgu;
    DI void operator()(const f32x4 (&acc)[2][2][4][2], const Unit& u, int wr, int wc, int fr, int fq) const {
        const int row0 = u.pm * 256 + wr * 64 + fr, x0 = u.pn * 128 + wc * 32 + 8 * fq;
        const float* bb = bgu + (size_t)u.e * 2048 + 2 * x0;
        float bg[8], bu[8];
#pragma unroll
        for (int i = 0; i < 4; ++i) { const f32x4 t = *(const f32x4*)(bb + 4 * i); bg[2 * i] = t[0]; bu[2 * i] = t[1]; bg[2 * i + 1] = t[2]; bu[2 * i + 1] = t[3]; }
#pragma unroll
        for (int ai = 0; ai < 2; ++ai)
#pragma unroll
            for (int m = 0; m < 4; ++m) { const size_t row = row0 + ai * 128 + m * 16; float o[8];
#pragma unroll
                for (int j = 0; j < 8; ++j) { float g = acc[ai][0][m][j >> 2][j & 3] + bg[j], up = acc[ai][1][m][j >> 2][j & 3] + bu[j];
                    g = fminf(g, 7.f); up = fminf(fmaxf(up, -7.f), 7.f); o[j] = (up + 1.f) * g * sigmoid_(1.702f * g); }
                u32x4 w; w.x = pk2(o[0], o[1]); w.y = pk2(o[2], o[3]); w.z = pk2(o[4], o[5]); w.w = pk2(o[6], o[7]);
                *(u32x4*)(act + row * DM + x0) = w; }
    } };
struct EpiDown { static constexpr bool PERM = true; bf16_t* ys; const float* bdn;
    DI void operator()(const f32x4 (&acc)[2][2][4][2], const Unit& u, int wr, int wc, int fr, int fq) const {
        const int row0 = u.pm * 256 + wr * 64 + fr, col0 = u.pn * 256 + wc * 32 + 8 * fq;
        f32x4 bv[2][2];
#pragma unroll
        for (int bj = 0; bj < 2; ++bj) { bv[bj][0] = *(const f32x4*)(bdn + (size_t)u.e * DM + col0 + bj * 128); bv[bj][1] = *(const f32x4*)(bdn + (size_t)u.e * DM + col0 + bj * 128 + 4); }
#pragma unroll
        for (int ai = 0; ai < 2; ++ai)
#pragma unroll
            for (int m = 0; m < 4; ++m) { const size_t row = row0 + ai * 128 + m * 16;
#pragma unroll
                for (int bj = 0; bj < 2; ++bj) { const f32x4 v0 = acc[ai][bj][m][0] + bv[bj][0], v1 = acc[ai][bj][m][1] + bv[bj][1];
                    u32x4 w; w.x = pk2(v0[0], v0[1]); w.y = pk2(v0[2], v0[3]); w.z = pk2(v1[0], v1[1]); w.w = pk2(v1[2], v1[3]);
                    *(u32x4*)(ys + row * DM + col0 + bj * 128) = w; } }
    } };

DI void moe_tables(const int* cnt  , LAS unsigned char* lds) {
    LAS int* tstart = (LAS int*)(lds + LDS_CTRL + 64); LAS int* lcnt = (LAS int*)(lds + LDS_CTRL + 256);
    if (ltid() < 64) { const int t = ltid(); const int c = t < 32 ? cnt[t * 64] : 0; int v = (c + 255) >> 8;
#pragma unroll
        for (int o = 1; o < 32; o <<= 1) { const int y = __shfl_up(v, o); if ((t & 31) >= o) v += y; }
        if (t < 32) { tstart[t + 1] = v; lcnt[t] = c; } if (t == 0) tstart[0] = 0; }
    __syncthreads();
}
template <bool G_> struct MoeOrder {
    static constexpr bool GATHER = G_;
    int nN, G, c; const LAS int* tstart; const LAS int* lcnt; const char* A; const char* Bt; size_t b_estride, tstep; const int* rowtok;
    DI bool next(int i, Unit& u) const {
        const int L = i * G + c, rt = L / nN; if (rt >= tstart[32]) return false;
        int e = 0; while (tstart[e + 1] <= rt) ++e;
        u.pm = rt; u.pn = L % nN; u.e = e; const int rem = lcnt[e] - (rt - tstart[e]) * 256; u.cnt = rem < 256 ? rem : 256; return true; }
    DI const char* a_ptr(const Unit& u) const { return GATHER ? A : A + (size_t)u.pm * tstep; }
    DI const char* b_ptr(const Unit& u) const { return Bt + (size_t)u.e * b_estride + (size_t)u.pn * tstep; }
    DI int a_row(const Unit& u, int R) const { return R < u.cnt ? rowtok[u.e * 32768 + (u.pm - tstart[u.e]) * 256 + R] : 0; }
};
DI void phase_router(CArgs& a, int l, const float* xmid, LAS unsigned char* lds) {
    const int tid = ltid(), wid = tid >> 6, lane = tid & 63, r = lane & 15, q = lane >> 4;
    LAS bf16_t* Whi = (LAS bf16_t*)lds; LAS bf16_t* Wlo = (LAS bf16_t*)(lds + 66048);
    LAS float* scr = (LAS float*)(lds + 132096 + wid * 2112);
    LAS int* hist = (LAS int*)(lds + 148992); LAS int* basep = (LAS int*)(lds + 148992 + 128);
    const float* wr_ = a.w_router + (size_t)l * DM * NEXP;
    for (int i = tid; i < DM * NEXP; i += NTHREADS) { const int k = i >> 5, e = i & 31; const float v = wr_[i]; const bf16_t hi = f2bf(v); Whi[e * 1032 + k] = hi; Wlo[e * 1032 + k] = f2bf(v - bf2f(hi)); }
    __syncthreads();
    const float* mod = (const float*)(a.ws + WS_MOD) + (size_t)l * 8 * 6144;
    const float* nf = a.norm_ffn + l * DM;
    bf16_t* H = (bf16_t*)(a.ws + WS_H);
    int* cntg = (int*)(a.ws + WS_CNT) + l * 32 * 64;
    int* rowtok = (int*)(a.ws + WS_ROWTOK); int* tokslot = (int*)(a.ws + WS_TOKSLOT); float* gates = (float*)(a.ws + WS_GATES);
    for (int blk = lbid(); blk < NTOK / 128; blk += lgrid()) {
        if (tid < 32) hist[tid] = 0;
        const int row = blk * 128 + wid * 16 + r, b = row >> 12;
        const float* xr = xmid + (size_t)row * DM; const float* mb = mod + (size_t)b * 6144;
        float ss = 0.f;
        for (int ks = 0; ks < 32; ++ks) { const f32x4 x0 = *(const f32x4*)(xr + ks * 32 + 8 * q), x1 = *(const f32x4*)(xr + ks * 32 + 8 * q + 4);
            ss += x0[0] * x0[0] + x0[1] * x0[1] + x0[2] * x0[2] + x0[3] * x0[3] + x1[0] * x1[0] + x1[1] * x1[1] + x1[2] * x1[2] + x1[3] * x1[3]; }
        ss += __shfl_xor(ss, 16); ss += __shfl_xor(ss, 32);
        const float rs = rsqrtf(ss * (1.f / 1024.f) + 1e-6f);
        f32x4 acc0 = {0.f, 0.f, 0.f, 0.f}, acc1 = {0.f, 0.f, 0.f, 0.f};
        for (int ks = 0; ks < 32; ++ks) { const int k0 = ks * 32 + 8 * q;
            const f32x4 x0 = *(const f32x4*)(xr + k0), x1 = *(const f32x4*)(xr + k0 + 4);
            float hv[8];
#pragma unroll
            for (int j = 0; j < 8; ++j) { const float xv = j < 4 ? x0[j & 3] : x1[j & 3]; hv[j] = xv * rs * nf[k0 + j] * (1.f + mb[4096 + k0 + j]) + mb[3072 + k0 + j]; }
            u32x4 hi; hi.x = pk2(hv[0], hv[1]); hi.y = pk2(hv[2], hv[3]); hi.z = pk2(hv[4], hv[5]); hi.w = pk2(hv[6], hv[7]);
            *(u32x4*)(H + (size_t)row * DM + k0) = hi;
            u32x4 lo; lo.x = pk2(hv[0] - bflo(hi.x), hv[1] - bfhi(hi.x)); lo.y = pk2(hv[2] - bflo(hi.y), hv[3] - bfhi(hi.y)); lo.z = pk2(hv[4] - bflo(hi.z), hv[5] - bfhi(hi.z)); lo.w = pk2(hv[6] - bflo(hi.w), hv[7] - bfhi(hi.w));
            const bf16x8 ah = __builtin_bit_cast(bf16x8, hi), al = __builtin_bit_cast(bf16x8, lo);
            const bf16x8 b0h = *(const LAS bf16x8*)(Whi + r * 1032 + k0), b0l = *(const LAS bf16x8*)(Wlo + r * 1032 + k0);
            const bf16x8 b1h = *(const LAS bf16x8*)(Whi + (16 + r) * 1032 + k0), b1l = *(const LAS bf16x8*)(Wlo + (16 + r) * 1032 + k0);
            acc0 = __builtin_amdgcn_mfma_f32_16x16x32_bf16(ah, b0h, acc0, 0, 0, 0); acc0 = __builtin_amdgcn_mfma_f32_16x16x32_bf16(ah, b0l, acc0, 0, 0, 0); acc0 = __builtin_amdgcn_mfma_f32_16x16x32_bf16(al, b0h, acc0, 0, 0, 0);
            acc1 = __builtin_amdgcn_mfma_f32_16x16x32_bf16(ah, b1h, acc1, 0, 0, 0); acc1 = __builtin_amdgcn_mfma_f32_16x16x32_bf16(ah, b1l, acc1, 0, 0, 0); acc1 = __builtin_amdgcn_mfma_f32_16x16x32_bf16(al, b1h, acc1, 0, 0, 0); }
        const float br0 = a.b_router[l * 32 + r], br1 = a.b_router[l * 32 + 16 + r];
#pragma unroll
        for (int j = 0; j < 4; ++j) { scr[(4 * q + j) * 33 + r] = acc0[j] + br0; scr[(4 * q + j) * 33 + 16 + r] = acc1[j] + br1; }
        __syncthreads();
        int te[4] = {0, 0, 0, 0}; float tg[4] = {0.f, 0.f, 0.f, 0.f}; int rk[4] = {0, 0, 0, 0};
        if (lane < 16) {
            float v[32];
#pragma unroll
            for (int e = 0; e < 32; ++e) v[e] = scr[lane * 33 + e];
            float tv[4];
#pragma unroll
            for (int k = 0; k < 4; ++k) { float best = -3.0e38f; int bi = 0;
#pragma unroll
                for (int e = 0; e < 32; ++e) { if (v[e] > best) { best = v[e]; bi = e; } }
                tv[k] = best; te[k] = bi;
#pragma unroll
                for (int e = 0; e < 32; ++e) v[e] = (e == bi) ? -3.0e38f : v[e]; }
            const float e1 = __expf(tv[1] - tv[0]), e2 = __expf(tv[2] - tv[0]), e3 = __expf(tv[3] - tv[0]); const float inv = 1.f / (1.f + e1 + e2 + e3);
            tg[0] = inv; tg[1] = e1 * inv; tg[2] = e2 * inv; tg[3] = e3 * inv;
#pragma unroll
            for (int k = 0; k < 4; ++k) rk[k] = atomicAdd((int*)&hist[te[k]], 1);
        }
        __syncthreads();
        if (tid < 32) basep[tid] = atomicAdd(&cntg[tid * 64], hist[tid]);
        __syncthreads();
        if (lane < 16) { const int tok = blk * 128 + wid * 16 + lane;
#pragma unroll
            for (int k = 0; k < 4; ++k) { const int pos = basep[te[k]] + rk[k]; rowtok[te[k] * 32768 + pos] = tok; tokslot[tok * 4 + k] = te[k] * 32768 + pos; gates[tok * 4 + k] = tg[k]; } }
        __syncthreads();
    }
}

DI void phase_combine(CArgs& a, int l, const float* xmid, float* xnew, LAS unsigned char* lds) {
    const LAS int* tstart = (const LAS int*)(lds + LDS_CTRL + 64);
    const int lane = ltid() & 63, gw = lbid() * 8 + (ltid() >> 6), nw = lgrid() * 8;
    const float* mod = (const float*)(a.ws + WS_MOD);
    const bf16_t* YS = (const bf16_t*)(a.ws + WS_R1 + R1_YS);
    const int* tokslot = (const int*)(a.ws + WS_TOKSLOT); const float* gates = (const float*)(a.ws + WS_GATES);
    bf16_t* H = (bf16_t*)(a.ws + WS_H);
    for (int row = gw; row < NTOK; row += nw) {
        const int b = row >> 12; const float* mb = mod + ((size_t)l * 8 + b) * 6144;
        size_t pr[4]; float gt[4];
#pragma unroll
        for (int k = 0; k < 4; ++k) { const int s = tokslot[row * 4 + k]; pr[k] = (size_t)(tstart[s >> 15] * 256 + (s & 32767)); gt[k] = gates[row * 4 + k]; }
        float xn[16]; float ss = 0.f;
#pragma unroll
        for (int i = 0; i < 2; ++i) { const int c0 = lane * 8 + 512 * i; float f[8];
#pragma unroll
            for (int j = 0; j < 8; ++j) f[j] = 0.f;
#pragma unroll
            for (int k = 0; k < 4; ++k) { const u32x4 y = *(const u32x4*)(YS + pr[k] * DM + c0);
                f[0] += gt[k] * bflo(y.x); f[1] += gt[k] * bfhi(y.x); f[2] += gt[k] * bflo(y.y); f[3] += gt[k] * bfhi(y.y); f[4] += gt[k] * bflo(y.z); f[5] += gt[k] * bfhi(y.z); f[6] += gt[k] * bflo(y.w); f[7] += gt[k] * bfhi(y.w); }
            const f32x4 x0 = *(const f32x4*)(xmid + (size_t)row * DM + c0), x1 = *(const f32x4*)(xmid + (size_t)row * DM + c0 + 4);
#pragma unroll
            for (int j = 0; j < 8; ++j) { const float xv = (j < 4 ? x0[j & 3] : x1[j & 3]) + mb[5120 + c0 + j] * f[j]; xn[8 * i + j] = xv; ss += xv * xv; } }
        ss = wave_sum(ss); const float rs = rsqrtf(ss * (1.f / 1024.f) + 1e-6f);
        if (l == 0) {
            const float* mb2 = mod + ((size_t)8 + b) * 6144; const float* g = a.norm_mix + DM;
#pragma unroll
            for (int i = 0; i < 2; ++i) { const int c0 = lane * 8 + 512 * i;
                *(f32x4*)(xnew + (size_t)row * DM + c0) = (f32x4){xn[8 * i], xn[8 * i + 1], xn[8 * i + 2], xn[8 * i + 3]};
                *(f32x4*)(xnew + (size_t)row * DM + c0 + 4) = (f32x4){xn[8 * i + 4], xn[8 * i + 5], xn[8 * i + 6], xn[8 * i + 7]};
                float o[8];
#pragma unroll
                for (int j = 0; j < 8; ++j) o[j] = xn[8 * i + j] * rs * g[c0 + j] * (1.f + mb2[1024 + c0 + j]) + mb2[c0 + j];
                u32x4 w; w.x = pk2(o[0], o[1]); w.y = pk2(o[2], o[3]); w.z = pk2(o[4], o[5]); w.w = pk2(o[6], o[7]);
                *(u32x4*)(H + (size_t)row * DM + c0) = w; }
        } else {
#pragma unroll
            for (int i = 0; i < 2; ++i) { const int c0 = lane * 8 + 512 * i; float o[8];
#pragma unroll
                for (int j = 0; j < 8; ++j) o[j] = xn[8 * i + j] * rs * a.norm_final[c0 + j];
                *(f32x4*)(a.out + (size_t)row * DM + c0) = (f32x4){o[0], o[1], o[2], o[3]}; *(f32x4*)(a.out + (size_t)row * DM + c0 + 4) = (f32x4){o[4], o[5], o[6], o[7]}; }
        }
    }
}
DI float wave_incl_scan(float v, int lane) {
#pragma unroll
    for (int o = 1; o < 64; o <<= 1) { const float y = __shfl_up(v, o); if (lane >= o) v += y; }
    return v;
}
DI void conv8(const bf16_t* p, int pos, const float* w, int chs, const float* bias, float (&out)[8]) {
    float acc[8];
    if (bias) { const f32x4 b0 = *(const f32x4*)bias, b1 = *(const f32x4*)(bias + 4); acc[0] = b0[0]; acc[1] = b0[1]; acc[2] = b0[2]; acc[3] = b0[3]; acc[4] = b1[0]; acc[5] = b1[1]; acc[6] = b1[2]; acc[7] = b1[3]; }
    else {
#pragma unroll
        for (int i = 0; i < 8; ++i) acc[i] = 0.f; }
#pragma unroll
    for (int j = 0; j < 4; ++j) {
        if (pos - 3 + j >= 0) { const u32x4 xv = *(const u32x4*)(p - (ptrdiff_t)(3 - j) * NP); const f32x4 w0 = *(const f32x4*)(w + j * chs), w1 = *(const f32x4*)(w + j * chs + 4);
            acc[0] += w0[0] * bflo(xv.x); acc[1] += w0[1] * bfhi(xv.x); acc[2] += w0[2] * bflo(xv.y); acc[3] += w0[3] * bfhi(xv.y);
            acc[4] += w1[0] * bflo(xv.z); acc[5] += w1[1] * bfhi(xv.z); acc[6] += w1[2] * bflo(xv.w); acc[7] += w1[3] * bfhi(xv.w); } }
#pragma unroll
    for (int i = 0; i < 8; ++i) out[i] = silu_(acc[i]);
}
DI f32x4 mm16(const LAS bf16_t* A, int lda, int m0, const LAS bf16_t* Bt, int ldb, int n0, int K, int lane) {
    f32x4 acc = {0.f, 0.f, 0.f, 0.f}; const int r = lane & 15, q = lane >> 4;
    for (int k0 = 0; k0 < K; k0 += 32) { const bf16x8 av = *(const LAS bf16x8*)(A + (m0 + r) * lda + k0 + 8 * q), bv = *(const LAS bf16x8*)(Bt + (n0 + r) * ldb + k0 + 8 * q);
        acc = __builtin_amdgcn_mfma_f32_16x16x32_bf16(av, bv, acc, 0, 0, 0); }
    return acc;
}
DI void frag_store8(char* base, int nkb, int row, int k0, const float (&v)[8]) {
    const int rt = row >> 5, r = row & 31, kb = k0 >> 4, aa = (k0 >> 3) & 1;
    char* p = base + ((size_t)((rt * nkb + kb) * 64 + r)) * 16 + aa * 8;
    *(u32x2*)p = (u32x2){pk2(v[0], v[1]), pk2(v[2], v[3])};
    *(u32x2*)(p + 512) = (u32x2){pk2(v[4], v[5]), pk2(v[6], v[7])};
}
DI void export_frags(char* dst, const LAS bf16_t* M, int ld, int R, int KK, int coloff) {
    const int nkb = KK >> 4, pieces = (R >> 5) * nkb * 64;
    for (int p = ltid(); p < pieces; p += NTHREADS) { const int lane = p & 63, f = p >> 6, kb = f % nkb, rt = f / nkb, r = lane & 31, h = lane >> 5;
        const LAS bf16_t* s = M + (rt * 32 + r) * ld + coloff + kb * 16 + 4 * h;
        const u32x2 lo = *(const LAS u32x2*)s, hi = *(const LAS u32x2*)(s + 8);
        *(u32x4*)(dst + (size_t)p * 16) = (u32x4){lo.x, lo.y, hi.x, hi.y}; }
}
DI void export_acc(char* dst, const LAS bf16_t* M, int ld, int nct) {
    const int pieces = nct * 2 * 64;
    for (int p = ltid(); p < pieces; p += NTHREADS) { const int lane = p & 63, tile = p >> 6, rt = tile & 1, ct = tile >> 1, r = lane & 31, h = lane >> 5;
        unsigned w[8];
#pragma unroll
        for (int i = 0; i < 8; ++i) { const int r0 = rt * 32 + ((2 * i) & 3) + 8 * ((2 * i) >> 2) + 4 * h;
            w[i] = (unsigned)M[r0 * ld + ct * 32 + r] | ((unsigned)M[(r0 + 1) * ld + ct * 32 + r] << 16); }
        *(u32x4*)(dst + (size_t)p * 32) = (u32x4){w[0], w[1], w[2], w[3]}; *(u32x4*)(dst + (size_t)p * 32 + 16) = (u32x4){w[4], w[5], w[6], w[7]}; }
}

DI void prep_gla(CArgs& a, int l, int u, LAS unsigned char* lds) {
    const int tid = ltid(), wid = tid >> 6, lane = tid & 63;
    const int n = u & 63, bh = u >> 6, b = bh >> 2, h = bh & 3, T0 = b * SEQ + n * 64;
    LAS float* G = (LAS float*)lds; LAS bf16_t* QD = (LAS bf16_t*)(lds + 16640); LAS bf16_t* KI = (LAS bf16_t*)(lds + 25856); LAS bf16_t* KT = (LAS bf16_t*)(lds + 35072);
    LAS bf16_t* PB = (LAS bf16_t*)(lds + 44288); LAS bf16_t* V = (LAS bf16_t*)(lds + 53504);
    const bf16_t* P = (const bf16_t*)(a.ws + WS_R1 + R1_PROJ); const float* small = (const float*)(a.ws + WS_SMALL);
    char* ub = a.ws + WS_R1 + R1_SGLA + (size_t)u * GLA_UNIT;
    const int l_ = tid >> 3, d0 = (tid & 7) * 8; const size_t T = (size_t)(T0 + l_);
    { float lr[16];
#pragma unroll
      for (int i = 0; i < 4; ++i) { const f32x4 t = *(const f32x4*)(small + T * 32 + 4 * i); lr[4 * i] = t[0]; lr[4 * i + 1] = t[1]; lr[4 * i + 2] = t[2]; lr[4 * i + 3] = t[3]; }
      const float* w2 = a.gla_w2 + (size_t)l * 16 * 256 + h * 64 + d0; const float* b2 = a.gla_b2 + l * 256 + h * 64 + d0;
      float s[8];
#pragma unroll
      for (int i = 0; i < 8; ++i) s[i] = b2[i];
#pragma unroll
      for (int j = 0; j < 16; ++j) { const f32x4 w0 = *(const f32x4*)(w2 + j * 256), w1 = *(const f32x4*)(w2 + j * 256 + 4);
          s[0] += lr[j] * w0[0]; s[1] += lr[j] * w0[1]; s[2] += lr[j] * w0[2]; s[3] += lr[j] * w0[3]; s[4] += lr[j] * w1[0]; s[5] += lr[j] * w1[1]; s[6] += lr[j] * w1[2]; s[7] += lr[j] * w1[3]; }
#pragma unroll
      for (int i = 0; i < 8; ++i) G[l_ * 65 + d0 + i] = -softplus_(-s[i]) * (1.f / 16.f); }
    __syncthreads();
    if (tid < 64) { float run = 0.f; for (int i = 0; i < 64; ++i) { run += G[i * 65 + tid]; G[i * 65 + tid] = run; } }
    __syncthreads();
    { const u32x4 q8 = *(const u32x4*)(P + T * NP + PC_GLA_Q + h * 64 + d0), k8 = *(const u32x4*)(P + T * NP + PC_GLA_K + h * 64 + d0);
      const float qf[8] = {bflo(q8.x), bfhi(q8.x), bflo(q8.y), bfhi(q8.y), bflo(q8.z), bfhi(q8.z), bflo(q8.w), bfhi(q8.w)};
      const float kf[8] = {bflo(k8.x), bfhi(k8.x), bflo(k8.y), bfhi(k8.y), bflo(k8.z), bfhi(k8.z), bflo(k8.w), bfhi(k8.w)};
      float qd[8], ki[8];
#pragma unroll
      for (int i = 0; i < 8; ++i) { const float bc = G[l_ * 65 + d0 + i], bl = G[63 * 65 + d0 + i]; qd[i] = qf[i] * 0.125f * __expf(bc); ki[i] = kf[i] * __expf(-bc);
          KT[(d0 + i) * 72 + l_] = f2bf(kf[i] * __expf(bl - bc)); }
      *(LAS u32x4*)(QD + l_ * 72 + d0) = (u32x4){pk2(qd[0], qd[1]), pk2(qd[2], qd[3]), pk2(qd[4], qd[5]), pk2(qd[6], qd[7])};
      *(LAS u32x4*)(KI + l_ * 72 + d0) = (u32x4){pk2(ki[0], ki[1]), pk2(ki[2], ki[3]), pk2(ki[4], ki[5]), pk2(ki[6], ki[7])};
      frag_store8(ub + GLA_OQ, 4, l_, d0, qd); }
    if (tid < 64) ((float*)(ub + GLA_OD))[tid] = __expf(G[63 * 65 + tid]);
#pragma unroll
    for (int rep = 0; rep < 2; ++rep) { const int idx = rep * NTHREADS + tid, lr_ = idx >> 4, c0 = (idx & 15) * 8;
        *(LAS u32x4*)(V + lr_ * 136 + c0) = *(const u32x4*)(P + (size_t)(T0 + lr_) * NP + PC_GLA_V + h * 128 + c0); }
    __syncthreads();
#pragma unroll
    for (int t2 = 0; t2 < 2; ++t2) { const int t = wid * 2 + t2, mt = t >> 2, nt = t & 3; const f32x4 acc = mm16(QD, 72, mt * 16, KI, 72, nt * 16, 64, lane);
        const int r = lane & 15, q = lane >> 4, m = nt * 16 + r;
#pragma unroll
        for (int j = 0; j < 4; ++j) { const int lrow = mt * 16 + 4 * q + j; PB[lrow * 72 + m] = f2bf(m <= lrow ? acc[j] : 0.f); } }
    __syncthreads();
    export_frags(ub + GLA_OP, PB, 72, 64, 64, 0);
    export_frags(ub + GLA_OK, KT, 72, 64, 64, 0);
    export_acc(ub + GLA_OU, V, 136, 4);
    __syncthreads();
}

DI void prep_ssd(CArgs& a, int l, int u, LAS unsigned char* lds) {
    const int tid = ltid(), wid = tid >> 6, lane = tid & 63;
    const int n = u & 63, bh = u >> 6, b = bh >> 3, hh = bh & 7, g = hh >> 2, T0 = b * SEQ + n * 64;
    LAS bf16_t* CC = (LAS bf16_t*)lds; LAS bf16_t* CBm = (LAS bf16_t*)(lds + 9216); LAS bf16_t* KT = (LAS bf16_t*)(lds + 18432); LAS bf16_t* PB = (LAS bf16_t*)(lds + 27648);
    LAS bf16_t* V = (LAS bf16_t*)(lds + 36864); LAS float* SDT = (LAS float*)(lds + 46080); LAS float* SCUM = (LAS float*)(lds + 46080 + 256);
    const bf16_t* P = (const bf16_t*)(a.ws + WS_R1 + R1_PROJ); const float* small = (const float*)(a.ws + WS_SMALL);
    char* ub = a.ws + WS_R1 + R1_SSSD + (size_t)u * SSD_UNIT;
    if (tid < 64) { const float dt = softplus_(small[(size_t)(T0 + tid) * 32 + 24 + hh] + a.ssd_dt_bias[l * 8 + hh]); const float aa = -__expf(a.ssd_a_log[l * 8 + hh]);
        const float cum = wave_incl_scan(dt * aa, lane); SDT[tid] = dt; SCUM[tid] = cum; }
    __syncthreads();
    { const int l_ = tid >> 3, c8 = (tid & 7) * 8; const size_t T = (size_t)(T0 + l_); const int pos = n * 64 + l_;
      const float cl = SCUM[l_], c63 = SCUM[63], dtl = SDT[l_];
      const float* cw = a.ssd_conv_w + (size_t)l * 4 * 768; const float* cb = a.ssd_conv_b + l * 768;
      float v[8];
      { const int c = hh * 64 + c8; conv8(P + T * NP + PC_SSD_XBC + c, pos, cw + c, 768, cb + c, v);
        *(LAS u32x4*)(V + l_ * 72 + c8) = (u32x4){pk2(v[0] * dtl, v[1] * dtl), pk2(v[2] * dtl, v[3] * dtl), pk2(v[4] * dtl, v[5] * dtl), pk2(v[6] * dtl, v[7] * dtl)}; }
      { const int c = 512 + g * 64 + c8; conv8(P + T * NP + PC_SSD_XBC + c, pos, cw + c, 768, cb + c, v);
        *(LAS u32x4*)(CBm + l_ * 72 + c8) = (u32x4){pk2(v[0], v[1]), pk2(v[2], v[3]), pk2(v[4], v[5]), pk2(v[6], v[7])};
        const float ek = __expf(c63 - cl);
#pragma unroll
        for (int i = 0; i < 8; ++i) KT[(c8 + i) * 72 + l_] = f2bf(v[i] * ek); }
      { const int c = 640 + g * 64 + c8; conv8(P + T * NP + PC_SSD_XBC + c, pos, cw + c, 768, cb + c, v);
        *(LAS u32x4*)(CC + l_ * 72 + c8) = (u32x4){pk2(v[0], v[1]), pk2(v[2], v[3]), pk2(v[4], v[5]), pk2(v[6], v[7])};
        const float eq = __expf(cl); float qd[8];
#pragma unroll
        for (int i = 0; i < 8; ++i) qd[i] = v[i] * eq;
        frag_store8(ub + SSD_OQ, 4, l_, c8, qd); } }
    if (tid < 64) ((float*)(ub + SSD_OD))[tid] = __expf(SCUM[63]);
    __syncthreads();
#pragma unroll
    for (int t2 = 0; t2 < 2; ++t2) { const int t = wid * 2 + t2, mt = t >> 2, nt = t & 3; const f32x4 acc = mm16(CC, 72, mt * 16, CBm, 72, nt * 16, 64, lane);
        const int r = lane & 15, q = lane >> 4, m = nt * 16 + r; const float cm = SCUM[m];
#pragma unroll
        for (int j = 0; j < 4; ++j) { const int lrow = mt * 16 + 4 * q + j; PB[lrow * 72 + m] = f2bf(m <= lrow ? acc[j] * __expf(SCUM[lrow] - cm) : 0.f); } }
    __syncthreads();
    export_frags(ub + SSD_OP, PB, 72, 64, 64, 0);
    export_frags(ub + SSD_OK, KT, 72, 64, 64, 0);
    export_acc(ub + SSD_OU, V, 72, 2);
    __syncthreads();
}

DI void gdn_scalars(CArgs& a, int l, int h, int T0, LAS float* SB, LAS float* SC) {
    const int tid = ltid();
    if (tid < 64) { const float* small = (const float*)(a.ws + WS_SMALL) + (size_t)(T0 + tid) * 32;
        const float beta = sigmoid_(small[20 + h]); const float gg = -__expf(a.gdn_a_log[l * 4 + h]) * softplus_(small[16 + h] + a.gdn_dt_bias[l * 4 + h]);
        const float cum = wave_incl_scan(gg, tid); SB[tid] = beta; SC[tid] = cum; }
}
DI void gdn_conv_item(CArgs& a, int l, int part, int h, int T0, int n, int l_, int grp, float (&v)[8]) {
    const int c = part * 512 + h * 128 + grp * 8;
    const bf16_t* P = (const bf16_t*)(a.ws + WS_R1 + R1_PROJ);
    conv8(P + (size_t)(T0 + l_) * NP + PC_GDN_QKV + c, n * 64 + l_, a.gdn_conv_w + (size_t)l * 4 * 1536 + c, 1536, nullptr, v);
    if (part < 2) { float ss = 0.f;
#pragma unroll
        for (int i = 0; i < 8; ++i) ss += v[i] * v[i];
        ss += __shfl_xor(ss, 1); ss += __shfl_xor(ss, 2); ss += __shfl_xor(ss, 4); ss += __shfl_xor(ss, 8);
        const float rn = rsqrtf(ss + 1e-6f) * (part == 0 ? 0.08838834764831845f : 1.f);
#pragma unroll
        for (int i = 0; i < 8; ++i) v[i] *= rn; }
}
DI void gdn_prep1(CArgs& a, int l, int u, LAS unsigned char* lds, LAS float* slot) {
    const int tid = ltid(), wid = tid >> 6, lane = tid & 63;
    const int n = u & 63, bh = u >> 6, b = bh >> 2, h = bh & 3, T0 = b * SEQ + n * 64;
    LAS bf16_t* Kb = (LAS bf16_t*)lds; LAS float* SB = (LAS float*)(lds + 17408); LAS float* SC = (LAS float*)(lds + 17408 + 256);
    gdn_scalars(a, l, h, T0, SB, SC);
#pragma unroll
    for (int rep = 0; rep < 2; ++rep) { const int idx = rep * NTHREADS + tid, l_ = idx >> 4, grp = idx & 15; float v[8]; gdn_conv_item(a, l, 1, h, T0, n, l_, grp, v);
        *(LAS u32x4*)(Kb + l_ * 136 + grp * 8) = (u32x4){pk2(v[0], v[1]), pk2(v[2], v[3]), pk2(v[4], v[5]), pk2(v[6], v[7])}; }
    __syncthreads();
#pragma unroll
    for (int t2 = 0; t2 < 2; ++t2) { const int t = wid * 2 + t2, mt = t >> 2, nt = t & 3; const f32x4 acc = mm16(Kb, 136, mt * 16, Kb, 136, nt * 16, 128, lane);
        const int r = lane & 15, q = lane >> 4, m = nt * 16 + r; const float cm = SC[m];
#pragma unroll
        for (int j = 0; j < 4; ++j) { const int lrow = mt * 16 + 4 * q + j; slot[lrow * 65 + m] = (m < lrow) ? SB[lrow] * acc[j] * __expf(SC[lrow] - cm) : 0.f; } }
    __syncthreads();
}
DI void gdn_invert(LAS float* sl, bf16_t* tout, int lane) {
    for (int lrow = 0; lrow < 64; ++lrow) {
        const float arow = sl[lrow * 65 + lane]; float acc = (lane == lrow) ? 1.f : 0.f;
        for (int m = 0; m < lrow; ++m) { const float s = __uint_as_float((unsigned)__builtin_amdgcn_readlane((int)__float_as_uint(arow), m)); acc -= s * sl[m * 65 + lane]; }
        sl[lrow * 65 + lane] = acc;
    }
#pragma unroll 4
    for (int it = 0; it < 32; ++it) { const int rowi = it * 2 + (lane >> 5), cj = (lane & 31) * 2; ((unsigned*)tout)[rowi * 32 + (lane & 31)] = pk2(sl[rowi * 65 + cj], sl[rowi * 65 + cj + 1]); }
}
DI void gdn_prep2(CArgs& a, int l, int u, LAS unsigned char* lds) {
    const int tid = ltid(), wid = tid >> 6, lane = tid & 63;
    const int n = u & 63, bh = u >> 6, b = bh >> 2, h = bh & 3, T0 = b * SEQ + n * 64;
    LAS bf16_t* Kb = (LAS bf16_t*)lds; LAS bf16_t* Qb = (LAS bf16_t*)(lds + 17408); LAS bf16_t* SOL = (LAS bf16_t*)lds;
    LAS bf16_t* RT = (LAS bf16_t*)(lds + 34816); LAS bf16_t* KT = (LAS bf16_t*)(lds + 71680); LAS bf16_t* Tb = (LAS bf16_t*)(lds + 90112); LAS bf16_t* PB = (LAS bf16_t*)(lds + 99328);
    LAS float* SB = (LAS float*)(lds + 108544); LAS float* SC = (LAS float*)(lds + 108544 + 256);
    char* ub = a.ws + WS_R1 + R1_SGDN + (size_t)u * GDN_UNIT;
    gdn_scalars(a, l, h, T0, SB, SC);
    __syncthreads();
#pragma unroll
    for (int rep = 0; rep < 2; ++rep) { const int idx = rep * NTHREADS + tid, l_ = idx >> 4, grp = idx & 15; const float cl = SC[l_], c63 = SC[63], be = SB[l_]; float v[8];
        gdn_conv_item(a, l, 0, h, T0, n, l_, grp, v);
        *(LAS u32x4*)(Qb + l_ * 136 + grp * 8) = (u32x4){pk2(v[0], v[1]), pk2(v[2], v[3]), pk2(v[4], v[5]), pk2(v[6], v[7])};
        { const float eq = __expf(cl); float qd[8];
#pragma unroll
          for (int i = 0; i < 8; ++i) qd[i] = v[i] * eq;
          frag_store8(ub + GDN_OQ, 8, l_, grp * 8, qd); }
        gdn_conv_item(a, l, 1, h, T0, n, l_, grp, v);
        *(LAS u32x4*)(Kb + l_ * 136 + grp * 8) = (u32x4){pk2(v[0], v[1]), pk2(v[2], v[3]), pk2(v[4], v[5]), pk2(v[6], v[7])};
        { const float e1 = be * __expf(cl), e2 = __expf(c63 - cl);
#pragma unroll
          for (int i = 0; i < 8; ++i) { RT[(128 + grp * 8 + i) * 72 + l_] = f2bf(v[i] * e1); KT[(grp * 8 + i) * 72 + l_] = f2bf(v[i] * e2); } }
        gdn_conv_item(a, l, 2, h, T0, n, l_, grp, v);
#pragma unroll
        for (int i = 0; i < 8; ++i) RT[(grp * 8 + i) * 72 + l_] = f2bf(v[i] * be); }
    { const bf16_t* tsrc = (const bf16_t*)(a.ws + WS_TSCR) + (size_t)u * 4096; const int row = tid >> 3, c0 = (tid & 7) * 8;
      *(LAS u32x4*)(Tb + row * 72 + c0) = *(const u32x4*)(tsrc + row * 64 + c0); }
    if (tid < 128) ((float*)(ub + GDN_OD))[tid] = __expf(SC[63]);
    __syncthreads();
#pragma unroll
    for (int t2 = 0; t2 < 2; ++t2) { const int t = wid * 2 + t2, mt = t >> 2, nt = t & 3; const f32x4 acc = mm16(Qb, 136, mt * 16, Kb, 136, nt * 16, 128, lane);
        const int r = lane & 15, q = lane >> 4, m = nt * 16 + r; const float cm = SC[m];
#pragma unroll
        for (int j = 0; j < 4; ++j) { const int lrow = mt * 16 + 4 * q + j; PB[lrow * 72 + m] = f2bf(m <= lrow ? acc[j] * __expf(SC[lrow] - cm) : 0.f); } }
    f32x4 sacc[8];
#pragma unroll
    for (int t2 = 0; t2 < 8; ++t2) { const int t = wid * 8 + t2, mt = t & 3, ntile = t >> 2; sacc[t2] = mm16(Tb, 72, mt * 16, RT, 72, ntile * 16, 64, lane); }
    __syncthreads();
#pragma unroll
    for (int t2 = 0; t2 < 8; ++t2) { const int t = wid * 8 + t2, mt = t & 3, ntile = t >> 2; const int r = lane & 15, q = lane >> 4, cc = ntile * 16 + r; const float sg = cc < 128 ? 1.f : -1.f;
#pragma unroll
        for (int j = 0; j < 4; ++j) SOL[(mt * 16 + 4 * q + j) * 264 + cc] = f2bf(sacc[t2][j] * sg); }
    __syncthreads();
    export_frags(ub + GDN_OP, PB, 72, 64, 64, 0);
    export_frags(ub + GDN_OK, KT, 72, 128, 64, 0);
    export_frags(ub + GDN_OW, SOL, 264, 64, 128, 128);
    export_acc(ub + GDN_OU, SOL, 264, 4);
    __syncthreads();
}
DI void phase_prep(CArgs& a, int l, LAS unsigned char* lds) {
    const int wid = ltid() >> 6, lane = ltid() & 63;
    LAS float* slots = (LAS float*)(lds + 20480);
    for (int u0 = lbid(); u0 < 2048; u0 += 8 * lgrid()) {
        int nb = 0;
        for (int j = 0; j < 8; ++j) { const int u = u0 + j * lgrid(); if (u < 2048) { gdn_prep1(a, l, u, lds, slots + j * 4160); nb = j + 1; } }
        if (wid < nb) gdn_invert(slots + wid * 4160, (bf16_t*)(a.ws + WS_TSCR) + (size_t)(u0 + wid * lgrid()) * 4096, lane);
        asm volatile("s_waitcnt vmcnt(0)" ::: "memory");
        __syncthreads();
        for (int j = 0; j < nb; ++j) gdn_prep2(a, l, u0 + j * lgrid(), lds);
    }
    for (int u = lbid(); u < 2048; u += lgrid()) prep_gla(a, l, u, lds);
    for (int u = lbid(); u < 4096; u += lgrid()) prep_ssd(a, l, u, lds);
}
DI bf16x8 pack16(const f32x16& x, int s) {
    u32x4 p; p.x = pk2(x[8 * s], x[8 * s + 1]); p.y = pk2(x[8 * s + 2], x[8 * s + 3]); p.z = pk2(x[8 * s + 4], x[8 * s + 5]); p.w = pk2(x[8 * s + 6], x[8 * s + 7]);
    return __builtin_bit_cast(bf16x8, p);
}
#define MFMA32(a, b, c) __builtin_amdgcn_mfma_f32_32x32x16_bf16((a), (b), (c), 0, 0, 0)
template <int DK, bool HAS_W, int NH, int NCT, int UNIT, int OQ, int OW, int OP, int OK, int OU, int OD>
DI void scan_wg(const char* ops0, const char* ops1, char* ob0, char* ob1, LAS unsigned char* lds) {
    constexpr int NKB = DK / 16, NDT = DK / 32, BUF = NH * UNIT, OUNIT = NCT * 2 * 2048;
    static_assert(2 * BUF <= LDS_CTRL, "scan LDS");
    const int tid = ltid(), wid = __builtin_amdgcn_readfirstlane(tid >> 6), lane = tid & 63, h = lane >> 5;
    const int hd = (NH == 2) ? (wid >> 1) & 1 : 0, ct = (NH == 2) ? (wid & 1) : (wid & 3);
    auto load_step = [&](int n, int buf) {
        const int lt = tid - 256;
#pragma unroll
        for (int k = 0; k < NH; ++k) { const char* src = (k == 0 ? ops0 : ops1) + (size_t)n * UNIT; LAS unsigned char* dst = lds + buf * BUF + k * UNIT;
            for (int i = lt; i < UNIT / 16; i += 256) *(LAS u32x4*)(dst + i * 16) = *(const u32x4*)(src + (size_t)i * 16); }
    };
    f32x16 S[NDT]; bf16x8 Sb[NKB];
#pragma unroll
    for (int d = 0; d < NDT; ++d)
#pragma unroll
        for (int i = 0; i < 16; ++i) S[d][i] = 0.f;
#pragma unroll
    for (int k = 0; k < NKB; ++k) Sb[k] = (bf16x8){0, 0, 0, 0, 0, 0, 0, 0};
    if (wid >= 4) load_step(0, 0);
    __syncthreads();
    char* ob = (hd == 0 ? ob0 : ob1);
    for (int n = 0; n < 64; ++n) {
        if (wid >= 4) { if (n + 1 < 64) load_step(n + 1, (n + 1) & 1); }
        else {
            const LAS unsigned char* lb = lds + (n & 1) * BUF + hd * UNIT;
            f32x16 U[2];
#pragma unroll
            for (int rt = 0; rt < 2; ++rt) { const LAS unsigned char* up = lb + OU + ((ct * 2 + rt) * 64 + lane) * 32; const u32x4 w0 = *(const LAS u32x4*)up, w1 = *(const LAS u32x4*)(up + 16);
                U[rt][0] = bflo(w0.x); U[rt][1] = bfhi(w0.x); U[rt][2] = bflo(w0.y); U[rt][3] = bfhi(w0.y); U[rt][4] = bflo(w0.z); U[rt][5] = bfhi(w0.z); U[rt][6] = bflo(w0.w); U[rt][7] = bfhi(w0.w);
                U[rt][8] = bflo(w1.x); U[rt][9] = bfhi(w1.x); U[rt][10] = bflo(w1.y); U[rt][11] = bfhi(w1.y); U[rt][12] = bflo(w1.z); U[rt][13] = bfhi(w1.z); U[rt][14] = bflo(w1.w); U[rt][15] = bfhi(w1.w); }
            if constexpr (HAS_W) {
#pragma unroll
                for (int rt = 0; rt < 2; ++rt)
#pragma unroll
                    for (int kb = 0; kb < NKB; ++kb) U[rt] = MFMA32(*(const LAS bf16x8*)(lb + OW + ((rt * NKB + kb) * 64 + lane) * 16), Sb[kb], U[rt]);
            }
            bf16x8 Ub[4];
            Ub[0] = pack16(U[0], 0); Ub[1] = pack16(U[0], 1); Ub[2] = pack16(U[1], 0); Ub[3] = pack16(U[1], 1);
#pragma unroll
            for (int rt = 0; rt < 2; ++rt) { f32x16 O;
#pragma unroll
                for (int i = 0; i < 16; ++i) O[i] = 0.f;
#pragma unroll
                for (int kb = 0; kb < NKB; ++kb) O = MFMA32(*(const LAS bf16x8*)(lb + OQ + ((rt * NKB + kb) * 64 + lane) * 16), Sb[kb], O);
#pragma unroll
                for (int kb = 0; kb < 4; ++kb) O = MFMA32(*(const LAS bf16x8*)(lb + OP + ((rt * 4 + kb) * 64 + lane) * 16), Ub[kb], O);
                char* op = ob + (size_t)n * OUNIT + ((ct * 2 + rt) * 64 + lane) * 32;
                *(u32x4*)op = (u32x4){pk2(O[0], O[1]), pk2(O[2], O[3]), pk2(O[4], O[5]), pk2(O[6], O[7])};
                *(u32x4*)(op + 16) = (u32x4){pk2(O[8], O[9]), pk2(O[10], O[11]), pk2(O[12], O[13]), pk2(O[14], O[15])}; }
#pragma unroll
            for (int d = 0; d < NDT; ++d) {
#pragma unroll
                for (int g = 0; g < 4; ++g) { const f32x4 dv = *(const LAS f32x4*)(lb + OD + (d * 32 + 8 * g + 4 * h) * 4);
                    S[d][4 * g] *= dv[0]; S[d][4 * g + 1] *= dv[1]; S[d][4 * g + 2] *= dv[2]; S[d][4 * g + 3] *= dv[3]; }
#pragma unroll
                for (int kb = 0; kb < 4; ++kb) S[d] = MFMA32(*(const LAS bf16x8*)(lb + OK + ((d * 4 + kb) * 64 + lane) * 16), Ub[kb], S[d]);
                Sb[2 * d] = pack16(S[d], 0); Sb[2 * d + 1] = pack16(S[d], 1); }
        }
        __syncthreads();
    }
}
DI void phase_scan(CArgs& a, LAS unsigned char* lds) {
    char* r1 = a.ws + WS_R1; char* obuf = r1 + R1_OBUF;
    for (int it = lbid(); it < 96; it += lgrid()) {
        if (it < 32) { const char* ops = r1 + R1_SGDN + (size_t)it * 64 * GDN_UNIT; char* ob = obuf + OB_GDN + (size_t)it * 64 * 16384;
            scan_wg<128, true, 1, 4, GDN_UNIT, GDN_OQ, GDN_OW, GDN_OP, GDN_OK, GDN_OU, GDN_OD>(ops, ops, ob, ob, lds); }
        else if (it < 64) { const int i2 = it - 32; const char* ops = r1 + R1_SGLA + (size_t)i2 * 64 * GLA_UNIT; char* ob = obuf + OB_GLA + (size_t)i2 * 64 * 16384;
            scan_wg<64, false, 1, 4, GLA_UNIT, GLA_OQ, 0, GLA_OP, GLA_OK, GLA_OU, GLA_OD>(ops, ops, ob, ob, lds); }
        else { const int i2 = (it - 64) * 2; const char* ops = r1 + R1_SSSD + (size_t)i2 * 64 * SSD_UNIT; char* ob = obuf + OB_SSD + (size_t)i2 * 64 * 8192;
            scan_wg<64, false, 2, 2, SSD_UNIT, SSD_OQ, 0, SSD_OP, SSD_OK, SSD_OU, SSD_OD>(ops, ops + (size_t)64 * SSD_UNIT, ob, ob + (size_t)64 * 8192, lds); }
    }
}

DI float otile_ld(const LAS unsigned char* tl, int l_, int e) {
    const int ct = e >> 5, r = e & 31, rt = l_ >> 5, lr = l_ & 31, h = (lr >> 2) & 1, i = (lr & 3) + 4 * (lr >> 3);
    return bf2f(*(const LAS bf16_t*)(tl + ((ct * 2 + rt) * 64 + h * 32 + r) * 32 + i * 2));
}
DI void phase_post(CArgs& a, int l, LAS unsigned char* lds) {
    const int tid = ltid(); char* r1 = a.ws + WS_R1; const bf16_t* P = (const bf16_t*)(r1 + R1_PROJ); const char* obuf = r1 + R1_OBUF; bf16_t* Y = (bf16_t*)(r1 + R1_YMIX);
    const int l_ = tid >> 3, sub = tid & 7;
    for (int u = lbid(); u < 5120; u += lgrid()) {
        if (u < 4096) {
            const int ty = u >> 11, uu = u & 2047, n = uu & 63, bh = uu >> 6, b = bh >> 2, h = bh & 3; const size_t T = (size_t)b * SEQ + n * 64 + l_;
            const char* src = obuf + (ty ? OB_GDN : OB_GLA) + (size_t)uu * 16384;
#pragma unroll
            for (int rep = 0; rep < 2; ++rep) { const int i = rep * NTHREADS + tid; *(LAS u32x4*)(lds + i * 16) = *(const u32x4*)(src + (size_t)i * 16); }
            __syncthreads();
            float o[16]; float ss = 0.f;
#pragma unroll
            for (int j = 0; j < 16; ++j) { o[j] = otile_ld(lds, l_, sub * 16 + j); ss += o[j] * o[j]; }
            ss += __shfl_xor(ss, 1); ss += __shfl_xor(ss, 2); ss += __shfl_xor(ss, 4);
            const float rs = rsqrtf(ss * (1.f / 128.f) + 1e-6f);
            const float* ng = (ty ? a.gdn_norm : a.gla_norm) + l * 128 + sub * 16;
            const bf16_t* gp = P + T * NP + (ty ? PC_GDN_G : PC_GLA_R) + h * 128 + sub * 16;
            const u32x4 g0 = *(const u32x4*)gp, g1 = *(const u32x4*)(gp + 8);
            const float gv[16] = {bflo(g0.x), bfhi(g0.x), bflo(g0.y), bfhi(g0.y), bflo(g0.z), bfhi(g0.z), bflo(g0.w), bfhi(g0.w), bflo(g1.x), bfhi(g1.x), bflo(g1.y), bfhi(g1.y), bflo(g1.z), bfhi(g1.z), bflo(g1.w), bfhi(g1.w)};
            float y[16];
#pragma unroll
            for (int j = 0; j < 16; ++j) y[j] = o[j] * rs * ng[j] * silu_(gv[j]);
            bf16_t* yp = Y + ((size_t)ty * NTOK + T) * 512 + h * 128 + sub * 16;
            *(u32x4*)yp = (u32x4){pk2(y[0], y[1]), pk2(y[2], y[3]), pk2(y[4], y[5]), pk2(y[6], y[7])};
            *(u32x4*)(yp + 8) = (u32x4){pk2(y[8], y[9]), pk2(y[10], y[11]), pk2(y[12], y[13]), pk2(y[14], y[15])};
            __syncthreads();
        } else {
            const int uu = u - 4096, n = uu & 63, bg = uu >> 6, b = bg >> 1, g = bg & 1; const size_t T = (size_t)b * SEQ + n * 64 + l_;
#pragma unroll
            for (int rep = 0; rep < 4; ++rep) { const int i = rep * NTHREADS + tid, hq = i >> 9, ii = i & 511;
                *(LAS u32x4*)(lds + i * 16) = *(const u32x4*)(obuf + OB_SSD + ((size_t)((b * 8 + g * 4 + hq) * 64 + n)) * 8192 + (size_t)ii * 16); }
            __syncthreads();
            const int hq = sub >> 1, hh = g * 4 + hq, p0 = (sub & 1) * 32; const float dsk = a.ssd_d[l * 8 + hh];
            float y[32]; float ss = 0.f;
#pragma unroll
            for (int c8 = 0; c8 < 4; ++c8) { const int ch = hh * 64 + p0 + c8 * 8; float xc[8];
                conv8(P + T * NP + PC_SSD_XBC + ch, n * 64 + l_, a.ssd_conv_w + (size_t)l * 4 * 768 + ch, 768, a.ssd_conv_b + l * 768 + ch, xc);
                const u32x4 z8 = *(const u32x4*)(P + T * NP + PC_SSD_Z + ch);
                const float zf[8] = {bflo(z8.x), bfhi(z8.x), bflo(z8.y), bfhi(z8.y), bflo(z8.z), bfhi(z8.z), bflo(z8.w), bfhi(z8.w)};
#pragma unroll
                for (int j = 0; j < 8; ++j) { const float ov = otile_ld(lds + hq * 8192, l_, p0 + c8 * 8 + j); const float yv = (ov + dsk * xc[j]) * silu_(zf[j]); y[c8 * 8 + j] = yv; ss += yv * yv; } }
            ss += __shfl_xor(ss, 1); ss += __shfl_xor(ss, 2); ss += __shfl_xor(ss, 4);
            const float rs = rsqrtf(ss * (1.f / 256.f) + 1e-6f);
            const float* ng = a.ssd_norm + l * 512 + hh * 64 + p0;
            bf16_t* yp = Y + ((size_t)2 * NTOK + T) * 512 + hh * 64 + p0;
#pragma unroll
            for (int c8 = 0; c8 < 4; ++c8) { float t[8];
#pragma unroll
                for (int j = 0; j < 8; ++j) t[j] = y[c8 * 8 + j] * rs * ng[c8 * 8 + j];
                *(u32x4*)(yp + c8 * 8) = (u32x4){pk2(t[0], t[1]), pk2(t[2], t[3]), pk2(t[4], t[5]), pk2(t[6], t[7])}; }
            __syncthreads();
        }
    }
}
DI CArgs& load_args() { CArgs* p = (CArgs*)__builtin_amdgcn_kernarg_segment_ptr(); asm volatile("" : "+s"(p)); return *p; }
DI void grid_sync(LAS unsigned char* lds) {
    CArgs& a = load_args(); XcdBarrier b; b.bar = (unsigned*)(a.ws + WS_CTL); b.x = xb_xcc_id(); b.st = (volatile LAS unsigned*)(lds + LDS_CTRL); xcd_barrier(b); }
__global__ void __launch_bounds__(NTHREADS, 2) fwd_kernel(Args a_unused) {
    extern __shared__ __attribute__((aligned(16))) unsigned char lds_raw[];
    LAS unsigned char* lds = (LAS unsigned char*)lds_raw;
    const int tid = ltid();
    if (tid < 256) ((LAS unsigned*)(lds + LDS_CTRL))[tid] = 0u;
    __syncthreads();
    { CArgs& a = load_args(); (void)xcd_barrier_post((unsigned*)(a.ws + WS_CTL), (volatile LAS unsigned*)(lds + LDS_CTRL)); }
    const int G = lgrid(), c = lbid();
    { CArgs& a = load_args(); phase_mod(a, lds); }
    { CArgs& a = load_args(); phase_cvt(a, lds); }
    grid_sync(lds);
    { CArgs& a = load_args(); phase_norm0(a); }
    grid_sync(lds);
    for (int l = 0; l < 2; ++l) {
        { CArgs& a = load_args(); char* r1 = a.ws + WS_R1;
          pg8::StaticOrder S; S.init(NTOK, NP, DM, G, c, a.ws + WS_H, a.ws + WS_WIN + (size_t)l * NP * DM * 2);
          EpiProj E{(bf16_t*)(r1 + R1_PROJ), (float*)(a.ws + WS_SMALL)};
          pg8::gemm_phase<EpiProj, pg8::StaticOrder>(lds, DM, S, E); }
        grid_sync(lds);
        { CArgs& a = load_args(); phase_prep(a, l, lds); }
        grid_sync(lds);
        { CArgs& a = load_args(); phase_scan(a, lds); }
        grid_sync(lds);
        { CArgs& a = load_args(); phase_post(a, l, lds); }
        grid_sync(lds);
        { CArgs& a = load_args(); char* r1 = a.ws + WS_R1;
          pg8::StaticOrder S; S.init(NTOK, 3072, 512, G, c, r1 + R1_YMIX, a.ws + WS_WBR + (size_t)l * 3 * DM * 512 * 2); S.pn_per_a = 4; S.a_pnstride = (size_t)NTOK * 512 * 2;
          EpiGate E{(const bf16_t*)(r1 + R1_PROJ), a.b_merge + l * 3072, (bf16_t*)(r1 + R1_GATED)};
          pg8::gemm_phase<EpiGate, pg8::StaticOrder>(lds, 512, S, E); }
        grid_sync(lds);
        { CArgs& a = load_args(); char* r1 = a.ws + WS_R1;
          pg8::StaticOrder S; S.init(NTOK, DM, 3072, G, c, r1 + R1_GATED, a.ws + WS_WOUT + (size_t)l * DM * 3072 * 2);
          EpiResid E{(l == 0) ? a.x : (const float*)(a.ws + WS_XB), (float*)(a.ws + WS_XA), (const float*)(a.ws + WS_MOD) + (size_t)l * 8 * 6144 + 2048};
          pg8::gemm_phase<EpiResid, pg8::StaticOrder>(lds, 3072, S, E); }
        grid_sync(lds);
        { CArgs& a = load_args(); phase_router(a, l, (const float*)(a.ws + WS_XA), lds); }
        grid_sync(lds);
        { CArgs& a = load_args(); char* r1 = a.ws + WS_R1;
          moe_tables((const int*)(a.ws + WS_CNT) + l * 32 * 64, lds);
          MoeOrder<true> S{8, G, c, (const LAS int*)(lds + LDS_CTRL + 64), (const LAS int*)(lds + LDS_CTRL + 256), (const char*)(a.ws + WS_H), a.ws + WS_WGU + (size_t)l * NEXP * 2048 * DM * 2,
                           (size_t)2048 * DM * 2, (size_t)256 * DM * 2, (const int*)(a.ws + WS_ROWTOK)};
          EpiSwiglu E{(bf16_t*)(r1 + R1_ACT), a.b_gu + (size_t)l * NEXP * 2048};
          pg8::gemm_phase<EpiSwiglu, MoeOrder<true>>(lds, DM, S, E); }
        grid_sync(lds);
        { CArgs& a = load_args(); char* r1 = a.ws + WS_R1;
          MoeOrder<false> S{4, G, c, (const LAS int*)(lds + LDS_CTRL + 64), (const LAS int*)(lds + LDS_CTRL + 256), (const char*)(r1 + R1_ACT), a.ws + WS_WDN + (size_t)l * NEXP * DM * DM * 2,
                            (size_t)DM * DM * 2, (size_t)256 * DM * 2, nullptr};
          EpiDown E{(bf16_t*)(r1 + R1_YS), a.b_dn + (size_t)l * NEXP * DM};
          pg8::gemm_phase<EpiDown, MoeOrder<false>>(lds, DM, S, E); }
        grid_sync(lds);
        { CArgs& a = load_args(); phase_combine(a, l, (const float*)(a.ws + WS_XA), (float*)(a.ws + WS_XB), lds); }
        grid_sync(lds);
    }
}

extern "C" void kernel_launch(void* const* d_in, const int* in_sizes, int n_in, void* d_out, int out_size, void* d_ws, size_t ws_size, hipStream_t stream) {
    static int grid = 0;
    if (grid == 0) {
        if (n_in != 32 || ws_size < WS_END) { fprintf(stderr, "kernel_launch: unexpected inputs (n_in %d, ws %zu, need %zu)\n", n_in, ws_size, (size_t)WS_END); grid = -1; return; }
        int dev = 0, cus = 0, per_cu = 0;
        if (hipGetDevice(&dev) != hipSuccess || hipDeviceGetAttribute(&cus, hipDeviceAttributeMultiprocessorCount, dev) != hipSuccess) { grid = -1; return; }
        if (hipFuncSetAttribute((const void*)fwd_kernel, hipFuncAttributeMaxDynamicSharedMemorySize, LDS_BYTES) != hipSuccess) { fprintf(stderr, "kernel_launch: hipFuncSetAttribute failed\n"); grid = -1; return; }
        if (hipOccupancyMaxActiveBlocksPerMultiprocessor(&per_cu, (const void*)fwd_kernel, NTHREADS, LDS_BYTES) != hipSuccess || per_cu < 1) { fprintf(stderr, "kernel_launch: occupancy query says %d\n", per_cu); grid = -1; return; }
        grid = cus;
    }
    if (grid < 0) return;
    (void)hipMemsetAsync((char*)d_ws + WS_CTL, 0, 65536, stream);
    Args a{};
    const float** pp = (const float**)&a;
    for (int i = 0; i < 32; ++i) pp[i] = (const float*)d_in[i];
    a.out = (float*)d_out; a.ws = (char*)d_ws;
    hipLaunchKernelGGL(fwd_kernel, dim3(grid), dim3(NTHREADS), LDS_BYTES, stream, a);
}
```

```cpp
#include <hip/hip_runtime.h>
#include <cstdio>
#include <cstdint>
#define DI __device__ __forceinline__
#define LAS __attribute__((address_space(3)))
typedef unsigned short bf16_t;
typedef short bf16x8 __attribute__((ext_vector_type(8)));
typedef float f32x4 __attribute__((ext_vector_type(4)));
typedef float f32x2 __attribute__((ext_vector_type(2)));
typedef float f32x16 __attribute__((ext_vector_type(16)));
typedef unsigned u32x4 __attribute__((ext_vector_type(4)));
typedef unsigned u32x2 __attribute__((ext_vector_type(2)));
typedef __bf16 hbf16x2 __attribute__((ext_vector_type(2)));

DI int ltid() { int t = threadIdx.x; asm volatile("" : "+v"(t)); return t; }
DI int lbid() { int t = blockIdx.x; asm volatile("" : "+s"(t)); return t; }
DI int lgrid() { int t = gridDim.x; asm volatile("" : "+s"(t)); return t; }
DI unsigned pk2(float a, float b) { f32x2 v = {a, b}; hbf16x2 r = __builtin_convertvector(v, hbf16x2); return __builtin_bit_cast(unsigned, r); }
DI float bflo(unsigned w) { return __uint_as_float(w << 16); }
DI float bfhi(unsigned w) { return __uint_as_float(w & 0xffff0000u); }
DI float bf2f(bf16_t v) { return __uint_as_float(((unsigned)v) << 16); }
DI bf16_t f2bf(float a) { return (bf16_t)(pk2(a, 0.f) & 0xffffu); }
DI float sigmoid_(float x) { return 1.f / (1.f + __expf(-x)); }
DI float silu_(float x) { return x / (1.f + __expf(-x)); }
DI float softplus_(float x) { return fmaxf(x, 0.f) + log1pf(__expf(-fabsf(x))); }

namespace pg8 {
constexpr int BM = 256, BK = 64, HALF = 128, HTB = HALF * BK * 2, STAGE_BYTES = 8 * HTB, NXCD = 8, WGM = 8;
__host__ __device__ __forceinline__ int lds_byte(int r, int c) { const int st = (r >> 4) * 2 + (c >> 5), rr = r & 15, cc = c & 31, ob = rr * 64 + cc * 2; return st * 1024 + (ob ^ (((ob >> 9) & 1) << 5)); }
__host__ __device__ __forceinline__ void stage_rc(int b, int& R, int& C) { const int st = b / 1024, sb = b % 1024, swz = sb ^ (((sb >> 9) & 1) << 5); R = (st >> 1) * 16 + swz / 64; C = (st & 1) * 32 + (swz % 64) / 2; }
__host__ __device__ __forceinline__ int perm32(int rho) { const int n = rho >> 4, i = rho & 15; return 8 * (i >> 2) + 4 * n + (i & 3); }

struct Unit { int pm, pn, e, cnt; };

struct StaticOrder {
    static constexpr bool GATHER = false;
    int nM, nN, nwg, G, c;
    const char* A; const char* Bt; size_t a_tstep, b_tstep, a_pnstride; int pn_per_a;
    DI void init(int M, int N, int K, int G_, int c_, const void* A_, const void* Bt_) { nM = M / BM; nN = N / BM; nwg = nM * nN; G = G_; c = c_; A = (const char*)A_; Bt = (const char*)Bt_; a_tstep = (size_t)BM * K * 2; b_tstep = (size_t)BM * K * 2; a_pnstride = 0; pn_per_a = 1 << 30; }
    DI bool next(int i, Unit& u) const {
        const long L = (long)i * G + c; if (L >= nwg) return false;
        int wgid = (int)L; { const int q = nwg / NXCD, r = nwg % NXCD, xcd = wgid % NXCD, off = wgid / NXCD; wgid = (xcd < r ? xcd * (q + 1) : r * (q + 1) + (xcd - r) * q) + off; }
        const int nig = WGM * nN, gid = wgid / nig, fm = gid * WGM, gsz = (nM - fm) < WGM ? (nM - fm) : WGM;
        u.pm = fm + ((wgid % nig) % gsz); u.pn = (wgid % nig) / gsz; u.e = 0; u.cnt = 256; return true;
    }
    DI const char* a_ptr(const Unit& u) const { return A + (size_t)(u.pn / pn_per_a) * a_pnstride + (size_t)u.pm * a_tstep; }
    DI const char* b_ptr(const Unit& u) const { return Bt + (size_t)u.pn * b_tstep; }
    DI int a_row(const Unit&, int) const { return 0; }
};

typedef int i32x4 __attribute__((ext_vector_type(4)));
typedef int i32x8 __attribute__((ext_vector_type(8)));
template <class Epi, class Sched, bool FP8 = false, bool ALIGN_EPI = true>
DI void gemm_phase(LAS unsigned char* lds, const int K, const Sched& S, const Epi& E) {
    constexpr bool GATHER = Sched::GATHER;
    const int tid = ltid(), wid = __builtin_amdgcn_readfirstlane(tid >> 6), lane = tid & 63, wr = wid >> 2, wc = wid & 3, fr = lane & 15, fq = lane >> 4;
    const int nt = K / BK;
    unsigned voffA[2], voffB[2]; int RA[2], CA[2];
#pragma unroll
    for (int i = 0; i < 2; ++i) { int R, C; stage_rc(tid * 16 + i * 8192, R, C); const int Rb = Epi::PERM ? ((R & ~31) + perm32(R & 31)) : R; RA[i] = R; CA[i] = C;
        voffA[i] = (unsigned)(R * K + C) * 2u; voffB[i] = (unsigned)(Rb * K + C) * 2u; }
    const size_t kstep = (size_t)(BK * 2);
    const size_t hstepB = (size_t)HALF * K * 2;
    const size_t hstepA = GATHER ? 0 : hstepB;
    const unsigned ldsw = (unsigned)wid * 1024u;
    const int aoff = lds_byte(wr * 64 + fr, fq * 8), boff = lds_byte(wc * 32 + fr, fq * 8);
#define PG8_SA(b, h) (((b) * 2 + (h)) * HTB)
#define PG8_SB(b, h) ((4 + (b) * 2 + (h)) * HTB)
#define PG8_STAGE(bufoff, gbase, voff) do { _Pragma("unroll") for (int _i = 0; _i < 2; ++_i) \
        __builtin_amdgcn_global_load_lds((const unsigned*)((const char*)(gbase) + (voff)[_i]), (LAS unsigned*)(lds + (bufoff) + ldsw + _i * 8192), 16, 0, 0); } while (0)
#define PG8_CAT(x, y) __builtin_shufflevector(__builtin_bit_cast(i32x4, x), __builtin_bit_cast(i32x4, y), 0, 1, 2, 3, 4, 5, 6, 7)
#define PG8_LDA8(dst, b, h) do { _Pragma("unroll") for (int m = 0; m < 4; ++m) dst[m] = PG8_CAT(*(const LAS bf16x8*)(lds + PG8_SA(b, h) + aoff + m * 2048), *(const LAS bf16x8*)(lds + PG8_SA(b, h) + aoff + m * 2048 + 1024)); } while (0)
#define PG8_LDB8(dst, b, h) do { _Pragma("unroll") for (int n = 0; n < 2; ++n) dst[n] = PG8_CAT(*(const LAS bf16x8*)(lds + PG8_SB(b, h) + boff + n * 2048), *(const LAS bf16x8*)(lds + PG8_SB(b, h) + boff + n * 2048 + 1024)); } while (0)
#define PG8_MMA8(ai, bj, At, Bt) do { __builtin_amdgcn_s_setprio(1); _Pragma("unroll") for (int m = 0; m < 4; ++m) _Pragma("unroll") for (int n = 0; n < 2; ++n) \
        asm volatile("v_mfma_scale_f32_16x16x128_f8f6f4 %0, %1, %2, %0, %3, %3 op_sel_hi:[0,0,0]" : "+v"(acc[ai][bj][m][n]) : "v"(Bt[n]), "v"(At[m]), "v"(one_scale)); __builtin_amdgcn_s_setprio(0); } while (0)
#define PG8_LDA(dst, b, h) do { _Pragma("unroll") for (int m = 0; m < 4; ++m) _Pragma("unroll") for (int k = 0; k < 2; ++k) dst[m][k] = *(const LAS bf16x8*)(lds + PG8_SA(b, h) + aoff + m * 2048 + k * 1024); } while (0)
#define PG8_LDB(dst, b, h) do { _Pragma("unroll") for (int n = 0; n < 2; ++n) _Pragma("unroll") for (int k = 0; k < 2; ++k) dst[n][k] = *(const LAS bf16x8*)(lds + PG8_SB(b, h) + boff + n * 2048 + k * 1024); } while (0)
#define PG8_MMA(ai, bj, At, Bt) do { __builtin_amdgcn_s_setprio(1); _Pragma("unroll") for (int m = 0; m < 4; ++m) _Pragma("unroll") for (int n = 0; n < 2; ++n) _Pragma("unroll") for (int k = 0; k < 2; ++k) \
        acc[ai][bj][m][n] = __builtin_amdgcn_mfma_f32_16x16x32_bf16(Bt[n][k], At[m][k], acc[ai][bj][m][n], 0, 0, 0); __builtin_amdgcn_s_setprio(0); } while (0)
#define PG8_WAIT_V(n) asm volatile("s_waitcnt vmcnt(" #n ")" ::: "memory")
#define PG8_WAIT_L(n) asm volatile("s_waitcnt lgkmcnt(" #n ")" ::: "memory")
#define PG8_BAR __builtin_amdgcn_s_barrier()
#define PG8_SCHED __builtin_amdgcn_sched_barrier(0)
    Unit cur, nxt; int ui = 0;
    if (!S.next(0, cur)) return;
    f32x4 acc[2][2][4][2];
#pragma unroll
    for (int a = 0; a < 2; ++a)
#pragma unroll
        for (int b = 0; b < 2; ++b)
#pragma unroll
            for (int m = 0; m < 4; ++m)
#pragma unroll
                for (int n = 0; n < 2; ++n) acc[a][b][m][n] = (f32x4){0.f, 0.f, 0.f, 0.f};
    bf16x8 At[4][2], B0[2][2], B1[2][2]; i32x8 Ct[4], C0[2], C1[2]; const int one_scale = 0x7f7f7f7f;
    const char* cA = S.a_ptr(cur); const char* cB = S.b_ptr(cur);
    unsigned vC0[2], vC1[2], vN0[2], vN1[2];
    if constexpr (GATHER) {
#pragma unroll
        for (int i = 0; i < 2; ++i) { vC0[i] = (unsigned)(S.a_row(cur, RA[i]) * K + CA[i]) * 2u; vC1[i] = (unsigned)(S.a_row(cur, HALF + RA[i]) * K + CA[i]) * 2u; vN0[i] = vC0[i]; vN1[i] = vC1[i]; }
    } else {
#pragma unroll
        for (int i = 0; i < 2; ++i) { vC0[i] = voffA[i]; vC1[i] = voffA[i]; vN0[i] = voffA[i]; vN1[i] = voffA[i]; }
    }
    PG8_STAGE(PG8_SB(0, 0), cB, voffB); PG8_STAGE(PG8_SB(0, 1), cB + hstepB, voffB); PG8_STAGE(PG8_SA(0, 0), cA, vC0); PG8_STAGE(PG8_SA(0, 1), cA + hstepA, vC1);
    if (wr == 1) PG8_BAR;
    PG8_WAIT_V(2); PG8_BAR;
    PG8_STAGE(PG8_SB(1, 0), cB + kstep, voffB); PG8_STAGE(PG8_SA(1, 0), cA + kstep, vC0); PG8_STAGE(PG8_SB(1, 1), cB + hstepB + kstep, voffB);
    PG8_WAIT_V(6); PG8_BAR;
    for (;;) {
        const bool has_next = S.next(ui + 1, nxt);
        const char* nA = has_next ? S.a_ptr(nxt) : cA; const char* nB = has_next ? S.b_ptr(nxt) : cB;
        if constexpr (GATHER) { if (has_next) {
#pragma unroll
            for (int i = 0; i < 2; ++i) { vN0[i] = (unsigned)(S.a_row(nxt, RA[i]) * K + CA[i]) * 2u; vN1[i] = (unsigned)(S.a_row(nxt, HALF + RA[i]) * K + CA[i]) * 2u; } } }
#pragma unroll 1
        for (int t = 0; t < nt; t += 2) {
            const bool last = (t == nt - 2);
            const char* a1 = cA + (size_t)(t + 1) * kstep;
            const char* a2 = last ? nA : cA + (size_t)(t + 2) * kstep; const char* b2 = last ? nB : cB + (size_t)(t + 2) * kstep;
            const char* a3 = a2 + kstep; const char* b3 = b2 + kstep;
            unsigned w0[2], w1[2];
            if constexpr (GATHER) { w0[0] = last ? vN0[0] : vC0[0]; w0[1] = last ? vN0[1] : vC0[1]; w1[0] = last ? vN1[0] : vC1[0]; w1[1] = last ? vN1[1] : vC1[1]; }
            else { w0[0] = voffA[0]; w0[1] = voffA[1]; w1[0] = voffA[0]; w1[1] = voffA[1]; }
            if constexpr (FP8) {
            PG8_LDB8(C0, 0, 0); PG8_LDB8(C1, 0, 1); PG8_SCHED; PG8_LDA8(Ct, 0, 0); PG8_STAGE(PG8_SA(1, 1), a1 + hstepA, vC1);
            PG8_WAIT_V(8); PG8_WAIT_L(0); PG8_BAR; PG8_MMA8(0, 0, Ct, C0); PG8_MMA8(0, 1, Ct, C1); PG8_BAR; PG8_SCHED;
            PG8_LDA8(Ct, 0, 1); PG8_STAGE(PG8_SB(0, 0), b2, voffB); PG8_STAGE(PG8_SB(0, 1), b2 + hstepB, voffB); PG8_STAGE(PG8_SA(0, 0), a2, w0);
            PG8_WAIT_V(8); PG8_WAIT_L(0); PG8_BAR; PG8_MMA8(1, 0, Ct, C0); PG8_MMA8(1, 1, Ct, C1); PG8_BAR; PG8_SCHED;
            PG8_LDB8(C0, 1, 0); PG8_LDB8(C1, 1, 1); PG8_SCHED; PG8_LDA8(Ct, 1, 0); PG8_STAGE(PG8_SA(0, 1), a2 + hstepA, w1);
            PG8_WAIT_V(8); PG8_WAIT_L(0); PG8_BAR; PG8_MMA8(0, 0, Ct, C0); PG8_MMA8(0, 1, Ct, C1); PG8_BAR; PG8_SCHED;
            PG8_LDA8(Ct, 1, 1); PG8_STAGE(PG8_SB(1, 0), b3, voffB); PG8_STAGE(PG8_SB(1, 1), b3 + hstepB, voffB); PG8_STAGE(PG8_SA(1, 0), a3, w0);
            PG8_WAIT_V(8); PG8_WAIT_L(0); PG8_BAR; PG8_MMA8(1, 0, Ct, C0); PG8_MMA8(1, 1, Ct, C1); PG8_BAR; PG8_SCHED;
                    } else {
            PG8_LDB(B0, 0, 0); PG8_LDB(B1, 0, 1); PG8_SCHED; PG8_LDA(At, 0, 0); PG8_STAGE(PG8_SA(1, 1), a1 + hstepA, vC1);
            PG8_WAIT_V(8); PG8_WAIT_L(0); PG8_BAR; PG8_MMA(0, 0, At, B0); PG8_MMA(0, 1, At, B1); PG8_BAR; PG8_SCHED;
            PG8_LDA(At, 0, 1); PG8_STAGE(PG8_SB(0, 0), b2, voffB); PG8_STAGE(PG8_SB(0, 1), b2 + hstepB, voffB); PG8_STAGE(PG8_SA(0, 0), a2, w0);
            PG8_WAIT_V(8); PG8_WAIT_L(0); PG8_BAR; PG8_MMA(1, 0, At, B0); PG8_MMA(1, 1, At, B1); PG8_BAR; PG8_SCHED;
            PG8_LDB(B0, 1, 0); PG8_LDB(B1, 1, 1); PG8_SCHED; PG8_LDA(At, 1, 0); PG8_STAGE(PG8_SA(0, 1), a2 + hstepA, w1);
            PG8_WAIT_V(8); PG8_WAIT_L(0); PG8_BAR; PG8_MMA(0, 0, At, B0); PG8_MMA(0, 1, At, B1); PG8_BAR; PG8_SCHED;
            PG8_LDA(At, 1, 1); PG8_STAGE(PG8_SB(1, 0), b3, voffB); PG8_STAGE(PG8_SB(1, 1), b3 + hstepB, voffB); PG8_STAGE(PG8_SA(1, 0), a3, w0);
            PG8_WAIT_V(8); PG8_WAIT_L(0); PG8_BAR; PG8_MMA(1, 0, At, B0); PG8_MMA(1, 1, At, B1); PG8_BAR; PG8_SCHED;
                    }
        }
        if constexpr (FP8) asm volatile("s_nop 15\n\ts_nop 15" ::: "memory");
        if constexpr (ALIGN_EPI) { if (wr == 0) PG8_BAR; }
        E(acc, cur, wr, wc, fr, fq);
        if (!has_next) break;
#pragma unroll
        for (int a = 0; a < 2; ++a)
#pragma unroll
            for (int b = 0; b < 2; ++b)
#pragma unroll
                for (int m = 0; m < 4; ++m)
#pragma unroll
                    for (int n = 0; n < 2; ++n) acc[a][b][m][n] = (f32x4){0.f, 0.f, 0.f, 0.f};
        cur = nxt; cA = nA; cB = nB; ++ui;
        if constexpr (GATHER) { vC0[0] = vN0[0]; vC0[1] = vN0[1]; vC1[0] = vN1[0]; vC1[1] = vN1[1]; }
        if constexpr (ALIGN_EPI) { if (wr == 1) PG8_BAR; }
    }
    PG8_WAIT_V(0);
    if constexpr (!ALIGN_EPI) { if (wr == 0) PG8_BAR; }
    PG8_BAR;
#undef PG8_SA
#undef PG8_SB
#undef PG8_STAGE
#undef PG8_LDA
#undef PG8_LDA8
#undef PG8_LDB8
#undef PG8_MMA8
#undef PG8_CAT
#undef PG8_LDB
#undef PG8_MMA
#undef PG8_WAIT_V
#undef PG8_WAIT_L
#undef PG8_BAR
#undef PG8_SCHED
}
}
using pg8::Unit;

#define XB_TMO      128
#define XB_XCNT(j)  (256  + 64 * (j))
#define XB_XSUB(j)  (1280 + 64 * (j))
#define XB_XGEN(j)  (2304 + 64 * (j))
#define XB_TOP      3328
#define XB_TOPGEN   3392
#define XCD_BAR_WORDS 3456
#define XB_SPIN_CAP (1u << 18)
DI unsigned xb_ld(unsigned* p)              { return __hip_atomic_load(p, __ATOMIC_RELAXED, __HIP_MEMORY_SCOPE_AGENT); }
DI unsigned xb_add(unsigned* p, unsigned v) { return __hip_atomic_fetch_add(p, v, __ATOMIC_RELAXED, __HIP_MEMORY_SCOPE_AGENT); }
DI unsigned xb_xcc_id() { return (unsigned)__builtin_amdgcn_s_getreg((3 << 11) | 20) & 0xFu; }
#define XB_SPIN(cond, bar) do { unsigned _sp = 0; while (cond) { __builtin_amdgcn_s_sleep(1); \
    if ((++_sp & 255u) == 0u) { if (xb_ld(&(bar)[XB_TMO])) break; if (_sp > XB_SPIN_CAP) { atomicAdd(&(bar)[XB_TMO], 1u); break; } } } } while (0)
struct XcdBarrier { unsigned* bar; unsigned x; volatile LAS unsigned* st; };
DI XcdBarrier xcd_barrier_post(unsigned* bar, volatile LAS unsigned* st) {
    XcdBarrier b; b.bar = bar; b.x = xb_xcc_id(); b.st = st;
    if (threadIdx.x == 0) (void)xb_add(&bar[XB_XCNT(b.x)], 1u);
    return b;
}
DI void xcd_barrier_complete(unsigned* bar, unsigned x, unsigned& nloc, unsigned& nx) {
    const unsigned G = gridDim.x * gridDim.y * gridDim.z;
    unsigned sum, cnt, mine, sp = 0u;
    for (;;) {
        sum = 0u; cnt = 0u; mine = 0u;
#pragma unroll
        for (unsigned j = 0; j < 16; ++j) { const unsigned c = xb_ld(&bar[XB_XCNT(j)]); sum += c; cnt += (c > 0u) ? 1u : 0u; mine = (j == x) ? c : mine; }
        if (sum == G) break;
        __builtin_amdgcn_s_sleep(1);
        if ((++sp & 255u) == 0u) { if (xb_ld(&bar[XB_TMO])) break; if (sp > XB_SPIN_CAP) { atomicAdd(&bar[XB_TMO], 1u); break; } }
    }
    nloc = mine > 0u ? mine : 1u; nx = cnt > 0u ? cnt : 1u;
}
DI void xcd_barrier(const XcdBarrier& b) {
    asm volatile("s_waitcnt vmcnt(0)" ::: "memory");
    __syncthreads();
    if (threadIdx.x == 0) {
        unsigned* bar = b.bar;
        __builtin_amdgcn_s_waitcnt(0);
        unsigned nloc = b.st[0], nx = b.st[1];
        if (nloc == 0u) { xcd_barrier_complete(bar, b.x, nloc, nx); b.st[0] = nloc; b.st[1] = nx; }
        const unsigned old = xb_add(&bar[XB_XSUB(b.x)], 1u);
        const unsigned gen = old / nloc;
        if (old + 1u == (gen + 1u) * nloc) {
            __builtin_amdgcn_fence(__ATOMIC_RELEASE, "agent");
            asm volatile("s_waitcnt vmcnt(0)" ::: "memory");
            const unsigned og = xb_add(&bar[XB_TOP], 1u);
            const unsigned tg = og / nx;
            if (og + 1u == (tg + 1u) * nx) xb_add(&bar[XB_TOPGEN], 1u);
            else XB_SPIN(xb_ld(&bar[XB_TOPGEN]) == tg, bar);
            __builtin_amdgcn_fence(__ATOMIC_ACQUIRE, "agent");
            xb_add(&bar[XB_XGEN(b.x)], 1u);
            asm volatile("s_waitcnt vmcnt(0)" ::: "memory");
        } else {
            XB_SPIN(xb_ld(&bar[XB_XGEN(b.x)]) == gen, bar);
            __builtin_amdgcn_fence(__ATOMIC_ACQUIRE, "agent");
            asm volatile("s_waitcnt vmcnt(0)" ::: "memory");
        }
    }
    __syncthreads();
}
constexpr int DM = 1024, NB = 8, SEQ = 4096, NTOK = NB * SEQ, NCHUNK = 64, NP = 8192, NEXP = 32;
constexpr int PC_GLA_Q = 0, PC_GLA_K = 256, PC_GLA_V = 512, PC_GLA_R = 1024, PC_GDN_QKV = 1536, PC_GDN_G = 3072, PC_SSD_Z = 3584, PC_SSD_XBC = 4096, PC_MERGE = 4864, PC_SMALL = 7936;
constexpr int IN_COLS = 7968;
constexpr int NTHREADS = 512;
constexpr int LDS_BYTES = 155648;
constexpr int LDS_CTRL = LDS_BYTES - 1024;
constexpr int GLA_UNIT = 41984, GDN_UNIT = 74752, SSD_UNIT = 33792;
constexpr int GLA_OQ = 0, GLA_OP = 8192, GLA_OK = 16384, GLA_OU = 24576, GLA_OD = 40960;
constexpr int GDN_OQ = 0, GDN_OW = 16384, GDN_OP = 32768, GDN_OK = 40960, GDN_OU = 57344, GDN_OD = 73728;
constexpr int SSD_OQ = 0, SSD_OP = 8192, SSD_OK = 16384, SSD_OU = 24576, SSD_OD = 32768;
constexpr size_t WS_CTL = 0, WS_CNT = 16384, WS_MOD = 65536;
constexpr size_t WS_WIN = 458752, WS_WBR = WS_WIN + 33554432ull, WS_WOUT = WS_WBR + 6291456ull, WS_WGU = WS_WOUT + 12582912ull, WS_WDN = WS_WGU + 268435456ull;
constexpr size_t WS_H = WS_WDN + 134217728ull, WS_SMALL = WS_H + 67108864ull, WS_XA = WS_SMALL + 4194304ull, WS_XB = WS_XA + 134217728ull;
constexpr size_t WS_ROWTOK = WS_XB + 134217728ull, WS_TOKSLOT = WS_ROWTOK + 4194304ull, WS_GATES = WS_TOKSLOT + 524288ull, WS_TSCR = WS_GATES + 524288ull, WS_R1 = WS_TSCR + 16777216ull;
constexpr size_t R1_PROJ = 0, R1_SGLA = 536870912ull, R1_SGDN = R1_SGLA + 2048ull * GLA_UNIT, R1_SSSD = R1_SGDN + 2048ull * GDN_UNIT, R1_OBUF = R1_SSSD + 4096ull * SSD_UNIT;
constexpr size_t R1_YMIX = R1_OBUF + 100663296ull, R1_END = R1_YMIX + 100663296ull, R1_GATED = R1_SGLA, R1_ACT = 0, R1_YS = 285212672ull;
constexpr size_t WS_END = WS_R1 + R1_END;
constexpr size_t OB_GLA = 0, OB_GDN = 33554432ull, OB_SSD = 67108864ull;

struct Args {
    const float *x, *c, *w_mod, *b_mod, *norm_mix, *norm_ffn, *norm_final, *w_in, *gla_w2, *gla_b2, *gla_norm, *gdn_conv_w, *gdn_a_log, *gdn_dt_bias, *gdn_norm,
        *ssd_conv_w, *ssd_conv_b, *ssd_a_log, *ssd_dt_bias, *ssd_d, *ssd_norm, *w_br_gla, *w_br_gdn, *w_br_ssd, *b_merge, *w_out, *w_router, *b_router, *w_gu, *b_gu, *w_dn, *b_dn;
    float* out; char* ws;
};
typedef const Args __attribute__((address_space(4))) CArgs;

DI void phase_mod(CArgs& a, LAS unsigned char* lds) {
    LAS float* cact = (LAS float*)lds;
    LAS float* red = (LAS float*)(lds + 32768);
    const int tid = ltid();
    for (int i = tid; i < 8192; i += NTHREADS) cact[i] = silu_(a.c[i]);
    __syncthreads();
    float* mod = (float*)(a.ws + WS_MOD);
    for (int blk = lbid(); blk < 256; blk += lgrid()) {
        const int jj = tid & 63, ks = tid >> 6, col = blk * 48 + jj;
        float s[8];
#pragma unroll
        for (int b = 0; b < 8; ++b) s[b] = 0.f;
        if (jj < 48) {
            const int l = col / 6144, j = col % 6144;
            const float* w = a.w_mod + (size_t)l * DM * 6144 + j;
            for (int k = ks * 128; k < ks * 128 + 128; ++k) { const float wv = w[(size_t)k * 6144];
#pragma unroll
                for (int b = 0; b < 8; ++b) s[b] += cact[b * 1024 + k] * wv; }
        }
#pragma unroll
        for (int b = 0; b < 8; ++b) red[(ks * 64 + jj) * 8 + b] = s[b];
        __syncthreads();
        if (tid < 48 * 8) { const int j2 = tid >> 3, b = tid & 7, col2 = blk * 48 + j2, l = col2 / 6144, j = col2 % 6144; float t = 0.f;
#pragma unroll
            for (int k2 = 0; k2 < 8; ++k2) t += red[(k2 * 64 + j2) * 8 + b];
            mod[((size_t)l * 8 + b) * 6144 + j] = t + a.b_mod[l * 6144 + j]; }
        __syncthreads();
    }
}
DI int win_dst(int c) {
    if (c < 1024) return c;
    if (c < 1040) return PC_SMALL + (c - 1024);
    if (c < 1552) return PC_GLA_R + (c - 1040);
    if (c < 3088) return PC_GDN_QKV + (c - 1552);
    if (c < 3092) return PC_SMALL + 16 + (c - 3088);
    if (c < 3096) return PC_SMALL + 20 + (c - 3092);
    if (c < 3608) return PC_GDN_G + (c - 3096);
    if (c < 4120) return PC_SSD_Z + (c - 3608);
    if (c < 4888) return PC_SSD_XBC + (c - 4120);
    if (c < 4896) return PC_SMALL + 24 + (c - 4888);
    return PC_MERGE + (c - 4896);
}
DI unsigned pk4_fp8(float a, float b, float c, float d) { int w = 0; w = __builtin_amdgcn_cvt_pk_fp8_f32(a, b, w, false); w = __builtin_amdgcn_cvt_pk_fp8_f32(c, d, w, true); return (unsigned)w; }
constexpr float W8_SCALE = 32.f, W8_INV = 1.f / 32.f;
template <int KIND, bool F8 = false> DI void cvt_tile(const float* src, int ld_src, int ncols, int k0, int n0, bf16_t* dst, int ld_dst, int kd0, LAS float* T) {
    const int tid = ltid();
    { const int jj = tid & 127, kk = tid >> 7; const bool ok = (n0 + jj) < ncols;
#pragma unroll
      for (int i = 0; i < 16; ++i) { const int k = kk + 4 * i; T[k * 129 + jj] = ok ? src[(size_t)(k0 + k) * ld_src + n0 + jj] : 0.f; } }
    __syncthreads();
    { const int j = tid >> 2, kq = tid & 3, c = n0 + j;
      if (c < ncols) {
        int drow;
        if (KIND == 0) drow = c; else if (KIND == 1) drow = (c & ~255) + (c & 1) * 128 + ((c & 255) >> 1); else drow = win_dst(c);
        u32x4 w0, w1; float v[16];
#pragma unroll
        for (int i = 0; i < 16; ++i) v[i] = T[(kq * 16 + i) * 129 + j];
        w0.x = pk2(v[0], v[1]); w0.y = pk2(v[2], v[3]); w0.z = pk2(v[4], v[5]); w0.w = pk2(v[6], v[7]);
        w1.x = pk2(v[8], v[9]); w1.y = pk2(v[10], v[11]); w1.z = pk2(v[12], v[13]); w1.w = pk2(v[14], v[15]);
        if constexpr (F8) { unsigned char* d8 = (unsigned char*)dst + (size_t)drow * ld_dst + kd0 + k0 + kq * 16;
            *(u32x4*)d8 = (u32x4){pk4_fp8(v[0] * W8_SCALE, v[1] * W8_SCALE, v[2] * W8_SCALE, v[3] * W8_SCALE), pk4_fp8(v[4] * W8_SCALE, v[5] * W8_SCALE, v[6] * W8_SCALE, v[7] * W8_SCALE),
                                  pk4_fp8(v[8] * W8_SCALE, v[9] * W8_SCALE, v[10] * W8_SCALE, v[11] * W8_SCALE), pk4_fp8(v[12] * W8_SCALE, v[13] * W8_SCALE, v[14] * W8_SCALE, v[15] * W8_SCALE)}; }
        else { bf16_t* d = dst + (size_t)drow * ld_dst + kd0 + k0 + kq * 16;
        *(u32x4*)d = w0; *(u32x4*)(d + 8) = w1; } } }
    __syncthreads();
}
DI void phase_cvt(CArgs& a, LAS unsigned char* lds) {
    LAS float* T = (LAS float*)lds;
    constexpr int T_IN = 16 * 63, T_BR = 3 * 8 * 8, T_OUT = 3 * 16 * 8, T_GU = 32 * 16 * 16, T_DN = 32 * 16 * 8, T_L = T_IN + T_BR + T_OUT + T_GU + T_DN;
    for (int g = lbid(); g < 2 * T_L; g += lgrid()) {
        const int l = g / T_L; int r = g % T_L;
        if (r < T_IN) { const int kt = r % 16, ntile = r / 16;
            cvt_tile<2>(a.w_in + (size_t)l * DM * IN_COLS, IN_COLS, IN_COLS, kt * 64, ntile * 128, (bf16_t*)(a.ws + WS_WIN) + (size_t)l * NP * DM, DM, 0, T); continue; }
        r -= T_IN;
        if (r < T_BR) { const int br = r / 64, kt = (r % 64) % 8, ntile = (r % 64) / 8; const float* src = (br == 0 ? a.w_br_gla : br == 1 ? a.w_br_gdn : a.w_br_ssd) + (size_t)l * 512 * DM;
            cvt_tile<0>(src, DM, DM, kt * 64, ntile * 128, (bf16_t*)(a.ws + WS_WBR) + ((size_t)l * 3 + br) * DM * 512, 512, 0, T); continue; }
        r -= T_BR;
        if (r < T_OUT) { const int cp = r / 128, kt = (r % 128) % 16, ntile = (r % 128) / 16;
            cvt_tile<0>(a.w_out + (size_t)l * DM * DM, DM, DM, kt * 64, ntile * 128, (bf16_t*)(a.ws + WS_WOUT) + (size_t)l * DM * 3072, 3072, cp * 1024, T); continue; }
        r -= T_OUT;
        if (r < T_GU) { const int e = r / 256, kt = (r % 256) % 16, ntile = (r % 256) / 16;
            cvt_tile<1, true>(a.w_gu + ((size_t)l * NEXP + e) * DM * 2048, 2048, 2048, kt * 64, ntile * 128, (bf16_t*)(a.ws + WS_WGU + ((size_t)l * NEXP + e) * 2048 * DM), DM, 0, T); continue; }
        r -= T_GU;
        { const int e = r / 128, kt = (r % 128) % 16, ntile = (r % 128) / 16;
            cvt_tile<0, true>(a.w_dn + ((size_t)l * NEXP + e) * DM * DM, DM, DM, kt * 64, ntile * 128, (bf16_t*)(a.ws + WS_WDN + ((size_t)l * NEXP + e) * DM * DM), DM, 0, T); }
    }
    for (size_t i = (size_t)lbid() * NTHREADS + ltid(); i < 2ull * 224 * DM / 8; i += (size_t)lgrid() * NTHREADS) {
        const size_t l = i / (224 * DM / 8), rr = i % (224 * DM / 8);
        *(u32x4*)((bf16_t*)(a.ws + WS_WIN) + (l * NP + IN_COLS) * DM + rr * 8) = (u32x4){0u, 0u, 0u, 0u}; }
}

DI float wave_sum(float v) {
#pragma unroll
    for (int o = 32; o > 0; o >>= 1) v += __shfl_xor(v, o);
    return v;
}
DI void phase_norm0(CArgs& a) {
    const int lane = ltid() & 63, gw = lbid() * 8 + (ltid() >> 6), nw = lgrid() * 8;
    const float* mod = (const float*)(a.ws + WS_MOD);
    bf16_t* H = (bf16_t*)(a.ws + WS_H);
    for (int row = gw; row < NTOK; row += nw) {
        const int b = row >> 12; const float* xr = a.x + (size_t)row * DM; const float* mb = mod + (size_t)b * 6144;
        f32x4 v[4]; float ss = 0.f;
#pragma unroll
        for (int i = 0; i < 2; ++i) { v[2 * i] = *(const f32x4*)(xr + lane * 8 + 512 * i); v[2 * i + 1] = *(const f32x4*)(xr + lane * 8 + 512 * i + 4); }
#pragma unroll
        for (int i = 0; i < 4; ++i) ss += v[i][0] * v[i][0] + v[i][1] * v[i][1] + v[i][2] * v[i][2] + v[i][3] * v[i][3];
        ss = wave_sum(ss); const float rs = rsqrtf(ss * (1.f / 1024.f) + 1e-6f);
#pragma unroll
        for (int i = 0; i < 2; ++i) { const int c0 = lane * 8 + 512 * i; float o[8];
#pragma unroll
            for (int j = 0; j < 8; ++j) { const float xv = v[2 * i + (j >> 2)][j & 3]; o[j] = xv * rs * a.norm_mix[c0 + j] * (1.f + mb[1024 + c0 + j]) + mb[c0 + j]; }
            u32x4 w; w.x = pk2(o[0], o[1]); w.y = pk2(o[2], o[3]); w.z = pk2(o[4], o[5]); w.w = pk2(o[6], o[7]);
            *(u32x4*)(H + (size_t)row * DM + c0) = w; }
    }
}

struct EpiProj { static constexpr bool PERM = true; bf16_t* P; float* small;
    DI void operator()(const f32x4 (&acc)[2][2][4][2], const Unit& u, int wr, int wc, int fr, int fq) const {
        const int row0 = u.pm * 256 + wr * 64 + fr, col0 = u.pn * 256 + wc * 32 + 8 * fq;
#pragma unroll
        for (int ai = 0; ai < 2; ++ai)
#pragma unroll
            for (int m = 0; m < 4; ++m) { const int row = row0 + ai * 128 + m * 16; bf16_t* rowp = P + (size_t)row * NP + col0;
#pragma unroll
                for (int bj = 0; bj < 2; ++bj) { const f32x4 v0 = acc[ai][bj][m][0], v1 = acc[ai][bj][m][1];
                    u32x4 w; w.x = pk2(v0[0], v0[1]); w.y = pk2(v0[2], v0[3]); w.z = pk2(v1[0], v1[1]); w.w = pk2(v1[2], v1[3]);
                    *(u32x4*)(rowp + bj * 128) = w; }
                if (u.pn == 31 && wc == 0) { float* sp = small + (size_t)row * 32 + 8 * fq; *(f32x4*)sp = acc[ai][0][m][0]; *(f32x4*)(sp + 4) = acc[ai][0][m][1]; } }
    } };
struct EpiGate { static constexpr bool PERM = true; const bf16_t* P; const float* bmerge; bf16_t* G;
    DI void operator()(const f32x4 (&acc)[2][2][4][2], const Unit& u, int wr, int wc, int fr, int fq) const {
        const int row0 = u.pm * 256 + wr * 64 + fr, col0 = u.pn * 256 + wc * 32 + 8 * fq;
        f32x4 bv[2][2];
#pragma unroll
        for (int bj = 0; bj < 2; ++bj) { bv[bj][0] = *(const f32x4*)(bmerge + col0 + bj * 128); bv[bj][1] = *(const f32x4*)(bmerge + col0 + bj * 128 + 4); }
#pragma unroll
        for (int ai = 0; ai < 2; ++ai)
#pragma unroll
            for (int m = 0; m < 4; ++m) { const size_t row = row0 + ai * 128 + m * 16;
#pragma unroll
                for (int bj = 0; bj < 2; ++bj) { const u32x4 mr = *(const u32x4*)(P + row * NP + PC_MERGE + col0 + bj * 128); const f32x4 v0 = acc[ai][bj][m][0], v1 = acc[ai][bj][m][1];
                    float o[8];
                    o[0] = v0[0] * sigmoid_(bflo(mr.x) + bv[bj][0][0]); o[1] = v0[1] * sigmoid_(bfhi(mr.x) + bv[bj][0][1]); o[2] = v0[2] * sigmoid_(bflo(mr.y) + bv[bj][0][2]); o[3] = v0[3] * sigmoid_(bfhi(mr.y) + bv[bj][0][3]);
                    o[4] = v1[0] * sigmoid_(bflo(mr.z) + bv[bj][1][0]); o[5] = v1[1] * sigmoid_(bfhi(mr.z) + bv[bj][1][1]); o[6] = v1[2] * sigmoid_(bflo(mr.w) + bv[bj][1][2]); o[7] = v1[3] * sigmoid_(bfhi(mr.w) + bv[bj][1][3]);
                    u32x4 w; w.x = pk2(o[0], o[1]); w.y = pk2(o[2], o[3]); w.z = pk2(o[4], o[5]); w.w = pk2(o[6], o[7]);
                    *(u32x4*)(G + row * 3072 + col0 + bj * 128) = w; } }
    } };
struct EpiResid { static constexpr bool PERM = false; const float* xin; float* xout; const float* gm;
    DI void operator()(const f32x4 (&acc)[2][2][4][2], const Unit& u, int wr, int wc, int fr, int fq) const {
        const int row0 = u.pm * 256 + wr * 64 + fr, col0 = u.pn * 256 + wc * 32 + 4 * fq; const int b = (u.pm * 256) >> 12;
        f32x4 gv[2][2];
#pragma unroll
        for (int bj = 0; bj < 2; ++bj)
#pragma unroll
            for (int n = 0; n < 2; ++n) gv[bj][n] = *(const f32x4*)(gm + (size_t)b * 6144 + col0 + bj * 128 + n * 16);
#pragma unroll
        for (int ai = 0; ai < 2; ++ai)
#pragma unroll
            for (int m = 0; m < 4; ++m) { const size_t off = (size_t)(row0 + ai * 128 + m * 16) * DM + col0;
#pragma unroll
                for (int bj = 0; bj < 2; ++bj)
#pragma unroll
                    for (int n = 0; n < 2; ++n) { const f32x4 xi = *(const f32x4*)(xin + off + bj * 128 + n * 16); *(f32x4*)(xout + off + bj * 128 + n * 16) = xi + gv[bj][n] * acc[ai][bj][m][n]; } }
    } };
struct EpiSwiglu { static constexpr bool PERM = true; unsigned char* act; const float* bgu;
    DI void operator()(const f32x4 (&acc)[2][2][4][2], const Unit& u, int wr, int wc, int fr, int fq) const {
        const int row0 = u.pm * 256 + wr * 64 + fr, x0 = u.pn * 128 + wc * 32 + 8 * fq;
        const float* bb = bgu + (size_t)u.e * 2048 + 2 * x0;
        float bg[8], bu[8];
#pragma unroll
        for (int i = 0; i < 4; ++i) { const f32x4 t = *(const f32x4*)(bb + 4 * i); bg[2 * i] = t[0]; bu[2 * i] = t[1]; bg[2 * i + 1] = t[2]; bu[2 * i + 1] = t[3]; }
#pragma unroll
        for (int ai = 0; ai < 2; ++ai)
#pragma unroll
            for (int m = 0; m < 4; ++m) { const size_t row = row0 + ai * 128 + m * 16; float o[8];
#pragma unroll
                for (int j = 0; j < 8; ++j) { float g = acc[ai][0][m][j >> 2][j & 3] * W8_INV + bg[j], up = acc[ai][1][m][j >> 2][j & 3] * W8_INV + bu[j];
                    g = fminf(g, 7.f); up = fminf(fmaxf(up, -7.f), 7.f); o[j] = (up + 1.f) * g * sigmoid_(1.702f * g); }
                *(u32x2*)(act + row * DM + x0) = (u32x2){pk4_fp8(o[0], o[1], o[2], o[3]), pk4_fp8(o[4], o[5], o[6], o[7])}; }
    } };
struct EpiDown { static constexpr bool PERM = true; bf16_t* ys; const float* bdn;
    DI void operator()(const f32x4 (&acc)[2][2][4][2], const Unit& u, int wr, int wc, int fr, int fq) const {
        const int row0 = u.pm * 256 + wr * 64 + fr, col0 = u.pn * 256 + wc * 32 + 8 * fq;
        f32x4 bv[2][2];
#pragma unroll
        for (int bj = 0; bj < 2; ++bj) { bv[bj][0] = *(const f32x4*)(bdn + (size_t)u.e * DM + col0 + bj * 128); bv[bj][1] = *(const f32x4*)(bdn + (size_t)u.e * DM + col0 + bj * 128 + 4); }
#pragma unroll
        for (int ai = 0; ai < 2; ++ai)
#pragma unroll
            for (int m = 0; m < 4; ++m) { const size_t row = row0 + ai * 128 + m * 16;
#pragma unroll
                for (int bj = 0; bj < 2; ++bj) { const f32x4 v0 = acc[ai][bj][m][0] * W8_INV + bv[bj][0], v1 = acc[ai][bj][m][1] * W8_INV + bv[bj][1];
                    u32x4 w; w.x = pk2(v0[0], v0[1]); w.y = pk2(v0[2], v0[3]); w.z = pk2(v1[0], v1[1]); w.w = pk2(v1[2], v1[3]);
                    *(u32x4*)(ys + row * DM + col0 + bj * 128) = w; } }
    } };

DI void moe_tables(const int* cnt  , LAS unsigned char* lds) {
    LAS int* tstart = (LAS int*)(lds + LDS_CTRL + 64); LAS int* lcnt = (LAS int*)(lds + LDS_CTRL + 256);
    if (ltid() < 64) { const int t = ltid(); const int c = t < 32 ? cnt[t * 64] : 0; int v = (c + 255) >> 8;
#pragma unroll
        for (int o = 1; o < 32; o <<= 1) { const int y = __shfl_up(v, o); if ((t & 31) >= o) v += y; }
        if (t < 32) { tstart[t + 1] = v; lcnt[t] = c; } if (t == 0) tstart[0] = 0; }
    __syncthreads();
}
template <bool G_> struct MoeOrder {
    static constexpr bool GATHER = G_;
    int nN, G, c; const LAS int* tstart; const LAS int* lcnt; const char* A; const char* Bt; size_t b_estride, tstep; const int* rowtok;
    DI bool next(int i, Unit& u) const {
        const int L = i * G + c, rt = L / nN; if (rt >= tstart[32]) return false;
        int e = 0; while (tstart[e + 1] <= rt) ++e;
        u.pm = rt; u.pn = L % nN; u.e = e; const int rem = lcnt[e] - (rt - tstart[e]) * 256; u.cnt = rem < 256 ? rem : 256; return true; }
    DI const char* a_ptr(const Unit& u) const { return GATHER ? A : A + (size_t)u.pm * tstep; }
    DI const char* b_ptr(const Unit& u) const { return Bt + (size_t)u.e * b_estride + (size_t)u.pn * tstep; }
    DI int a_row(const Unit& u, int R) const { return R < u.cnt ? rowtok[u.e * 32768 + (u.pm - tstart[u.e]) * 256 + R] : 0; }
};
DI void phase_router(CArgs& a, int l, const float* xmid, LAS unsigned char* lds) {
    const int tid = ltid(), wid = tid >> 6, lane = tid & 63, r = lane & 15, q = lane >> 4;
    LAS bf16_t* Whi = (LAS bf16_t*)lds; LAS bf16_t* Wlo = (LAS bf16_t*)(lds + 66048);
    LAS float* scr = (LAS float*)(lds + 132096 + wid * 2112);
    LAS int* hist = (LAS int*)(lds + 148992); LAS int* basep = (LAS int*)(lds + 148992 + 128);
    const float* wr_ = a.w_router + (size_t)l * DM * NEXP;
    for (int i = tid; i < DM * NEXP; i += NTHREADS) { const int k = i >> 5, e = i & 31; const float v = wr_[i]; const bf16_t hi = f2bf(v); Whi[e * 1032 + k] = hi; Wlo[e * 1032 + k] = f2bf(v - bf2f(hi)); }
    __syncthreads();
    const float* mod = (const float*)(a.ws + WS_MOD) + (size_t)l * 8 * 6144;
    const float* nf = a.norm_ffn + l * DM;
    bf16_t* H = (bf16_t*)(a.ws + WS_H);
    int* cntg = (int*)(a.ws + WS_CNT) + l * 32 * 64;
    int* rowtok = (int*)(a.ws + WS_ROWTOK); int* tokslot = (int*)(a.ws + WS_TOKSLOT); float* gates = (float*)(a.ws + WS_GATES);
    for (int blk = lbid(); blk < NTOK / 128; blk += lgrid()) {
        if (tid < 32) hist[tid] = 0;
        const int row = blk * 128 + wid * 16 + r, b = row >> 12;
        const float* xr = xmid + (size_t)row * DM; const float* mb = mod + (size_t)b * 6144;
        float ss = 0.f;
        for (int ks = 0; ks < 32; ++ks) { const f32x4 x0 = *(const f32x4*)(xr + ks * 32 + 8 * q), x1 = *(const f32x4*)(xr + ks * 32 + 8 * q + 4);
            ss += x0[0] * x0[0] + x0[1] * x0[1] + x0[2] * x0[2] + x0[3] * x0[3] + x1[0] * x1[0] + x1[1] * x1[1] + x1[2] * x1[2] + x1[3] * x1[3]; }
        ss += __shfl_xor(ss, 16); ss += __shfl_xor(ss, 32);
        const float rs = rsqrtf(ss * (1.f / 1024.f) + 1e-6f);
        f32x4 acc0 = {0.f, 0.f, 0.f, 0.f}, acc1 = {0.f, 0.f, 0.f, 0.f};
        for (int ks = 0; ks < 32; ++ks) { const int k0 = ks * 32 + 8 * q;
            const f32x4 x0 = *(const f32x4*)(xr + k0), x1 = *(const f32x4*)(xr + k0 + 4);
            float hv[8];
#pragma unroll
            for (int j = 0; j < 8; ++j) { const float xv = j < 4 ? x0[j & 3] : x1[j & 3]; hv[j] = xv * rs * nf[k0 + j] * (1.f + mb[4096 + k0 + j]) + mb[3072 + k0 + j]; }
            u32x4 hi; hi.x = pk2(hv[0], hv[1]); hi.y = pk2(hv[2], hv[3]); hi.z = pk2(hv[4], hv[5]); hi.w = pk2(hv[6], hv[7]);
            *(u32x2*)((unsigned char*)H + (size_t)row * DM + k0) = (u32x2){pk4_fp8(hv[0], hv[1], hv[2], hv[3]), pk4_fp8(hv[4], hv[5], hv[6], hv[7])};
            u32x4 lo; lo.x = pk2(hv[0] - bflo(hi.x), hv[1] - bfhi(hi.x)); lo.y = pk2(hv[2] - bflo(hi.y), hv[3] - bfhi(hi.y)); lo.z = pk2(hv[4] - bflo(hi.z), hv[5] - bfhi(hi.z)); lo.w = pk2(hv[6] - bflo(hi.w), hv[7] - bfhi(hi.w));
            const bf16x8 ah = __builtin_bit_cast(bf16x8, hi), al = __builtin_bit_cast(bf16x8, lo);
            const bf16x8 b0h = *(const LAS bf16x8*)(Whi + r * 1032 + k0), b0l = *(const LAS bf16x8*)(Wlo + r * 1032 + k0);
            const bf16x8 b1h = *(const LAS bf16x8*)(Whi + (16 + r) * 1032 + k0), b1l = *(const LAS bf16x8*)(Wlo + (16 + r) * 1032 + k0);
            acc0 = __builtin_amdgcn_mfma_f32_16x16x32_bf16(ah, b0h, acc0, 0, 0, 0); acc0 = __builtin_amdgcn_mfma_f32_16x16x32_bf16(ah, b0l, acc0, 0, 0, 0); acc0 = __builtin_amdgcn_mfma_f32_16x16x32_bf16(al, b0h, acc0, 0, 0, 0);
            acc1 = __builtin_amdgcn_mfma_f32_16x16x32_bf16(ah, b1h, acc1, 0, 0, 0); acc1 = __builtin_amdgcn_mfma_f32_16x16x32_bf16(ah, b1l, acc1, 0, 0, 0); acc1 = __builtin_amdgcn_mfma_f32_16x16x32_bf16(al, b1h, acc1, 0, 0, 0); }
        const float br0 = a.b_router[l * 32 + r], br1 = a.b_router[l * 32 + 16 + r];
#pragma unroll
        for (int j = 0; j < 4; ++j) { scr[(4 * q + j) * 33 + r] = acc0[j] + br0; scr[(4 * q + j) * 33 + 16 + r] = acc1[j] + br1; }
        __syncthreads();
        int te[4] = {0, 0, 0, 0}; float tg[4] = {0.f, 0.f, 0.f, 0.f}; int rk[4] = {0, 0, 0, 0};
        if (lane < 16) {
            float v[32];
#pragma unroll
            for (int e = 0; e < 32; ++e) v[e] = scr[lane * 33 + e];
            float tv[4];
#pragma unroll
            for (int k = 0; k < 4; ++k) { float best = -3.0e38f; int bi = 0;
#pragma unroll
                for (int e = 0; e < 32; ++e) { if (v[e] > best) { best = v[e]; bi = e; } }
                tv[k] = best; te[k] = bi;
#pragma unroll
                for (int e = 0; e < 32; ++e) v[e] = (e == bi) ? -3.0e38f : v[e]; }
            const float e1 = __expf(tv[1] - tv[0]), e2 = __expf(tv[2] - tv[0]), e3 = __expf(tv[3] - tv[0]); const float inv = 1.f / (1.f + e1 + e2 + e3);
            tg[0] = inv; tg[1] = e1 * inv; tg[2] = e2 * inv; tg[3] = e3 * inv;
#pragma unroll
            for (int k = 0; k < 4; ++k) rk[k] = atomicAdd((int*)&hist[te[k]], 1);
        }
        __syncthreads();
        if (tid < 32) basep[tid] = atomicAdd(&cntg[tid * 64], hist[tid]);
        __syncthreads();
        if (lane < 16) { const int tok = blk * 128 + wid * 16 + lane;
#pragma unroll
            for (int k = 0; k < 4; ++k) { const int pos = basep[te[k]] + rk[k]; rowtok[te[k] * 32768 + pos] = tok; tokslot[tok * 4 + k] = te[k] * 32768 + pos; gates[tok * 4 + k] = tg[k]; } }
        __syncthreads();
    }
}

DI void phase_combine(CArgs& a, int l, const float* xmid, float* xnew, LAS unsigned char* lds) {
    const LAS int* tstart = (const LAS int*)(lds + LDS_CTRL + 64);
    const int lane = ltid() & 63, gw = lbid() * 8 + (ltid() >> 6), nw = lgrid() * 8;
    const float* mod = (const float*)(a.ws + WS_MOD);
    const bf16_t* YS = (const bf16_t*)(a.ws + WS_R1 + R1_YS);
    const int* tokslot = (const int*)(a.ws + WS_TOKSLOT); const float* gates = (const float*)(a.ws + WS_GATES);
    bf16_t* H = (bf16_t*)(a.ws + WS_H);
    for (int row = gw; row < NTOK; row += nw) {
        const int b = row >> 12; const float* mb = mod + ((size_t)l * 8 + b) * 6144;
        size_t pr[4]; float gt[4];
#pragma unroll
        for (int k = 0; k < 4; ++k) { const int s = tokslot[row * 4 + k]; pr[k] = (size_t)(tstart[s >> 15] * 256 + (s & 32767)); gt[k] = gates[row * 4 + k]; }
        float xn[16]; float ss = 0.f;
#pragma unroll
        for (int i = 0; i < 2; ++i) { const int c0 = lane * 8 + 512 * i; float f[8];
#pragma unroll
            for (int j = 0; j < 8; ++j) f[j] = 0.f;
#pragma unroll
            for (int k = 0; k < 4; ++k) { const u32x4 y = *(const u32x4*)(YS + pr[k] * DM + c0);
                f[0] += gt[k] * bflo(y.x); f[1] += gt[k] * bfhi(y.x); f[2] += gt[k] * bflo(y.y); f[3] += gt[k] * bfhi(y.y); f[4] += gt[k] * bflo(y.z); f[5] += gt[k] * bfhi(y.z); f[6] += gt[k] * bflo(y.w); f[7] += gt[k] * bfhi(y.w); }
            const f32x4 x0 = *(const f32x4*)(xmid + (size_t)row * DM + c0), x1 = *(const f32x4*)(xmid + (size_t)row * DM + c0 + 4);
#pragma unroll
            for (int j = 0; j < 8; ++j) { const float xv = (j < 4 ? x0[j & 3] : x1[j & 3]) + mb[5120 + c0 + j] * f[j]; xn[8 * i + j] = xv; ss += xv * xv; } }
        ss = wave_sum(ss); const float rs = rsqrtf(ss * (1.f / 1024.f) + 1e-6f);
        if (l == 0) {
            const float* mb2 = mod + ((size_t)8 + b) * 6144; const float* g = a.norm_mix + DM;
#pragma unroll
            for (int i = 0; i < 2; ++i) { const int c0 = lane * 8 + 512 * i;
                *(f32x4*)(xnew + (size_t)row * DM + c0) = (f32x4){xn[8 * i], xn[8 * i + 1], xn[8 * i + 2], xn[8 * i + 3]};
                *(f32x4*)(xnew + (size_t)row * DM + c0 + 4) = (f32x4){xn[8 * i + 4], xn[8 * i + 5], xn[8 * i + 6], xn[8 * i + 7]};
                float o[8];
#pragma unroll
                for (int j = 0; j < 8; ++j) o[j] = xn[8 * i + j] * rs * g[c0 + j] * (1.f + mb2[1024 + c0 + j]) + mb2[c0 + j];
                u32x4 w; w.x = pk2(o[0], o[1]); w.y = pk2(o[2], o[3]); w.z = pk2(o[4], o[5]); w.w = pk2(o[6], o[7]);
                *(u32x4*)(H + (size_t)row * DM + c0) = w; }
        } else {
#pragma unroll
            for (int i = 0; i < 2; ++i) { const int c0 = lane * 8 + 512 * i; float o[8];
#pragma unroll
                for (int j = 0; j < 8; ++j) o[j] = xn[8 * i + j] * rs * a.norm_final[c0 + j];
                *(f32x4*)(a.out + (size_t)row * DM + c0) = (f32x4){o[0], o[1], o[2], o[3]}; *(f32x4*)(a.out + (size_t)row * DM + c0 + 4) = (f32x4){o[4], o[5], o[6], o[7]}; }
        }
    }
}
DI float wave_incl_scan(float v, int lane) {
#pragma unroll
    for (int o = 1; o < 64; o <<= 1) { const float y = __shfl_up(v, o); if (lane >= o) v += y; }
    return v;
}
DI void conv8(const bf16_t* p, int pos, const float* w, int chs, const float* bias, float (&out)[8]) {
    float acc[8];
    if (bias) { const f32x4 b0 = *(const f32x4*)bias, b1 = *(const f32x4*)(bias + 4); acc[0] = b0[0]; acc[1] = b0[1]; acc[2] = b0[2]; acc[3] = b0[3]; acc[4] = b1[0]; acc[5] = b1[1]; acc[6] = b1[2]; acc[7] = b1[3]; }
    else {
#pragma unroll
        for (int i = 0; i < 8; ++i) acc[i] = 0.f; }
#pragma unroll
    for (int j = 0; j < 4; ++j) {
        if (pos - 3 + j >= 0) { const u32x4 xv = *(const u32x4*)(p - (ptrdiff_t)(3 - j) * NP); const f32x4 w0 = *(const f32x4*)(w + j * chs), w1 = *(const f32x4*)(w + j * chs + 4);
            acc[0] += w0[0] * bflo(xv.x); acc[1] += w0[1] * bfhi(xv.x); acc[2] += w0[2] * bflo(xv.y); acc[3] += w0[3] * bfhi(xv.y);
            acc[4] += w1[0] * bflo(xv.z); acc[5] += w1[1] * bfhi(xv.z); acc[6] += w1[2] * bflo(xv.w); acc[7] += w1[3] * bfhi(xv.w); } }
#pragma unroll
    for (int i = 0; i < 8; ++i) out[i] = silu_(acc[i]);
}
DI f32x4 mm16(const LAS bf16_t* A, int lda, int m0, const LAS bf16_t* Bt, int ldb, int n0, int K, int lane) {
    f32x4 acc = {0.f, 0.f, 0.f, 0.f}; const int r = lane & 15, q = lane >> 4;
    for (int k0 = 0; k0 < K; k0 += 32) { const bf16x8 av = *(const LAS bf16x8*)(A + (m0 + r) * lda + k0 + 8 * q), bv = *(const LAS bf16x8*)(Bt + (n0 + r) * ldb + k0 + 8 * q);
        acc = __builtin_amdgcn_mfma_f32_16x16x32_bf16(av, bv, acc, 0, 0, 0); }
    return acc;
}
DI void frag_store8(char* base, int nkb, int row, int k0, const float (&v)[8]) {
    const int rt = row >> 5, r = row & 31, kb = k0 >> 4, aa = (k0 >> 3) & 1;
    char* p = base + ((size_t)((rt * nkb + kb) * 64 + r)) * 16 + aa * 8;
    *(u32x2*)p = (u32x2){pk2(v[0], v[1]), pk2(v[2], v[3])};
    *(u32x2*)(p + 512) = (u32x2){pk2(v[4], v[5]), pk2(v[6], v[7])};
}
DI void export_frags(char* dst, const LAS bf16_t* M, int ld, int R, int KK, int coloff) {
    const int nkb = KK >> 4, pieces = (R >> 5) * nkb * 64;
    for (int p = ltid(); p < pieces; p += NTHREADS) { const int lane = p & 63, f = p >> 6, kb = f % nkb, rt = f / nkb, r = lane & 31, h = lane >> 5;
        const LAS bf16_t* s = M + (rt * 32 + r) * ld + coloff + kb * 16 + 4 * h;
        const u32x2 lo = *(const LAS u32x2*)s, hi = *(const LAS u32x2*)(s + 8);
        *(u32x4*)(dst + (size_t)p * 16) = (u32x4){lo.x, lo.y, hi.x, hi.y}; }
}
DI void export_acc(char* dst, const LAS bf16_t* M, int ld, int nct) {
    const int pieces = nct * 2 * 64;
    for (int p = ltid(); p < pieces; p += NTHREADS) { const int lane = p & 63, tile = p >> 6, rt = tile & 1, ct = tile >> 1, r = lane & 31, h = lane >> 5;
        unsigned w[8];
#pragma unroll
        for (int i = 0; i < 8; ++i) { const int r0 = rt * 32 + ((2 * i) & 3) + 8 * ((2 * i) >> 2) + 4 * h;
            w[i] = (unsigned)M[r0 * ld + ct * 32 + r] | ((unsigned)M[(r0 + 1) * ld + ct * 32 + r] << 16); }
        *(u32x4*)(dst + (size_t)p * 32) = (u32x4){w[0], w[1], w[2], w[3]}; *(u32x4*)(dst + (size_t)p * 32 + 16) = (u32x4){w[4], w[5], w[6], w[7]}; }
}

DI void prep_gla(CArgs& a, int l, int u, LAS unsigned char* lds) {
    const int tid = ltid(), wid = tid >> 6, lane = tid & 63;
    const int n = u & 63, bh = u >> 6, b = bh >> 2, h = bh & 3, T0 = b * SEQ + n * 64;
    LAS float* G = (LAS float*)lds; LAS bf16_t* QD = (LAS bf16_t*)(lds + 16640); LAS bf16_t* KI = (LAS bf16_t*)(lds + 25856); LAS bf16_t* KT = (LAS bf16_t*)(lds + 35072);
    LAS bf16_t* PB = (LAS bf16_t*)(lds + 44288); LAS bf16_t* V = (LAS bf16_t*)(lds + 53504);
    const bf16_t* P = (const bf16_t*)(a.ws + WS_R1 + R1_PROJ); const float* small = (const float*)(a.ws + WS_SMALL);
    char* ub = a.ws + WS_R1 + R1_SGLA + (size_t)u * GLA_UNIT;
    const int l_ = tid >> 3, d0 = (tid & 7) * 8; const size_t T = (size_t)(T0 + l_);
    { float lr[16];
#pragma unroll
      for (int i = 0; i < 4; ++i) { const f32x4 t = *(const f32x4*)(small + T * 32 + 4 * i); lr[4 * i] = t[0]; lr[4 * i + 1] = t[1]; lr[4 * i + 2] = t[2]; lr[4 * i + 3] = t[3]; }
      const float* w2 = a.gla_w2 + (size_t)l * 16 * 256 + h * 64 + d0; const float* b2 = a.gla_b2 + l * 256 + h * 64 + d0;
      float s[8];
#pragma unroll
      for (int i = 0; i < 8; ++i) s[i] = b2[i];
#pragma unroll
      for (int j = 0; j < 16; ++j) { const f32x4 w0 = *(const f32x4*)(w2 + j * 256), w1 = *(const f32x4*)(w2 + j * 256 + 4);
          s[0] += lr[j] * w0[0]; s[1] += lr[j] * w0[1]; s[2] += lr[j] * w0[2]; s[3] += lr[j] * w0[3]; s[4] += lr[j] * w1[0]; s[5] += lr[j] * w1[1]; s[6] += lr[j] * w1[2]; s[7] += lr[j] * w1[3]; }
#pragma unroll
      for (int i = 0; i < 8; ++i) G[l_ * 65 + d0 + i] = -softplus_(-s[i]) * (1.f / 16.f); }
    __syncthreads();
    { LAS float* SEG = (LAS float*)(lds + 70912);
      const int d = tid & 63, sg = tid >> 6; float run = 0.f, vv[8];
#pragma unroll
      for (int i = 0; i < 8; ++i) { run += G[(sg * 8 + i) * 65 + d]; vv[i] = run; }
      SEG[sg * 64 + d] = run;
      __syncthreads();
      float pre = 0.f;
#pragma unroll
      for (int s2 = 0; s2 < 8; ++s2) pre += (s2 < sg) ? SEG[s2 * 64 + d] : 0.f;
#pragma unroll
      for (int i = 0; i < 8; ++i) G[(sg * 8 + i) * 65 + d] = vv[i] + pre; }
    __syncthreads();
    { const u32x4 q8 = *(const u32x4*)(P + T * NP + PC_GLA_Q + h * 64 + d0), k8 = *(const u32x4*)(P + T * NP + PC_GLA_K + h * 64 + d0);
      const float qf[8] = {bflo(q8.x), bfhi(q8.x), bflo(q8.y), bfhi(q8.y), bflo(q8.z), bfhi(q8.z), bflo(q8.w), bfhi(q8.w)};
      const float kf[8] = {bflo(k8.x), bfhi(k8.x), bflo(k8.y), bfhi(k8.y), bflo(k8.z), bfhi(k8.z), bflo(k8.w), bfhi(k8.w)};
      float qd[8], ki[8];
#pragma unroll
      for (int i = 0; i < 8; ++i) { const float bc = G[l_ * 65 + d0 + i], bl = G[63 * 65 + d0 + i]; qd[i] = qf[i] * 0.125f * __expf(bc); ki[i] = kf[i] * __expf(-bc);
          KT[(d0 + i) * 72 + l_] = f2bf(kf[i] * __expf(bl - bc)); }
      *(LAS u32x4*)(QD + l_ * 72 + d0) = (u32x4){pk2(qd[0], qd[1]), pk2(qd[2], qd[3]), pk2(qd[4], qd[5]), pk2(qd[6], qd[7])};
      *(LAS u32x4*)(KI + l_ * 72 + d0) = (u32x4){pk2(ki[0], ki[1]), pk2(ki[2], ki[3]), pk2(ki[4], ki[5]), pk2(ki[6], ki[7])};
      frag_store8(ub + GLA_OQ, 4, l_, d0, qd); }
    if (tid < 64) ((float*)(ub + GLA_OD))[tid] = __expf(G[63 * 65 + tid]);
#pragma unroll
    for (int rep = 0; rep < 2; ++rep) { const int idx = rep * NTHREADS + tid, lr_ = idx >> 4, c0 = (idx & 15) * 8;
        *(LAS u32x4*)(V + lr_ * 136 + c0) = *(const u32x4*)(P + (size_t)(T0 + lr_) * NP + PC_GLA_V + h * 128 + c0); }
    __syncthreads();
#pragma unroll
    for (int t2 = 0; t2 < 2; ++t2) { const int t = wid * 2 + t2, mt = t >> 2, nt = t & 3; const f32x4 acc = mm16(QD, 72, mt * 16, KI, 72, nt * 16, 64, lane);
        const int r = lane & 15, q = lane >> 4, m = nt * 16 + r;
#pragma unroll
        for (int j = 0; j < 4; ++j) { const int lrow = mt * 16 + 4 * q + j; PB[lrow * 72 + m] = f2bf(m <= lrow ? acc[j] : 0.f); } }
    __syncthreads();
    export_frags(ub + GLA_OP, PB, 72, 64, 64, 0);
    export_frags(ub + GLA_OK, KT, 72, 64, 64, 0);
    export_acc(ub + GLA_OU, V, 136, 4);
    __syncthreads();
}

DI void prep_ssd(CArgs& a, int l, int u, LAS unsigned char* lds) {
    const int tid = ltid(), wid = tid >> 6, lane = tid & 63;
    const int n = u & 63, bh = u >> 6, b = bh >> 3, hh = bh & 7, g = hh >> 2, T0 = b * SEQ + n * 64;
    LAS bf16_t* CC = (LAS bf16_t*)lds; LAS bf16_t* CBm = (LAS bf16_t*)(lds + 9216); LAS bf16_t* KT = (LAS bf16_t*)(lds + 18432); LAS bf16_t* PB = (LAS bf16_t*)(lds + 27648);
    LAS bf16_t* V = (LAS bf16_t*)(lds + 36864); LAS float* SDT = (LAS float*)(lds + 46080); LAS float* SCUM = (LAS float*)(lds + 46080 + 256);
    const bf16_t* P = (const bf16_t*)(a.ws + WS_R1 + R1_PROJ); const float* small = (const float*)(a.ws + WS_SMALL);
    char* ub = a.ws + WS_R1 + R1_SSSD + (size_t)u * SSD_UNIT;
    if (tid < 64) { const float dt = softplus_(small[(size_t)(T0 + tid) * 32 + 24 + hh] + a.ssd_dt_bias[l * 8 + hh]); const float aa = -__expf(a.ssd_a_log[l * 8 + hh]);
        const float cum = wave_incl_scan(dt * aa, lane); SDT[tid] = dt; SCUM[tid] = cum; }
    __syncthreads();
    { const int l_ = tid >> 3, c8 = (tid & 7) * 8; const size_t T = (size_t)(T0 + l_); const int pos = n * 64 + l_;
      const float cl = SCUM[l_], c63 = SCUM[63], dtl = SDT[l_];
      const float* cw = a.ssd_conv_w + (size_t)l * 4 * 768; const float* cb = a.ssd_conv_b + l * 768;
      float v[8];
      { const int c = hh * 64 + c8; conv8(P + T * NP + PC_SSD_XBC + c, pos, cw + c, 768, cb + c, v);
        *(LAS u32x4*)(V + l_ * 72 + c8) = (u32x4){pk2(v[0] * dtl, v[1] * dtl), pk2(v[2] * dtl, v[3] * dtl), pk2(v[4] * dtl, v[5] * dtl), pk2(v[6] * dtl, v[7] * dtl)}; }
      { const int c = 512 + g * 64 + c8; conv8(P + T * NP + PC_SSD_XBC + c, pos, cw + c, 768, cb + c, v);
        *(LAS u32x4*)(CBm + l_ * 72 + c8) = (u32x4){pk2(v[0], v[1]), pk2(v[2], v[3]), pk2(v[4], v[5]), pk2(v[6], v[7])};
        const float ek = __expf(c63 - cl);
#pragma unroll
        for (int i = 0; i < 8; ++i) KT[(c8 + i) * 72 + l_] = f2bf(v[i] * ek); }
      { const int c = 640 + g * 64 + c8; conv8(P + T * NP + PC_SSD_XBC + c, pos, cw + c, 768, cb + c, v);
        *(LAS u32x4*)(CC + l_ * 72 + c8) = (u32x4){pk2(v[0], v[1]), pk2(v[2], v[3]), pk2(v[4], v[5]), pk2(v[6], v[7])};
        const float eq = __expf(cl); float qd[8];
#pragma unroll
        for (int i = 0; i < 8; ++i) qd[i] = v[i] * eq;
        frag_store8(ub + SSD_OQ, 4, l_, c8, qd); } }
    if (tid < 64) ((float*)(ub + SSD_OD))[tid] = __expf(SCUM[63]);
    __syncthreads();
#pragma unroll
    for (int t2 = 0; t2 < 2; ++t2) { const int t = wid * 2 + t2, mt = t >> 2, nt = t & 3; const f32x4 acc = mm16(CC, 72, mt * 16, CBm, 72, nt * 16, 64, lane);
        const int r = lane & 15, q = lane >> 4, m = nt * 16 + r; const float cm = SCUM[m];
#pragma unroll
        for (int j = 0; j < 4; ++j) { const int lrow = mt * 16 + 4 * q + j; PB[lrow * 72 + m] = f2bf(m <= lrow ? acc[j] * __expf(SCUM[lrow] - cm) : 0.f); } }
    __syncthreads();
    export_frags(ub + SSD_OP, PB, 72, 64, 64, 0);
    export_frags(ub + SSD_OK, KT, 72, 64, 64, 0);
    export_acc(ub + SSD_OU, V, 72, 2);
    __syncthreads();
}

DI void gdn_scalars(CArgs& a, int l, int h, int T0, LAS float* SB, LAS float* SC) {
    const int tid = ltid();
    if (tid < 64) { const float* small = (const float*)(a.ws + WS_SMALL) + (size_t)(T0 + tid) * 32;
        const float beta = sigmoid_(small[20 + h]); const float gg = -__expf(a.gdn_a_log[l * 4 + h]) * softplus_(small[16 + h] + a.gdn_dt_bias[l * 4 + h]);
        const float cum = wave_incl_scan(gg, tid); SB[tid] = beta; SC[tid] = cum; }
}
DI void gdn_conv_item(CArgs& a, int l, int part, int h, int T0, int n, int l_, int grp, float (&v)[8]) {
    const int c = part * 512 + h * 128 + grp * 8;
    const bf16_t* P = (const bf16_t*)(a.ws + WS_R1 + R1_PROJ);
    conv8(P + (size_t)(T0 + l_) * NP + PC_GDN_QKV + c, n * 64 + l_, a.gdn_conv_w + (size_t)l * 4 * 1536 + c, 1536, nullptr, v);
    if (part < 2) { float ss = 0.f;
#pragma unroll
        for (int i = 0; i < 8; ++i) ss += v[i] * v[i];
        ss += __shfl_xor(ss, 1); ss += __shfl_xor(ss, 2); ss += __shfl_xor(ss, 4); ss += __shfl_xor(ss, 8);
        const float rn = rsqrtf(ss + 1e-6f) * (part == 0 ? 0.08838834764831845f : 1.f);
#pragma unroll
        for (int i = 0; i < 8; ++i) v[i] *= rn; }
}
DI void gdn_prep1(CArgs& a, int l, int u, LAS unsigned char* lds, LAS float* slot) {
    const int tid = ltid(), wid = tid >> 6, lane = tid & 63;
    const int n = u & 63, bh = u >> 6, b = bh >> 2, h = bh & 3, T0 = b * SEQ + n * 64;
    LAS bf16_t* Kb = (LAS bf16_t*)lds; LAS float* SB = (LAS float*)(lds + 17408); LAS float* SC = (LAS float*)(lds + 17408 + 256);
    gdn_scalars(a, l, h, T0, SB, SC);
#pragma unroll
    for (int rep = 0; rep < 2; ++rep) { const int idx = rep * NTHREADS + tid, l_ = idx >> 4, grp = idx & 15; float v[8]; gdn_conv_item(a, l, 1, h, T0, n, l_, grp, v);
        *(LAS u32x4*)(Kb + l_ * 136 + grp * 8) = (u32x4){pk2(v[0], v[1]), pk2(v[2], v[3]), pk2(v[4], v[5]), pk2(v[6], v[7])}; }
    __syncthreads();
#pragma unroll
    for (int t2 = 0; t2 < 2; ++t2) { const int t = wid * 2 + t2, mt = t >> 2, nt = t & 3; const f32x4 acc = mm16(Kb, 136, mt * 16, Kb, 136, nt * 16, 128, lane);
        const int r = lane & 15, q = lane >> 4, m = nt * 16 + r; const float cm = SC[m];
#pragma unroll
        for (int j = 0; j < 4; ++j) { const int lrow = mt * 16 + 4 * q + j; slot[lrow * 65 + m] = (m < lrow) ? SB[lrow] * acc[j] * __expf(SC[lrow] - cm) : 0.f; } }
    __syncthreads();
}
DI void gdn_invert(LAS float* sl, bf16_t* tout, int lane) {
    for (int lrow = 0; lrow < 64; ++lrow) {
        const float arow = sl[lrow * 65 + lane]; float acc = (lane == lrow) ? 1.f : 0.f;
        int m = 0;
        for (; m + 8 <= lrow; m += 8) { float t[8];
#pragma unroll
            for (int k = 0; k < 8; ++k) t[k] = sl[(m + k) * 65 + lane];
#pragma unroll
            for (int k = 0; k < 8; ++k) acc -= __uint_as_float((unsigned)__builtin_amdgcn_readlane((int)__float_as_uint(arow), m + k)) * t[k]; }
        for (; m < lrow; ++m) { const float s = __uint_as_float((unsigned)__builtin_amdgcn_readlane((int)__float_as_uint(arow), m)); acc -= s * sl[m * 65 + lane]; }
        sl[lrow * 65 + lane] = acc;
    }
#pragma unroll 4
    for (int it = 0; it < 32; ++it) { const int rowi = it * 2 + (lane >> 5), cj = (lane & 31) * 2; ((unsigned*)tout)[rowi * 32 + (lane & 31)] = pk2(sl[rowi * 65 + cj], sl[rowi * 65 + cj + 1]); }
}
DI void gdn_prep2(CArgs& a, int l, int u, LAS unsigned char* lds) {
    const int tid = ltid(), wid = tid >> 6, lane = tid & 63;
    const int n = u & 63, bh = u >> 6, b = bh >> 2, h = bh & 3, T0 = b * SEQ + n * 64;
    LAS bf16_t* Kb = (LAS bf16_t*)lds; LAS bf16_t* Qb = (LAS bf16_t*)(lds + 17408); LAS bf16_t* SOL = (LAS bf16_t*)lds;
    LAS bf16_t* RT = (LAS bf16_t*)(lds + 34816); LAS bf16_t* KT = (LAS bf16_t*)(lds + 71680); LAS bf16_t* Tb = (LAS bf16_t*)(lds + 90112); LAS bf16_t* PB = (LAS bf16_t*)(lds + 99328);
    LAS float* SB = (LAS float*)(lds + 108544); LAS float* SC = (LAS float*)(lds + 108544 + 256);
    char* ub = a.ws + WS_R1 + R1_SGDN + (size_t)u * GDN_UNIT;
    gdn_scalars(a, l, h, T0, SB, SC);
    __syncthreads();
#pragma unroll
    for (int rep = 0; rep < 2; ++rep) { const int idx = rep * NTHREADS + tid, l_ = idx >> 4, grp = idx & 15; const float cl = SC[l_], c63 = SC[63], be = SB[l_]; float v[8];
        gdn_conv_item(a, l, 0, h, T0, n, l_, grp, v);
        *(LAS u32x4*)(Qb + l_ * 136 + grp * 8) = (u32x4){pk2(v[0], v[1]), pk2(v[2], v[3]), pk2(v[4], v[5]), pk2(v[6], v[7])};
        { const float eq = __expf(cl); float qd[8];
#pragma unroll
          for (int i = 0; i < 8; ++i) qd[i] = v[i] * eq;
          frag_store8(ub + GDN_OQ, 8, l_, grp * 8, qd); }
        gdn_conv_item(a, l, 1, h, T0, n, l_, grp, v);
        *(LAS u32x4*)(Kb + l_ * 136 + grp * 8) = (u32x4){pk2(v[0], v[1]), pk2(v[2], v[3]), pk2(v[4], v[5]), pk2(v[6], v[7])};
        { const float e1 = be * __expf(cl), e2 = __expf(c63 - cl);
#pragma unroll
          for (int i = 0; i < 8; ++i) { RT[(128 + grp * 8 + i) * 72 + l_] = f2bf(v[i] * e1); KT[(grp * 8 + i) * 72 + l_] = f2bf(v[i] * e2); } }
        gdn_conv_item(a, l, 2, h, T0, n, l_, grp, v);
#pragma unroll
        for (int i = 0; i < 8; ++i) RT[(grp * 8 + i) * 72 + l_] = f2bf(v[i] * be); }
    { const bf16_t* tsrc = (const bf16_t*)(a.ws + WS_TSCR) + (size_t)u * 4096; const int row = tid >> 3, c0 = (tid & 7) * 8;
      *(LAS u32x4*)(Tb + row * 72 + c0) = *(const u32x4*)(tsrc + row * 64 + c0); }
    if (tid < 128) ((float*)(ub + GDN_OD))[tid] = __expf(SC[63]);
    __syncthreads();
#pragma unroll
    for (int t2 = 0; t2 < 2; ++t2) { const int t = wid * 2 + t2, mt = t >> 2, nt = t & 3; const f32x4 acc = mm16(Qb, 136, mt * 16, Kb, 136, nt * 16, 128, lane);
        const int r = lane & 15, q = lane >> 4, m = nt * 16 + r; const float cm = SC[m];
#pragma unroll
        for (int j = 0; j < 4; ++j) { const int lrow = mt * 16 + 4 * q + j; PB[lrow * 72 + m] = f2bf(m <= lrow ? acc[j] * __expf(SC[lrow] - cm) : 0.f); } }
    f32x4 sacc[8];
#pragma unroll
    for (int t2 = 0; t2 < 8; ++t2) { const int t = wid * 8 + t2, mt = t & 3, ntile = t >> 2; sacc[t2] = mm16(Tb, 72, mt * 16, RT, 72, ntile * 16, 64, lane); }
    __syncthreads();
#pragma unroll
    for (int t2 = 0; t2 < 8; ++t2) { const int t = wid * 8 + t2, mt = t & 3, ntile = t >> 2; const int r = lane & 15, q = lane >> 4, cc = ntile * 16 + r; const float sg = cc < 128 ? 1.f : -1.f;
#pragma unroll
        for (int j = 0; j < 4; ++j) SOL[(mt * 16 + 4 * q + j) * 264 + cc] = f2bf(sacc[t2][j] * sg); }
    __syncthreads();
    export_frags(ub + GDN_OP, PB, 72, 64, 64, 0);
    export_frags(ub + GDN_OK, KT, 72, 128, 64, 0);
    export_frags(ub + GDN_OW, SOL, 264, 64, 128, 128);
    export_acc(ub + GDN_OU, SOL, 264, 4);
    __syncthreads();
}
DI void phase_prep(CArgs& a, int l, LAS unsigned char* lds) {
    const int wid = ltid() >> 6, lane = ltid() & 63;
    LAS float* slots = (LAS float*)(lds + 20480);
    for (int u0 = lbid(); u0 < 2048; u0 += 8 * lgrid()) {
        int nb = 0;
        for (int j = 0; j < 8; ++j) { const int u = u0 + j * lgrid(); if (u < 2048) { gdn_prep1(a, l, u, lds, slots + j * 4160); nb = j + 1; } }
        if (wid < nb) gdn_invert(slots + wid * 4160, (bf16_t*)(a.ws + WS_TSCR) + (size_t)(u0 + wid * lgrid()) * 4096, lane);
        asm volatile("s_waitcnt vmcnt(0)" ::: "memory");
        __syncthreads();
        for (int j = 0; j < nb; ++j) gdn_prep2(a, l, u0 + j * lgrid(), lds);
    }
    for (int u = lbid(); u < 2048; u += lgrid()) prep_gla(a, l, u, lds);
    for (int u = lbid(); u < 4096; u += lgrid()) prep_ssd(a, l, u, lds);
}
DI bf16x8 pack16(const f32x16& x, int s) {
    u32x4 p; p.x = pk2(x[8 * s], x[8 * s + 1]); p.y = pk2(x[8 * s + 2], x[8 * s + 3]); p.z = pk2(x[8 * s + 4], x[8 * s + 5]); p.w = pk2(x[8 * s + 6], x[8 * s + 7]);
    return __builtin_bit_cast(bf16x8, p);
}
#define MFMA32(a, b, c) __builtin_amdgcn_mfma_f32_32x32x16_bf16((a), (b), (c), 0, 0, 0)
template <int DK, bool HAS_W, int NH, int NCT, int UNIT, int OQ, int OW, int OP, int OK, int OU, int OD>
DI void scan_wg(const char* ops0, const char* ops1, char* ob0, char* ob1, LAS unsigned char* lds) {
    constexpr int NKB = DK / 16, NDT = DK / 32, BUF = NH * UNIT, OUNIT = NCT * 2 * 2048;
    static_assert(2 * BUF <= LDS_CTRL, "scan LDS");
    const int tid = ltid(), wid = __builtin_amdgcn_readfirstlane(tid >> 6), lane = tid & 63, h = lane >> 5;
    const int hd = (NH == 2) ? (wid >> 1) & 1 : 0, ct = (NH == 2) ? (wid & 1) : (wid & 3);
    static_assert(UNIT % 1024 == 0, "unit = whole 1 KiB chunks");
    auto load_step = [&](int n, int buf) {
        const int lw = wid - 4;
#pragma unroll
        for (int k = 0; k < NH; ++k) { const char* src = (k == 0 ? ops0 : ops1) + (size_t)n * UNIT + lane * 16 + lw * 1024; unsigned dst = (unsigned)(buf * BUF + k * UNIT + lw * 1024);
#pragma unroll 1
            for (int ch = lw; ch < UNIT / 1024; ch += 4) { __builtin_amdgcn_global_load_lds((const unsigned*)src, (LAS unsigned*)(lds + dst), 16, 0, 0); src += 4096; dst += 4096u; } }
        asm volatile("s_waitcnt vmcnt(0)" ::: "memory");
    };
    f32x16 S[NDT]; bf16x8 Sb[NKB];
#pragma unroll
    for (int d = 0; d < NDT; ++d)
#pragma unroll
        for (int i = 0; i < 16; ++i) S[d][i] = 0.f;
#pragma unroll
    for (int k = 0; k < NKB; ++k) Sb[k] = (bf16x8){0, 0, 0, 0, 0, 0, 0, 0};
    if (wid >= 4) load_step(0, 0);
    __syncthreads();
    char* ob = (hd == 0 ? ob0 : ob1);
    for (int n = 0; n < 64; ++n) {
        if (wid >= 4) { if (n + 1 < 64) load_step(n + 1, (n + 1) & 1); }
        else {
            const LAS unsigned char* lb = lds + (n & 1) * BUF + hd * UNIT;
            f32x16 U[2];
#pragma unroll
            for (int rt = 0; rt < 2; ++rt) { const LAS unsigned char* up = lb + OU + ((ct * 2 + rt) * 64 + lane) * 32; const u32x4 w0 = *(const LAS u32x4*)up, w1 = *(const LAS u32x4*)(up + 16);
                U[rt][0] = bflo(w0.x); U[rt][1] = bfhi(w0.x); U[rt][2] = bflo(w0.y); U[rt][3] = bfhi(w0.y); U[rt][4] = bflo(w0.z); U[rt][5] = bfhi(w0.z); U[rt][6] = bflo(w0.w); U[rt][7] = bfhi(w0.w);
                U[rt][8] = bflo(w1.x); U[rt][9] = bfhi(w1.x); U[rt][10] = bflo(w1.y); U[rt][11] = bfhi(w1.y); U[rt][12] = bflo(w1.z); U[rt][13] = bfhi(w1.z); U[rt][14] = bflo(w1.w); U[rt][15] = bfhi(w1.w); }
            if constexpr (HAS_W) {
#pragma unroll
                for (int rt = 0; rt < 2; ++rt)
#pragma unroll
                    for (int k4 = 0; k4 < NKB; k4 += 4) { bf16x8 fw[4];
#pragma unroll
                        for (int kb = 0; kb < 4; ++kb) fw[kb] = *(const LAS bf16x8*)(lb + OW + ((rt * NKB + k4 + kb) * 64 + lane) * 16);
#pragma unroll
                        for (int kb = 0; kb < 4; ++kb) U[rt] = MFMA32(fw[kb], Sb[k4 + kb], U[rt]); }
            }
            bf16x8 Ub[4];
            Ub[0] = pack16(U[0], 0); Ub[1] = pack16(U[0], 1); Ub[2] = pack16(U[1], 0); Ub[3] = pack16(U[1], 1);
#pragma unroll
            for (int rt = 0; rt < 2; ++rt) { f32x16 O;
#pragma unroll
                for (int i = 0; i < 16; ++i) O[i] = 0.f;
                { bf16x8 fp[4];
#pragma unroll
                  for (int kb = 0; kb < 4; ++kb) fp[kb] = *(const LAS bf16x8*)(lb + OP + ((rt * 4 + kb) * 64 + lane) * 16);
#pragma unroll
                  for (int kb = 0; kb < 4; ++kb) O = MFMA32(fp[kb], Ub[kb], O); }
#pragma unroll
                for (int k4 = 0; k4 < NKB; k4 += 4) { bf16x8 fq[4];
#pragma unroll
                    for (int kb = 0; kb < 4; ++kb) fq[kb] = *(const LAS bf16x8*)(lb + OQ + ((rt * NKB + k4 + kb) * 64 + lane) * 16);
#pragma unroll
                    for (int kb = 0; kb < 4; ++kb) O = MFMA32(fq[kb], Sb[k4 + kb], O); }
                char* op = ob + (size_t)n * OUNIT + ((ct * 2 + rt) * 64 + lane) * 32;
                *(u32x4*)op = (u32x4){pk2(O[0], O[1]), pk2(O[2], O[3]), pk2(O[4], O[5]), pk2(O[6], O[7])};
                *(u32x4*)(op + 16) = (u32x4){pk2(O[8], O[9]), pk2(O[10], O[11]), pk2(O[12], O[13]), pk2(O[14], O[15])}; }
#pragma unroll
            for (int d = 0; d < NDT; ++d) {
#pragma unroll
                for (int g = 0; g < 4; ++g) { const f32x4 dv = *(const LAS f32x4*)(lb + OD + (d * 32 + 8 * g + 4 * h) * 4);
                    S[d][4 * g] *= dv[0]; S[d][4 * g + 1] *= dv[1]; S[d][4 * g + 2] *= dv[2]; S[d][4 * g + 3] *= dv[3]; }
                bf16x8 fk[4];
#pragma unroll
                for (int kb = 0; kb < 4; ++kb) fk[kb] = *(const LAS bf16x8*)(lb + OK + ((d * 4 + kb) * 64 + lane) * 16);
#pragma unroll
                for (int kb = 0; kb < 4; ++kb) S[d] = MFMA32(fk[kb], Ub[kb], S[d]);
                Sb[2 * d] = pack16(S[d], 0); Sb[2 * d + 1] = pack16(S[d], 1); }
        }
        __syncthreads();
    }
}
DI void phase_scan(CArgs& a, LAS unsigned char* lds) {
    char* r1 = a.ws + WS_R1; char* obuf = r1 + R1_OBUF;
    for (int it = lbid(); it < 96; it += lgrid()) {
        if (it < 32) { const char* ops = r1 + R1_SGDN + (size_t)it * 64 * GDN_UNIT; char* ob = obuf + OB_GDN + (size_t)it * 64 * 16384;
            scan_wg<128, true, 1, 4, GDN_UNIT, GDN_OQ, GDN_OW, GDN_OP, GDN_OK, GDN_OU, GDN_OD>(ops, ops, ob, ob, lds); }
        else if (it < 64) { const int i2 = it - 32; const char* ops = r1 + R1_SGLA + (size_t)i2 * 64 * GLA_UNIT; char* ob = obuf + OB_GLA + (size_t)i2 * 64 * 16384;
            scan_wg<64, false, 1, 4, GLA_UNIT, GLA_OQ, 0, GLA_OP, GLA_OK, GLA_OU, GLA_OD>(ops, ops, ob, ob, lds); }
        else { const int i2 = (it - 64) * 2; const char* ops = r1 + R1_SSSD + (size_t)i2 * 64 * SSD_UNIT; char* ob = obuf + OB_SSD + (size_t)i2 * 64 * 8192;
            scan_wg<64, false, 2, 2, SSD_UNIT, SSD_OQ, 0, SSD_OP, SSD_OK, SSD_OU, SSD_OD>(ops, ops + (size_t)64 * SSD_UNIT, ob, ob + (size_t)64 * 8192, lds); }
    }
}

DI float otile_ld(const LAS unsigned char* tl, int l_, int e) {
    const int ct = e >> 5, r = e & 31, rt = l_ >> 5, lr = l_ & 31, h = (lr >> 2) & 1, i = (lr & 3) + 4 * (lr >> 3);
    return bf2f(*(const LAS bf16_t*)(tl + ((ct * 2 + rt) * 64 + h * 32 + r) * 32 + i * 2));
}
DI void phase_post(CArgs& a, int l, LAS unsigned char* lds) {
    const int tid = ltid(); char* r1 = a.ws + WS_R1; const bf16_t* P = (const bf16_t*)(r1 + R1_PROJ); const char* obuf = r1 + R1_OBUF; bf16_t* Y = (bf16_t*)(r1 + R1_YMIX);
    const int l_ = tid >> 3, sub = tid & 7;
    for (int u = lbid(); u < 5120; u += lgrid()) {
        if (u < 4096) {
            const int ty = u >> 11, uu = u & 2047, n = uu & 63, bh = uu >> 6, b = bh >> 2, h = bh & 3; const size_t T = (size_t)b * SEQ + n * 64 + l_;
            const char* src = obuf + (ty ? OB_GDN : OB_GLA) + (size_t)uu * 16384;
#pragma unroll
            for (int rep = 0; rep < 2; ++rep) { const int i = rep * NTHREADS + tid; *(LAS u32x4*)(lds + i * 16) = *(const u32x4*)(src + (size_t)i * 16); }
            __syncthreads();
            float o[16]; float ss = 0.f;
#pragma unroll
            for (int j = 0; j < 16; ++j) { o[j] = otile_ld(lds, l_, sub * 16 + j); ss += o[j] * o[j]; }
            ss += __shfl_xor(ss, 1); ss += __shfl_xor(ss, 2); ss += __shfl_xor(ss, 4);
            const float rs = rsqrtf(ss * (1.f / 128.f) + 1e-6f);
            const float* ng = (ty ? a.gdn_norm : a.gla_norm) + l * 128 + sub * 16;
            const bf16_t* gp = P + T * NP + (ty ? PC_GDN_G : PC_GLA_R) + h * 128 + sub * 16;
            const u32x4 g0 = *(const u32x4*)gp, g1 = *(const u32x4*)(gp + 8);
            const float gv[16] = {bflo(g0.x), bfhi(g0.x), bflo(g0.y), bfhi(g0.y), bflo(g0.z), bfhi(g0.z), bflo(g0.w), bfhi(g0.w), bflo(g1.x), bfhi(g1.x), bflo(g1.y), bfhi(g1.y), bflo(g1.z), bfhi(g1.z), bflo(g1.w), bfhi(g1.w)};
            float y[16];
#pragma unroll
            for (int j = 0; j < 16; ++j) y[j] = o[j] * rs * ng[j] * silu_(gv[j]);
            bf16_t* yp = Y + ((size_t)ty * NTOK + T) * 512 + h * 128 + sub * 16;
            *(u32x4*)yp = (u32x4){pk2(y[0], y[1]), pk2(y[2], y[3]), pk2(y[4], y[5]), pk2(y[6], y[7])};
            *(u32x4*)(yp + 8) = (u32x4){pk2(y[8], y[9]), pk2(y[10], y[11]), pk2(y[12], y[13]), pk2(y[14], y[15])};
            __syncthreads();
        } else {
            const int uu = u - 4096, n = uu & 63, bg = uu >> 6, b = bg >> 1, g = bg & 1; const size_t T = (size_t)b * SEQ + n * 64 + l_;
#pragma unroll
            for (int rep = 0; rep < 4; ++rep) { const int i = rep * NTHREADS + tid, hq = i >> 9, ii = i & 511;
                *(LAS u32x4*)(lds + i * 16) = *(const u32x4*)(obuf + OB_SSD + ((size_t)((b * 8 + g * 4 + hq) * 64 + n)) * 8192 + (size_t)ii * 16); }
            __syncthreads();
            const int hq = sub >> 1, hh = g * 4 + hq, p0 = (sub & 1) * 32; const float dsk = a.ssd_d[l * 8 + hh];
            float y[32]; float ss = 0.f;
#pragma unroll
            for (int c8 = 0; c8 < 4; ++c8) { const int ch = hh * 64 + p0 + c8 * 8; float xc[8];
                conv8(P + T * NP + PC_SSD_XBC + ch, n * 64 + l_, a.ssd_conv_w + (size_t)l * 4 * 768 + ch, 768, a.ssd_conv_b + l * 768 + ch, xc);
                const u32x4 z8 = *(const u32x4*)(P + T * NP + PC_SSD_Z + ch);
                const float zf[8] = {bflo(z8.x), bfhi(z8.x), bflo(z8.y), bfhi(z8.y), bflo(z8.z), bfhi(z8.z), bflo(z8.w), bfhi(z8.w)};
#pragma unroll
                for (int j = 0; j < 8; ++j) { const float ov = otile_ld(lds + hq * 8192, l_, p0 + c8 * 8 + j); const float yv = (ov + dsk * xc[j]) * silu_(zf[j]); y[c8 * 8 + j] = yv; ss += yv * yv; } }
            ss += __shfl_xor(ss, 1); ss += __shfl_xor(ss, 2); ss += __shfl_xor(ss, 4);
            const float rs = rsqrtf(ss * (1.f / 256.f) + 1e-6f);
            const float* ng = a.ssd_norm + l * 512 + hh * 64 + p0;
            bf16_t* yp = Y + ((size_t)2 * NTOK + T) * 512 + hh * 64 + p0;
#pragma unroll
            for (int c8 = 0; c8 < 4; ++c8) { float t[8];
#pragma unroll
                for (int j = 0; j < 8; ++j) t[j] = y[c8 * 8 + j] * rs * ng[c8 * 8 + j];
                *(u32x4*)(yp + c8 * 8) = (u32x4){pk2(t[0], t[1]), pk2(t[2], t[3]), pk2(t[4], t[5]), pk2(t[6], t[7])}; }
            __syncthreads();
        }
    }
}
DI CArgs& load_args() { CArgs* p = (CArgs*)__builtin_amdgcn_kernarg_segment_ptr(); asm volatile("" : "+s"(p)); return *p; }
DI void grid_sync(LAS unsigned char* lds) {
    CArgs& a = load_args(); XcdBarrier b; b.bar = (unsigned*)(a.ws + WS_CTL); b.x = xb_xcc_id(); b.st = (volatile LAS unsigned*)(lds + LDS_CTRL); xcd_barrier(b); }
__global__ void __launch_bounds__(NTHREADS, 2) fwd_kernel(Args a_unused) {
    extern __shared__ __attribute__((aligned(16))) unsigned char lds_raw[];
    LAS unsigned char* lds = (LAS unsigned char*)lds_raw;
    const int tid = ltid();
    if (tid < 256) ((LAS unsigned*)(lds + LDS_CTRL))[tid] = 0u;
    __syncthreads();
    { CArgs& a = load_args(); (void)xcd_barrier_post((unsigned*)(a.ws + WS_CTL), (volatile LAS unsigned*)(lds + LDS_CTRL)); }
    const int G = lgrid(), c = lbid();
#ifndef REP_CVT
#define REP_CVT 1
#endif
#ifndef REP_INPROJ
#define REP_INPROJ 1
#endif
#ifndef REP_PREP
#define REP_PREP 1
#endif
#ifndef REP_SCAN
#define REP_SCAN 1
#endif
#ifndef REP_POST
#define REP_POST 1
#endif
#ifndef REP_BR
#define REP_BR 1
#endif
#ifndef REP_OUT
#define REP_OUT 1
#endif
#ifndef REP_GU
#define REP_GU 1
#endif
#ifndef REP_DN
#define REP_DN 1
#endif
#ifndef REP_COMB
#define REP_COMB 1
#endif
#define REPEAT(n) for (int rep_ = 0; rep_ < (n); ++rep_)
    { CArgs& a = load_args(); phase_mod(a, lds); }
    REPEAT(REP_CVT) { CArgs& a = load_args(); phase_cvt(a, lds); }
    grid_sync(lds);
    { CArgs& a = load_args(); phase_norm0(a); }
    grid_sync(lds);
    for (int l = 0; l < 2; ++l) {
        REPEAT(REP_INPROJ) {
        { CArgs& a = load_args(); char* r1 = a.ws + WS_R1;
          pg8::StaticOrder S; S.init(NTOK, NP, DM, G, c, a.ws + WS_H, a.ws + WS_WIN + (size_t)l * NP * DM * 2);
          EpiProj E{(bf16_t*)(r1 + R1_PROJ), (float*)(a.ws + WS_SMALL)};
          pg8::gemm_phase<EpiProj, pg8::StaticOrder>(lds, DM, S, E); }
        grid_sync(lds); }
        REPEAT(REP_PREP) { { CArgs& a = load_args(); phase_prep(a, l, lds); }
        grid_sync(lds); }
        REPEAT(REP_SCAN) { { CArgs& a = load_args(); phase_scan(a, lds); }
        grid_sync(lds); }
        REPEAT(REP_POST) { { CArgs& a = load_args(); phase_post(a, l, lds); }
        grid_sync(lds); }
        REPEAT(REP_BR) {
        { CArgs& a = load_args(); char* r1 = a.ws + WS_R1;
          pg8::StaticOrder S; S.init(NTOK, 3072, 512, G, c, r1 + R1_YMIX, a.ws + WS_WBR + (size_t)l * 3 * DM * 512 * 2); S.pn_per_a = 4; S.a_pnstride = (size_t)NTOK * 512 * 2;
          EpiGate E{(const bf16_t*)(r1 + R1_PROJ), a.b_merge + l * 3072, (bf16_t*)(r1 + R1_GATED)};
          pg8::gemm_phase<EpiGate, pg8::StaticOrder>(lds, 512, S, E); }
        grid_sync(lds); }
        REPEAT(REP_OUT) {
        { CArgs& a = load_args(); char* r1 = a.ws + WS_R1;
          pg8::StaticOrder S; S.init(NTOK, DM, 3072, G, c, r1 + R1_GATED, a.ws + WS_WOUT + (size_t)l * DM * 3072 * 2);
          EpiResid E{(l == 0) ? a.x : (const float*)(a.ws + WS_XB), (float*)(a.ws + WS_XA), (const float*)(a.ws + WS_MOD) + (size_t)l * 8 * 6144 + 2048};
          pg8::gemm_phase<EpiResid, pg8::StaticOrder>(lds, 3072, S, E); }
        grid_sync(lds); }
        { CArgs& a = load_args(); phase_router(a, l, (const float*)(a.ws + WS_XA), lds); }
        grid_sync(lds);
        REPEAT(REP_GU) {
        { CArgs& a = load_args(); char* r1 = a.ws + WS_R1;
          moe_tables((const int*)(a.ws + WS_CNT) + l * 32 * 64, lds);
          MoeOrder<true> S{8, G, c, (const LAS int*)(lds + LDS_CTRL + 64), (const LAS int*)(lds + LDS_CTRL + 256), (const char*)(a.ws + WS_H), a.ws + WS_WGU + (size_t)l * NEXP * 2048 * DM,
                           (size_t)2048 * DM, (size_t)256 * DM, (const int*)(a.ws + WS_ROWTOK)};
          EpiSwiglu E{(unsigned char*)(r1 + R1_ACT), a.b_gu + (size_t)l * NEXP * 2048};
          pg8::gemm_phase<EpiSwiglu, MoeOrder<true>, true>(lds, DM / 2, S, E); }
        grid_sync(lds); }
        REPEAT(REP_DN) {
        { CArgs& a = load_args(); char* r1 = a.ws + WS_R1;
          MoeOrder<false> S{4, G, c, (const LAS int*)(lds + LDS_CTRL + 64), (const LAS int*)(lds + LDS_CTRL + 256), (const char*)(r1 + R1_ACT), a.ws + WS_WDN + (size_t)l * NEXP * DM * DM,
                            (size_t)DM * DM, (size_t)256 * DM, nullptr};
          EpiDown E{(bf16_t*)(r1 + R1_YS), a.b_dn + (size_t)l * NEXP * DM};
          pg8::gemm_phase<EpiDown, MoeOrder<false>, true>(lds, DM / 2, S, E); }
        grid_sync(lds); }
        REPEAT(REP_COMB) { { CArgs& a = load_args(); phase_combine(a, l, (const float*)(a.ws + WS_XA), (float*)(a.ws + WS_XB), lds); }
        grid_sync(lds); }
    }
}

extern "C" void kernel_launch(void* const* d_in, const int* in_sizes, int n_in, void* d_out, int out_size, void* d_ws, size_t ws_size, hipStream_t stream) {
    static int grid = 0;
    if (grid == 0) {
        if (n_in != 32 || ws_size < WS_END) { fprintf(stderr, "kernel_launch: unexpected inputs (n_in %d, ws %zu, need %zu)\n", n_in, ws_size, (size_t)WS_END); grid = -1; return; }
        int dev = 0, cus = 0, per_cu = 0;
        if (hipGetDevice(&dev) != hipSuccess || hipDeviceGetAttribute(&cus, hipDeviceAttributeMultiprocessorCount, dev) != hipSuccess) { grid = -1; return; }
        if (hipFuncSetAttribute((const void*)fwd_kernel, hipFuncAttributeMaxDynamicSharedMemorySize, LDS_BYTES) != hipSuccess) { fprintf(stderr, "kernel_launch: hipFuncSetAttribute failed\n"); grid = -1; return; }
        if (hipOccupancyMaxActiveBlocksPerMultiprocessor(&per_cu, (const void*)fwd_kernel, NTHREADS, LDS_BYTES) != hipSuccess || per_cu < 1) { fprintf(stderr, "kernel_launch: occupancy query says %d\n", per_cu); grid = -1; return; }
        grid = cus;
    }
    if (grid < 0) return;
    (void)hipMemsetAsync((char*)d_ws + WS_CTL, 0, 65536, stream);
    Args a{};
    const float** pp = (const float**)&a;
    for (int i = 0; i < 32; ++i) pp[i] = (const float*)d_in[i];
    a.out = (float*)d_out; a.ws = (char*)d_ws;
    hipLaunchKernelGGL(fwd_kernel, dim3(grid), dim3(NTHREADS), LDS_BYTES, stream, a);
}
```

```cpp
#include <hip/hip_runtime.h>
#include <cstdio>
#include <cstdint>
#define DI __device__ __forceinline__
#define LAS __attribute__((address_space(3)))
typedef unsigned short bf16_t;
typedef short bf16x8 __attribute__((ext_vector_type(8)));
typedef float f32x4 __attribute__((ext_vector_type(4)));
typedef float f32x2 __attribute__((ext_vector_type(2)));
typedef float f32x16 __attribute__((ext_vector_type(16)));
typedef unsigned u32x4 __attribute__((ext_vector_type(4)));
typedef unsigned u32x2 __attribute__((ext_vector_type(2)));
typedef __bf16 hbf16x2 __attribute__((ext_vector_type(2)));

DI int ltid() { int t = threadIdx.x; asm volatile("" : "+v"(t)); return t; }
DI int lbid() { int t = blockIdx.x; asm volatile("" : "+s"(t)); return t; }
DI int lgrid() { int t = gridDim.x; asm volatile("" : "+s"(t)); return t; }
DI unsigned pk2(float a, float b) { f32x2 v = {a, b}; hbf16x2 r = __builtin_convertvector(v, hbf16x2); return __builtin_bit_cast(unsigned, r); }
DI float bflo(unsigned w) { return __uint_as_float(w << 16); }
DI float bfhi(unsigned w) { return __uint_as_float(w & 0xffff0000u); }
DI float bf2f(bf16_t v) { return __uint_as_float(((unsigned)v) << 16); }
DI bf16_t f2bf(float a) { return (bf16_t)(pk2(a, 0.f) & 0xffffu); }
DI float sigmoid_(float x) { return 1.f / (1.f + __expf(-x)); }
DI float silu_(float x) { return x / (1.f + __expf(-x)); }
DI float softplus_(float x) { return fmaxf(x, 0.f) + log1pf(__expf(-fabsf(x))); }

namespace pg8 {
constexpr int BM = 256, BK = 64, HALF = 128, HTB = HALF * BK * 2, STAGE_BYTES = 8 * HTB, NXCD = 8, WGM = 8;
__host__ __device__ __forceinline__ int lds_byte(int r, int c) { const int st = (r >> 4) * 2 + (c >> 5), rr = r & 15, cc = c & 31, ob = rr * 64 + cc * 2; return st * 1024 + (ob ^ (((ob >> 9) & 1) << 5)); }
__host__ __device__ __forceinline__ void stage_rc(int b, int& R, int& C) { const int st = b / 1024, sb = b % 1024, swz = sb ^ (((sb >> 9) & 1) << 5); R = (st >> 1) * 16 + swz / 64; C = (st & 1) * 32 + (swz % 64) / 2; }
__host__ __device__ __forceinline__ int perm32(int rho) { const int n = rho >> 4, i = rho & 15; return 8 * (i >> 2) + 4 * n + (i & 3); }

struct Unit { int pm, pn, e, cnt; };

struct StaticOrder {
    static constexpr bool GATHER = false;
    int nM, nN, nwg, G, c;
    const char* A; const char* Bt; size_t a_tstep, b_tstep, a_pnstride; int pn_per_a;
    DI void init(int M, int N, int K, int G_, int c_, const void* A_, const void* Bt_) { nM = M / BM; nN = N / BM; nwg = nM * nN; G = G_; c = c_; A = (const char*)A_; Bt = (const char*)Bt_; a_tstep = (size_t)BM * K * 2; b_tstep = (size_t)BM * K * 2; a_pnstride = 0; pn_per_a = 1 << 30; }
    DI bool next(int i, Unit& u) const {
        const long L = (long)i * G + c; if (L >= nwg) return false;
        int wgid = (int)L; { const int q = nwg / NXCD, r = nwg % NXCD, xcd = wgid % NXCD, off = wgid / NXCD; wgid = (xcd < r ? xcd * (q + 1) : r * (q + 1) + (xcd - r) * q) + off; }
        const int nig = WGM * nN, gid = wgid / nig, fm = gid * WGM, gsz = (nM - fm) < WGM ? (nM - fm) : WGM;
        u.pm = fm + ((wgid % nig) % gsz); u.pn = (wgid % nig) / gsz; u.e = 0; u.cnt = 256; return true;
    }
    DI const char* a_ptr(const Unit& u) const { return A + (size_t)(u.pn / pn_per_a) * a_pnstride + (size_t)u.pm * a_tstep; }
    DI const char* b_ptr(const Unit& u) const { return Bt + (size_t)u.pn * b_tstep; }
    DI int a_row(const Unit&, int) const { return 0; }
};

typedef int i32x4 __attribute__((ext_vector_type(4)));
typedef int i32x8 __attribute__((ext_vector_type(8)));
struct BranchOrder : StaticOrder {
    DI bool next(int i, Unit& u) const { if (!StaticOrder::next(i / 3, u)) return false; u.pn += 4 * (i % 3); return true; }
};
template <class Epi, class Sched, bool FP8 = false, bool ALIGN_EPI = true>
DI void gemm_phase(LAS unsigned char* lds, const int K, const Sched& S, const Epi& E) {
    constexpr bool GATHER = Sched::GATHER;
    const int tid = ltid(), wid = __builtin_amdgcn_readfirstlane(tid >> 6), lane = tid & 63, wr = wid >> 2, wc = wid & 3, fr = lane & 15, fq = lane >> 4;
    const int nt = K / BK;
    unsigned voffA[2], voffB[2]; int RA[2], CA[2];
#pragma unroll
    for (int i = 0; i < 2; ++i) { int R, C; stage_rc(tid * 16 + i * 8192, R, C); const int Rb = Epi::PERM ? ((R & ~31) + perm32(R & 31)) : R; RA[i] = R; CA[i] = C;
        voffA[i] = (unsigned)(R * K + C) * 2u; voffB[i] = (unsigned)(Rb * K + C) * 2u; }
    const size_t kstep = (size_t)(BK * 2);
    const size_t hstepB = (size_t)HALF * K * 2;
    const size_t hstepA = GATHER ? 0 : hstepB;
    const unsigned ldsw = (unsigned)wid * 1024u;
    const int aoff = lds_byte(wr * 64 + fr, fq * 8), boff = lds_byte(wc * 32 + fr, fq * 8);
#define PG8_SA(b, h) (((b) * 2 + (h)) * HTB)
#define PG8_SB(b, h) ((4 + (b) * 2 + (h)) * HTB)
#define PG8_STAGE(bufoff, gbase, voff) do { _Pragma("unroll") for (int _i = 0; _i < 2; ++_i) \
        __builtin_amdgcn_global_load_lds((const unsigned*)((const char*)(gbase) + (voff)[_i]), (LAS unsigned*)(lds + (bufoff) + ldsw + _i * 8192), 16, 0, 0); } while (0)
#define PG8_CAT(x, y) __builtin_shufflevector(__builtin_bit_cast(i32x4, x), __builtin_bit_cast(i32x4, y), 0, 1, 2, 3, 4, 5, 6, 7)
#define PG8_LDA8(dst, b, h) do { _Pragma("unroll") for (int m = 0; m < 4; ++m) dst[m] = PG8_CAT(*(const LAS bf16x8*)(lds + PG8_SA(b, h) + aoff + m * 2048), *(const LAS bf16x8*)(lds + PG8_SA(b, h) + aoff + m * 2048 + 1024)); } while (0)
#define PG8_LDB8(dst, b, h) do { _Pragma("unroll") for (int n = 0; n < 2; ++n) dst[n] = PG8_CAT(*(const LAS bf16x8*)(lds + PG8_SB(b, h) + boff + n * 2048), *(const LAS bf16x8*)(lds + PG8_SB(b, h) + boff + n * 2048 + 1024)); } while (0)
#define PG8_MMA8(ai, bj, At, Bt) do { __builtin_amdgcn_s_setprio(1); _Pragma("unroll") for (int m = 0; m < 4; ++m) _Pragma("unroll") for (int n = 0; n < 2; ++n) \
        asm volatile("v_mfma_scale_f32_16x16x128_f8f6f4 %0, %1, %2, %0, %3, %3 op_sel_hi:[0,0,0]" : "+v"(acc[ai][bj][m][n]) : "v"(Bt[n]), "v"(At[m]), "v"(one_scale)); __builtin_amdgcn_s_setprio(0); } while (0)
#define PG8_LDA(dst, b, h) do { _Pragma("unroll") for (int m = 0; m < 4; ++m) _Pragma("unroll") for (int k = 0; k < 2; ++k) dst[m][k] = *(const LAS bf16x8*)(lds + PG8_SA(b, h) + aoff + m * 2048 + k * 1024); } while (0)
#define PG8_LDB(dst, b, h) do { _Pragma("unroll") for (int n = 0; n < 2; ++n) _Pragma("unroll") for (int k = 0; k < 2; ++k) dst[n][k] = *(const LAS bf16x8*)(lds + PG8_SB(b, h) + boff + n * 2048 + k * 1024); } while (0)
#define PG8_MMA(ai, bj, At, Bt) do { __builtin_amdgcn_s_setprio(1); _Pragma("unroll") for (int m = 0; m < 4; ++m) _Pragma("unroll") for (int n = 0; n < 2; ++n) _Pragma("unroll") for (int k = 0; k < 2; ++k) \
        acc[ai][bj][m][n] = __builtin_amdgcn_mfma_f32_16x16x32_bf16(Bt[n][k], At[m][k], acc[ai][bj][m][n], 0, 0, 0); __builtin_amdgcn_s_setprio(0); } while (0)
#define PG8_WAIT_V(n) asm volatile("s_waitcnt vmcnt(" #n ")" ::: "memory")
#define PG8_WAIT_L(n) asm volatile("s_waitcnt lgkmcnt(" #n ")" ::: "memory")
#define PG8_BAR __builtin_amdgcn_s_barrier()
#define PG8_SCHED __builtin_amdgcn_sched_barrier(0)
    Unit cur, nxt; int ui = 0;
    if (!S.next(0, cur)) return;
    f32x4 acc[2][2][4][2];
#pragma unroll
    for (int a = 0; a < 2; ++a)
#pragma unroll
        for (int b = 0; b < 2; ++b)
#pragma unroll
            for (int m = 0; m < 4; ++m)
#pragma unroll
                for (int n = 0; n < 2; ++n) acc[a][b][m][n] = (f32x4){0.f, 0.f, 0.f, 0.f};
    bf16x8 At[4][2], B0[2][2], B1[2][2]; i32x8 Ct[4], C0[2], C1[2]; const int one_scale = 0x7f7f7f7f;
    const char* cA = S.a_ptr(cur); const char* cB = S.b_ptr(cur);
    unsigned vC0[2], vC1[2], vN0[2], vN1[2];
    if constexpr (GATHER) {
#pragma unroll
        for (int i = 0; i < 2; ++i) { vC0[i] = (unsigned)(S.a_row(cur, RA[i]) * K + CA[i]) * 2u; vC1[i] = (unsigned)(S.a_row(cur, HALF + RA[i]) * K + CA[i]) * 2u; vN0[i] = vC0[i]; vN1[i] = vC1[i]; }
    } else {
#pragma unroll
        for (int i = 0; i < 2; ++i) { vC0[i] = voffA[i]; vC1[i] = voffA[i]; vN0[i] = voffA[i]; vN1[i] = voffA[i]; }
    }
    PG8_STAGE(PG8_SB(0, 0), cB, voffB); PG8_STAGE(PG8_SB(0, 1), cB + hstepB, voffB); PG8_STAGE(PG8_SA(0, 0), cA, vC0); PG8_STAGE(PG8_SA(0, 1), cA + hstepA, vC1);
    if (wr == 1) PG8_BAR;
    PG8_WAIT_V(2); PG8_BAR;
    PG8_STAGE(PG8_SB(1, 0), cB + kstep, voffB); PG8_STAGE(PG8_SA(1, 0), cA + kstep, vC0); PG8_STAGE(PG8_SB(1, 1), cB + hstepB + kstep, voffB);
    PG8_WAIT_V(6); PG8_BAR;
    for (;;) {
        const bool has_next = S.next(ui + 1, nxt);
        const char* nA = has_next ? S.a_ptr(nxt) : cA; const char* nB = has_next ? S.b_ptr(nxt) : cB;
        if constexpr (GATHER) { if (has_next) {
#pragma unroll
            for (int i = 0; i < 2; ++i) { vN0[i] = (unsigned)(S.a_row(nxt, RA[i]) * K + CA[i]) * 2u; vN1[i] = (unsigned)(S.a_row(nxt, HALF + RA[i]) * K + CA[i]) * 2u; } } }
#pragma unroll 1
        for (int t = 0; t < nt; t += 2) {
            const bool last = (t == nt - 2);
            const char* a1 = cA + (size_t)(t + 1) * kstep;
            const char* a2 = last ? nA : cA + (size_t)(t + 2) * kstep; const char* b2 = last ? nB : cB + (size_t)(t + 2) * kstep;
            const char* a3 = a2 + kstep; const char* b3 = b2 + kstep;
            unsigned w0[2], w1[2];
            if constexpr (GATHER) { w0[0] = last ? vN0[0] : vC0[0]; w0[1] = last ? vN0[1] : vC0[1]; w1[0] = last ? vN1[0] : vC1[0]; w1[1] = last ? vN1[1] : vC1[1]; }
            else { w0[0] = voffA[0]; w0[1] = voffA[1]; w1[0] = voffA[0]; w1[1] = voffA[1]; }
            if constexpr (FP8) {
            PG8_LDB8(C0, 0, 0); PG8_LDB8(C1, 0, 1); PG8_SCHED; PG8_LDA8(Ct, 0, 0); PG8_STAGE(PG8_SA(1, 1), a1 + hstepA, vC1);
            PG8_WAIT_V(8); PG8_WAIT_L(0); PG8_BAR; PG8_MMA8(0, 0, Ct, C0); PG8_MMA8(0, 1, Ct, C1); PG8_BAR; PG8_SCHED;
            PG8_LDA8(Ct, 0, 1); PG8_STAGE(PG8_SB(0, 0), b2, voffB); PG8_STAGE(PG8_SB(0, 1), b2 + hstepB, voffB); PG8_STAGE(PG8_SA(0, 0), a2, w0);
            PG8_WAIT_V(8); PG8_WAIT_L(0); PG8_BAR; PG8_MMA8(1, 0, Ct, C0); PG8_MMA8(1, 1, Ct, C1); PG8_BAR; PG8_SCHED;
            PG8_LDB8(C0, 1, 0); PG8_LDB8(C1, 1, 1); PG8_SCHED; PG8_LDA8(Ct, 1, 0); PG8_STAGE(PG8_SA(0, 1), a2 + hstepA, w1);
            PG8_WAIT_V(8); PG8_WAIT_L(0); PG8_BAR; PG8_MMA8(0, 0, Ct, C0); PG8_MMA8(0, 1, Ct, C1); PG8_BAR; PG8_SCHED;
            PG8_LDA8(Ct, 1, 1); PG8_STAGE(PG8_SB(1, 0), b3, voffB); PG8_STAGE(PG8_SB(1, 1), b3 + hstepB, voffB); PG8_STAGE(PG8_SA(1, 0), a3, w0);
            PG8_WAIT_V(8); PG8_WAIT_L(0); PG8_BAR; PG8_MMA8(1, 0, Ct, C0); PG8_MMA8(1, 1, Ct, C1); PG8_BAR; PG8_SCHED;
                    } else {
            PG8_LDB(B0, 0, 0); PG8_LDB(B1, 0, 1); PG8_SCHED; PG8_LDA(At, 0, 0); PG8_STAGE(PG8_SA(1, 1), a1 + hstepA, vC1);
            PG8_WAIT_V(8); PG8_WAIT_L(0); PG8_BAR; PG8_MMA(0, 0, At, B0); PG8_MMA(0, 1, At, B1); PG8_BAR; PG8_SCHED;
            PG8_LDA(At, 0, 1); PG8_STAGE(PG8_SB(0, 0), b2, voffB); PG8_STAGE(PG8_SB(0, 1), b2 + hstepB, voffB); PG8_STAGE(PG8_SA(0, 0), a2, w0);
            PG8_WAIT_V(8); PG8_WAIT_L(0); PG8_BAR; PG8_MMA(1, 0, At, B0); PG8_MMA(1, 1, At, B1); PG8_BAR; PG8_SCHED;
            PG8_LDB(B0, 1, 0); PG8_LDB(B1, 1, 1); PG8_SCHED; PG8_LDA(At, 1, 0); PG8_STAGE(PG8_SA(0, 1), a2 + hstepA, w1);
            PG8_WAIT_V(8); PG8_WAIT_L(0); PG8_BAR; PG8_MMA(0, 0, At, B0); PG8_MMA(0, 1, At, B1); PG8_BAR; PG8_SCHED;
            PG8_LDA(At, 1, 1); PG8_STAGE(PG8_SB(1, 0), b3, voffB); PG8_STAGE(PG8_SB(1, 1), b3 + hstepB, voffB); PG8_STAGE(PG8_SA(1, 0), a3, w0);
            PG8_WAIT_V(8); PG8_WAIT_L(0); PG8_BAR; PG8_MMA(1, 0, At, B0); PG8_MMA(1, 1, At, B1); PG8_BAR; PG8_SCHED;
                    }
        }
        if constexpr (FP8) asm volatile("s_nop 15\n\ts_nop 15" ::: "memory");
        if constexpr (ALIGN_EPI) { if (wr == 0) PG8_BAR; }
        E(acc, cur, wr, wc, fr, fq);
        if (!has_next) break;
#pragma unroll
        for (int a = 0; a < 2; ++a)
#pragma unroll
            for (int b = 0; b < 2; ++b)
#pragma unroll
                for (int m = 0; m < 4; ++m)
#pragma unroll
                    for (int n = 0; n < 2; ++n) acc[a][b][m][n] = (f32x4){0.f, 0.f, 0.f, 0.f};
        cur = nxt; cA = nA; cB = nB; ++ui;
        if constexpr (GATHER) { vC0[0] = vN0[0]; vC0[1] = vN0[1]; vC1[0] = vN1[0]; vC1[1] = vN1[1]; }
        if constexpr (ALIGN_EPI) { if (wr == 1) PG8_BAR; }
    }
    PG8_WAIT_V(0);
    if constexpr (!ALIGN_EPI) { if (wr == 0) PG8_BAR; }
    PG8_BAR;
#undef PG8_SA
#undef PG8_SB
#undef PG8_STAGE
#undef PG8_LDA
#undef PG8_LDA8
#undef PG8_LDB8
#undef PG8_MMA8
#undef PG8_CAT
#undef PG8_LDB
#undef PG8_MMA
#undef PG8_WAIT_V
#undef PG8_WAIT_L
#undef PG8_BAR
#undef PG8_SCHED
}
}
using pg8::Unit;

#define XB_TMO      128
#define XB_XCNT(j)  (256  + 64 * (j))
#define XB_XSUB(j)  (1280 + 64 * (j))
#define XB_XGEN(j)  (2304 + 64 * (j))
#define XB_TOP      3328
#define XB_TOPGEN   3392
#define XCD_BAR_WORDS 3456
#define XB_SPIN_CAP (1u << 18)
DI unsigned xb_ld(unsigned* p)              { return __hip_atomic_load(p, __ATOMIC_RELAXED, __HIP_MEMORY_SCOPE_AGENT); }
DI unsigned xb_add(unsigned* p, unsigned v) { return __hip_atomic_fetch_add(p, v, __ATOMIC_RELAXED, __HIP_MEMORY_SCOPE_AGENT); }
DI unsigned xb_xcc_id() { return (unsigned)__builtin_amdgcn_s_getreg((3 << 11) | 20) & 0xFu; }
#define XB_SPIN(cond, bar) do { unsigned _sp = 0; while (cond) { __builtin_amdgcn_s_sleep(1); \
    if ((++_sp & 255u) == 0u) { if (xb_ld(&(bar)[XB_TMO])) break; if (_sp > XB_SPIN_CAP) { atomicAdd(&(bar)[XB_TMO], 1u); break; } } } } while (0)
struct XcdBarrier { unsigned* bar; unsigned x; volatile LAS unsigned* st; };
DI XcdBarrier xcd_barrier_post(unsigned* bar, volatile LAS unsigned* st) {
    XcdBarrier b; b.bar = bar; b.x = xb_xcc_id(); b.st = st;
    if (threadIdx.x == 0) (void)xb_add(&bar[XB_XCNT(b.x)], 1u);
    return b;
}
DI void xcd_barrier_complete(unsigned* bar, unsigned x, unsigned& nloc, unsigned& nx) {
    const unsigned G = gridDim.x * gridDim.y * gridDim.z;
    unsigned sum, cnt, mine, sp = 0u;
    for (;;) {
        sum = 0u; cnt = 0u; mine = 0u;
#pragma unroll
        for (unsigned j = 0; j < 16; ++j) { const unsigned c = xb_ld(&bar[XB_XCNT(j)]); sum += c; cnt += (c > 0u) ? 1u : 0u; mine = (j == x) ? c : mine; }
        if (sum == G) break;
        __builtin_amdgcn_s_sleep(1);
        if ((++sp & 255u) == 0u) { if (xb_ld(&bar[XB_TMO])) break; if (sp > XB_SPIN_CAP) { atomicAdd(&bar[XB_TMO], 1u); break; } }
    }
    nloc = mine > 0u ? mine : 1u; nx = cnt > 0u ? cnt : 1u;
}
DI void xcd_barrier(const XcdBarrier& b) {
    asm volatile("s_waitcnt vmcnt(0)" ::: "memory");
    __syncthreads();
    if (threadIdx.x == 0) {
        unsigned* bar = b.bar;
        __builtin_amdgcn_s_waitcnt(0);
        unsigned nloc = b.st[0], nx = b.st[1];
        if (nloc == 0u) { xcd_barrier_complete(bar, b.x, nloc, nx); b.st[0] = nloc; b.st[1] = nx; }
        const unsigned old = xb_add(&bar[XB_XSUB(b.x)], 1u);
        const unsigned gen = old / nloc;
        if (old + 1u == (gen + 1u) * nloc) {
            __builtin_amdgcn_fence(__ATOMIC_RELEASE, "agent");
            asm volatile("s_waitcnt vmcnt(0)" ::: "memory");
            const unsigned og = xb_add(&bar[XB_TOP], 1u);
            const unsigned tg = og / nx;
            if (og + 1u == (tg + 1u) * nx) xb_add(&bar[XB_TOPGEN], 1u);
            else XB_SPIN(xb_ld(&bar[XB_TOPGEN]) == tg, bar);
            __builtin_amdgcn_fence(__ATOMIC_ACQUIRE, "agent");
            xb_add(&bar[XB_XGEN(b.x)], 1u);
            asm volatile("s_waitcnt vmcnt(0)" ::: "memory");
        } else {
            XB_SPIN(xb_ld(&bar[XB_XGEN(b.x)]) == gen, bar);
            __builtin_amdgcn_fence(__ATOMIC_ACQUIRE, "agent");
            asm volatile("s_waitcnt vmcnt(0)" ::: "memory");
        }
    }
    __syncthreads();
}
constexpr int DM = 1024, NB = 8, SEQ = 4096, NTOK = NB * SEQ, NCHUNK = 64, NP = 8192, NEXP = 32;
constexpr int PC_GLA_Q = 0, PC_GLA_K = 256, PC_GLA_V = 512, PC_GLA_R = 1024, PC_GDN_QKV = 1536, PC_GDN_G = 3072, PC_SSD_Z = 3584, PC_SSD_XBC = 4096, PC_MERGE = 4864, PC_SMALL = 7936;
constexpr int IN_COLS = 7968;
constexpr int NTHREADS = 512;
#ifndef INPROJ_FP8
#define INPROJ_FP8 0
#endif
constexpr int LDS_BYTES = 155648;
constexpr int LDS_CTRL = LDS_BYTES - 1024;
constexpr int GLA_UNIT = 41984, GDN_UNIT = 74752, SSD_UNIT = 33792;
constexpr int GLA_OQ = 0, GLA_OP = 8192, GLA_OK = 16384, GLA_OU = 24576, GLA_OD = 40960;
constexpr int GDN_OQ = 0, GDN_OW = 16384, GDN_OP = 32768, GDN_OK = 40960, GDN_OU = 57344, GDN_OD = 73728;
constexpr int SSD_OQ = 0, SSD_OP = 8192, SSD_OK = 16384, SSD_OU = 24576, SSD_OD = 32768;
constexpr size_t WS_CTL = 0, WS_CNT = 16384, WS_MOD = 65536;
constexpr size_t WS_WIN = 458752, WS_WBR = WS_WIN + 33554432ull, WS_WOUT = WS_WBR + 6291456ull, WS_WGU = WS_WOUT + 12582912ull, WS_WDN = WS_WGU + 268435456ull;
constexpr size_t WS_H = WS_WDN + 134217728ull, WS_SMALL = WS_H + 67108864ull, WS_XA = WS_SMALL + 4194304ull, WS_XB = WS_XA + 134217728ull;
constexpr size_t WS_ROWTOK = WS_XB + 134217728ull, WS_TOKSLOT = WS_ROWTOK + 4194304ull, WS_GATES = WS_TOKSLOT + 524288ull, WS_TSCR = WS_GATES + 524288ull, WS_R1 = WS_TSCR + 16777216ull;
constexpr size_t R1_PROJ = 0, R1_SGLA = 536870912ull, R1_SGDN = R1_SGLA + 2048ull * GLA_UNIT, R1_SSSD = R1_SGDN + 2048ull * GDN_UNIT, R1_OBUF = R1_SSSD + 4096ull * SSD_UNIT;
constexpr size_t R1_YMIX = R1_OBUF + 100663296ull, R1_MERGED = R1_YMIX + 100663296ull, R1_END = R1_MERGED + 67108864ull, R1_GATED = R1_SGLA, R1_ACT = 0, R1_YS = 285212672ull;
constexpr size_t WS_END = WS_R1 + R1_END;
constexpr size_t OB_GLA = 0, OB_GDN = 33554432ull, OB_SSD = 67108864ull;

struct Args {
    const float *x, *c, *w_mod, *b_mod, *norm_mix, *norm_ffn, *norm_final, *w_in, *gla_w2, *gla_b2, *gla_norm, *gdn_conv_w, *gdn_a_log, *gdn_dt_bias, *gdn_norm,
        *ssd_conv_w, *ssd_conv_b, *ssd_a_log, *ssd_dt_bias, *ssd_d, *ssd_norm, *w_br_gla, *w_br_gdn, *w_br_ssd, *b_merge, *w_out, *w_router, *b_router, *w_gu, *b_gu, *w_dn, *b_dn;
    float* out; char* ws;
};
typedef const Args __attribute__((address_space(4))) CArgs;

DI void phase_mod(CArgs& a, LAS unsigned char* lds) {
    LAS float* cact = (LAS float*)lds;
    LAS float* red = (LAS float*)(lds + 32768);
    const int tid = ltid();
    for (int i = tid; i < 8192; i += NTHREADS) cact[i] = silu_(a.c[i]);
    __syncthreads();
    float* mod = (float*)(a.ws + WS_MOD);
    for (int blk = lbid(); blk < 256; blk += lgrid()) {
        const int jj = tid & 63, ks = tid >> 6, col = blk * 48 + jj;
        float s[8];
#pragma unroll
        for (int b = 0; b < 8; ++b) s[b] = 0.f;
        if (jj < 48) {
            const int l = col / 6144, j = col % 6144;
            const float* w = a.w_mod + (size_t)l * DM * 6144 + j;
            for (int k = ks * 128; k < ks * 128 + 128; ++k) { const float wv = w[(size_t)k * 6144];
#pragma unroll
                for (int b = 0; b < 8; ++b) s[b] += cact[b * 1024 + k] * wv; }
        }
#pragma unroll
        for (int b = 0; b < 8; ++b) red[(ks * 64 + jj) * 8 + b] = s[b];
        __syncthreads();
        if (tid < 48 * 8) { const int j2 = tid >> 3, b = tid & 7, col2 = blk * 48 + j2, l = col2 / 6144, j = col2 % 6144; float t = 0.f;
#pragma unroll
            for (int k2 = 0; k2 < 8; ++k2) t += red[(k2 * 64 + j2) * 8 + b];
            mod[((size_t)l * 8 + b) * 6144 + j] = t + a.b_mod[l * 6144 + j]; }
        __syncthreads();
    }
}
DI int win_dst(int c) {
    if (c < 1024) return c;
    if (c < 1040) return PC_SMALL + (c - 1024);
    if (c < 1552) return PC_GLA_R + (c - 1040);
    if (c < 3088) return PC_GDN_QKV + (c - 1552);
    if (c < 3092) return PC_SMALL + 16 + (c - 3088);
    if (c < 3096) return PC_SMALL + 20 + (c - 3092);
    if (c < 3608) return PC_GDN_G + (c - 3096);
    if (c < 4120) return PC_SSD_Z + (c - 3608);
    if (c < 4888) return PC_SSD_XBC + (c - 4120);
    if (c < 4896) return PC_SMALL + 24 + (c - 4888);
    return PC_MERGE + (c - 4896);
}
DI unsigned pk4_fp8(float a, float b, float c, float d) { int w = 0; w = __builtin_amdgcn_cvt_pk_fp8_f32(a, b, w, false); w = __builtin_amdgcn_cvt_pk_fp8_f32(c, d, w, true); return (unsigned)w; }
constexpr float W8_SCALE = 32.f, W8_INV = 1.f / 32.f;
template <int KIND, bool F8 = false> DI void cvt_tile(const float* src, int ld_src, int ncols, int k0, int n0, bf16_t* dst, int ld_dst, int kd0, LAS float* T) {
    const int tid = ltid();
    { const int jj = tid & 127, kk = tid >> 7; const bool ok = (n0 + jj) < ncols;
#pragma unroll
      for (int i = 0; i < 16; ++i) { const int k = kk + 4 * i; T[k * 129 + jj] = ok ? src[(size_t)(k0 + k) * ld_src + n0 + jj] : 0.f; } }
    __syncthreads();
    { const int j = tid >> 2, kq = tid & 3, c = n0 + j;
      if (c < ncols) {
        int drow;
        if (KIND == 0) drow = c; else if (KIND == 1) drow = (c & ~255) + (c & 1) * 128 + ((c & 255) >> 1); else drow = win_dst(c);
        u32x4 w0, w1; float v[16];
#pragma unroll
        for (int i = 0; i < 16; ++i) v[i] = T[(kq * 16 + i) * 129 + j];
        w0.x = pk2(v[0], v[1]); w0.y = pk2(v[2], v[3]); w0.z = pk2(v[4], v[5]); w0.w = pk2(v[6], v[7]);
        w1.x = pk2(v[8], v[9]); w1.y = pk2(v[10], v[11]); w1.z = pk2(v[12], v[13]); w1.w = pk2(v[14], v[15]);
        if constexpr (F8) { unsigned char* d8 = (unsigned char*)dst + (size_t)drow * ld_dst + kd0 + k0 + kq * 16;
            *(u32x4*)d8 = (u32x4){pk4_fp8(v[0] * W8_SCALE, v[1] * W8_SCALE, v[2] * W8_SCALE, v[3] * W8_SCALE), pk4_fp8(v[4] * W8_SCALE, v[5] * W8_SCALE, v[6] * W8_SCALE, v[7] * W8_SCALE),
                                  pk4_fp8(v[8] * W8_SCALE, v[9] * W8_SCALE, v[10] * W8_SCALE, v[11] * W8_SCALE), pk4_fp8(v[12] * W8_SCALE, v[13] * W8_SCALE, v[14] * W8_SCALE, v[15] * W8_SCALE)}; }
        else { bf16_t* d = dst + (size_t)drow * ld_dst + kd0 + k0 + kq * 16;
        *(u32x4*)d = w0; *(u32x4*)(d + 8) = w1; } } }
    __syncthreads();
}
DI void phase_cvt(CArgs& a, LAS unsigned char* lds) {
    LAS float* T = (LAS float*)lds;
    constexpr int T_IN = 16 * 63, T_BR = 3 * 8 * 8, T_OUT = 16 * 8, T_GU = 32 * 16 * 16, T_DN = 32 * 16 * 8, T_L = T_IN + T_BR + T_OUT + T_GU + T_DN;
    for (int g = lbid(); g < 2 * T_L; g += lgrid()) {
        const int l = g / T_L; int r = g % T_L;
        if (r < T_IN) { const int kt = r % 16, ntile = r / 16;
            cvt_tile<2, INPROJ_FP8 != 0>(a.w_in + (size_t)l * DM * IN_COLS, IN_COLS, IN_COLS, kt * 64, ntile * 128, (bf16_t*)(a.ws + WS_WIN + (size_t)l * NP * DM * (INPROJ_FP8 ? 1 : 2)), DM, 0, T); continue; }
        r -= T_IN;
        if (r < T_BR) { const int br = r / 64, kt = (r % 64) % 8, ntile = (r % 64) / 8; const float* src = (br == 0 ? a.w_br_gla : br == 1 ? a.w_br_gdn : a.w_br_ssd) + (size_t)l * 512 * DM;
            cvt_tile<0>(src, DM, DM, kt * 64, ntile * 128, (bf16_t*)(a.ws + WS_WBR) + ((size_t)l * 3 + br) * DM * 512, 512, 0, T); continue; }
        r -= T_BR;
        if (r < T_OUT) { const int kt = r % 16, ntile = r / 16;
            cvt_tile<0>(a.w_out + (size_t)l * DM * DM, DM, DM, kt * 64, ntile * 128, (bf16_t*)(a.ws + WS_WOUT) + (size_t)l * DM * DM, DM, 0, T); continue; }
        r -= T_OUT;
        if (r < T_GU) { const int e = r / 256, kt = (r % 256) % 16, ntile = (r % 256) / 16;
            cvt_tile<1, true>(a.w_gu + ((size_t)l * NEXP + e) * DM * 2048, 2048, 2048, kt * 64, ntile * 128, (bf16_t*)(a.ws + WS_WGU + ((size_t)l * NEXP + e) * 2048 * DM), DM, 0, T); continue; }
        r -= T_GU;
        { const int e = r / 128, kt = (r % 128) % 16, ntile = (r % 128) / 16;
            cvt_tile<0, true>(a.w_dn + ((size_t)l * NEXP + e) * DM * DM, DM, DM, kt * 64, ntile * 128, (bf16_t*)(a.ws + WS_WDN + ((size_t)l * NEXP + e) * DM * DM), DM, 0, T); }
    }
    { constexpr size_t RB = (size_t)DM * (INPROJ_FP8 ? 1 : 2), NV = 224 * RB / 16;
      for (size_t i = (size_t)lbid() * NTHREADS + ltid(); i < 2 * NV; i += (size_t)lgrid() * NTHREADS) { const size_t l = i / NV, rr = i % NV;
          *(u32x4*)(a.ws + WS_WIN + (l * NP + IN_COLS) * RB + rr * 16) = (u32x4){0u, 0u, 0u, 0u}; } }
}

DI float wave_sum(float v) {
#pragma unroll
    for (int o = 32; o > 0; o >>= 1) v += __shfl_xor(v, o);
    return v;
}
DI void phase_norm0(CArgs& a) {
    const int lane = ltid() & 63, gw = lbid() * 8 + (ltid() >> 6), nw = lgrid() * 8;
    const float* mod = (const float*)(a.ws + WS_MOD);
    bf16_t* H = (bf16_t*)(a.ws + WS_H);
    for (int row = gw; row < NTOK; row += nw) {
        const int b = row >> 12; const float* xr = a.x + (size_t)row * DM; const float* mb = mod + (size_t)b * 6144;
        f32x4 v[4]; float ss = 0.f;
#pragma unroll
        for (int i = 0; i < 2; ++i) { v[2 * i] = *(const f32x4*)(xr + lane * 8 + 512 * i); v[2 * i + 1] = *(const f32x4*)(xr + lane * 8 + 512 * i + 4); }
#pragma unroll
        for (int i = 0; i < 4; ++i) ss += v[i][0] * v[i][0] + v[i][1] * v[i][1] + v[i][2] * v[i][2] + v[i][3] * v[i][3];
        ss = wave_sum(ss); const float rs = rsqrtf(ss * (1.f / 1024.f) + 1e-6f);
#pragma unroll
        for (int i = 0; i < 2; ++i) { const int c0 = lane * 8 + 512 * i; float o[8];
#pragma unroll
            for (int j = 0; j < 8; ++j) { const float xv = v[2 * i + (j >> 2)][j & 3]; o[j] = xv * rs * a.norm_mix[c0 + j] * (1.f + mb[1024 + c0 + j]) + mb[c0 + j]; }
#if INPROJ_FP8
            *(u32x2*)((unsigned char*)H + (size_t)row * DM + c0) = (u32x2){pk4_fp8(o[0], o[1], o[2], o[3]), pk4_fp8(o[4], o[5], o[6], o[7])};
#else
            u32x4 w; w.x = pk2(o[0], o[1]); w.y = pk2(o[2], o[3]); w.z = pk2(o[4], o[5]); w.w = pk2(o[6], o[7]);
            *(u32x4*)(H + (size_t)row * DM + c0) = w;
#endif
        }
    }
}

struct EpiProj { static constexpr bool PERM = true; bf16_t* P; float* small; float sc;
    DI void operator()(const f32x4 (&acc)[2][2][4][2], const Unit& u, int wr, int wc, int fr, int fq) const {
        const int row0 = u.pm * 256 + wr * 64 + fr, col0 = u.pn * 256 + wc * 32 + 8 * fq;
#pragma unroll
        for (int ai = 0; ai < 2; ++ai)
#pragma unroll
            for (int m = 0; m < 4; ++m) { const int row = row0 + ai * 128 + m * 16; bf16_t* rowp = P + (size_t)row * NP + col0;
#pragma unroll
                for (int bj = 0; bj < 2; ++bj) { const f32x4 v0 = acc[ai][bj][m][0] * sc, v1 = acc[ai][bj][m][1] * sc;
                    u32x4 w; w.x = pk2(v0[0], v0[1]); w.y = pk2(v0[2], v0[3]); w.z = pk2(v1[0], v1[1]); w.w = pk2(v1[2], v1[3]);
                    *(u32x4*)(rowp + bj * 128) = w; }
                if (u.pn == 31 && wc == 0) { float* sp = small + (size_t)row * 32 + 8 * fq; *(f32x4*)sp = acc[ai][0][m][0] * sc; *(f32x4*)(sp + 4) = acc[ai][0][m][1] * sc; } }
    } };
struct EpiGate { static constexpr bool PERM = true; const bf16_t* P; const float* bmerge; bf16_t* G; bf16_t* M;
    DI void operator()(const f32x4 (&acc)[2][2][4][2], const Unit& u, int wr, int wc, int fr, int fq) const {
        const int row0 = u.pm * 256 + wr * 64 + fr, col0 = u.pn * 256 + wc * 32 + 8 * fq; const bool fin = u.pn >= 8;
        f32x4 bv[2][2];
#pragma unroll
        for (int bj = 0; bj < 2; ++bj) { bv[bj][0] = *(const f32x4*)(bmerge + col0 + bj * 128); bv[bj][1] = *(const f32x4*)(bmerge + col0 + bj * 128 + 4); }
#pragma unroll
        for (int ai = 0; ai < 2; ++ai)
#pragma unroll
            for (int m = 0; m < 4; ++m) { const size_t row = row0 + ai * 128 + m * 16;
#pragma unroll
                for (int bj = 0; bj < 2; ++bj) { const u32x4 mr = *(const u32x4*)(P + row * NP + PC_MERGE + col0 + bj * 128); const f32x4 v0 = acc[ai][bj][m][0], v1 = acc[ai][bj][m][1];
                    float o[8];
                    o[0] = v0[0] * sigmoid_(bflo(mr.x) + bv[bj][0][0]); o[1] = v0[1] * sigmoid_(bfhi(mr.x) + bv[bj][0][1]); o[2] = v0[2] * sigmoid_(bflo(mr.y) + bv[bj][0][2]); o[3] = v0[3] * sigmoid_(bfhi(mr.y) + bv[bj][0][3]);
                    o[4] = v1[0] * sigmoid_(bflo(mr.z) + bv[bj][1][0]); o[5] = v1[1] * sigmoid_(bfhi(mr.z) + bv[bj][1][1]); o[6] = v1[2] * sigmoid_(bflo(mr.w) + bv[bj][1][2]); o[7] = v1[3] * sigmoid_(bfhi(mr.w) + bv[bj][1][3]);
                    if (fin) { const int cm = col0 - 2048 + bj * 128;
                        const u32x4 g0 = *(const u32x4*)(G + row * 3072 + cm), g1 = *(const u32x4*)(G + row * 3072 + 1024 + cm);
                        o[0] += bflo(g0.x) + bflo(g1.x); o[1] += bfhi(g0.x) + bfhi(g1.x); o[2] += bflo(g0.y) + bflo(g1.y); o[3] += bfhi(g0.y) + bfhi(g1.y);
                        o[4] += bflo(g0.z) + bflo(g1.z); o[5] += bfhi(g0.z) + bfhi(g1.z); o[6] += bflo(g0.w) + bflo(g1.w); o[7] += bfhi(g0.w) + bfhi(g1.w);
                        u32x4 w; w.x = pk2(o[0], o[1]); w.y = pk2(o[2], o[3]); w.z = pk2(o[4], o[5]); w.w = pk2(o[6], o[7]);
                        *(u32x4*)(M + row * DM + cm) = w; }
                    else { u32x4 w; w.x = pk2(o[0], o[1]); w.y = pk2(o[2], o[3]); w.z = pk2(o[4], o[5]); w.w = pk2(o[6], o[7]);
                        *(u32x4*)(G + row * 3072 + col0 + bj * 128) = w; } } }
    } };
struct EpiResid { static constexpr bool PERM = false; const float* xin; float* xout; const float* gm;
    DI void operator()(const f32x4 (&acc)[2][2][4][2], const Unit& u, int wr, int wc, int fr, int fq) const {
        const int row0 = u.pm * 256 + wr * 64 + fr, col0 = u.pn * 256 + wc * 32 + 4 * fq; const int b = (u.pm * 256) >> 12;
        f32x4 gv[2][2];
#pragma unroll
        for (int bj = 0; bj < 2; ++bj)
#pragma unroll
            for (int n = 0; n < 2; ++n) gv[bj][n] = *(const f32x4*)(gm + (size_t)b * 6144 + col0 + bj * 128 + n * 16);
#pragma unroll
        for (int ai = 0; ai < 2; ++ai)
#pragma unroll
            for (int m = 0; m < 4; ++m) { const size_t off = (size_t)(row0 + ai * 128 + m * 16) * DM + col0;
#pragma unroll
                for (int bj = 0; bj < 2; ++bj)
#pragma unroll
                    for (int n = 0; n < 2; ++n) { const f32x4 xi = *(const f32x4*)(xin + off + bj * 128 + n * 16); *(f32x4*)(xout + off + bj * 128 + n * 16) = xi + gv[bj][n] * acc[ai][bj][m][n]; } }
    } };
struct EpiSwiglu { static constexpr bool PERM = true; unsigned char* act; const float* bgu;
    DI void operator()(const f32x4 (&acc)[2][2][4][2], const Unit& u, int wr, int wc, int fr, int fq) const {
        const int row0 = u.pm * 256 + wr * 64 + fr, x0 = u.pn * 128 + wc * 32 + 8 * fq;
        const float* bb = bgu + (size_t)u.e * 2048 + 2 * x0;
        float bg[8], bu[8];
#pragma unroll
        for (int i = 0; i < 4; ++i) { const f32x4 t = *(const f32x4*)(bb + 4 * i); bg[2 * i] = t[0]; bu[2 * i] = t[1]; bg[2 * i + 1] = t[2]; bu[2 * i + 1] = t[3]; }
#pragma unroll
        for (int ai = 0; ai < 2; ++ai)
#pragma unroll
            for (int m = 0; m < 4; ++m) { const size_t row = row0 + ai * 128 + m * 16; float o[8];
#pragma unroll
                for (int j = 0; j < 8; ++j) { float g = acc[ai][0][m][j >> 2][j & 3] * W8_INV + bg[j], up = acc[ai][1][m][j >> 2][j & 3] * W8_INV + bu[j];
                    g = fminf(g, 7.f); up = fminf(fmaxf(up, -7.f), 7.f); o[j] = (up + 1.f) * g * sigmoid_(1.702f * g); }
                *(u32x2*)(act + row * DM + x0) = (u32x2){pk4_fp8(o[0], o[1], o[2], o[3]), pk4_fp8(o[4], o[5], o[6], o[7])}; }
    } };
struct EpiDown { static constexpr bool PERM = true; bf16_t* ys; const float* bdn;
    DI void operator()(const f32x4 (&acc)[2][2][4][2], const Unit& u, int wr, int wc, int fr, int fq) const {
        const int row0 = u.pm * 256 + wr * 64 + fr, col0 = u.pn * 256 + wc * 32 + 8 * fq;
        f32x4 bv[2][2];
#pragma unroll
        for (int bj = 0; bj < 2; ++bj) { bv[bj][0] = *(const f32x4*)(bdn + (size_t)u.e * DM + col0 + bj * 128); bv[bj][1] = *(const f32x4*)(bdn + (size_t)u.e * DM + col0 + bj * 128 + 4); }
#pragma unroll
        for (int ai = 0; ai < 2; ++ai)
#pragma unroll
            for (int m = 0; m < 4; ++m) { const size_t row = row0 + ai * 128 + m * 16;
#pragma unroll
                for (int bj = 0; bj < 2; ++bj) { const f32x4 v0 = acc[ai][bj][m][0] * W8_INV + bv[bj][0], v1 = acc[ai][bj][m][1] * W8_INV + bv[bj][1];
                    u32x4 w; w.x = pk2(v0[0], v0[1]); w.y = pk2(v0[2], v0[3]); w.z = pk2(v1[0], v1[1]); w.w = pk2(v1[2], v1[3]);
                    *(u32x4*)(ys + row * DM + col0 + bj * 128) = w; } }
    } };

DI void moe_tables(const int* cnt  , LAS unsigned char* lds) {
    LAS int* tstart = (LAS int*)(lds + LDS_CTRL + 64); LAS int* lcnt = (LAS int*)(lds + LDS_CTRL + 256);
    if (ltid() < 64) { const int t = ltid(); const int c = t < 32 ? cnt[t * 64] : 0; int v = (c + 255) >> 8;
#pragma unroll
        for (int o = 1; o < 32; o <<= 1) { const int y = __shfl_up(v, o); if ((t & 31) >= o) v += y; }
        if (t < 32) { tstart[t + 1] = v; lcnt[t] = c; } if (t == 0) tstart[0] = 0; }
    __syncthreads();
}
template <bool G_> struct MoeOrder {
    static constexpr bool GATHER = G_;
    int nN, G, c; const LAS int* tstart; const LAS int* lcnt; const char* A; const char* Bt; size_t b_estride, tstep; const int* rowtok;
    DI bool next(int i, Unit& u) const {
        const int L = i * G + c, rt = L / nN; if (rt >= tstart[32]) return false;
        int e = 0; while (tstart[e + 1] <= rt) ++e;
        u.pm = rt; u.pn = L % nN; u.e = e; const int rem = lcnt[e] - (rt - tstart[e]) * 256; u.cnt = rem < 256 ? rem : 256; return true; }
    DI const char* a_ptr(const Unit& u) const { return GATHER ? A : A + (size_t)u.pm * tstep; }
    DI const char* b_ptr(const Unit& u) const { return Bt + (size_t)u.e * b_estride + (size_t)u.pn * tstep; }
    DI int a_row(const Unit& u, int R) const { return R < u.cnt ? rowtok[u.e * 32768 + (u.pm - tstart[u.e]) * 256 + R] : 0; }
};
DI void phase_router(CArgs& a, int l, const float* xmid, LAS unsigned char* lds) {
    const int tid = ltid(), wid = tid >> 6, lane = tid & 63, r = lane & 15, q = lane >> 4;
    LAS bf16_t* Whi = (LAS bf16_t*)lds; LAS bf16_t* Wlo = (LAS bf16_t*)(lds + 66048);
    LAS float* scr = (LAS float*)(lds + 132096 + wid * 2112);
    LAS int* hist = (LAS int*)(lds + 148992); LAS int* basep = (LAS int*)(lds + 148992 + 128);
    const float* wr_ = a.w_router + (size_t)l * DM * NEXP;
    for (int i = tid; i < DM * NEXP; i += NTHREADS) { const int k = i >> 5, e = i & 31; const float v = wr_[i]; const bf16_t hi = f2bf(v); Whi[e * 1032 + k] = hi; Wlo[e * 1032 + k] = f2bf(v - bf2f(hi)); }
    __syncthreads();
    const float* mod = (const float*)(a.ws + WS_MOD) + (size_t)l * 8 * 6144;
    const float* nf = a.norm_ffn + l * DM;
    bf16_t* H = (bf16_t*)(a.ws + WS_H);
    int* cntg = (int*)(a.ws + WS_CNT) + l * 32 * 64;
    int* rowtok = (int*)(a.ws + WS_ROWTOK); int* tokslot = (int*)(a.ws + WS_TOKSLOT); float* gates = (float*)(a.ws + WS_GATES);
    for (int blk = lbid(); blk < NTOK / 128; blk += lgrid()) {
        if (tid < 32) hist[tid] = 0;
        const int row = blk * 128 + wid * 16 + r, b = row >> 12;
        const float* xr = xmid + (size_t)row * DM; const float* mb = mod + (size_t)b * 6144;
        float ss = 0.f;
        for (int ks = 0; ks < 32; ++ks) { const f32x4 x0 = *(const f32x4*)(xr + ks * 32 + 8 * q), x1 = *(const f32x4*)(xr + ks * 32 + 8 * q + 4);
            ss += x0[0] * x0[0] + x0[1] * x0[1] + x0[2] * x0[2] + x0[3] * x0[3] + x1[0] * x1[0] + x1[1] * x1[1] + x1[2] * x1[2] + x1[3] * x1[3]; }
        ss += __shfl_xor(ss, 16); ss += __shfl_xor(ss, 32);
        const float rs = rsqrtf(ss * (1.f / 1024.f) + 1e-6f);
        f32x4 acc0 = {0.f, 0.f, 0.f, 0.f}, acc1 = {0.f, 0.f, 0.f, 0.f};
        for (int ks = 0; ks < 32; ++ks) { const int k0 = ks * 32 + 8 * q;
            const f32x4 x0 = *(const f32x4*)(xr + k0), x1 = *(const f32x4*)(xr + k0 + 4);
            float hv[8];
#pragma unroll
            for (int j = 0; j < 8; ++j) { const float xv = j < 4 ? x0[j & 3] : x1[j & 3]; hv[j] = xv * rs * nf[k0 + j] * (1.f + mb[4096 + k0 + j]) + mb[3072 + k0 + j]; }
            u32x4 hi; hi.x = pk2(hv[0], hv[1]); hi.y = pk2(hv[2], hv[3]); hi.z = pk2(hv[4], hv[5]); hi.w = pk2(hv[6], hv[7]);
            *(u32x2*)((unsigned char*)H + (size_t)row * DM + k0) = (u32x2){pk4_fp8(hv[0], hv[1], hv[2], hv[3]), pk4_fp8(hv[4], hv[5], hv[6], hv[7])};
            u32x4 lo; lo.x = pk2(hv[0] - bflo(hi.x), hv[1] - bfhi(hi.x)); lo.y = pk2(hv[2] - bflo(hi.y), hv[3] - bfhi(hi.y)); lo.z = pk2(hv[4] - bflo(hi.z), hv[5] - bfhi(hi.z)); lo.w = pk2(hv[6] - bflo(hi.w), hv[7] - bfhi(hi.w));
            const bf16x8 ah = __builtin_bit_cast(bf16x8, hi), al = __builtin_bit_cast(bf16x8, lo);
            const bf16x8 b0h = *(const LAS bf16x8*)(Whi + r * 1032 + k0), b0l = *(const LAS bf16x8*)(Wlo + r * 1032 + k0);
            const bf16x8 b1h = *(const LAS bf16x8*)(Whi + (16 + r) * 1032 + k0), b1l = *(const LAS bf16x8*)(Wlo + (16 + r) * 1032 + k0);
            acc0 = __builtin_amdgcn_mfma_f32_16x16x32_bf16(ah, b0h, acc0, 0, 0, 0); acc0 = __builtin_amdgcn_mfma_f32_16x16x32_bf16(ah, b0l, acc0, 0, 0, 0); acc0 = __builtin_amdgcn_mfma_f32_16x16x32_bf16(al, b0h, acc0, 0, 0, 0);
            acc1 = __builtin_amdgcn_mfma_f32_16x16x32_bf16(ah, b1h, acc1, 0, 0, 0); acc1 = __builtin_amdgcn_mfma_f32_16x16x32_bf16(ah, b1l, acc1, 0, 0, 0); acc1 = __builtin_amdgcn_mfma_f32_16x16x32_bf16(al, b1h, acc1, 0, 0, 0); }
        const float br0 = a.b_router[l * 32 + r], br1 = a.b_router[l * 32 + 16 + r];
#pragma unroll
        for (int j = 0; j < 4; ++j) { scr[(4 * q + j) * 33 + r] = acc0[j] + br0; scr[(4 * q + j) * 33 + 16 + r] = acc1[j] + br1; }
        __syncthreads();
        int te[4] = {0, 0, 0, 0}; float tg[4] = {0.f, 0.f, 0.f, 0.f}; int rk[4] = {0, 0, 0, 0};
        if (lane < 16) {
            float v[32];
#pragma unroll
            for (int e = 0; e < 32; ++e) v[e] = scr[lane * 33 + e];
            float tv[4];
#pragma unroll
            for (int k = 0; k < 4; ++k) { float best = -3.0e38f; int bi = 0;
#pragma unroll
                for (int e = 0; e < 32; ++e) { if (v[e] > best) { best = v[e]; bi = e; } }
                tv[k] = best; te[k] = bi;
#pragma unroll
                for (int e = 0; e < 32; ++e) v[e] = (e == bi) ? -3.0e38f : v[e]; }
            const float e1 = __expf(tv[1] - tv[0]), e2 = __expf(tv[2] - tv[0]), e3 = __expf(tv[3] - tv[0]); const float inv = 1.f / (1.f + e1 + e2 + e3);
            tg[0] = inv; tg[1] = e1 * inv; tg[2] = e2 * inv; tg[3] = e3 * inv;
#pragma unroll
            for (int k = 0; k < 4; ++k) rk[k] = atomicAdd((int*)&hist[te[k]], 1);
        }
        __syncthreads();
        if (tid < 32) basep[tid] = atomicAdd(&cntg[tid * 64], hist[tid]);
        __syncthreads();
        if (lane < 16) { const int tok = blk * 128 + wid * 16 + lane;
#pragma unroll
            for (int k = 0; k < 4; ++k) { const int pos = basep[te[k]] + rk[k]; rowtok[te[k] * 32768 + pos] = tok; tokslot[tok * 4 + k] = te[k] * 32768 + pos; gates[tok * 4 + k] = tg[k]; } }
        __syncthreads();
    }
}

DI void phase_combine(CArgs& a, int l, const float* xmid, float* xnew, LAS unsigned char* lds) {
    const LAS int* tstart = (const LAS int*)(lds + LDS_CTRL + 64);
    const int lane = ltid() & 63, gw = lbid() * 8 + (ltid() >> 6), nw = lgrid() * 8;
    const float* mod = (const float*)(a.ws + WS_MOD);
    const bf16_t* YS = (const bf16_t*)(a.ws + WS_R1 + R1_YS);
    const int* tokslot = (const int*)(a.ws + WS_TOKSLOT); const float* gates = (const float*)(a.ws + WS_GATES);
    bf16_t* H = (bf16_t*)(a.ws + WS_H);
    for (int row = gw; row < NTOK; row += nw) {
        const int b = row >> 12; const float* mb = mod + ((size_t)l * 8 + b) * 6144;
        size_t pr[4]; float gt[4];
#pragma unroll
        for (int k = 0; k < 4; ++k) { const int s = tokslot[row * 4 + k]; pr[k] = (size_t)(tstart[s >> 15] * 256 + (s & 32767)); gt[k] = gates[row * 4 + k]; }
        float xn[16]; float ss = 0.f;
#pragma unroll
        for (int i = 0; i < 2; ++i) { const int c0 = lane * 8 + 512 * i; float f[8];
#pragma unroll
            for (int j = 0; j < 8; ++j) f[j] = 0.f;
#pragma unroll
            for (int k = 0; k < 4; ++k) { const u32x4 y = *(const u32x4*)(YS + pr[k] * DM + c0);
                f[0] += gt[k] * bflo(y.x); f[1] += gt[k] * bfhi(y.x); f[2] += gt[k] * bflo(y.y); f[3] += gt[k] * bfhi(y.y); f[4] += gt[k] * bflo(y.z); f[5] += gt[k] * bfhi(y.z); f[6] += gt[k] * bflo(y.w); f[7] += gt[k] * bfhi(y.w); }
            const f32x4 x0 = *(const f32x4*)(xmid + (size_t)row * DM + c0), x1 = *(const f32x4*)(xmid + (size_t)row * DM + c0 + 4);
#pragma unroll
            for (int j = 0; j < 8; ++j) { const float xv = (j < 4 ? x0[j & 3] : x1[j & 3]) + mb[5120 + c0 + j] * f[j]; xn[8 * i + j] = xv; ss += xv * xv; } }
        ss = wave_sum(ss); const float rs = rsqrtf(ss * (1.f / 1024.f) + 1e-6f);
        if (l == 0) {
            const float* mb2 = mod + ((size_t)8 + b) * 6144; const float* g = a.norm_mix + DM;
#pragma unroll
            for (int i = 0; i < 2; ++i) { const int c0 = lane * 8 + 512 * i;
                *(f32x4*)(xnew + (size_t)row * DM + c0) = (f32x4){xn[8 * i], xn[8 * i + 1], xn[8 * i + 2], xn[8 * i + 3]};
                *(f32x4*)(xnew + (size_t)row * DM + c0 + 4) = (f32x4){xn[8 * i + 4], xn[8 * i + 5], xn[8 * i + 6], xn[8 * i + 7]};
                float o[8];
#pragma unroll
                for (int j = 0; j < 8; ++j) o[j] = xn[8 * i + j] * rs * g[c0 + j] * (1.f + mb2[1024 + c0 + j]) + mb2[c0 + j];
#if INPROJ_FP8
                *(u32x2*)((unsigned char*)H + (size_t)row * DM + c0) = (u32x2){pk4_fp8(o[0], o[1], o[2], o[3]), pk4_fp8(o[4], o[5], o[6], o[7])};
#else
                u32x4 w; w.x = pk2(o[0], o[1]); w.y = pk2(o[2], o[3]); w.z = pk2(o[4], o[5]); w.w = pk2(o[6], o[7]);
                *(u32x4*)(H + (size_t)row * DM + c0) = w;
#endif
            }
        } else {
#pragma unroll
            for (int i = 0; i < 2; ++i) { const int c0 = lane * 8 + 512 * i; float o[8];
#pragma unroll
                for (int j = 0; j < 8; ++j) o[j] = xn[8 * i + j] * rs * a.norm_final[c0 + j];
                *(f32x4*)(a.out + (size_t)row * DM + c0) = (f32x4){o[0], o[1], o[2], o[3]}; *(f32x4*)(a.out + (size_t)row * DM + c0 + 4) = (f32x4){o[4], o[5], o[6], o[7]}; }
        }
    }
}
DI float wave_incl_scan(float v, int lane) {
#pragma unroll
    for (int o = 1; o < 64; o <<= 1) { const float y = __shfl_up(v, o); if (lane >= o) v += y; }
    return v;
}
DI void conv8(const bf16_t* p, int pos, const float* w, int chs, const float* bias, float (&out)[8]) {
    float acc[8];
    if (bias) { const f32x4 b0 = *(const f32x4*)bias, b1 = *(const f32x4*)(bias + 4); acc[0] = b0[0]; acc[1] = b0[1]; acc[2] = b0[2]; acc[3] = b0[3]; acc[4] = b1[0]; acc[5] = b1[1]; acc[6] = b1[2]; acc[7] = b1[3]; }
    else {
#pragma unroll
        for (int i = 0; i < 8; ++i) acc[i] = 0.f; }
#pragma unroll
    for (int j = 0; j < 4; ++j) {
        if (pos - 3 + j >= 0) { const u32x4 xv = *(const u32x4*)(p - (ptrdiff_t)(3 - j) * NP); const f32x4 w0 = *(const f32x4*)(w + j * chs), w1 = *(const f32x4*)(w + j * chs + 4);
            acc[0] += w0[0] * bflo(xv.x); acc[1] += w0[1] * bfhi(xv.x); acc[2] += w0[2] * bflo(xv.y); acc[3] += w0[3] * bfhi(xv.y);
            acc[4] += w1[0] * bflo(xv.z); acc[5] += w1[1] * bfhi(xv.z); acc[6] += w1[2] * bflo(xv.w); acc[7] += w1[3] * bfhi(xv.w); } }
#pragma unroll
    for (int i = 0; i < 8; ++i) out[i] = silu_(acc[i]);
}
DI f32x4 mm16(const LAS bf16_t* A, int lda, int m0, const LAS bf16_t* Bt, int ldb, int n0, int K, int lane) {
    f32x4 acc = {0.f, 0.f, 0.f, 0.f}; const int r = lane & 15, q = lane >> 4;
    for (int k0 = 0; k0 < K; k0 += 32) { const bf16x8 av = *(const LAS bf16x8*)(A + (m0 + r) * lda + k0 + 8 * q), bv = *(const LAS bf16x8*)(Bt + (n0 + r) * ldb + k0 + 8 * q);
        acc = __builtin_amdgcn_mfma_f32_16x16x32_bf16(av, bv, acc, 0, 0, 0); }
    return acc;
}
DI void frag_store8(char* base, int nkb, int row, int k0, const float (&v)[8]) {
    const int rt = row >> 5, r = row & 31, kb = k0 >> 4, aa = (k0 >> 3) & 1;
    char* p = base + ((size_t)((rt * nkb + kb) * 64 + r)) * 16 + aa * 8;
    *(u32x2*)p = (u32x2){pk2(v[0], v[1]), pk2(v[2], v[3])};
    *(u32x2*)(p + 512) = (u32x2){pk2(v[4], v[5]), pk2(v[6], v[7])};
}
DI void export_frags(char* dst, const LAS bf16_t* M, int ld, int R, int KK, int coloff) {
    const int nkb = KK >> 4, pieces = (R >> 5) * nkb * 64;
    for (int p = ltid(); p < pieces; p += NTHREADS) { const int lane = p & 63, f = p >> 6, kb = f % nkb, rt = f / nkb, r = lane & 31, h = lane >> 5;
        const LAS bf16_t* s = M + (rt * 32 + r) * ld + coloff + kb * 16 + 4 * h;
        const u32x2 lo = *(const LAS u32x2*)s, hi = *(const LAS u32x2*)(s + 8);
        *(u32x4*)(dst + (size_t)p * 16) = (u32x4){lo.x, lo.y, hi.x, hi.y}; }
}
DI void export_acc(char* dst, const LAS bf16_t* M, int ld, int nct) {
    const int pieces = nct * 2 * 64;
    for (int p = ltid(); p < pieces; p += NTHREADS) { const int lane = p & 63, tile = p >> 6, rt = tile & 1, ct = tile >> 1, r = lane & 31, h = lane >> 5;
        unsigned w[8];
#pragma unroll
        for (int i = 0; i < 8; ++i) { const int r0 = rt * 32 + ((2 * i) & 3) + 8 * ((2 * i) >> 2) + 4 * h;
            w[i] = (unsigned)M[r0 * ld + ct * 32 + r] | ((unsigned)M[(r0 + 1) * ld + ct * 32 + r] << 16); }
        *(u32x4*)(dst + (size_t)p * 32) = (u32x4){w[0], w[1], w[2], w[3]}; *(u32x4*)(dst + (size_t)p * 32 + 16) = (u32x4){w[4], w[5], w[6], w[7]}; }
}

DI u32x4 ldg_or0(const bf16_t* p, bool ok) { return ok ? *(const u32x4*)p : (u32x4){0u, 0u, 0u, 0u}; }
DI void conv8r(const u32x4 (&t)[4], const LAS float* wt, int ws, const LAS float* bias, float (&out)[8]) {
    float acc[8];
#pragma unroll
    for (int i = 0; i < 8; ++i) acc[i] = bias ? bias[i] : 0.f;
#pragma unroll
    for (int j = 0; j < 4; ++j) { const LAS float* w = wt + j * ws; const u32x4 xv = t[j];
        acc[0] += w[0] * bflo(xv.x); acc[1] += w[1] * bfhi(xv.x); acc[2] += w[2] * bflo(xv.y); acc[3] += w[3] * bfhi(xv.y);
        acc[4] += w[4] * bflo(xv.z); acc[5] += w[5] * bfhi(xv.z); acc[6] += w[6] * bflo(xv.w); acc[7] += w[7] * bfhi(xv.w); }
#pragma unroll
    for (int i = 0; i < 8; ++i) out[i] = silu_(acc[i]);
}
struct GlaRaw { f32x4 lr[4]; u32x4 q8, k8, v8[2]; };
DI void gla_load(CArgs& a, int u, GlaRaw& r) {
    const int tid = ltid(); const int n = u & 63, bh = u >> 6, b = bh >> 2, h = bh & 3, T0 = b * SEQ + n * 64;
    const bf16_t* P = (const bf16_t*)(a.ws + WS_R1 + R1_PROJ); const float* small = (const float*)(a.ws + WS_SMALL);
    const int l_ = tid >> 3, d0 = (tid & 7) * 8; const size_t T = (size_t)(T0 + l_);
#pragma unroll
    for (int i = 0; i < 4; ++i) r.lr[i] = *(const f32x4*)(small + T * 32 + 4 * i);
    r.q8 = *(const u32x4*)(P + T * NP + PC_GLA_Q + h * 64 + d0); r.k8 = *(const u32x4*)(P + T * NP + PC_GLA_K + h * 64 + d0);
#pragma unroll
    for (int rep = 0; rep < 2; ++rep) { const int idx = rep * NTHREADS + tid, lr_ = idx >> 4, c0 = (idx & 15) * 8; r.v8[rep] = *(const u32x4*)(P + (size_t)(T0 + lr_) * NP + PC_GLA_V + h * 128 + c0); }
}
DI void gla_table(CArgs& a, int l, int h, LAS float* WT) {
    for (int i = ltid(); i < 17 * 64; i += NTHREADS) { const int j = i >> 6, d = i & 63; WT[i] = j < 16 ? a.gla_w2[(size_t)l * 16 * 256 + j * 256 + h * 64 + d] : a.gla_b2[l * 256 + h * 64 + d]; }
}
template <class F> DI void gla_compute(CArgs& a, int u, const GlaRaw& rw, LAS unsigned char* lds, F&& prefetch) {
    const int tid = ltid(), wid = tid >> 6, lane = tid & 63;
    LAS float* G = (LAS float*)lds; LAS bf16_t* QD = (LAS bf16_t*)(lds + 16640); LAS bf16_t* KI = (LAS bf16_t*)(lds + 25856); LAS bf16_t* KT = (LAS bf16_t*)(lds + 35072);
    LAS bf16_t* PB = (LAS bf16_t*)(lds + 44288); LAS bf16_t* V = (LAS bf16_t*)(lds + 53504); LAS float* SEG = (LAS float*)(lds + 70912); const LAS float* WT = (const LAS float*)(lds + 72960);
    char* ub = a.ws + WS_R1 + R1_SGLA + (size_t)u * GLA_UNIT;
    const int l_ = tid >> 3, d0 = (tid & 7) * 8;
    { float s[8];
#pragma unroll
      for (int i = 0; i < 8; ++i) s[i] = WT[16 * 64 + d0 + i];
#pragma unroll
      for (int j = 0; j < 16; ++j) { const float lv = rw.lr[j >> 2][j & 3];
#pragma unroll
          for (int i = 0; i < 8; ++i) s[i] += lv * WT[j * 64 + d0 + i]; }
#pragma unroll
      for (int i = 0; i < 8; ++i) G[l_ * 65 + d0 + i] = -softplus_(-s[i]) * (1.f / 16.f); }
#pragma unroll
    for (int rep = 0; rep < 2; ++rep) { const int idx = rep * NTHREADS + tid, lr_ = idx >> 4, c0 = (idx & 15) * 8; *(LAS u32x4*)(V + lr_ * 136 + c0) = rw.v8[rep]; }
    const u32x4 q8 = rw.q8, k8 = rw.k8;
    prefetch();
    __syncthreads();
    { const int d = tid & 63, sg = tid >> 6; float run = 0.f, vv[8];
#pragma unroll
      for (int i = 0; i < 8; ++i) { run += G[(sg * 8 + i) * 65 + d]; vv[i] = run; }
      SEG[sg * 64 + d] = run;
      __syncthreads();
      float pre = 0.f;
#pragma unroll
      for (int s2 = 0; s2 < 8; ++s2) pre += (s2 < sg) ? SEG[s2 * 64 + d] : 0.f;
#pragma unroll
      for (int i = 0; i < 8; ++i) G[(sg * 8 + i) * 65 + d] = vv[i] + pre; }
    __syncthreads();
    { const float qf[8] = {bflo(q8.x), bfhi(q8.x), bflo(q8.y), bfhi(q8.y), bflo(q8.z), bfhi(q8.z), bflo(q8.w), bfhi(q8.w)};
      const float kf[8] = {bflo(k8.x), bfhi(k8.x), bflo(k8.y), bfhi(k8.y), bflo(k8.z), bfhi(k8.z), bflo(k8.w), bfhi(k8.w)};
      float qd[8], ki[8];
#pragma unroll
      for (int i = 0; i < 8; ++i) { const float bc = G[l_ * 65 + d0 + i], bl = G[63 * 65 + d0 + i]; qd[i] = qf[i] * 0.125f * __expf(bc); ki[i] = kf[i] * __expf(-bc);
          KT[(d0 + i) * 72 + l_] = f2bf(kf[i] * __expf(bl - bc)); }
      *(LAS u32x4*)(QD + l_ * 72 + d0) = (u32x4){pk2(qd[0], qd[1]), pk2(qd[2], qd[3]), pk2(qd[4], qd[5]), pk2(qd[6], qd[7])};
      *(LAS u32x4*)(KI + l_ * 72 + d0) = (u32x4){pk2(ki[0], ki[1]), pk2(ki[2], ki[3]), pk2(ki[4], ki[5]), pk2(ki[6], ki[7])};
      frag_store8(ub + GLA_OQ, 4, l_, d0, qd); }
    if (tid < 64) ((float*)(ub + GLA_OD))[tid] = __expf(G[63 * 65 + tid]);
    __syncthreads();
#pragma unroll
    for (int t2 = 0; t2 < 2; ++t2) { const int t = wid * 2 + t2, mt = t >> 2, nt = t & 3; const f32x4 acc = mm16(QD, 72, mt * 16, KI, 72, nt * 16, 64, lane);
        const int r = lane & 15, q = lane >> 4, m = nt * 16 + r;
#pragma unroll
        for (int j = 0; j < 4; ++j) { const int lrow = mt * 16 + 4 * q + j; PB[lrow * 72 + m] = f2bf(m <= lrow ? acc[j] : 0.f); } }
    __syncthreads();
    export_frags(ub + GLA_OP, PB, 72, 64, 64, 0);
    export_frags(ub + GLA_OK, KT, 72, 64, 64, 0);
    export_acc(ub + GLA_OU, V, 136, 4);
    __syncthreads();
}
struct SsdRaw { u32x4 t[3][4]; float dtr, p0, p1, p2; };
DI void ssd_load(CArgs& a, int u, SsdRaw& r) {
    const int tid = ltid(); const int n = u & 63, bh = u >> 6, b = bh >> 3, hh = bh & 7, g = hh >> 2, T0 = b * SEQ + n * 64;
    const bf16_t* P = (const bf16_t*)(a.ws + WS_R1 + R1_PROJ); const float* small = (const float*)(a.ws + WS_SMALL);
    const int l_ = tid >> 3, c8 = (tid & 7) * 8, pos = n * 64 + l_; const bf16_t* pr = P + (size_t)(T0 + l_) * NP + PC_SSD_XBC + c8;
    const int cb[3] = {hh * 64, 512 + g * 64, 640 + g * 64};
#pragma unroll
    for (int p = 0; p < 3; ++p)
#pragma unroll
        for (int j = 0; j < 4; ++j) r.t[p][j] = ldg_or0(pr + cb[p] - (ptrdiff_t)(3 - j) * NP, pos - 3 + j >= 0);
    r.dtr = tid < 64 ? small[(size_t)(T0 + tid) * 32 + 24 + hh] : 0.f; r.p0 = 0.f; r.p1 = 0.f; r.p2 = 0.f;
}
DI void ssd_table(CArgs& a, int l, int hh, LAS float* WT) {
    const int g = hh >> 2;
    for (int i = ltid(); i < 3 * 5 * 64; i += NTHREADS) { const int p = i / 320, j = (i % 320) >> 6, ch = i & 63; const int col = (p == 0 ? hh * 64 : p == 1 ? 512 + g * 64 : 640 + g * 64) + ch;
        WT[i] = j < 4 ? a.ssd_conv_w[(size_t)l * 4 * 768 + j * 768 + col] : a.ssd_conv_b[l * 768 + col]; }
}
template <class F> DI void ssd_compute(CArgs& a, int l, int u, const SsdRaw& rw, LAS unsigned char* lds, F&& prefetch) {
    const int tid = ltid(), wid = tid >> 6, lane = tid & 63;
    const int bh = u >> 6, hh = bh & 7;
    LAS bf16_t* CC = (LAS bf16_t*)lds; LAS bf16_t* CBm = (LAS bf16_t*)(lds + 9216); LAS bf16_t* KT = (LAS bf16_t*)(lds + 18432); LAS bf16_t* PB = (LAS bf16_t*)(lds + 27648);
    LAS bf16_t* V = (LAS bf16_t*)(lds + 36864); LAS float* SDT = (LAS float*)(lds + 46080); LAS float* SCUM = (LAS float*)(lds + 46080 + 256); const LAS float* WT = (const LAS float*)(lds + 47104);
    char* ub = a.ws + WS_R1 + R1_SSSD + (size_t)u * SSD_UNIT;
    if (tid < 64) { const float dt = softplus_(rw.dtr + a.ssd_dt_bias[l * 8 + hh]); const float aa = -__expf(a.ssd_a_log[l * 8 + hh]);
        const float cum = wave_incl_scan(dt * aa, lane); SDT[tid] = dt; SCUM[tid] = cum; }
    float vx[8], vb[8], vc[8];
    { const int c8 = (tid & 7) * 8;
      conv8r(rw.t[0], WT + c8, 64, WT + 4 * 64 + c8, vx); conv8r(rw.t[1], WT + 320 + c8, 64, WT + 320 + 4 * 64 + c8, vb); conv8r(rw.t[2], WT + 640 + c8, 64, WT + 640 + 4 * 64 + c8, vc); }
    prefetch();
    __syncthreads();
    { const int l_ = tid >> 3, c8 = (tid & 7) * 8; const float cl = SCUM[l_], c63 = SCUM[63], dtl = SDT[l_];
      *(LAS u32x4*)(V + l_ * 72 + c8) = (u32x4){pk2(vx[0] * dtl, vx[1] * dtl), pk2(vx[2] * dtl, vx[3] * dtl), pk2(vx[4] * dtl, vx[5] * dtl), pk2(vx[6] * dtl, vx[7] * dtl)};
      *(LAS u32x4*)(CBm + l_ * 72 + c8) = (u32x4){pk2(vb[0], vb[1]), pk2(vb[2], vb[3]), pk2(vb[4], vb[5]), pk2(vb[6], vb[7])};
      const float ek = __expf(c63 - cl);
#pragma unroll
      for (int i = 0; i < 8; ++i) KT[(c8 + i) * 72 + l_] = f2bf(vb[i] * ek);
      *(LAS u32x4*)(CC + l_ * 72 + c8) = (u32x4){pk2(vc[0], vc[1]), pk2(vc[2], vc[3]), pk2(vc[4], vc[5]), pk2(vc[6], vc[7])};
      const float eq = __expf(cl); float qd[8];
#pragma unroll
      for (int i = 0; i < 8; ++i) qd[i] = vc[i] * eq;
      frag_store8(ub + SSD_OQ, 4, l_, c8, qd); }
    if (tid < 64) ((float*)(ub + SSD_OD))[tid] = __expf(SCUM[63]);
    __syncthreads();
#pragma unroll
    for (int t2 = 0; t2 < 2; ++t2) { const int t = wid * 2 + t2, mt = t >> 2, nt = t & 3; const f32x4 acc = mm16(CC, 72, mt * 16, CBm, 72, nt * 16, 64, lane);
        const int r = lane & 15, q = lane >> 4, m = nt * 16 + r; const float cm = SCUM[m];
#pragma unroll
        for (int j = 0; j < 4; ++j) { const int lrow = mt * 16 + 4 * q + j; PB[lrow * 72 + m] = f2bf(m <= lrow ? acc[j] * __expf(SCUM[lrow] - cm) : 0.f); } }
    __syncthreads();
    export_frags(ub + SSD_OP, PB, 72, 64, 64, 0);
    export_frags(ub + SSD_OK, KT, 72, 64, 64, 0);
    export_acc(ub + SSD_OU, V, 72, 2);
    __syncthreads();
}
template <int NP_> struct GdnRaw { u32x4 t[NP_][2][4]; u32x4 tb; float ar, br, p0, p1; };
template <int NP_> DI void gdn_load(CArgs& a, int u, GdnRaw<NP_>& r, bool with_t) {
    const int tid = ltid(); const int n = u & 63, bh = u >> 6, b = bh >> 2, h = bh & 3, T0 = b * SEQ + n * 64;
    const bf16_t* P = (const bf16_t*)(a.ws + WS_R1 + R1_PROJ); const float* small = (const float*)(a.ws + WS_SMALL);
#pragma unroll
    for (int rep = 0; rep < 2; ++rep) { const int idx = rep * NTHREADS + tid, l_ = idx >> 4, grp = idx & 15, pos = n * 64 + l_; const bf16_t* pr = P + (size_t)(T0 + l_) * NP + PC_GDN_QKV + h * 128 + grp * 8;
#pragma unroll
        for (int p = 0; p < NP_; ++p) { const int part = NP_ == 1 ? 1 : p;
#pragma unroll
            for (int j = 0; j < 4; ++j) r.t[p][rep][j] = ldg_or0(pr + part * 512 - (ptrdiff_t)(3 - j) * NP, pos - 3 + j >= 0); } }
    r.ar = tid < 64 ? small[(size_t)(T0 + tid) * 32 + 16 + h] : 0.f; r.br = tid < 64 ? small[(size_t)(T0 + tid) * 32 + 20 + h] : 0.f; r.p0 = 0.f; r.p1 = 0.f;
    if (with_t) { const bf16_t* tsrc = (const bf16_t*)(a.ws + WS_TSCR) + (size_t)u * 4096; r.tb = *(const u32x4*)(tsrc + (tid >> 3) * 64 + (tid & 7) * 8); } else r.tb = (u32x4){0u, 0u, 0u, 0u};
}
DI void gdn_table(CArgs& a, int l, int h, LAS float* WT) {
    for (int i = ltid(); i < 3 * 4 * 128; i += NTHREADS) { const int p = i >> 9, j = (i >> 7) & 3, d = i & 127; WT[i] = a.gdn_conv_w[(size_t)l * 4 * 1536 + j * 1536 + p * 512 + h * 128 + d]; }
}
DI void gdn_scalars_r(CArgs& a, int l, int h, float ar, float br, LAS float* SB, LAS float* SC) {
    const int tid = ltid();
    if (tid < 64) { const float beta = sigmoid_(br); const float gg = -__expf(a.gdn_a_log[l * 4 + h]) * softplus_(ar + a.gdn_dt_bias[l * 4 + h]);
        const float cum = wave_incl_scan(gg, tid); SB[tid] = beta; SC[tid] = cum; }
}
DI void gdn_norm8(float (&v)[8], float post) {
    float ss = 0.f;
#pragma unroll
    for (int i = 0; i < 8; ++i) ss += v[i] * v[i];
    ss += __shfl_xor(ss, 1); ss += __shfl_xor(ss, 2); ss += __shfl_xor(ss, 4); ss += __shfl_xor(ss, 8);
    const float rn = rsqrtf(ss + 1e-6f) * post;
#pragma unroll
    for (int i = 0; i < 8; ++i) v[i] *= rn;
}
template <class F> DI void gdn_compute1(CArgs& a, int l, int u, const GdnRaw<1>& rw, LAS unsigned char* lds, LAS float* slot, F&& prefetch) {
    const int tid = ltid(), wid = tid >> 6, lane = tid & 63; const int h = (u >> 6) & 3;
    LAS bf16_t* Kb = (LAS bf16_t*)lds; LAS float* SB = (LAS float*)(lds + 17408); LAS float* SC = (LAS float*)(lds + 17408 + 256); const LAS float* WT = (const LAS float*)(lds + 17920);
    gdn_scalars_r(a, l, h, rw.ar, rw.br, SB, SC);
#pragma unroll
    for (int rep = 0; rep < 2; ++rep) { const int idx = rep * NTHREADS + tid, l_ = idx >> 4, grp = idx & 15; float v[8]; conv8r(rw.t[0][rep], WT + grp * 8, 128, nullptr, v); gdn_norm8(v, 1.f);
        *(LAS u32x4*)(Kb + l_ * 136 + grp * 8) = (u32x4){pk2(v[0], v[1]), pk2(v[2], v[3]), pk2(v[4], v[5]), pk2(v[6], v[7])}; }
    prefetch();
    __syncthreads();
#pragma unroll
    for (int t2 = 0; t2 < 2; ++t2) { const int t = wid * 2 + t2, mt = t >> 2, nt = t & 3; const f32x4 acc = mm16(Kb, 136, mt * 16, Kb, 136, nt * 16, 128, lane);
        const int r = lane & 15, q = lane >> 4, m = nt * 16 + r; const float cm = SC[m];
#pragma unroll
        for (int j = 0; j < 4; ++j) { const int lrow = mt * 16 + 4 * q + j; slot[lrow * 65 + m] = (m < lrow) ? SB[lrow] * acc[j] * __expf(SC[lrow] - cm) : 0.f; } }
    __syncthreads();
}
DI void gdn_invert(LAS float* sl, bf16_t* tout, int lane) {
    for (int lrow = 0; lrow < 64; ++lrow) {
        const float arow = sl[lrow * 65 + lane]; float acc = (lane == lrow) ? 1.f : 0.f;
        int m = 0;
        for (; m + 8 <= lrow; m += 8) { float t[8];
#pragma unroll
            for (int k = 0; k < 8; ++k) t[k] = sl[(m + k) * 65 + lane];
#pragma unroll
            for (int k = 0; k < 8; ++k) acc -= __uint_as_float((unsigned)__builtin_amdgcn_readlane((int)__float_as_uint(arow), m + k)) * t[k]; }
        for (; m < lrow; ++m) { const float s = __uint_as_float((unsigned)__builtin_amdgcn_readlane((int)__float_as_uint(arow), m)); acc -= s * sl[m * 65 + lane]; }
        sl[lrow * 65 + lane] = acc;
    }
#pragma unroll 4
    for (int it = 0; it < 32; ++it) { const int rowi = it * 2 + (lane >> 5), cj = (lane & 31) * 2; ((unsigned*)tout)[rowi * 32 + (lane & 31)] = pk2(sl[rowi * 65 + cj], sl[rowi * 65 + cj + 1]); }
}
template <class F> DI void gdn_compute2(CArgs& a, int l, int u, const GdnRaw<3>& rw, LAS unsigned char* lds, F&& prefetch) {
    const int tid = ltid(), wid = tid >> 6, lane = tid & 63; const int h = (u >> 6) & 3;
    LAS bf16_t* Kb = (LAS bf16_t*)lds; LAS bf16_t* Qb = (LAS bf16_t*)(lds + 17408); LAS bf16_t* SOL = (LAS bf16_t*)lds;
    LAS bf16_t* RT = (LAS bf16_t*)(lds + 34816); LAS bf16_t* KT = (LAS bf16_t*)(lds + 71680); LAS bf16_t* Tb = (LAS bf16_t*)(lds + 90112); LAS bf16_t* PB = (LAS bf16_t*)(lds + 99328);
    LAS float* SB = (LAS float*)(lds + 108544); LAS float* SC = (LAS float*)(lds + 108544 + 256); const LAS float* WT = (const LAS float*)(lds + 109056);
    char* ub = a.ws + WS_R1 + R1_SGDN + (size_t)u * GDN_UNIT;
    gdn_scalars_r(a, l, h, rw.ar, rw.br, SB, SC);
    float vq[2][8], vk[2][8], vv[2][8];
#pragma unroll
    for (int rep = 0; rep < 2; ++rep) { const int grp = (rep * NTHREADS + tid) & 15;
        conv8r(rw.t[0][rep], WT + grp * 8, 128, nullptr, vq[rep]); gdn_norm8(vq[rep], 0.08838834764831845f);
        conv8r(rw.t[1][rep], WT + 512 + grp * 8, 128, nullptr, vk[rep]); gdn_norm8(vk[rep], 1.f);
        conv8r(rw.t[2][rep], WT + 1024 + grp * 8, 128, nullptr, vv[rep]); }
    *(LAS u32x4*)(Tb + (tid >> 3) * 72 + (tid & 7) * 8) = rw.tb;
    prefetch();
    __syncthreads();
#pragma unroll
    for (int rep = 0; rep < 2; ++rep) { const int idx = rep * NTHREADS + tid, l_ = idx >> 4, grp = idx & 15; const float cl = SC[l_], c63 = SC[63], be = SB[l_];
        *(LAS u32x4*)(Qb + l_ * 136 + grp * 8) = (u32x4){pk2(vq[rep][0], vq[rep][1]), pk2(vq[rep][2], vq[rep][3]), pk2(vq[rep][4], vq[rep][5]), pk2(vq[rep][6], vq[rep][7])};
        { const float eq = __expf(cl); float qd[8];
#pragma unroll
          for (int i = 0; i < 8; ++i) qd[i] = vq[rep][i] * eq;
          frag_store8(ub + GDN_OQ, 8, l_, grp * 8, qd); }
        *(LAS u32x4*)(Kb + l_ * 136 + grp * 8) = (u32x4){pk2(vk[rep][0], vk[rep][1]), pk2(vk[rep][2], vk[rep][3]), pk2(vk[rep][4], vk[rep][5]), pk2(vk[rep][6], vk[rep][7])};
        { const float e1 = be * __expf(cl), e2 = __expf(c63 - cl);
#pragma unroll
          for (int i = 0; i < 8; ++i) { RT[(128 + grp * 8 + i) * 72 + l_] = f2bf(vk[rep][i] * e1); KT[(grp * 8 + i) * 72 + l_] = f2bf(vk[rep][i] * e2); RT[(grp * 8 + i) * 72 + l_] = f2bf(vv[rep][i] * be); } } }
    if (tid < 128) ((float*)(ub + GDN_OD))[tid] = __expf(SC[63]);
    __syncthreads();
#pragma unroll
    for (int t2 = 0; t2 < 2; ++t2) { const int t = wid * 2 + t2, mt = t >> 2, nt = t & 3; const f32x4 acc = mm16(Qb, 136, mt * 16, Kb, 136, nt * 16, 128, lane);
        const int r = lane & 15, q = lane >> 4, m = nt * 16 + r; const float cm = SC[m];
#pragma unroll
        for (int j = 0; j < 4; ++j) { const int lrow = mt * 16 + 4 * q + j; PB[lrow * 72 + m] = f2bf(m <= lrow ? acc[j] * __expf(SC[lrow] - cm) : 0.f); } }
    f32x4 sacc[8];
#pragma unroll
    for (int t2 = 0; t2 < 8; ++t2) { const int t = wid * 8 + t2, mt = t & 3, ntile = t >> 2; sacc[t2] = mm16(Tb, 72, mt * 16, RT, 72, ntile * 16, 64, lane); }
    __syncthreads();
#pragma unroll
    for (int t2 = 0; t2 < 8; ++t2) { const int t = wid * 8 + t2, mt = t & 3, ntile = t >> 2; const int r = lane & 15, q = lane >> 4, cc = ntile * 16 + r; const float sg = cc < 128 ? 1.f : -1.f;
#pragma unroll
        for (int j = 0; j < 4; ++j) SOL[(mt * 16 + 4 * q + j) * 264 + cc] = f2bf(sacc[t2][j] * sg); }
    __syncthreads();
    export_frags(ub + GDN_OP, PB, 72, 64, 64, 0);
    export_frags(ub + GDN_OK, KT, 72, 128, 64, 0);
    export_frags(ub + GDN_OW, SOL, 264, 64, 128, 128);
    export_acc(ub + GDN_OU, SOL, 264, 4);
    __syncthreads();
}
DI void phase_prep(CArgs& a, int l, LAS unsigned char* lds) {
    const int wid = ltid() >> 6, lane = ltid() & 63; const int w = lbid(), Gd = lgrid();
    { const int upw = (2048 + Gd - 1) / Gd, u0 = w * upw, u1 = (u0 + upw < 2048) ? u0 + upw : 2048;
      LAS float* slots = (LAS float*)(lds + 20480);
      for (int ub = u0; ub < u1; ub += 8) { const int nb = (u1 - ub) < 8 ? (u1 - ub) : 8; int curh = -1;
          GdnRaw<1> r1; gdn_load<1>(a, ub, r1, false);
          for (int j = 0; j < nb; ++j) { const int u = ub + j;
              if ((u >> 6) != curh) { curh = u >> 6; __syncthreads(); LAS float* WT = (LAS float*)(lds + 17920); for (int i = ltid(); i < 512; i += NTHREADS) WT[i] = a.gdn_conv_w[(size_t)l * 4 * 1536 + (i >> 7) * 1536 + 512 + (curh & 3) * 128 + (i & 127)]; __syncthreads(); }
              GdnRaw<1> rn = r1;
              gdn_compute1(a, l, u, r1, lds, slots + j * 4160, [&]() { if (j + 1 < nb) gdn_load<1>(a, u + 1, rn, false); }); r1 = rn; }
          if (wid < nb) gdn_invert(slots + wid * 4160, (bf16_t*)(a.ws + WS_TSCR) + (size_t)(ub + wid) * 4096, lane);
          asm volatile("s_waitcnt vmcnt(0)" ::: "memory");
          __syncthreads();
          curh = -1;
          GdnRaw<3> r3; gdn_load<3>(a, ub, r3, true);
          for (int j = 0; j < nb; ++j) { const int u = ub + j;
              if ((u >> 6) != curh) { curh = u >> 6; __syncthreads(); gdn_table(a, l, curh & 3, (LAS float*)(lds + 109056)); __syncthreads(); }
              GdnRaw<3> rn = r3;
              gdn_compute2(a, l, u, r3, lds, [&]() { if (j + 1 < nb) gdn_load<3>(a, u + 1, rn, true); }); r3 = rn; } } }
    { const int upw = (2048 + Gd - 1) / Gd, u0 = w * upw, u1 = (u0 + upw < 2048) ? u0 + upw : 2048; int curh = -1;
      if (u0 < u1) { GlaRaw r; gla_load(a, u0, r);
          for (int u = u0; u < u1; ++u) {
              if ((u >> 6) != curh) { curh = u >> 6; __syncthreads(); gla_table(a, l, curh & 3, (LAS float*)(lds + 72960)); __syncthreads(); }
              GlaRaw rn = r;
              gla_compute(a, u, r, lds, [&]() { if (u + 1 < u1) gla_load(a, u + 1, rn); }); r = rn; } } }
    { const int upw = (4096 + Gd - 1) / Gd, u0 = w * upw, u1 = (u0 + upw < 4096) ? u0 + upw : 4096; int curh = -1;
      if (u0 < u1) { SsdRaw r; ssd_load(a, u0, r);
          for (int u = u0; u < u1; ++u) {
              if ((u >> 6) != curh) { curh = u >> 6; __syncthreads(); ssd_table(a, l, curh & 7, (LAS float*)(lds + 47104)); __syncthreads(); }
              SsdRaw rn = r;
              ssd_compute(a, l, u, r, lds, [&]() { if (u + 1 < u1) ssd_load(a, u + 1, rn); }); r = rn; } } }
}
DI bf16x8 pack16(const f32x16& x, int s) {
    u32x4 p; p.x = pk2(x[8 * s], x[8 * s + 1]); p.y = pk2(x[8 * s + 2], x[8 * s + 3]); p.z = pk2(x[8 * s + 4], x[8 * s + 5]); p.w = pk2(x[8 * s + 6], x[8 * s + 7]);
    return __builtin_bit_cast(bf16x8, p);
}
#define MFMA32(a, b, c) __builtin_amdgcn_mfma_f32_32x32x16_bf16((a), (b), (c), 0, 0, 0)
template <int DK, bool HAS_W, int NH, int NCT, int UNIT, int OQ, int OW, int OP, int OK, int OU, int OD>
DI void scan_wg(const char* ops0, const char* ops1, char* ob0, char* ob1, LAS unsigned char* lds) {
    constexpr int NKB = DK / 16, NDT = DK / 32, BUF = NH * UNIT, OUNIT = NCT * 2 * 2048;
    static_assert(2 * BUF <= LDS_CTRL, "scan LDS");
    const int tid = ltid(), wid = __builtin_amdgcn_readfirstlane(tid >> 6), lane = tid & 63, h = lane >> 5;
    const int hd = (NH == 2) ? (wid >> 1) & 1 : 0, ct = (NH == 2) ? (wid & 1) : (wid & 3);
    static_assert(UNIT % 1024 == 0, "unit = whole 1 KiB chunks");
    auto load_step = [&](int n, int buf) {
        const int lw = wid - 4;
#pragma unroll
        for (int k = 0; k < NH; ++k) { const char* src = (k == 0 ? ops0 : ops1) + (size_t)n * UNIT + lane * 16 + lw * 1024; unsigned dst = (unsigned)(buf * BUF + k * UNIT + lw * 1024);
#pragma unroll 1
            for (int ch = lw; ch < UNIT / 1024; ch += 4) { __builtin_amdgcn_global_load_lds((const unsigned*)src, (LAS unsigned*)(lds + dst), 16, 0, 0); src += 4096; dst += 4096u; } }
        asm volatile("s_waitcnt vmcnt(0)" ::: "memory");
    };
    f32x16 S[NDT]; bf16x8 Sb[NKB];
#pragma unroll
    for (int d = 0; d < NDT; ++d)
#pragma unroll
        for (int i = 0; i < 16; ++i) S[d][i] = 0.f;
#pragma unroll
    for (int k = 0; k < NKB; ++k) Sb[k] = (bf16x8){0, 0, 0, 0, 0, 0, 0, 0};
    if (wid >= 4) load_step(0, 0);
    __syncthreads();
    char* ob = (hd == 0 ? ob0 : ob1);
    for (int n = 0; n < 64; ++n) {
        if (wid >= 4) { if (n + 1 < 64) load_step(n + 1, (n + 1) & 1); }
        else {
            const LAS unsigned char* lb = lds + (n & 1) * BUF + hd * UNIT;
            f32x16 U[2];
#pragma unroll
            for (int rt = 0; rt < 2; ++rt) { const LAS unsigned char* up = lb + OU + ((ct * 2 + rt) * 64 + lane) * 32; const u32x4 w0 = *(const LAS u32x4*)up, w1 = *(const LAS u32x4*)(up + 16);
                U[rt][0] = bflo(w0.x); U[rt][1] = bfhi(w0.x); U[rt][2] = bflo(w0.y); U[rt][3] = bfhi(w0.y); U[rt][4] = bflo(w0.z); U[rt][5] = bfhi(w0.z); U[rt][6] = bflo(w0.w); U[rt][7] = bfhi(w0.w);
                U[rt][8] = bflo(w1.x); U[rt][9] = bfhi(w1.x); U[rt][10] = bflo(w1.y); U[rt][11] = bfhi(w1.y); U[rt][12] = bflo(w1.z); U[rt][13] = bfhi(w1.z); U[rt][14] = bflo(w1.w); U[rt][15] = bfhi(w1.w); }
            if constexpr (HAS_W) {
#pragma unroll
                for (int rt = 0; rt < 2; ++rt)
#pragma unroll
                    for (int k4 = 0; k4 < NKB; k4 += 4) { bf16x8 fw[4];
#pragma unroll
                        for (int kb = 0; kb < 4; ++kb) fw[kb] = *(const LAS bf16x8*)(lb + OW + ((rt * NKB + k4 + kb) * 64 + lane) * 16);
#pragma unroll
                        for (int kb = 0; kb < 4; ++kb) U[rt] = MFMA32(fw[kb], Sb[k4 + kb], U[rt]); }
            }
            bf16x8 Ub[4];
            Ub[0] = pack16(U[0], 0); Ub[1] = pack16(U[0], 1); Ub[2] = pack16(U[1], 0); Ub[3] = pack16(U[1], 1);
#pragma unroll
            for (int rt = 0; rt < 2; ++rt) { f32x16 O;
#pragma unroll
                for (int i = 0; i < 16; ++i) O[i] = 0.f;
                { bf16x8 fp[4];
#pragma unroll
                  for (int kb = 0; kb < 4; ++kb) fp[kb] = *(const LAS bf16x8*)(lb + OP + ((rt * 4 + kb) * 64 + lane) * 16);
#pragma unroll
                  for (int kb = 0; kb < 4; ++kb) O = MFMA32(fp[kb], Ub[kb], O); }
#pragma unroll
                for (int k4 = 0; k4 < NKB; k4 += 4) { bf16x8 fq[4];
#pragma unroll
                    for (int kb = 0; kb < 4; ++kb) fq[kb] = *(const LAS bf16x8*)(lb + OQ + ((rt * NKB + k4 + kb) * 64 + lane) * 16);
#pragma unroll
                    for (int kb = 0; kb < 4; ++kb) O = MFMA32(fq[kb], Sb[k4 + kb], O); }
                char* op = ob + (size_t)n * OUNIT + ((ct * 2 + rt) * 64 + lane) * 32;
                *(u32x4*)op = (u32x4){pk2(O[0], O[1]), pk2(O[2], O[3]), pk2(O[4], O[5]), pk2(O[6], O[7])};
                *(u32x4*)(op + 16) = (u32x4){pk2(O[8], O[9]), pk2(O[10], O[11]), pk2(O[12], O[13]), pk2(O[14], O[15])}; }
#pragma unroll
            for (int d = 0; d < NDT; ++d) {
#pragma unroll
                for (int g = 0; g < 4; ++g) { const f32x4 dv = *(const LAS f32x4*)(lb + OD + (d * 32 + 8 * g + 4 * h) * 4);
                    S[d][4 * g] *= dv[0]; S[d][4 * g + 1] *= dv[1]; S[d][4 * g + 2] *= dv[2]; S[d][4 * g + 3] *= dv[3]; }
                bf16x8 fk[4];
#pragma unroll
                for (int kb = 0; kb < 4; ++kb) fk[kb] = *(const LAS bf16x8*)(lb + OK + ((d * 4 + kb) * 64 + lane) * 16);
#pragma unroll
                for (int kb = 0; kb < 4; ++kb) S[d] = MFMA32(fk[kb], Ub[kb], S[d]);
                Sb[2 * d] = pack16(S[d], 0); Sb[2 * d + 1] = pack16(S[d], 1); }
        }
        __syncthreads();
    }
}
DI void phase_scan(CArgs& a, LAS unsigned char* lds) {
    char* r1 = a.ws + WS_R1; char* obuf = r1 + R1_OBUF;
    for (int it = lbid(); it < 96; it += lgrid()) {
        if (it < 32) { const char* ops = r1 + R1_SGDN + (size_t)it * 64 * GDN_UNIT; char* ob = obuf + OB_GDN + (size_t)it * 64 * 16384;
            scan_wg<128, true, 1, 4, GDN_UNIT, GDN_OQ, GDN_OW, GDN_OP, GDN_OK, GDN_OU, GDN_OD>(ops, ops, ob, ob, lds); }
        else if (it < 64) { const int i2 = it - 32; const char* ops = r1 + R1_SGLA + (size_t)i2 * 64 * GLA_UNIT; char* ob = obuf + OB_GLA + (size_t)i2 * 64 * 16384;
            scan_wg<64, false, 1, 4, GLA_UNIT, GLA_OQ, 0, GLA_OP, GLA_OK, GLA_OU, GLA_OD>(ops, ops, ob, ob, lds); }
        else { const int i2 = (it - 64) * 2; const char* ops = r1 + R1_SSSD + (size_t)i2 * 64 * SSD_UNIT; char* ob = obuf + OB_SSD + (size_t)i2 * 64 * 8192;
            scan_wg<64, false, 2, 2, SSD_UNIT, SSD_OQ, 0, SSD_OP, SSD_OK, SSD_OU, SSD_OD>(ops, ops + (size_t)64 * SSD_UNIT, ob, ob + (size_t)64 * 8192, lds); }
    }
}

DI float otile_ld(const LAS unsigned char* tl, int l_, int e) {
    const int ct = e >> 5, r = e & 31, rt = l_ >> 5, lr = l_ & 31, h = (lr >> 2) & 1, i = (lr & 3) + 4 * (lr >> 3);
    return bf2f(*(const LAS bf16_t*)(tl + ((ct * 2 + rt) * 64 + h * 32 + r) * 32 + i * 2));
}
DI void phase_post(CArgs& a, int l, LAS unsigned char* lds) {
    const int tid = ltid(); char* r1 = a.ws + WS_R1; const bf16_t* P = (const bf16_t*)(r1 + R1_PROJ); const char* obuf = r1 + R1_OBUF; bf16_t* Y = (bf16_t*)(r1 + R1_YMIX);
    const int l_ = tid >> 3, sub = tid & 7;
    for (int u = lbid(); u < 5120; u += lgrid()) {
        if (u < 4096) {
            const int ty = u >> 11, uu = u & 2047, n = uu & 63, bh = uu >> 6, b = bh >> 2, h = bh & 3; const size_t T = (size_t)b * SEQ + n * 64 + l_;
            const char* src = obuf + (ty ? OB_GDN : OB_GLA) + (size_t)uu * 16384;
#pragma unroll
            for (int rep = 0; rep < 2; ++rep) { const int i = rep * NTHREADS + tid; *(LAS u32x4*)(lds + i * 16) = *(const u32x4*)(src + (size_t)i * 16); }
            __syncthreads();
            float o[16]; float ss = 0.f;
#pragma unroll
            for (int j = 0; j < 16; ++j) { o[j] = otile_ld(lds, l_, sub * 16 + j); ss += o[j] * o[j]; }
            ss += __shfl_xor(ss, 1); ss += __shfl_xor(ss, 2); ss += __shfl_xor(ss, 4);
            const float rs = rsqrtf(ss * (1.f / 128.f) + 1e-6f);
            const float* ng = (ty ? a.gdn_norm : a.gla_norm) + l * 128 + sub * 16;
            const bf16_t* gp = P + T * NP + (ty ? PC_GDN_G : PC_GLA_R) + h * 128 + sub * 16;
            const u32x4 g0 = *(const u32x4*)gp, g1 = *(const u32x4*)(gp + 8);
            const float gv[16] = {bflo(g0.x), bfhi(g0.x), bflo(g0.y), bfhi(g0.y), bflo(g0.z), bfhi(g0.z), bflo(g0.w), bfhi(g0.w), bflo(g1.x), bfhi(g1.x), bflo(g1.y), bfhi(g1.y), bflo(g1.z), bfhi(g1.z), bflo(g1.w), bfhi(g1.w)};
            float y[16];
#pragma unroll
            for (int j = 0; j < 16; ++j) y[j] = o[j] * rs * ng[j] * silu_(gv[j]);
            bf16_t* yp = Y + ((size_t)ty * NTOK + T) * 512 + h * 128 + sub * 16;
            *(u32x4*)yp = (u32x4){pk2(y[0], y[1]), pk2(y[2], y[3]), pk2(y[4], y[5]), pk2(y[6], y[7])};
            *(u32x4*)(yp + 8) = (u32x4){pk2(y[8], y[9]), pk2(y[10], y[11]), pk2(y[12], y[13]), pk2(y[14], y[15])};
            __syncthreads();
        } else {
            const int uu = u - 4096, n = uu & 63, bg = uu >> 6, b = bg >> 1, g = bg & 1; const size_t T = (size_t)b * SEQ + n * 64 + l_;
#pragma unroll
            for (int rep = 0; rep < 4; ++rep) { const int i = rep * NTHREADS + tid, hq = i >> 9, ii = i & 511;
                *(LAS u32x4*)(lds + i * 16) = *(const u32x4*)(obuf + OB_SSD + ((size_t)((b * 8 + g * 4 + hq) * 64 + n)) * 8192 + (size_t)ii * 16); }
            __syncthreads();
            const int hq = sub >> 1, hh = g * 4 + hq, p0 = (sub & 1) * 32; const float dsk = a.ssd_d[l * 8 + hh];
            float y[32]; float ss = 0.f;
#pragma unroll
            for (int c8 = 0; c8 < 4; ++c8) { const int ch = hh * 64 + p0 + c8 * 8; float xc[8];
                conv8(P + T * NP + PC_SSD_XBC + ch, n * 64 + l_, a.ssd_conv_w + (size_t)l * 4 * 768 + ch, 768, a.ssd_conv_b + l * 768 + ch, xc);
                const u32x4 z8 = *(const u32x4*)(P + T * NP + PC_SSD_Z + ch);
                const float zf[8] = {bflo(z8.x), bfhi(z8.x), bflo(z8.y), bfhi(z8.y), bflo(z8.z), bfhi(z8.z), bflo(z8.w), bfhi(z8.w)};
#pragma unroll
                for (int j = 0; j < 8; ++j) { const float ov = otile_ld(lds + hq * 8192, l_, p0 + c8 * 8 + j); const float yv = (ov + dsk * xc[j]) * silu_(zf[j]); y[c8 * 8 + j] = yv; ss += yv * yv; } }
            ss += __shfl_xor(ss, 1); ss += __shfl_xor(ss, 2); ss += __shfl_xor(ss, 4);
            const float rs = rsqrtf(ss * (1.f / 256.f) + 1e-6f);
            const float* ng = a.ssd_norm + l * 512 + hh * 64 + p0;
            bf16_t* yp = Y + ((size_t)2 * NTOK + T) * 512 + hh * 64 + p0;
#pragma unroll
            for (int c8 = 0; c8 < 4; ++c8) { float t[8];
#pragma unroll
                for (int j = 0; j < 8; ++j) t[j] = y[c8 * 8 + j] * rs * ng[c8 * 8 + j];
                *(u32x4*)(yp + c8 * 8) = (u32x4){pk2(t[0], t[1]), pk2(t[2], t[3]), pk2(t[4], t[5]), pk2(t[6], t[7])}; }
            __syncthreads();
        }
    }
}
DI CArgs& load_args() { CArgs* p = (CArgs*)__builtin_amdgcn_kernarg_segment_ptr(); asm volatile("" : "+s"(p)); return *p; }
DI void grid_sync(LAS unsigned char* lds) {
    CArgs& a = load_args(); XcdBarrier b; b.bar = (unsigned*)(a.ws + WS_CTL); b.x = xb_xcc_id(); b.st = (volatile LAS unsigned*)(lds + LDS_CTRL); xcd_barrier(b); }
__global__ void __launch_bounds__(NTHREADS, 2) fwd_kernel(Args a_unused) {
    extern __shared__ __attribute__((aligned(16))) unsigned char lds_raw[];
    LAS unsigned char* lds = (LAS unsigned char*)lds_raw;
    const int tid = ltid();
    if (tid < 256) ((LAS unsigned*)(lds + LDS_CTRL))[tid] = 0u;
    __syncthreads();
    { CArgs& a = load_args(); (void)xcd_barrier_post((unsigned*)(a.ws + WS_CTL), (volatile LAS unsigned*)(lds + LDS_CTRL)); }
    const int G = lgrid(), c = lbid();
#ifndef REP_CVT
#define REP_CVT 1
#endif
#ifndef REP_INPROJ
#define REP_INPROJ 1
#endif
#ifndef REP_PREP
#define REP_PREP 1
#endif
#ifndef REP_SCAN
#define REP_SCAN 1
#endif
#ifndef REP_POST
#define REP_POST 1
#endif
#ifndef REP_BR
#define REP_BR 1
#endif
#ifndef REP_OUT
#define REP_OUT 1
#endif
#ifndef REP_GU
#define REP_GU 1
#endif
#ifndef REP_DN
#define REP_DN 1
#endif
#ifndef REP_COMB
#define REP_COMB 1
#endif
#define REPEAT(n) for (int rep_ = 0; rep_ < (n); ++rep_)
    { CArgs& a = load_args(); phase_mod(a, lds); }
    REPEAT(REP_CVT) { CArgs& a = load_args(); phase_cvt(a, lds); }
    grid_sync(lds);
    { CArgs& a = load_args(); phase_norm0(a); }
    grid_sync(lds);
    for (int l = 0; l < 2; ++l) {
        REPEAT(REP_INPROJ) {
        { CArgs& a = load_args(); char* r1 = a.ws + WS_R1;
#if INPROJ_FP8
          pg8::StaticOrder S; S.init(NTOK, NP, DM / 2, G, c, a.ws + WS_H, a.ws + WS_WIN + (size_t)l * NP * DM);
          EpiProj E{(bf16_t*)(r1 + R1_PROJ), (float*)(a.ws + WS_SMALL), W8_INV};
          pg8::gemm_phase<EpiProj, pg8::StaticOrder, true>(lds, DM / 2, S, E);
#else
          pg8::StaticOrder S; S.init(NTOK, NP, DM, G, c, a.ws + WS_H, a.ws + WS_WIN + (size_t)l * NP * DM * 2);
          EpiProj E{(bf16_t*)(r1 + R1_PROJ), (float*)(a.ws + WS_SMALL), 1.f};
          pg8::gemm_phase<EpiProj, pg8::StaticOrder>(lds, DM, S, E);
#endif
        }
        grid_sync(lds); }
        REPEAT(REP_PREP) { { CArgs& a = load_args(); phase_prep(a, l, lds); }
        grid_sync(lds); }
        REPEAT(REP_SCAN) { { CArgs& a = load_args(); phase_scan(a, lds); }
        grid_sync(lds); }
        REPEAT(REP_POST) { { CArgs& a = load_args(); phase_post(a, l, lds); }
        grid_sync(lds); }
        REPEAT(REP_BR) {
        { CArgs& a = load_args(); char* r1 = a.ws + WS_R1;
          pg8::BranchOrder S; S.init(NTOK, DM, 512, G, c, r1 + R1_YMIX, a.ws + WS_WBR + (size_t)l * 3 * DM * 512 * 2); S.pn_per_a = 4; S.a_pnstride = (size_t)NTOK * 512 * 2;
          EpiGate E{(const bf16_t*)(r1 + R1_PROJ), a.b_merge + l * 3072, (bf16_t*)(r1 + R1_GATED), (bf16_t*)(r1 + R1_MERGED)};
          pg8::gemm_phase<EpiGate, pg8::BranchOrder>(lds, 512, S, E); }
        grid_sync(lds); }
        REPEAT(REP_OUT) {
        { CArgs& a = load_args(); char* r1 = a.ws + WS_R1;
          pg8::StaticOrder S; S.init(NTOK, DM, DM, G, c, r1 + R1_MERGED, a.ws + WS_WOUT + (size_t)l * DM * DM * 2);
          EpiResid E{(l == 0) ? a.x : (const float*)(a.ws + WS_XB), (float*)(a.ws + WS_XA), (const float*)(a.ws + WS_MOD) + (size_t)l * 8 * 6144 + 2048};
          pg8::gemm_phase<EpiResid, pg8::StaticOrder>(lds, DM, S, E); }
        grid_sync(lds); }
        { CArgs& a = load_args(); phase_router(a, l, (const float*)(a.ws + WS_XA), lds); }
        grid_sync(lds);
        REPEAT(REP_GU) {
        { CArgs& a = load_args(); char* r1 = a.ws + WS_R1;
          moe_tables((const int*)(a.ws + WS_CNT) + l * 32 * 64, lds);
          MoeOrder<true> S{8, G, c, (const LAS int*)(lds + LDS_CTRL + 64), (const LAS int*)(lds + LDS_CTRL + 256), (const char*)(a.ws + WS_H), a.ws + WS_WGU + (size_t)l * NEXP * 2048 * DM,
                           (size_t)2048 * DM, (size_t)256 * DM, (const int*)(a.ws + WS_ROWTOK)};
          EpiSwiglu E{(unsigned char*)(r1 + R1_ACT), a.b_gu + (size_t)l * NEXP * 2048};
          pg8::gemm_phase<EpiSwiglu, MoeOrder<true>, true>(lds, DM / 2, S, E); }
        grid_sync(lds); }
        REPEAT(REP_DN) {
        { CArgs& a = load_args(); char* r1 = a.ws + WS_R1;
          MoeOrder<false> S{4, G, c, (const LAS int*)(lds + LDS_CTRL + 64), (const LAS int*)(lds + LDS_CTRL + 256), (const char*)(r1 + R1_ACT), a.ws + WS_WDN + (size_t)l * NEXP * DM * DM,
                            (size_t)DM * DM, (size_t)256 * DM, nullptr};
          EpiDown E{(bf16_t*)(r1 + R1_YS), a.b_dn + (size_t)l * NEXP * DM};
          pg8::gemm_phase<EpiDown, MoeOrder<false>, true>(lds, DM / 2, S, E); }
        grid_sync(lds); }
        REPEAT(REP_COMB) { { CArgs& a = load_args(); phase_combine(a, l, (const float*)(a.ws + WS_XA), (float*)(a.ws + WS_XB), lds); }
        grid_sync(lds); }
    }
}

extern "C" void kernel_launch(void* const* d_in, const int* in_sizes, int n_in, void* d_out, int out_size, void* d_ws, size_t ws_size, hipStream_t stream) {
    static int grid = 0;
    if (grid == 0) {
        if (n_in != 32 || ws_size < WS_END) { fprintf(stderr, "kernel_launch: unexpected inputs (n_in %d, ws %zu, need %zu)\n", n_in, ws_size, (size_t)WS_END); grid = -1; return; }
        int dev = 0, cus = 0, per_cu = 0;
        if (hipGetDevice(&dev) != hipSuccess || hipDeviceGetAttribute(&cus, hipDeviceAttributeMultiprocessorCount, dev) != hipSuccess) { grid = -1; return; }
        if (hipFuncSetAttribute((const void*)fwd_kernel, hipFuncAttributeMaxDynamicSharedMemorySize, LDS_BYTES) != hipSuccess) { fprintf(stderr, "kernel_launch: hipFuncSetAttribute failed\n"); grid = -1; return; }
        if (hipOccupancyMaxActiveBlocksPerMultiprocessor(&per_cu, (const void*)fwd_kernel, NTHREADS, LDS_BYTES) != hipSuccess || per_cu < 1) { fprintf(stderr, "kernel_launch: occupancy query says %d\n", per_cu); grid = -1; return; }
        grid = cus;
    }
    if (grid < 0) return;
    (void)hipMemsetAsync((char*)d_ws + WS_CTL, 0, 65536, stream);
    Args a{};
    const float** pp = (const float**)&a;
    for (int i = 0; i < 32; ++i) pp[i] = (const float*)d_in[i];
    a.out = (float*)d_out; a.ws = (char*)d_ws;
    hipLaunchKernelGGL(fwd_kernel, dim3(grid), dim3(NTHREADS), LDS_BYTES, stream, a);
}
```

```cpp
#include <hip/hip_runtime.h>
#include <cstdio>
#include <cstdint>
#define DI __device__ __forceinline__
#define LAS __attribute__((address_space(3)))
typedef unsigned short bf16_t;
typedef short bf16x8 __attribute__((ext_vector_type(8)));
typedef float f32x4 __attribute__((ext_vector_type(4)));
typedef float f32x2 __attribute__((ext_vector_type(2)));
typedef float f32x16 __attribute__((ext_vector_type(16)));
typedef unsigned u32x4 __attribute__((ext_vector_type(4)));
typedef unsigned u32x2 __attribute__((ext_vector_type(2)));
typedef __bf16 hbf16x2 __attribute__((ext_vector_type(2)));

DI int ltid() { int t = threadIdx.x; asm volatile("" : "+v"(t)); return t; }
DI int lbid() { int t = blockIdx.x; asm volatile("" : "+s"(t)); return t; }
DI int lgrid() { int t = gridDim.x; asm volatile("" : "+s"(t)); return t; }
DI unsigned pk2(float a, float b) { f32x2 v = {a, b}; hbf16x2 r = __builtin_convertvector(v, hbf16x2); return __builtin_bit_cast(unsigned, r); }
DI float bflo(unsigned w) { return __uint_as_float(w << 16); }
DI float bfhi(unsigned w) { return __uint_as_float(w & 0xffff0000u); }
DI float bf2f(bf16_t v) { return __uint_as_float(((unsigned)v) << 16); }
DI bf16_t f2bf(float a) { return (bf16_t)(pk2(a, 0.f) & 0xffffu); }
DI float sigmoid_(float x) { return 1.f / (1.f + __expf(-x)); }
DI float silu_(float x) { return x / (1.f + __expf(-x)); }
DI float softplus_(float x) { return fmaxf(x, 0.f) + log1pf(__expf(-fabsf(x))); }

namespace pg8 {
constexpr int BM = 256, BK = 64, HALF = 128, HTB = HALF * BK * 2, STAGE_BYTES = 8 * HTB, NXCD = 8, WGM = 8;
__host__ __device__ __forceinline__ int lds_byte(int r, int c) { const int st = (r >> 4) * 2 + (c >> 5), rr = r & 15, cc = c & 31, ob = rr * 64 + cc * 2; return st * 1024 + (ob ^ (((ob >> 9) & 1) << 5)); }
__host__ __device__ __forceinline__ void stage_rc(int b, int& R, int& C) { const int st = b / 1024, sb = b % 1024, swz = sb ^ (((sb >> 9) & 1) << 5); R = (st >> 1) * 16 + swz / 64; C = (st & 1) * 32 + (swz % 64) / 2; }
__host__ __device__ __forceinline__ int perm32(int rho) { const int n = rho >> 4, i = rho & 15; return 8 * (i >> 2) + 4 * n + (i & 3); }

struct Unit { int pm, pn, e, cnt; };

struct StaticOrder {
    static constexpr bool GATHER = false;
    int nM, nN, nwg, G, c;
    const char* A; const char* Bt; size_t a_tstep, b_tstep, a_pnstride; int pn_per_a;
    DI void init(int M, int N, int K, int G_, int c_, const void* A_, const void* Bt_) { nM = M / BM; nN = N / BM; nwg = nM * nN; G = G_; c = c_; A = (const char*)A_; Bt = (const char*)Bt_; a_tstep = (size_t)BM * K * 2; b_tstep = (size_t)BM * K * 2; a_pnstride = 0; pn_per_a = 1 << 30; }
    DI bool next(int i, Unit& u) const {
        const long L = (long)i * G + c; if (L >= nwg) return false;
        int wgid = (int)L; { const int q = nwg / NXCD, r = nwg % NXCD, xcd = wgid % NXCD, off = wgid / NXCD; wgid = (xcd < r ? xcd * (q + 1) : r * (q + 1) + (xcd - r) * q) + off; }
        const int nig = WGM * nN, gid = wgid / nig, fm = gid * WGM, gsz = (nM - fm) < WGM ? (nM - fm) : WGM;
        u.pm = fm + ((wgid % nig) % gsz); u.pn = (wgid % nig) / gsz; u.e = 0; u.cnt = 256; return true;
    }
    DI const char* a_ptr(const Unit& u) const { return A + (size_t)(u.pn / pn_per_a) * a_pnstride + (size_t)u.pm * a_tstep; }
    DI const char* b_ptr(const Unit& u) const { return Bt + (size_t)u.pn * b_tstep; }
    DI int a_row(const Unit&, int) const { return 0; }
};

typedef int i32x4 __attribute__((ext_vector_type(4)));
typedef int i32x8 __attribute__((ext_vector_type(8)));
struct BranchOrder : StaticOrder {
    DI bool next(int i, Unit& u) const { if (!StaticOrder::next(i / 3, u)) return false; u.pn += 4 * (i % 3); return true; }
};
template <class Epi, class Sched, int MODE = 0  , bool ALIGN_EPI = true>
DI void gemm_phase(LAS unsigned char* lds, const int K, const Sched& S, const Epi& E) {
    constexpr bool GATHER = Sched::GATHER; constexpr bool FP8 = (MODE == 1);
    const int tid = ltid(), wid = __builtin_amdgcn_readfirstlane(tid >> 6), lane = tid & 63, wr = wid >> 2, wc = wid & 3, fr = lane & 15, fq = lane >> 4;
    const int nt = K / BK;
    unsigned voffA[2], voffB[2]; int RA[2], CA[2];
#pragma unroll
    for (int i = 0; i < 2; ++i) { int R, C; stage_rc(tid * 16 + i * 8192, R, C); const int Rb = Epi::PERM ? ((R & ~31) + perm32(R & 31)) : R; RA[i] = R; CA[i] = C;
        voffA[i] = (unsigned)(R * K + C) * 2u; voffB[i] = (unsigned)(Rb * K + C) * 2u; }
    const size_t kstep = (size_t)(BK * 2);
    const size_t hstepB = (size_t)HALF * K * 2;
    const size_t hstepA = GATHER ? 0 : hstepB;
    const unsigned ldsw = (unsigned)wid * 1024u;
    const int aoff = lds_byte(wr * 64 + fr, fq * 8), boff = lds_byte(wc * 32 + fr, fq * 8);
#define PG8_SA(b, h) (((b) * 2 + (h)) * HTB)
#define PG8_SB(b, h) ((4 + (b) * 2 + (h)) * HTB)
#define PG8_STAGE(bufoff, gbase, voff) do { _Pragma("unroll") for (int _i = 0; _i < 2; ++_i) \
        __builtin_amdgcn_global_load_lds((const unsigned*)((const char*)(gbase) + (voff)[_i]), (LAS unsigned*)(lds + (bufoff) + ldsw + _i * 8192), 16, 0, 0); } while (0)
#define PG8_CAT(x, y) __builtin_shufflevector(__builtin_bit_cast(i32x4, x), __builtin_bit_cast(i32x4, y), 0, 1, 2, 3, 4, 5, 6, 7)
#define PG8_LDA8(dst, b, h) do { _Pragma("unroll") for (int m = 0; m < 4; ++m) dst[m] = PG8_CAT(*(const LAS bf16x8*)(lds + PG8_SA(b, h) + aoff + m * 2048), *(const LAS bf16x8*)(lds + PG8_SA(b, h) + aoff + m * 2048 + 1024)); } while (0)
#define PG8_LDB8(dst, b, h) do { _Pragma("unroll") for (int n = 0; n < 2; ++n) dst[n] = PG8_CAT(*(const LAS bf16x8*)(lds + PG8_SB(b, h) + boff + n * 2048), *(const LAS bf16x8*)(lds + PG8_SB(b, h) + boff + n * 2048 + 1024)); } while (0)
#define PG8_MMA8(ai, bj, At, Bt) do { __builtin_amdgcn_s_setprio(1); _Pragma("unroll") for (int m = 0; m < 4; ++m) _Pragma("unroll") for (int n = 0; n < 2; ++n) \
        asm volatile("v_mfma_scale_f32_16x16x128_f8f6f4 %0, %1, %2, %0, %3, %3 op_sel_hi:[0,0,0]" : "+v"(acc[ai][bj][m][n]) : "v"(Bt[n]), "v"(At[m]), "v"(one_scale)); __builtin_amdgcn_s_setprio(0); } while (0)
#define PG8_LDA(dst, b, h) do { _Pragma("unroll") for (int m = 0; m < 4; ++m) _Pragma("unroll") for (int k = 0; k < 2; ++k) dst[m][k] = *(const LAS bf16x8*)(lds + PG8_SA(b, h) + aoff + m * 2048 + k * 1024); } while (0)
#define PG8_LDB(dst, b, h) do { _Pragma("unroll") for (int n = 0; n < 2; ++n) _Pragma("unroll") for (int k = 0; k < 2; ++k) dst[n][k] = *(const LAS bf16x8*)(lds + PG8_SB(b, h) + boff + n * 2048 + k * 1024); } while (0)
#define PG8_MMA(ai, bj, At, Bt) do { __builtin_amdgcn_s_setprio(1); _Pragma("unroll") for (int m = 0; m < 4; ++m) _Pragma("unroll") for (int n = 0; n < 2; ++n) _Pragma("unroll") for (int k = 0; k < 2; ++k) { \
        if constexpr (MODE == 2) acc[ai][bj][m][n] = __builtin_bit_cast(f32x4, __builtin_amdgcn_mfma_i32_16x16x64_i8(__builtin_bit_cast(i32x4, Bt[n][k]), __builtin_bit_cast(i32x4, At[m][k]), __builtin_bit_cast(i32x4, acc[ai][bj][m][n]), 0, 0, 0)); \
        else acc[ai][bj][m][n] = __builtin_amdgcn_mfma_f32_16x16x32_bf16(Bt[n][k], At[m][k], acc[ai][bj][m][n], 0, 0, 0); } __builtin_amdgcn_s_setprio(0); } while (0)
#define PG8_WAIT_V(n) asm volatile("s_waitcnt vmcnt(" #n ")" ::: "memory")
#define PG8_WAIT_L(n) asm volatile("s_waitcnt lgkmcnt(" #n ")" ::: "memory")
#define PG8_BAR __builtin_amdgcn_s_barrier()
#define PG8_SCHED __builtin_amdgcn_sched_barrier(0)
    Unit cur, nxt; int ui = 0;
    if (!S.next(0, cur)) return;
    f32x4 acc[2][2][4][2];
#pragma unroll
    for (int a = 0; a < 2; ++a)
#pragma unroll
        for (int b = 0; b < 2; ++b)
#pragma unroll
            for (int m = 0; m < 4; ++m)
#pragma unroll
                for (int n = 0; n < 2; ++n) acc[a][b][m][n] = (f32x4){0.f, 0.f, 0.f, 0.f};
    bf16x8 At[4][2], B0[2][2], B1[2][2]; i32x8 Ct[4], C0[2], C1[2]; const int one_scale = 0x7f7f7f7f;
    const char* cA = S.a_ptr(cur); const char* cB = S.b_ptr(cur);
    unsigned vC0[2], vC1[2], vN0[2], vN1[2];
    if constexpr (GATHER) {
#pragma unroll
        for (int i = 0; i < 2; ++i) { vC0[i] = (unsigned)(S.a_row(cur, RA[i]) * K + CA[i]) * 2u; vC1[i] = (unsigned)(S.a_row(cur, HALF + RA[i]) * K + CA[i]) * 2u; vN0[i] = vC0[i]; vN1[i] = vC1[i]; }
    } else {
#pragma unroll
        for (int i = 0; i < 2; ++i) { vC0[i] = voffA[i]; vC1[i] = voffA[i]; vN0[i] = voffA[i]; vN1[i] = voffA[i]; }
    }
    PG8_STAGE(PG8_SB(0, 0), cB, voffB); PG8_STAGE(PG8_SB(0, 1), cB + hstepB, voffB); PG8_STAGE(PG8_SA(0, 0), cA, vC0); PG8_STAGE(PG8_SA(0, 1), cA + hstepA, vC1);
    if (wr == 1) PG8_BAR;
    PG8_WAIT_V(2); PG8_BAR;
    PG8_STAGE(PG8_SB(1, 0), cB + kstep, voffB); PG8_STAGE(PG8_SA(1, 0), cA + kstep, vC0); PG8_STAGE(PG8_SB(1, 1), cB + hstepB + kstep, voffB);
    PG8_WAIT_V(6); PG8_BAR;
    for (;;) {
        const bool has_next = S.next(ui + 1, nxt);
        const char* nA = has_next ? S.a_ptr(nxt) : cA; const char* nB = has_next ? S.b_ptr(nxt) : cB;
        if constexpr (GATHER) { if (has_next) {
#pragma unroll
            for (int i = 0; i < 2; ++i) { vN0[i] = (unsigned)(S.a_row(nxt, RA[i]) * K + CA[i]) * 2u; vN1[i] = (unsigned)(S.a_row(nxt, HALF + RA[i]) * K + CA[i]) * 2u; } } }
#pragma unroll 1
        for (int t = 0; t < nt; t += 2) {
            const bool last = (t == nt - 2);
            const char* a1 = cA + (size_t)(t + 1) * kstep;
            const char* a2 = last ? nA : cA + (size_t)(t + 2) * kstep; const char* b2 = last ? nB : cB + (size_t)(t + 2) * kstep;
            const char* a3 = a2 + kstep; const char* b3 = b2 + kstep;
            unsigned w0[2], w1[2];
            if constexpr (GATHER) { w0[0] = last ? vN0[0] : vC0[0]; w0[1] = last ? vN0[1] : vC0[1]; w1[0] = last ? vN1[0] : vC1[0]; w1[1] = last ? vN1[1] : vC1[1]; }
            else { w0[0] = voffA[0]; w0[1] = voffA[1]; w1[0] = voffA[0]; w1[1] = voffA[1]; }
            if constexpr (FP8) {
            PG8_LDB8(C0, 0, 0); PG8_LDB8(C1, 0, 1); PG8_SCHED; PG8_LDA8(Ct, 0, 0); PG8_STAGE(PG8_SA(1, 1), a1 + hstepA, vC1);
            PG8_WAIT_V(8); PG8_WAIT_L(0); PG8_BAR; PG8_MMA8(0, 0, Ct, C0); PG8_MMA8(0, 1, Ct, C1); PG8_BAR; PG8_SCHED;
            PG8_LDA8(Ct, 0, 1); PG8_STAGE(PG8_SB(0, 0), b2, voffB); PG8_STAGE(PG8_SB(0, 1), b2 + hstepB, voffB); PG8_STAGE(PG8_SA(0, 0), a2, w0);
            PG8_WAIT_V(8); PG8_WAIT_L(0); PG8_BAR; PG8_MMA8(1, 0, Ct, C0); PG8_MMA8(1, 1, Ct, C1); PG8_BAR; PG8_SCHED;
            PG8_LDB8(C0, 1, 0); PG8_LDB8(C1, 1, 1); PG8_SCHED; PG8_LDA8(Ct, 1, 0); PG8_STAGE(PG8_SA(0, 1), a2 + hstepA, w1);
            PG8_WAIT_V(8); PG8_WAIT_L(0); PG8_BAR; PG8_MMA8(0, 0, Ct, C0); PG8_MMA8(0, 1, Ct, C1); PG8_BAR; PG8_SCHED;
            PG8_LDA8(Ct, 1, 1); PG8_STAGE(PG8_SB(1, 0), b3, voffB); PG8_STAGE(PG8_SB(1, 1), b3 + hstepB, voffB); PG8_STAGE(PG8_SA(1, 0), a3, w0);
            PG8_WAIT_V(8); PG8_WAIT_L(0); PG8_BAR; PG8_MMA8(1, 0, Ct, C0); PG8_MMA8(1, 1, Ct, C1); PG8_BAR; PG8_SCHED;
                    } else {
            PG8_LDB(B0, 0, 0); PG8_LDB(B1, 0, 1); PG8_SCHED; PG8_LDA(At, 0, 0); PG8_STAGE(PG8_SA(1, 1), a1 + hstepA, vC1);
            PG8_WAIT_V(8); PG8_WAIT_L(0); PG8_BAR; PG8_MMA(0, 0, At, B0); PG8_MMA(0, 1, At, B1); PG8_BAR; PG8_SCHED;
            PG8_LDA(At, 0, 1); PG8_STAGE(PG8_SB(0, 0), b2, voffB); PG8_STAGE(PG8_SB(0, 1), b2 + hstepB, voffB); PG8_STAGE(PG8_SA(0, 0), a2, w0);
            PG8_WAIT_V(8); PG8_WAIT_L(0); PG8_BAR; PG8_MMA(1, 0, At, B0); PG8_MMA(1, 1, At, B1); PG8_BAR; PG8_SCHED;
            PG8_LDB(B0, 1, 0); PG8_LDB(B1, 1, 1); PG8_SCHED; PG8_LDA(At, 1, 0); PG8_STAGE(PG8_SA(0, 1), a2 + hstepA, w1);
            PG8_WAIT_V(8); PG8_WAIT_L(0); PG8_BAR; PG8_MMA(0, 0, At, B0); PG8_MMA(0, 1, At, B1); PG8_BAR; PG8_SCHED;
            PG8_LDA(At, 1, 1); PG8_STAGE(PG8_SB(1, 0), b3, voffB); PG8_STAGE(PG8_SB(1, 1), b3 + hstepB, voffB); PG8_STAGE(PG8_SA(1, 0), a3, w0);
            PG8_WAIT_V(8); PG8_WAIT_L(0); PG8_BAR; PG8_MMA(1, 0, At, B0); PG8_MMA(1, 1, At, B1); PG8_BAR; PG8_SCHED;
                    }
        }
        if constexpr (FP8) asm volatile("s_nop 15\n\ts_nop 15" ::: "memory");
        if constexpr (ALIGN_EPI) { if (wr == 0) PG8_BAR; }
        E(acc, cur, wr, wc, fr, fq);
        if (!has_next) break;
#pragma unroll
        for (int a = 0; a < 2; ++a)
#pragma unroll
            for (int b = 0; b < 2; ++b)
#pragma unroll
                for (int m = 0; m < 4; ++m)
#pragma unroll
                    for (int n = 0; n < 2; ++n) acc[a][b][m][n] = (f32x4){0.f, 0.f, 0.f, 0.f};
        cur = nxt; cA = nA; cB = nB; ++ui;
        if constexpr (GATHER) { vC0[0] = vN0[0]; vC0[1] = vN0[1]; vC1[0] = vN1[0]; vC1[1] = vN1[1]; }
        if constexpr (ALIGN_EPI) { if (wr == 1) PG8_BAR; }
    }
    PG8_WAIT_V(0);
    if constexpr (!ALIGN_EPI) { if (wr == 0) PG8_BAR; }
    PG8_BAR;
#undef PG8_SA
#undef PG8_SB
#undef PG8_STAGE
#undef PG8_LDA
#undef PG8_LDA8
#undef PG8_LDB8
#undef PG8_MMA8
#undef PG8_CAT
#undef PG8_LDB
#undef PG8_MMA
#undef PG8_WAIT_V
#undef PG8_WAIT_L
#undef PG8_BAR
#undef PG8_SCHED
}
}
using pg8::Unit;

#define XB_TMO      128
#define XB_XCNT(j)  (256  + 64 * (j))
#define XB_XSUB(j)  (1280 + 64 * (j))
#define XB_XGEN(j)  (2304 + 64 * (j))
#define XB_TOP      3328
#define XB_TOPGEN   3392
#define XCD_BAR_WORDS 3456
#define XB_SPIN_CAP (1u << 18)
DI unsigned xb_ld(unsigned* p)              { return __hip_atomic_load(p, __ATOMIC_RELAXED, __HIP_MEMORY_SCOPE_AGENT); }
DI unsigned xb_add(unsigned* p, unsigned v) { return __hip_atomic_fetch_add(p, v, __ATOMIC_RELAXED, __HIP_MEMORY_SCOPE_AGENT); }
DI unsigned xb_xcc_id() { return (unsigned)__builtin_amdgcn_s_getreg((3 << 11) | 20) & 0xFu; }
#define XB_SPIN(cond, bar) do { unsigned _sp = 0; while (cond) { __builtin_amdgcn_s_sleep(1); \
    if ((++_sp & 255u) == 0u) { if (xb_ld(&(bar)[XB_TMO])) break; if (_sp > XB_SPIN_CAP) { atomicAdd(&(bar)[XB_TMO], 1u); break; } } } } while (0)
struct XcdBarrier { unsigned* bar; unsigned x; volatile LAS unsigned* st; };
DI XcdBarrier xcd_barrier_post(unsigned* bar, volatile LAS unsigned* st) {
    XcdBarrier b; b.bar = bar; b.x = xb_xcc_id(); b.st = st;
    if (threadIdx.x == 0) (void)xb_add(&bar[XB_XCNT(b.x)], 1u);
    return b;
}
DI void xcd_barrier_complete(unsigned* bar, unsigned x, unsigned& nloc, unsigned& nx) {
    const unsigned G = gridDim.x * gridDim.y * gridDim.z;
    unsigned sum, cnt, mine, sp = 0u;
    for (;;) {
        sum = 0u; cnt = 0u; mine = 0u;
#pragma unroll
        for (unsigned j = 0; j < 16; ++j) { const unsigned c = xb_ld(&bar[XB_XCNT(j)]); sum += c; cnt += (c > 0u) ? 1u : 0u; mine = (j == x) ? c : mine; }
        if (sum == G) break;
        __builtin_amdgcn_s_sleep(1);
        if ((++sp & 255u) == 0u) { if (xb_ld(&bar[XB_TMO])) break; if (sp > XB_SPIN_CAP) { atomicAdd(&bar[XB_TMO], 1u); break; } }
    }
    nloc = mine > 0u ? mine : 1u; nx = cnt > 0u ? cnt : 1u;
}
DI void xcd_barrier(const XcdBarrier& b) {
    asm volatile("s_waitcnt vmcnt(0)" ::: "memory");
    __syncthreads();
    if (threadIdx.x == 0) {
        unsigned* bar = b.bar;
        __builtin_amdgcn_s_waitcnt(0);
        unsigned nloc = b.st[0], nx = b.st[1];
        if (nloc == 0u) { xcd_barrier_complete(bar, b.x, nloc, nx); b.st[0] = nloc; b.st[1] = nx; }
        const unsigned old = xb_add(&bar[XB_XSUB(b.x)], 1u);
        const unsigned gen = old / nloc;
        if (old + 1u == (gen + 1u) * nloc) {
            __builtin_amdgcn_fence(__ATOMIC_RELEASE, "agent");
            asm volatile("s_waitcnt vmcnt(0)" ::: "memory");
            const unsigned og = xb_add(&bar[XB_TOP], 1u);
            const unsigned tg = og / nx;
            if (og + 1u == (tg + 1u) * nx) xb_add(&bar[XB_TOPGEN], 1u);
            else XB_SPIN(xb_ld(&bar[XB_TOPGEN]) == tg, bar);
            __builtin_amdgcn_fence(__ATOMIC_ACQUIRE, "agent");
            xb_add(&bar[XB_XGEN(b.x)], 1u);
            asm volatile("s_waitcnt vmcnt(0)" ::: "memory");
        } else {
            XB_SPIN(xb_ld(&bar[XB_XGEN(b.x)]) == gen, bar);
            __builtin_amdgcn_fence(__ATOMIC_ACQUIRE, "agent");
            asm volatile("s_waitcnt vmcnt(0)" ::: "memory");
        }
    }
    __syncthreads();
}
constexpr int DM = 1024, NB = 8, SEQ = 4096, NTOK = NB * SEQ, NCHUNK = 64, NP = 8192, NEXP = 32;
constexpr int PC_GLA_Q = 0, PC_GLA_K = 256, PC_GLA_V = 512, PC_GLA_R = 1024, PC_GDN_QKV = 1536, PC_GDN_G = 3072, PC_SSD_Z = 3584, PC_SSD_XBC = 4096, PC_MERGE = 4864, PC_SMALL = 7936;
constexpr int IN_COLS = 7968;
constexpr int NTHREADS = 512;
#ifndef INPROJ_I8
#define INPROJ_I8 1
#endif
constexpr int LDS_BYTES = 155648;
constexpr int LDS_CTRL = LDS_BYTES - 1024;
constexpr int GLA_UNIT = 41984, GDN_UNIT = 74752, SSD_UNIT = 33792;
constexpr int GLA_OQ = 0, GLA_OP = 8192, GLA_OK = 16384, GLA_OU = 24576, GLA_OD = 40960;
constexpr int GDN_OQ = 0, GDN_OW = 16384, GDN_OP = 32768, GDN_OK = 40960, GDN_OU = 57344, GDN_OD = 73728;
constexpr int SSD_OQ = 0, SSD_OP = 8192, SSD_OK = 16384, SSD_OU = 24576, SSD_OD = 32768;
constexpr size_t WS_CTL = 0, WS_CNT = 16384, WS_MOD = 65536;
constexpr size_t WS_WIN = 458752, WS_WBR = WS_WIN + 33554432ull, WS_WOUT = WS_WBR + 6291456ull, WS_WGU = WS_WOUT + 12582912ull, WS_WDN = WS_WGU + 268435456ull;
constexpr size_t WS_H = WS_WDN + 134217728ull, WS_SMALL = WS_H + 67108864ull, WS_XA = WS_SMALL + 4194304ull, WS_XB = WS_XA + 134217728ull;
constexpr size_t WS_ROWTOK = WS_XB + 134217728ull, WS_TOKSLOT = WS_ROWTOK + 4194304ull, WS_GATES = WS_TOKSLOT + 524288ull, WS_TSCR = WS_GATES + 524288ull, WS_R1 = WS_TSCR + 16777216ull;
constexpr size_t R1_PROJ = 0, R1_SGLA = 536870912ull, R1_SGDN = R1_SGLA + 2048ull * GLA_UNIT, R1_SSSD = R1_SGDN + 2048ull * GDN_UNIT, R1_OBUF = R1_SSSD + 4096ull * SSD_UNIT;
constexpr size_t R1_YMIX = R1_OBUF + 100663296ull, R1_MERGED = R1_YMIX + 100663296ull, R1_END = R1_MERGED + 67108864ull, R1_GATED = R1_SGLA, R1_ACT = 0, R1_YS = 285212672ull;
constexpr size_t WS_COLMAX = WS_R1 + R1_END, WS_SA = WS_COLMAX + 65536, WS_END = WS_SA + 131072;
constexpr size_t OB_GLA = 0, OB_GDN = 33554432ull, OB_SSD = 67108864ull;

struct Args {
    const float *x, *c, *w_mod, *b_mod, *norm_mix, *norm_ffn, *norm_final, *w_in, *gla_w2, *gla_b2, *gla_norm, *gdn_conv_w, *gdn_a_log, *gdn_dt_bias, *gdn_norm,
        *ssd_conv_w, *ssd_conv_b, *ssd_a_log, *ssd_dt_bias, *ssd_d, *ssd_norm, *w_br_gla, *w_br_gdn, *w_br_ssd, *b_merge, *w_out, *w_router, *b_router, *w_gu, *b_gu, *w_dn, *b_dn;
    float* out; char* ws;
};
typedef const Args __attribute__((address_space(4))) CArgs;

DI void phase_mod(CArgs& a, LAS unsigned char* lds) {
    LAS float* cact = (LAS float*)lds;
    LAS float* red = (LAS float*)(lds + 32768);
    const int tid = ltid();
    for (int i = tid; i < 8192; i += NTHREADS) cact[i] = silu_(a.c[i]);
    __syncthreads();
    float* mod = (float*)(a.ws + WS_MOD);
    for (int blk = lbid(); blk < 256; blk += lgrid()) {
        const int jj = tid & 63, ks = tid >> 6, col = blk * 48 + jj;
        float s[8];
#pragma unroll
        for (int b = 0; b < 8; ++b) s[b] = 0.f;
        if (jj < 48) {
            const int l = col / 6144, j = col % 6144;
            const float* w = a.w_mod + (size_t)l * DM * 6144 + j;
            for (int k = ks * 128; k < ks * 128 + 128; ++k) { const float wv = w[(size_t)k * 6144];
#pragma unroll
                for (int b = 0; b < 8; ++b) s[b] += cact[b * 1024 + k] * wv; }
        }
#pragma unroll
        for (int b = 0; b < 8; ++b) red[(ks * 64 + jj) * 8 + b] = s[b];
        __syncthreads();
        if (tid < 48 * 8) { const int j2 = tid >> 3, b = tid & 7, col2 = blk * 48 + j2, l = col2 / 6144, j = col2 % 6144; float t = 0.f;
#pragma unroll
            for (int k2 = 0; k2 < 8; ++k2) t += red[(k2 * 64 + j2) * 8 + b];
            mod[((size_t)l * 8 + b) * 6144 + j] = t + a.b_mod[l * 6144 + j]; }
        __syncthreads();
    }
}
DI int win_dst(int c) {
    if (c < 1024) return c;
    if (c < 1040) return PC_SMALL + (c - 1024);
    if (c < 1552) return PC_GLA_R + (c - 1040);
    if (c < 3088) return PC_GDN_QKV + (c - 1552);
    if (c < 3092) return PC_SMALL + 16 + (c - 3088);
    if (c < 3096) return PC_SMALL + 20 + (c - 3092);
    if (c < 3608) return PC_GDN_G + (c - 3096);
    if (c < 4120) return PC_SSD_Z + (c - 3608);
    if (c < 4888) return PC_SSD_XBC + (c - 4120);
    if (c < 4896) return PC_SMALL + 24 + (c - 4888);
    return PC_MERGE + (c - 4896);
}
DI unsigned pk4_fp8(float a, float b, float c, float d) { int w = 0; w = __builtin_amdgcn_cvt_pk_fp8_f32(a, b, w, false); w = __builtin_amdgcn_cvt_pk_fp8_f32(c, d, w, true); return (unsigned)w; }
DI unsigned pk4_i8(float a, float b, float c, float d) { const int x = (int)__builtin_rintf(a), y = (int)__builtin_rintf(b), z = (int)__builtin_rintf(c), w = (int)__builtin_rintf(d);
    return (unsigned)(x & 255) | ((unsigned)(y & 255) << 8) | ((unsigned)(z & 255) << 16) | ((unsigned)w << 24); }
DI float wave_max(float v) {
#pragma unroll
    for (int o = 32; o > 0; o >>= 1) v = fmaxf(v, __shfl_xor(v, o));
    return v;
}
constexpr float W8_SCALE = 32.f, W8_INV = 1.f / 32.f;
template <int KIND, int OUT = 0  > DI void cvt_tile(const float* src, int ld_src, int ncols, int k0, int n0, bf16_t* dst, int ld_dst, int kd0, LAS float* T, float* cmax = nullptr) {
    const int tid = ltid();
    { const int jj = tid & 127, kk = tid >> 7; const bool ok = (n0 + jj) < ncols;
#pragma unroll
      for (int i = 0; i < 16; ++i) { const int k = kk + 4 * i; T[k * 129 + jj] = ok ? src[(size_t)(k0 + k) * ld_src + n0 + jj] : 0.f; } }
    __syncthreads();
    { const int j = tid >> 2, kq = tid & 3, c = n0 + j;
      if (c < ncols) {
        int drow;
        if (KIND == 0) drow = c; else if (KIND == 1) drow = (c & ~255) + (c & 1) * 128 + ((c & 255) >> 1); else drow = win_dst(c);
        u32x4 w0, w1; float v[16];
#pragma unroll
        for (int i = 0; i < 16; ++i) v[i] = T[(kq * 16 + i) * 129 + j];
        if constexpr (OUT == 2) { float mx = 0.f;
#pragma unroll
            for (int i = 0; i < 16; ++i) mx = fmaxf(mx, fabsf(v[i]));
            atomicMax((unsigned*)cmax + drow, __float_as_uint(mx)); }
        else if constexpr (OUT == 3) { const float cm = cmax[drow], sc = cm > 0.f ? 127.f / cm : 0.f; unsigned char* d8 = (unsigned char*)dst + (size_t)drow * ld_dst + kd0 + k0 + kq * 16;
            *(u32x4*)d8 = (u32x4){pk4_i8(v[0] * sc, v[1] * sc, v[2] * sc, v[3] * sc), pk4_i8(v[4] * sc, v[5] * sc, v[6] * sc, v[7] * sc), pk4_i8(v[8] * sc, v[9] * sc, v[10] * sc, v[11] * sc), pk4_i8(v[12] * sc, v[13] * sc, v[14] * sc, v[15] * sc)}; }
        else {
        w0.x = pk2(v[0], v[1]); w0.y = pk2(v[2], v[3]); w0.z = pk2(v[4], v[5]); w0.w = pk2(v[6], v[7]);
        w1.x = pk2(v[8], v[9]); w1.y = pk2(v[10], v[11]); w1.z = pk2(v[12], v[13]); w1.w = pk2(v[14], v[15]);
        if constexpr (OUT == 1) { unsigned char* d8 = (unsigned char*)dst + (size_t)drow * ld_dst + kd0 + k0 + kq * 16;
            *(u32x4*)d8 = (u32x4){pk4_fp8(v[0] * W8_SCALE, v[1] * W8_SCALE, v[2] * W8_SCALE, v[3] * W8_SCALE), pk4_fp8(v[4] * W8_SCALE, v[5] * W8_SCALE, v[6] * W8_SCALE, v[7] * W8_SCALE),
                                  pk4_fp8(v[8] * W8_SCALE, v[9] * W8_SCALE, v[10] * W8_SCALE, v[11] * W8_SCALE), pk4_fp8(v[12] * W8_SCALE, v[13] * W8_SCALE, v[14] * W8_SCALE, v[15] * W8_SCALE)}; }
        else { bf16_t* d = dst + (size_t)drow * ld_dst + kd0 + k0 + kq * 16;
        *(u32x4*)d = w0; *(u32x4*)(d + 8) = w1; } } } }
    __syncthreads();
}
DI void phase_cvt(CArgs& a, LAS unsigned char* lds) {
    LAS float* T = (LAS float*)lds;
    constexpr int T_IN = 16 * 63, T_BR = 3 * 8 * 8, T_OUT = 16 * 8, T_GU = 32 * 16 * 16, T_DN = 32 * 16 * 8, T_L = T_IN + T_BR + T_OUT + T_GU + T_DN;
    for (int g = lbid(); g < 2 * T_L; g += lgrid()) {
        const int l = g / T_L; int r = g % T_L;
        if (r < T_IN) { const int kt = r % 16, ntile = r / 16;
            cvt_tile<2, INPROJ_I8 ? 2 : 0>(a.w_in + (size_t)l * DM * IN_COLS, IN_COLS, IN_COLS, kt * 64, ntile * 128, (bf16_t*)(a.ws + WS_WIN + (size_t)l * NP * DM * (INPROJ_I8 ? 1 : 2)), DM, 0, T, (float*)(a.ws + WS_COLMAX) + l * NP); continue; }
        r -= T_IN;
        if (r < T_BR) { const int br = r / 64, kt = (r % 64) % 8, ntile = (r % 64) / 8; const float* src = (br == 0 ? a.w_br_gla : br == 1 ? a.w_br_gdn : a.w_br_ssd) + (size_t)l * 512 * DM;
            cvt_tile<0>(src, DM, DM, kt * 64, ntile * 128, (bf16_t*)(a.ws + WS_WBR) + ((size_t)l * 3 + br) * DM * 512, 512, 0, T); continue; }
        r -= T_BR;
        if (r < T_OUT) { const int kt = r % 16, ntile = r / 16;
            cvt_tile<0>(a.w_out + (size_t)l * DM * DM, DM, DM, kt * 64, ntile * 128, (bf16_t*)(a.ws + WS_WOUT) + (size_t)l * DM * DM, DM, 0, T); continue; }
        r -= T_OUT;
        if (r < T_GU) { const int e = r / 256, kt = (r % 256) % 16, ntile = (r % 256) / 16;
            cvt_tile<1, 1>(a.w_gu + ((size_t)l * NEXP + e) * DM * 2048, 2048, 2048, kt * 64, ntile * 128, (bf16_t*)(a.ws + WS_WGU + ((size_t)l * NEXP + e) * 2048 * DM), DM, 0, T); continue; }
        r -= T_GU;
        { const int e = r / 128, kt = (r % 128) % 16, ntile = (r % 128) / 16;
            cvt_tile<0, 1>(a.w_dn + ((size_t)l * NEXP + e) * DM * DM, DM, DM, kt * 64, ntile * 128, (bf16_t*)(a.ws + WS_WDN + ((size_t)l * NEXP + e) * DM * DM), DM, 0, T); }
    }
    { constexpr size_t RB = (size_t)DM * (INPROJ_I8 ? 1 : 2), NV = 224 * RB / 16;
      for (size_t i = (size_t)lbid() * NTHREADS + ltid(); i < 2 * NV; i += (size_t)lgrid() * NTHREADS) { const size_t l = i / NV, rr = i % NV;
          *(u32x4*)(a.ws + WS_WIN + (l * NP + IN_COLS) * RB + rr * 16) = (u32x4){0u, 0u, 0u, 0u}; } }
}

DI void phase_cvt_win_i8(CArgs& a, LAS unsigned char* lds) {
    LAS float* T = (LAS float*)lds;
    for (int g = lbid(); g < 2 * 16 * 63; g += lgrid()) { const int l = g / (16 * 63), r = g % (16 * 63), kt = r % 16, ntile = r / 16;
        cvt_tile<2, 3>(a.w_in + (size_t)l * DM * IN_COLS, IN_COLS, IN_COLS, kt * 64, ntile * 128, (bf16_t*)(a.ws + WS_WIN + (size_t)l * NP * DM), DM, 0, T, (float*)(a.ws + WS_COLMAX) + l * NP); }
}
DI float wave_sum(float v) {
#pragma unroll
    for (int o = 32; o > 0; o >>= 1) v += __shfl_xor(v, o);
    return v;
}
DI void store_h_row(CArgs& a, int row, int lane, const float (&o)[16]) {
#if INPROJ_I8
    float mx = 0.f;
#pragma unroll
    for (int j = 0; j < 16; ++j) mx = fmaxf(mx, fabsf(o[j]));
    mx = wave_max(mx); const float inv = mx > 0.f ? 127.f / mx : 0.f;
    if (lane == 0) ((float*)(a.ws + WS_SA))[row] = mx * (1.f / 127.f);
#pragma unroll
    for (int i = 0; i < 2; ++i) *(u32x2*)((unsigned char*)(a.ws + WS_H) + (size_t)row * DM + lane * 8 + 512 * i) =
        (u32x2){pk4_i8(o[8 * i] * inv, o[8 * i + 1] * inv, o[8 * i + 2] * inv, o[8 * i + 3] * inv), pk4_i8(o[8 * i + 4] * inv, o[8 * i + 5] * inv, o[8 * i + 6] * inv, o[8 * i + 7] * inv)};
#else
#pragma unroll
    for (int i = 0; i < 2; ++i) { u32x4 w; w.x = pk2(o[8 * i], o[8 * i + 1]); w.y = pk2(o[8 * i + 2], o[8 * i + 3]); w.z = pk2(o[8 * i + 4], o[8 * i + 5]); w.w = pk2(o[8 * i + 6], o[8 * i + 7]);
        *(u32x4*)((bf16_t*)(a.ws + WS_H) + (size_t)row * DM + lane * 8 + 512 * i) = w; }
#endif
}
DI void phase_norm0(CArgs& a) {
    const int lane = ltid() & 63, gw = lbid() * 8 + (ltid() >> 6), nw = lgrid() * 8;
    const float* mod = (const float*)(a.ws + WS_MOD);
    bf16_t* H = (bf16_t*)(a.ws + WS_H);
    for (int row = gw; row < NTOK; row += nw) {
        const int b = row >> 12; const float* xr = a.x + (size_t)row * DM; const float* mb = mod + (size_t)b * 6144;
        f32x4 v[4]; float ss = 0.f;
#pragma unroll
        for (int i = 0; i < 2; ++i) { v[2 * i] = *(const f32x4*)(xr + lane * 8 + 512 * i); v[2 * i + 1] = *(const f32x4*)(xr + lane * 8 + 512 * i + 4); }
#pragma unroll
        for (int i = 0; i < 4; ++i) ss += v[i][0] * v[i][0] + v[i][1] * v[i][1] + v[i][2] * v[i][2] + v[i][3] * v[i][3];
        ss = wave_sum(ss); const float rs = rsqrtf(ss * (1.f / 1024.f) + 1e-6f);
        float o[16];
#pragma unroll
        for (int i = 0; i < 2; ++i) { const int c0 = lane * 8 + 512 * i;
#pragma unroll
            for (int j = 0; j < 8; ++j) { const float xv = v[2 * i + (j >> 2)][j & 3]; o[8 * i + j] = xv * rs * a.norm_mix[c0 + j] * (1.f + mb[1024 + c0 + j]) + mb[c0 + j]; } }
        store_h_row(a, row, lane, o);
    }
}

struct EpiProj { static constexpr bool PERM = true; bf16_t* P; float* small; const float* sa; const float* cmax;
    DI void operator()(const f32x4 (&acc)[2][2][4][2], const Unit& u, int wr, int wc, int fr, int fq) const {
        const int row0 = u.pm * 256 + wr * 64 + fr, col0 = u.pn * 256 + wc * 32 + 8 * fq;
        float sw[2][8];
#pragma unroll
        for (int bj = 0; bj < 2; ++bj)
#pragma unroll
            for (int j = 0; j < 8; ++j) sw[bj][j] = INPROJ_I8 ? cmax[col0 + bj * 128 + j] * (1.f / 127.f) : 1.f;
#pragma unroll
        for (int ai = 0; ai < 2; ++ai)
#pragma unroll
            for (int m = 0; m < 4; ++m) { const int row = row0 + ai * 128 + m * 16; bf16_t* rowp = P + (size_t)row * NP + col0; const float sr = INPROJ_I8 ? sa[row] : 1.f;
                float v[2][8];
#pragma unroll
                for (int bj = 0; bj < 2; ++bj)
#pragma unroll
                    for (int j = 0; j < 8; ++j) { const f32x4 t = acc[ai][bj][m][j >> 2]; v[bj][j] = INPROJ_I8 ? (float)__builtin_bit_cast(pg8::i32x4, t)[j & 3] * sr * sw[bj][j] : t[j & 3]; }
#pragma unroll
                for (int bj = 0; bj < 2; ++bj) { u32x4 w; w.x = pk2(v[bj][0], v[bj][1]); w.y = pk2(v[bj][2], v[bj][3]); w.z = pk2(v[bj][4], v[bj][5]); w.w = pk2(v[bj][6], v[bj][7]);
                    *(u32x4*)(rowp + bj * 128) = w; }
                if (u.pn == 31 && wc == 0) { float* sp = small + (size_t)row * 32 + 8 * fq; *(f32x4*)sp = (f32x4){v[0][0], v[0][1], v[0][2], v[0][3]}; *(f32x4*)(sp + 4) = (f32x4){v[0][4], v[0][5], v[0][6], v[0][7]}; } }
    } };
struct EpiGate { static constexpr bool PERM = true; const bf16_t* P; const float* bmerge; bf16_t* G; bf16_t* M;
    DI void operator()(const f32x4 (&acc)[2][2][4][2], const Unit& u, int wr, int wc, int fr, int fq) const {
        const int row0 = u.pm * 256 + wr * 64 + fr, col0 = u.pn * 256 + wc * 32 + 8 * fq; const bool fin = u.pn >= 8;
        f32x4 bv[2][2];
#pragma unroll
        for (int bj = 0; bj < 2; ++bj) { bv[bj][0] = *(const f32x4*)(bmerge + col0 + bj * 128); bv[bj][1] = *(const f32x4*)(bmerge + col0 + bj * 128 + 4); }
#pragma unroll
        for (int ai = 0; ai < 2; ++ai)
#pragma unroll
            for (int m = 0; m < 4; ++m) { const size_t row = row0 + ai * 128 + m * 16;
#pragma unroll
                for (int bj = 0; bj < 2; ++bj) { const u32x4 mr = *(const u32x4*)(P + row * NP + PC_MERGE + col0 + bj * 128); const f32x4 v0 = acc[ai][bj][m][0], v1 = acc[ai][bj][m][1];
                    float o[8];
                    o[0] = v0[0] * sigmoid_(bflo(mr.x) + bv[bj][0][0]); o[1] = v0[1] * sigmoid_(bfhi(mr.x) + bv[bj][0][1]); o[2] = v0[2] * sigmoid_(bflo(mr.y) + bv[bj][0][2]); o[3] = v0[3] * sigmoid_(bfhi(mr.y) + bv[bj][0][3]);
                    o[4] = v1[0] * sigmoid_(bflo(mr.z) + bv[bj][1][0]); o[5] = v1[1] * sigmoid_(bfhi(mr.z) + bv[bj][1][1]); o[6] = v1[2] * sigmoid_(bflo(mr.w) + bv[bj][1][2]); o[7] = v1[3] * sigmoid_(bfhi(mr.w) + bv[bj][1][3]);
                    if (fin) { const int cm = col0 - 2048 + bj * 128;
                        const u32x4 g0 = *(const u32x4*)(G + row * 3072 + cm), g1 = *(const u32x4*)(G + row * 3072 + 1024 + cm);
                        o[0] += bflo(g0.x) + bflo(g1.x); o[1] += bfhi(g0.x) + bfhi(g1.x); o[2] += bflo(g0.y) + bflo(g1.y); o[3] += bfhi(g0.y) + bfhi(g1.y);
                        o[4] += bflo(g0.z) + bflo(g1.z); o[5] += bfhi(g0.z) + bfhi(g1.z); o[6] += bflo(g0.w) + bflo(g1.w); o[7] += bfhi(g0.w) + bfhi(g1.w);
                        u32x4 w; w.x = pk2(o[0], o[1]); w.y = pk2(o[2], o[3]); w.z = pk2(o[4], o[5]); w.w = pk2(o[6], o[7]);
                        *(u32x4*)(M + row * DM + cm) = w; }
                    else { u32x4 w; w.x = pk2(o[0], o[1]); w.y = pk2(o[2], o[3]); w.z = pk2(o[4], o[5]); w.w = pk2(o[6], o[7]);
                        *(u32x4*)(G + row * 3072 + col0 + bj * 128) = w; } } }
    } };
struct EpiResid { static constexpr bool PERM = false; const float* xin; float* xout; const float* gm;
    DI void operator()(const f32x4 (&acc)[2][2][4][2], const Unit& u, int wr, int wc, int fr, int fq) const {
        const int row0 = u.pm * 256 + wr * 64 + fr, col0 = u.pn * 256 + wc * 32 + 4 * fq; const int b = (u.pm * 256) >> 12;
        f32x4 gv[2][2];
#pragma unroll
        for (int bj = 0; bj < 2; ++bj)
#pragma unroll
            for (int n = 0; n < 2; ++n) gv[bj][n] = *(const f32x4*)(gm + (size_t)b * 6144 + col0 + bj * 128 + n * 16);
#pragma unroll
        for (int ai = 0; ai < 2; ++ai)
#pragma unroll
            for (int m = 0; m < 4; ++m) { const size_t off = (size_t)(row0 + ai * 128 + m * 16) * DM + col0;
#pragma unroll
                for (int bj = 0; bj < 2; ++bj)
#pragma unroll
                    for (int n = 0; n < 2; ++n) { const f32x4 xi = *(const f32x4*)(xin + off + bj * 128 + n * 16); *(f32x4*)(xout + off + bj * 128 + n * 16) = xi + gv[bj][n] * acc[ai][bj][m][n]; } }
    } };
struct EpiSwiglu { static constexpr bool PERM = true; unsigned char* act; const float* bgu;
    DI void operator()(const f32x4 (&acc)[2][2][4][2], const Unit& u, int wr, int wc, int fr, int fq) const {
        const int row0 = u.pm * 256 + wr * 64 + fr, x0 = u.pn * 128 + wc * 32 + 8 * fq;
        const float* bb = bgu + (size_t)u.e * 2048 + 2 * x0;
        float bg[8], bu[8];
#pragma unroll
        for (int i = 0; i < 4; ++i) { const f32x4 t = *(const f32x4*)(bb + 4 * i); bg[2 * i] = t[0]; bu[2 * i] = t[1]; bg[2 * i + 1] = t[2]; bu[2 * i + 1] = t[3]; }
#pragma unroll
        for (int ai = 0; ai < 2; ++ai)
#pragma unroll
            for (int m = 0; m < 4; ++m) { const size_t row = row0 + ai * 128 + m * 16; float o[8];
#pragma unroll
                for (int j = 0; j < 8; ++j) { float g = acc[ai][0][m][j >> 2][j & 3] * W8_INV + bg[j], up = acc[ai][1][m][j >> 2][j & 3] * W8_INV + bu[j];
                    g = fminf(g, 7.f); up = fminf(fmaxf(up, -7.f), 7.f); o[j] = (up + 1.f) * g * sigmoid_(1.702f * g); }
                *(u32x2*)(act + row * DM + x0) = (u32x2){pk4_fp8(o[0], o[1], o[2], o[3]), pk4_fp8(o[4], o[5], o[6], o[7])}; }
    } };
struct EpiDown { static constexpr bool PERM = true; bf16_t* ys; const float* bdn;
    DI void operator()(const f32x4 (&acc)[2][2][4][2], const Unit& u, int wr, int wc, int fr, int fq) const {
        const int row0 = u.pm * 256 + wr * 64 + fr, col0 = u.pn * 256 + wc * 32 + 8 * fq;
        f32x4 bv[2][2];
#pragma unroll
        for (int bj = 0; bj < 2; ++bj) { bv[bj][0] = *(const f32x4*)(bdn + (size_t)u.e * DM + col0 + bj * 128); bv[bj][1] = *(const f32x4*)(bdn + (size_t)u.e * DM + col0 + bj * 128 + 4); }
#pragma unroll
        for (int ai = 0; ai < 2; ++ai)
#pragma unroll
            for (int m = 0; m < 4; ++m) { const size_t row = row0 + ai * 128 + m * 16;
#pragma unroll
                for (int bj = 0; bj < 2; ++bj) { const f32x4 v0 = acc[ai][bj][m][0] * W8_INV + bv[bj][0], v1 = acc[ai][bj][m][1] * W8_INV + bv[bj][1];
                    u32x4 w; w.x = pk2(v0[0], v0[1]); w.y = pk2(v0[2], v0[3]); w.z = pk2(v1[0], v1[1]); w.w = pk2(v1[2], v1[3]);
                    *(u32x4*)(ys + row * DM + col0 + bj * 128) = w; } }
    } };

DI void moe_tables(const int* cnt  , LAS unsigned char* lds) {
    LAS int* tstart = (LAS int*)(lds + LDS_CTRL + 64); LAS int* lcnt = (LAS int*)(lds + LDS_CTRL + 256);
    if (ltid() < 64) { const int t = ltid(); const int c = t < 32 ? cnt[t * 64] : 0; int v = (c + 255) >> 8;
#pragma unroll
        for (int o = 1; o < 32; o <<= 1) { const int y = __shfl_up(v, o); if ((t & 31) >= o) v += y; }
        if (t < 32) { tstart[t + 1] = v; lcnt[t] = c; } if (t == 0) tstart[0] = 0; }
    __syncthreads();
}
template <bool G_> struct MoeOrder {
    static constexpr bool GATHER = G_;
    int nN, G, c; const LAS int* tstart; const LAS int* lcnt; const char* A; const char* Bt; size_t b_estride, tstep; const int* rowtok;
    DI bool next(int i, Unit& u) const {
        const int L = i * G + c, rt = L / nN; if (rt >= tstart[32]) return false;
        int e = 0; while (tstart[e + 1] <= rt) ++e;
        u.pm = rt; u.pn = L % nN; u.e = e; const int rem = lcnt[e] - (rt - tstart[e]) * 256; u.cnt = rem < 256 ? rem : 256; return true; }
    DI const char* a_ptr(const Unit& u) const { return GATHER ? A : A + (size_t)u.pm * tstep; }
    DI const char* b_ptr(const Unit& u) const { return Bt + (size_t)u.e * b_estride + (size_t)u.pn * tstep; }
    DI int a_row(const Unit& u, int R) const { return R < u.cnt ? rowtok[u.e * 32768 + (u.pm - tstart[u.e]) * 256 + R] : 0; }
};
DI void phase_router(CArgs& a, int l, const float* xmid, LAS unsigned char* lds) {
    const int tid = ltid(), wid = tid >> 6, lane = tid & 63, r = lane & 15, q = lane >> 4;
    LAS bf16_t* Whi = (LAS bf16_t*)lds; LAS bf16_t* Wlo = (LAS bf16_t*)(lds + 66048);
    LAS float* scr = (LAS float*)(lds + 132096 + wid * 2112);
    LAS int* hist = (LAS int*)(lds + 148992); LAS int* basep = (LAS int*)(lds + 148992 + 128);
    const float* wr_ = a.w_router + (size_t)l * DM * NEXP;
    for (int i = tid; i < DM * NEXP; i += NTHREADS) { const int k = i >> 5, e = i & 31; const float v = wr_[i]; const bf16_t hi = f2bf(v); Whi[e * 1032 + k] = hi; Wlo[e * 1032 + k] = f2bf(v - bf2f(hi)); }
    __syncthreads();
    const float* mod = (const float*)(a.ws + WS_MOD) + (size_t)l * 8 * 6144;
    const float* nf = a.norm_ffn + l * DM;
    bf16_t* H = (bf16_t*)(a.ws + WS_H);
    int* cntg = (int*)(a.ws + WS_CNT) + l * 32 * 64;
    int* rowtok = (int*)(a.ws + WS_ROWTOK); int* tokslot = (int*)(a.ws + WS_TOKSLOT); float* gates = (float*)(a.ws + WS_GATES);
    for (int blk = lbid(); blk < NTOK / 128; blk += lgrid()) {
        if (tid < 32) hist[tid] = 0;
        const int row = blk * 128 + wid * 16 + r, b = row >> 12;
        const float* xr = xmid + (size_t)row * DM; const float* mb = mod + (size_t)b * 6144;
        float ss = 0.f;
        for (int ks = 0; ks < 32; ++ks) { const f32x4 x0 = *(const f32x4*)(xr + ks * 32 + 8 * q), x1 = *(const f32x4*)(xr + ks * 32 + 8 * q + 4);
            ss += x0[0] * x0[0] + x0[1] * x0[1] + x0[2] * x0[2] + x0[3] * x0[3] + x1[0] * x1[0] + x1[1] * x1[1] + x1[2] * x1[2] + x1[3] * x1[3]; }
        ss += __shfl_xor(ss, 16); ss += __shfl_xor(ss, 32);
        const float rs = rsqrtf(ss * (1.f / 1024.f) + 1e-6f);
        f32x4 acc0 = {0.f, 0.f, 0.f, 0.f}, acc1 = {0.f, 0.f, 0.f, 0.f};
        for (int ks = 0; ks < 32; ++ks) { const int k0 = ks * 32 + 8 * q;
            const f32x4 x0 = *(const f32x4*)(xr + k0), x1 = *(const f32x4*)(xr + k0 + 4);
            float hv[8];
#pragma unroll
            for (int j = 0; j < 8; ++j) { const float xv = j < 4 ? x0[j & 3] : x1[j & 3]; hv[j] = xv * rs * nf[k0 + j] * (1.f + mb[4096 + k0 + j]) + mb[3072 + k0 + j]; }
            u32x4 hi; hi.x = pk2(hv[0], hv[1]); hi.y = pk2(hv[2], hv[3]); hi.z = pk2(hv[4], hv[5]); hi.w = pk2(hv[6], hv[7]);
            *(u32x2*)((unsigned char*)H + (size_t)row * DM + k0) = (u32x2){pk4_fp8(hv[0], hv[1], hv[2], hv[3]), pk4_fp8(hv[4], hv[5], hv[6], hv[7])};
            u32x4 lo; lo.x = pk2(hv[0] - bflo(hi.x), hv[1] - bfhi(hi.x)); lo.y = pk2(hv[2] - bflo(hi.y), hv[3] - bfhi(hi.y)); lo.z = pk2(hv[4] - bflo(hi.z), hv[5] - bfhi(hi.z)); lo.w = pk2(hv[6] - bflo(hi.w), hv[7] - bfhi(hi.w));
            const bf16x8 ah = __builtin_bit_cast(bf16x8, hi), al = __builtin_bit_cast(bf16x8, lo);
            const bf16x8 b0h = *(const LAS bf16x8*)(Whi + r * 1032 + k0), b0l = *(const LAS bf16x8*)(Wlo + r * 1032 + k0);
            const bf16x8 b1h = *(const LAS bf16x8*)(Whi + (16 + r) * 1032 + k0), b1l = *(const LAS bf16x8*)(Wlo + (16 + r) * 1032 + k0);
            acc0 = __builtin_amdgcn_mfma_f32_16x16x32_bf16(ah, b0h, acc0, 0, 0, 0); acc0 = __builtin_amdgcn_mfma_f32_16x16x32_bf16(ah, b0l, acc0, 0, 0, 0); acc0 = __builtin_amdgcn_mfma_f32_16x16x32_bf16(al, b0h, acc0, 0, 0, 0);
            acc1 = __builtin_amdgcn_mfma_f32_16x16x32_bf16(ah, b1h, acc1, 0, 0, 0); acc1 = __builtin_amdgcn_mfma_f32_16x16x32_bf16(ah, b1l, acc1, 0, 0, 0); acc1 = __builtin_amdgcn_mfma_f32_16x16x32_bf16(al, b1h, acc1, 0, 0, 0); }
        const float br0 = a.b_router[l * 32 + r], br1 = a.b_router[l * 32 + 16 + r];
#pragma unroll
        for (int j = 0; j < 4; ++j) { scr[(4 * q + j) * 33 + r] = acc0[j] + br0; scr[(4 * q + j) * 33 + 16 + r] = acc1[j] + br1; }
        __syncthreads();
        int te[4] = {0, 0, 0, 0}; float tg[4] = {0.f, 0.f, 0.f, 0.f}; int rk[4] = {0, 0, 0, 0};
        if (lane < 16) {
            float v[32];
#pragma unroll
            for (int e = 0; e < 32; ++e) v[e] = scr[lane * 33 + e];
            float tv[4];
#pragma unroll
            for (int k = 0; k < 4; ++k) { float best = -3.0e38f; int bi = 0;
#pragma unroll
                for (int e = 0; e < 32; ++e) { if (v[e] > best) { best = v[e]; bi = e; } }
                tv[k] = best; te[k] = bi;
#pragma unroll
                for (int e = 0; e < 32; ++e) v[e] = (e == bi) ? -3.0e38f : v[e]; }
            const float e1 = __expf(tv[1] - tv[0]), e2 = __expf(tv[2] - tv[0]), e3 = __expf(tv[3] - tv[0]); const float inv = 1.f / (1.f + e1 + e2 + e3);
            tg[0] = inv; tg[1] = e1 * inv; tg[2] = e2 * inv; tg[3] = e3 * inv;
#pragma unroll
            for (int k = 0; k < 4; ++k) rk[k] = atomicAdd((int*)&hist[te[k]], 1);
        }
        __syncthreads();
        if (tid < 32) basep[tid] = atomicAdd(&cntg[tid * 64], hist[tid]);
        __syncthreads();
        if (lane < 16) { const int tok = blk * 128 + wid * 16 + lane;
#pragma unroll
            for (int k = 0; k < 4; ++k) { const int pos = basep[te[k]] + rk[k]; rowtok[te[k] * 32768 + pos] = tok; tokslot[tok * 4 + k] = te[k] * 32768 + pos; gates[tok * 4 + k] = tg[k]; } }
        __syncthreads();
    }
}

DI void phase_combine(CArgs& a, int l, const float* xmid, float* xnew, LAS unsigned char* lds) {
    const LAS int* tstart = (const LAS int*)(lds + LDS_CTRL + 64);
    const int lane = ltid() & 63, gw = lbid() * 8 + (ltid() >> 6), nw = lgrid() * 8;
    const float* mod = (const float*)(a.ws + WS_MOD);
    const bf16_t* YS = (const bf16_t*)(a.ws + WS_R1 + R1_YS);
    const int* tokslot = (const int*)(a.ws + WS_TOKSLOT); const float* gates = (const float*)(a.ws + WS_GATES);
    bf16_t* H = (bf16_t*)(a.ws + WS_H);
    for (int row = gw; row < NTOK; row += nw) {
        const int b = row >> 12; const float* mb = mod + ((size_t)l * 8 + b) * 6144;
        size_t pr[4]; float gt[4];
#pragma unroll
        for (int k = 0; k < 4; ++k) { const int s = tokslot[row * 4 + k]; pr[k] = (size_t)(tstart[s >> 15] * 256 + (s & 32767)); gt[k] = gates[row * 4 + k]; }
        float xn[16]; float ss = 0.f;
#pragma unroll
        for (int i = 0; i < 2; ++i) { const int c0 = lane * 8 + 512 * i; float f[8];
#pragma unroll
            for (int j = 0; j < 8; ++j) f[j] = 0.f;
#pragma unroll
            for (int k = 0; k < 4; ++k) { const u32x4 y = *(const u32x4*)(YS + pr[k] * DM + c0);
                f[0] += gt[k] * bflo(y.x); f[1] += gt[k] * bfhi(y.x); f[2] += gt[k] * bflo(y.y); f[3] += gt[k] * bfhi(y.y); f[4] += gt[k] * bflo(y.z); f[5] += gt[k] * bfhi(y.z); f[6] += gt[k] * bflo(y.w); f[7] += gt[k] * bfhi(y.w); }
            const f32x4 x0 = *(const f32x4*)(xmid + (size_t)row * DM + c0), x1 = *(const f32x4*)(xmid + (size_t)row * DM + c0 + 4);
#pragma unroll
            for (int j = 0; j < 8; ++j) { const float xv = (j < 4 ? x0[j & 3] : x1[j & 3]) + mb[5120 + c0 + j] * f[j]; xn[8 * i + j] = xv; ss += xv * xv; } }
        ss = wave_sum(ss); const float rs = rsqrtf(ss * (1.f / 1024.f) + 1e-6f);
        if (l == 0) {
            const float* mb2 = mod + ((size_t)8 + b) * 6144; const float* g = a.norm_mix + DM;
            float o[16];
#pragma unroll
            for (int i = 0; i < 2; ++i) { const int c0 = lane * 8 + 512 * i;
                *(f32x4*)(xnew + (size_t)row * DM + c0) = (f32x4){xn[8 * i], xn[8 * i + 1], xn[8 * i + 2], xn[8 * i + 3]};
                *(f32x4*)(xnew + (size_t)row * DM + c0 + 4) = (f32x4){xn[8 * i + 4], xn[8 * i + 5], xn[8 * i + 6], xn[8 * i + 7]};
#pragma unroll
                for (int j = 0; j < 8; ++j) o[8 * i + j] = xn[8 * i + j] * rs * g[c0 + j] * (1.f + mb2[1024 + c0 + j]) + mb2[c0 + j]; }
            store_h_row(a, row, lane, o);
        } else {
#pragma unroll
            for (int i = 0; i < 2; ++i) { const int c0 = lane * 8 + 512 * i; float o[8];
#pragma unroll
                for (int j = 0; j < 8; ++j) o[j] = xn[8 * i + j] * rs * a.norm_final[c0 + j];
                *(f32x4*)(a.out + (size_t)row * DM + c0) = (f32x4){o[0], o[1], o[2], o[3]}; *(f32x4*)(a.out + (size_t)row * DM + c0 + 4) = (f32x4){o[4], o[5], o[6], o[7]}; }
        }
    }
}
DI void lds_barrier() { asm volatile("s_waitcnt lgkmcnt(0)" ::: "memory"); __builtin_amdgcn_s_barrier(); asm volatile("" ::: "memory"); }
DI float wave_incl_scan(float v, int lane) {
#pragma unroll
    for (int o = 1; o < 64; o <<= 1) { const float y = __shfl_up(v, o); if (lane >= o) v += y; }
    return v;
}
DI void conv8(const bf16_t* p, int pos, const float* w, int chs, const float* bias, float (&out)[8]) {
    float acc[8];
    if (bias) { const f32x4 b0 = *(const f32x4*)bias, b1 = *(const f32x4*)(bias + 4); acc[0] = b0[0]; acc[1] = b0[1]; acc[2] = b0[2]; acc[3] = b0[3]; acc[4] = b1[0]; acc[5] = b1[1]; acc[6] = b1[2]; acc[7] = b1[3]; }
    else {
#pragma unroll
        for (int i = 0; i < 8; ++i) acc[i] = 0.f; }
#pragma unroll
    for (int j = 0; j < 4; ++j) {
        if (pos - 3 + j >= 0) { const u32x4 xv = *(const u32x4*)(p - (ptrdiff_t)(3 - j) * NP); const f32x4 w0 = *(const f32x4*)(w + j * chs), w1 = *(const f32x4*)(w + j * chs + 4);
            acc[0] += w0[0] * bflo(xv.x); acc[1] += w0[1] * bfhi(xv.x); acc[2] += w0[2] * bflo(xv.y); acc[3] += w0[3] * bfhi(xv.y);
            acc[4] += w1[0] * bflo(xv.z); acc[5] += w1[1] * bfhi(xv.z); acc[6] += w1[2] * bflo(xv.w); acc[7] += w1[3] * bfhi(xv.w); } }
#pragma unroll
    for (int i = 0; i < 8; ++i) out[i] = silu_(acc[i]);
}
DI f32x4 mm16(const LAS bf16_t* A, int lda, int m0, const LAS bf16_t* Bt, int ldb, int n0, int K, int lane) {
    f32x4 acc = {0.f, 0.f, 0.f, 0.f}; const int r = lane & 15, q = lane >> 4;
    for (int k0 = 0; k0 < K; k0 += 32) { const bf16x8 av = *(const LAS bf16x8*)(A + (m0 + r) * lda + k0 + 8 * q), bv = *(const LAS bf16x8*)(Bt + (n0 + r) * ldb + k0 + 8 * q);
        acc = __builtin_amdgcn_mfma_f32_16x16x32_bf16(av, bv, acc, 0, 0, 0); }
    return acc;
}
DI void frag_store8(char* base, int nkb, int row, int k0, const float (&v)[8]) {
    const int rt = row >> 5, r = row & 31, kb = k0 >> 4, aa = (k0 >> 3) & 1;
    char* p = base + ((size_t)((rt * nkb + kb) * 64 + r)) * 16 + aa * 8;
    *(u32x2*)p = (u32x2){pk2(v[0], v[1]), pk2(v[2], v[3])};
    *(u32x2*)(p + 512) = (u32x2){pk2(v[4], v[5]), pk2(v[6], v[7])};
}
DI void export_frags(char* dst, const LAS bf16_t* M, int ld, int R, int KK, int coloff) {
    const int nkb = KK >> 4, pieces = (R >> 5) * nkb * 64;
    for (int p = ltid(); p < pieces; p += NTHREADS) { const int lane = p & 63, f = p >> 6, kb = f % nkb, rt = f / nkb, r = lane & 31, h = lane >> 5;
        const LAS bf16_t* s = M + (rt * 32 + r) * ld + coloff + kb * 16 + 4 * h;
        const u32x2 lo = *(const LAS u32x2*)s, hi = *(const LAS u32x2*)(s + 8);
        *(u32x4*)(dst + (size_t)p * 16) = (u32x4){lo.x, lo.y, hi.x, hi.y}; }
}
DI void export_acc(char* dst, const LAS bf16_t* M, int ld, int nct) {
    const int pieces = nct * 2 * 64;
    for (int p = ltid(); p < pieces; p += NTHREADS) { const int lane = p & 63, tile = p >> 6, rt = tile & 1, ct = tile >> 1, r = lane & 31, h = lane >> 5;
        unsigned w[8];
#pragma unroll
        for (int i = 0; i < 8; ++i) { const int r0 = rt * 32 + ((2 * i) & 3) + 8 * ((2 * i) >> 2) + 4 * h;
            w[i] = (unsigned)M[r0 * ld + ct * 32 + r] | ((unsigned)M[(r0 + 1) * ld + ct * 32 + r] << 16); }
        *(u32x4*)(dst + (size_t)p * 32) = (u32x4){w[0], w[1], w[2], w[3]}; *(u32x4*)(dst + (size_t)p * 32 + 16) = (u32x4){w[4], w[5], w[6], w[7]}; }
}

DI u32x4 ldg_or0(const bf16_t* p, bool ok) { return ok ? *(const u32x4*)p : (u32x4){0u, 0u, 0u, 0u}; }
DI void conv8r(const u32x4 (&t)[4], const LAS float* wt, int ws, const LAS float* bias, float (&out)[8]) {
    float acc[8];
#pragma unroll
    for (int i = 0; i < 8; ++i) acc[i] = bias ? bias[i] : 0.f;
#pragma unroll
    for (int j = 0; j < 4; ++j) { const LAS float* w = wt + j * ws; const u32x4 xv = t[j];
        acc[0] += w[0] * bflo(xv.x); acc[1] += w[1] * bfhi(xv.x); acc[2] += w[2] * bflo(xv.y); acc[3] += w[3] * bfhi(xv.y);
        acc[4] += w[4] * bflo(xv.z); acc[5] += w[5] * bfhi(xv.z); acc[6] += w[6] * bflo(xv.w); acc[7] += w[7] * bfhi(xv.w); }
#pragma unroll
    for (int i = 0; i < 8; ++i) out[i] = silu_(acc[i]);
}
struct GlaRaw { f32x4 lr[4]; u32x4 q8, k8, v8[2]; };
DI void gla_load(CArgs& a, int u, GlaRaw& r) {
    const int tid = ltid(); const int n = u & 63, bh = u >> 6, b = bh >> 2, h = bh & 3, T0 = b * SEQ + n * 64;
    const bf16_t* P = (const bf16_t*)(a.ws + WS_R1 + R1_PROJ); const float* small = (const float*)(a.ws + WS_SMALL);
    const int l_ = tid >> 3, d0 = (tid & 7) * 8; const size_t T = (size_t)(T0 + l_);
#pragma unroll
    for (int i = 0; i < 4; ++i) r.lr[i] = *(const f32x4*)(small + T * 32 + 4 * i);
    r.q8 = *(const u32x4*)(P + T * NP + PC_GLA_Q + h * 64 + d0); r.k8 = *(const u32x4*)(P + T * NP + PC_GLA_K + h * 64 + d0);
#pragma unroll
    for (int rep = 0; rep < 2; ++rep) { const int idx = rep * NTHREADS + tid, lr_ = idx >> 4, c0 = (idx & 15) * 8; r.v8[rep] = *(const u32x4*)(P + (size_t)(T0 + lr_) * NP + PC_GLA_V + h * 128 + c0); }
}
DI void gla_table(CArgs& a, int l, int h, LAS float* WT) {
    for (int i = ltid(); i < 17 * 64; i += NTHREADS) { const int j = i >> 6, d = i & 63; WT[i] = j < 16 ? a.gla_w2[(size_t)l * 16 * 256 + j * 256 + h * 64 + d] : a.gla_b2[l * 256 + h * 64 + d]; }
}
template <class F> DI void gla_compute(CArgs& a, int u, const GlaRaw& rw, LAS unsigned char* lds, F&& prefetch) {
    const int tid = ltid(), wid = tid >> 6, lane = tid & 63;
    LAS float* G = (LAS float*)lds; LAS bf16_t* QD = (LAS bf16_t*)(lds + 16640); LAS bf16_t* KI = (LAS bf16_t*)(lds + 25856); LAS bf16_t* KT = (LAS bf16_t*)(lds + 35072);
    LAS bf16_t* PB = (LAS bf16_t*)(lds + 44288); LAS bf16_t* V = (LAS bf16_t*)(lds + 53504); LAS float* SEG = (LAS float*)(lds + 70912); const LAS float* WT = (const LAS float*)(lds + 72960);
    char* ub = a.ws + WS_R1 + R1_SGLA + (size_t)u * GLA_UNIT;
    const int l_ = tid >> 3, d0 = (tid & 7) * 8;
    { float s[8];
#pragma unroll
      for (int i = 0; i < 8; ++i) s[i] = WT[16 * 64 + d0 + i];
#pragma unroll
      for (int j = 0; j < 16; ++j) { const float lv = rw.lr[j >> 2][j & 3];
#pragma unroll
          for (int i = 0; i < 8; ++i) s[i] += lv * WT[j * 64 + d0 + i]; }
#pragma unroll
      for (int i = 0; i < 8; ++i) G[l_ * 65 + d0 + i] = -softplus_(-s[i]) * (1.f / 16.f); }
#pragma unroll
    for (int rep = 0; rep < 2; ++rep) { const int idx = rep * NTHREADS + tid, lr_ = idx >> 4, c0 = (idx & 15) * 8; *(LAS u32x4*)(V + lr_ * 136 + c0) = rw.v8[rep]; }
    const u32x4 q8 = rw.q8, k8 = rw.k8;
    prefetch();
    lds_barrier();
    { const int d = tid & 63, sg = tid >> 6; float run = 0.f, vv[8];
#pragma unroll
      for (int i = 0; i < 8; ++i) { run += G[(sg * 8 + i) * 65 + d]; vv[i] = run; }
      SEG[sg * 64 + d] = run;
      lds_barrier();
      float pre = 0.f;
#pragma unroll
      for (int s2 = 0; s2 < 8; ++s2) pre += (s2 < sg) ? SEG[s2 * 64 + d] : 0.f;
#pragma unroll
      for (int i = 0; i < 8; ++i) G[(sg * 8 + i) * 65 + d] = vv[i] + pre; }
    lds_barrier();
    { const float qf[8] = {bflo(q8.x), bfhi(q8.x), bflo(q8.y), bfhi(q8.y), bflo(q8.z), bfhi(q8.z), bflo(q8.w), bfhi(q8.w)};
      const float kf[8] = {bflo(k8.x), bfhi(k8.x), bflo(k8.y), bfhi(k8.y), bflo(k8.z), bfhi(k8.z), bflo(k8.w), bfhi(k8.w)};
      float qd[8], ki[8];
#pragma unroll
      for (int i = 0; i < 8; ++i) { const float bc = G[l_ * 65 + d0 + i], bl = G[63 * 65 + d0 + i]; qd[i] = qf[i] * 0.125f * __expf(bc); ki[i] = kf[i] * __expf(-bc);
          KT[(d0 + i) * 72 + l_] = f2bf(kf[i] * __expf(bl - bc)); }
      *(LAS u32x4*)(QD + l_ * 72 + d0) = (u32x4){pk2(qd[0], qd[1]), pk2(qd[2], qd[3]), pk2(qd[4], qd[5]), pk2(qd[6], qd[7])};
      *(LAS u32x4*)(KI + l_ * 72 + d0) = (u32x4){pk2(ki[0], ki[1]), pk2(ki[2], ki[3]), pk2(ki[4], ki[5]), pk2(ki[6], ki[7])};
      frag_store8(ub + GLA_OQ, 4, l_, d0, qd); }
    if (tid < 64) ((float*)(ub + GLA_OD))[tid] = __expf(G[63 * 65 + tid]);
    lds_barrier();
#pragma unroll
    for (int t2 = 0; t2 < 2; ++t2) { const int t = wid * 2 + t2, mt = t >> 2, nt = t & 3; const f32x4 acc = mm16(QD, 72, mt * 16, KI, 72, nt * 16, 64, lane);
        const int r = lane & 15, q = lane >> 4, m = nt * 16 + r;
#pragma unroll
        for (int j = 0; j < 4; ++j) { const int lrow = mt * 16 + 4 * q + j; PB[lrow * 72 + m] = f2bf(m <= lrow ? acc[j] : 0.f); } }
    lds_barrier();
    export_frags(ub + GLA_OP, PB, 72, 64, 64, 0);
    export_frags(ub + GLA_OK, KT, 72, 64, 64, 0);
    export_acc(ub + GLA_OU, V, 136, 4);
    lds_barrier();
}
struct SsdRaw { u32x4 t[3][4]; float dtr, p0, p1, p2; };
DI void ssd_load(CArgs& a, int u, SsdRaw& r) {
    const int tid = ltid(); const int n = u & 63, bh = u >> 6, b = bh >> 3, hh = bh & 7, g = hh >> 2, T0 = b * SEQ + n * 64;
    const bf16_t* P = (const bf16_t*)(a.ws + WS_R1 + R1_PROJ); const float* small = (const float*)(a.ws + WS_SMALL);
    const int l_ = tid >> 3, c8 = (tid & 7) * 8, pos = n * 64 + l_; const bf16_t* pr = P + (size_t)(T0 + l_) * NP + PC_SSD_XBC + c8;
    const int cb[3] = {hh * 64, 512 + g * 64, 640 + g * 64};
#pragma unroll
    for (int p = 0; p < 3; ++p)
#pragma unroll
        for (int j = 0; j < 4; ++j) r.t[p][j] = ldg_or0(pr + cb[p] - (ptrdiff_t)(3 - j) * NP, pos - 3 + j >= 0);
    r.dtr = tid < 64 ? small[(size_t)(T0 + tid) * 32 + 24 + hh] : 0.f; r.p0 = 0.f; r.p1 = 0.f; r.p2 = 0.f;
}
DI void ssd_table(CArgs& a, int l, int hh, LAS float* WT) {
    const int g = hh >> 2;
    for (int i = ltid(); i < 3 * 5 * 64; i += NTHREADS) { const int p = i / 320, j = (i % 320) >> 6, ch = i & 63; const int col = (p == 0 ? hh * 64 : p == 1 ? 512 + g * 64 : 640 + g * 64) + ch;
        WT[i] = j < 4 ? a.ssd_conv_w[(size_t)l * 4 * 768 + j * 768 + col] : a.ssd_conv_b[l * 768 + col]; }
}
template <class F> DI void ssd_compute(CArgs& a, int l, int u, const SsdRaw& rw, LAS unsigned char* lds, F&& prefetch) {
    const int tid = ltid(), wid = tid >> 6, lane = tid & 63;
    const int bh = u >> 6, hh = bh & 7;
    LAS bf16_t* CC = (LAS bf16_t*)lds; LAS bf16_t* CBm = (LAS bf16_t*)(lds + 9216); LAS bf16_t* KT = (LAS bf16_t*)(lds + 18432); LAS bf16_t* PB = (LAS bf16_t*)(lds + 27648);
    LAS bf16_t* V = (LAS bf16_t*)(lds + 36864); LAS float* SDT = (LAS float*)(lds + 46080); LAS float* SCUM = (LAS float*)(lds + 46080 + 256); const LAS float* WT = (const LAS float*)(lds + 47104);
    char* ub = a.ws + WS_R1 + R1_SSSD + (size_t)u * SSD_UNIT;
    if (tid < 64) { const float dt = softplus_(rw.dtr + a.ssd_dt_bias[l * 8 + hh]); const float aa = -__expf(a.ssd_a_log[l * 8 + hh]);
        const float cum = wave_incl_scan(dt * aa, lane); SDT[tid] = dt; SCUM[tid] = cum; }
    float vx[8], vb[8], vc[8];
    { const int c8 = (tid & 7) * 8;
      conv8r(rw.t[0], WT + c8, 64, WT + 4 * 64 + c8, vx); conv8r(rw.t[1], WT + 320 + c8, 64, WT + 320 + 4 * 64 + c8, vb); conv8r(rw.t[2], WT + 640 + c8, 64, WT + 640 + 4 * 64 + c8, vc); }
    prefetch();
    lds_barrier();
    { const int l_ = tid >> 3, c8 = (tid & 7) * 8; const float cl = SCUM[l_], c63 = SCUM[63], dtl = SDT[l_];
      *(LAS u32x4*)(V + l_ * 72 + c8) = (u32x4){pk2(vx[0] * dtl, vx[1] * dtl), pk2(vx[2] * dtl, vx[3] * dtl), pk2(vx[4] * dtl, vx[5] * dtl), pk2(vx[6] * dtl, vx[7] * dtl)};
      *(LAS u32x4*)(CBm + l_ * 72 + c8) = (u32x4){pk2(vb[0], vb[1]), pk2(vb[2], vb[3]), pk2(vb[4], vb[5]), pk2(vb[6], vb[7])};
      const float ek = __expf(c63 - cl);
#pragma unroll
      for (int i = 0; i < 8; ++i) KT[(c8 + i) * 72 + l_] = f2bf(vb[i] * ek);
      *(LAS u32x4*)(CC + l_ * 72 + c8) = (u32x4){pk2(vc[0], vc[1]), pk2(vc[2], vc[3]), pk2(vc[4], vc[5]), pk2(vc[6], vc[7])};
      const float eq = __expf(cl); float qd[8];
#pragma unroll
      for (int i = 0; i < 8; ++i) qd[i] = vc[i] * eq;
      frag_store8(ub + SSD_OQ, 4, l_, c8, qd); }
    if (tid < 64) ((float*)(ub + SSD_OD))[tid] = __expf(SCUM[63]);
    lds_barrier();
#pragma unroll
    for (int t2 = 0; t2 < 2; ++t2) { const int t = wid * 2 + t2, mt = t >> 2, nt = t & 3; const f32x4 acc = mm16(CC, 72, mt * 16, CBm, 72, nt * 16, 64, lane);
        const int r = lane & 15, q = lane >> 4, m = nt * 16 + r; const float cm = SCUM[m];
#pragma unroll
        for (int j = 0; j < 4; ++j) { const int lrow = mt * 16 + 4 * q + j; PB[lrow * 72 + m] = f2bf(m <= lrow ? acc[j] * __expf(SCUM[lrow] - cm) : 0.f); } }
    lds_barrier();
    export_frags(ub + SSD_OP, PB, 72, 64, 64, 0);
    export_frags(ub + SSD_OK, KT, 72, 64, 64, 0);
    export_acc(ub + SSD_OU, V, 72, 2);
    lds_barrier();
}
template <int NP_> struct GdnRaw { u32x4 t[NP_][2][4]; u32x4 tb; float ar, br, p0, p1; };
template <int NP_> DI void gdn_load(CArgs& a, int u, GdnRaw<NP_>& r, bool with_t) {
    const int tid = ltid(); const int n = u & 63, bh = u >> 6, b = bh >> 2, h = bh & 3, T0 = b * SEQ + n * 64;
    const bf16_t* P = (const bf16_t*)(a.ws + WS_R1 + R1_PROJ); const float* small = (const float*)(a.ws + WS_SMALL);
#pragma unroll
    for (int rep = 0; rep < 2; ++rep) { const int idx = rep * NTHREADS + tid, l_ = idx >> 4, grp = idx & 15, pos = n * 64 + l_; const bf16_t* pr = P + (size_t)(T0 + l_) * NP + PC_GDN_QKV + h * 128 + grp * 8;
#pragma unroll
        for (int p = 0; p < NP_; ++p) { const int part = NP_ == 1 ? 1 : p;
#pragma unroll
            for (int j = 0; j < 4; ++j) r.t[p][rep][j] = ldg_or0(pr + part * 512 - (ptrdiff_t)(3 - j) * NP, pos - 3 + j >= 0); } }
    r.ar = tid < 64 ? small[(size_t)(T0 + tid) * 32 + 16 + h] : 0.f; r.br = tid < 64 ? small[(size_t)(T0 + tid) * 32 + 20 + h] : 0.f; r.p0 = 0.f; r.p1 = 0.f;
    if (with_t) { const bf16_t* tsrc = (const bf16_t*)(a.ws + WS_TSCR) + (size_t)u * 4096; r.tb = *(const u32x4*)(tsrc + (tid >> 3) * 64 + (tid & 7) * 8); } else r.tb = (u32x4){0u, 0u, 0u, 0u};
}
DI void gdn_table(CArgs& a, int l, int h, LAS float* WT) {
    for (int i = ltid(); i < 3 * 4 * 128; i += NTHREADS) { const int p = i >> 9, j = (i >> 7) & 3, d = i & 127; WT[i] = a.gdn_conv_w[(size_t)l * 4 * 1536 + j * 1536 + p * 512 + h * 128 + d]; }
}
DI void gdn_scalars_r(CArgs& a, int l, int h, float ar, float br, LAS float* SB, LAS float* SC) {
    const int tid = ltid();
    if (tid < 64) { const float beta = sigmoid_(br); const float gg = -__expf(a.gdn_a_log[l * 4 + h]) * softplus_(ar + a.gdn_dt_bias[l * 4 + h]);
        const float cum = wave_incl_scan(gg, tid); SB[tid] = beta; SC[tid] = cum; }
}
DI void gdn_norm8(float (&v)[8], float post) {
    float ss = 0.f;
#pragma unroll
    for (int i = 0; i < 8; ++i) ss += v[i] * v[i];
    ss += __shfl_xor(ss, 1); ss += __shfl_xor(ss, 2); ss += __shfl_xor(ss, 4); ss += __shfl_xor(ss, 8);
    const float rn = rsqrtf(ss + 1e-6f) * post;
#pragma unroll
    for (int i = 0; i < 8; ++i) v[i] *= rn;
}
template <class F> DI void gdn_compute1(CArgs& a, int l, int u, const GdnRaw<1>& rw, LAS unsigned char* lds, LAS float* slot, F&& prefetch) {
    const int tid = ltid(), wid = tid >> 6, lane = tid & 63; const int h = (u >> 6) & 3;
    LAS bf16_t* Kb = (LAS bf16_t*)lds; LAS float* SB = (LAS float*)(lds + 17408); LAS float* SC = (LAS float*)(lds + 17408 + 256); const LAS float* WT = (const LAS float*)(lds + 17920);
    gdn_scalars_r(a, l, h, rw.ar, rw.br, SB, SC);
#pragma unroll
    for (int rep = 0; rep < 2; ++rep) { const int idx = rep * NTHREADS + tid, l_ = idx >> 4, grp = idx & 15; float v[8]; conv8r(rw.t[0][rep], WT + grp * 8, 128, nullptr, v); gdn_norm8(v, 1.f);
        *(LAS u32x4*)(Kb + l_ * 136 + grp * 8) = (u32x4){pk2(v[0], v[1]), pk2(v[2], v[3]), pk2(v[4], v[5]), pk2(v[6], v[7])}; }
    prefetch();
    lds_barrier();
#pragma unroll
    for (int t2 = 0; t2 < 2; ++t2) { const int t = wid * 2 + t2, mt = t >> 2, nt = t & 3; const f32x4 acc = mm16(Kb, 136, mt * 16, Kb, 136, nt * 16, 128, lane);
        const int r = lane & 15, q = lane >> 4, m = nt * 16 + r; const float cm = SC[m];
#pragma unroll
        for (int j = 0; j < 4; ++j) { const int lrow = mt * 16 + 4 * q + j; slot[lrow * 65 + m] = (m < lrow) ? SB[lrow] * acc[j] * __expf(SC[lrow] - cm) : 0.f; } }
    lds_barrier();
}
DI void gdn_invert(LAS float* sl, bf16_t* tout, int lane) {
    for (int lrow = 0; lrow < 64; ++lrow) {
        const float arow = sl[lrow * 65 + lane]; float acc = (lane == lrow) ? 1.f : 0.f;
        int m = 0;
        for (; m + 8 <= lrow; m += 8) { float t[8];
#pragma unroll
            for (int k = 0; k < 8; ++k) t[k] = sl[(m + k) * 65 + lane];
#pragma unroll
            for (int k = 0; k < 8; ++k) acc -= __uint_as_float((unsigned)__builtin_amdgcn_readlane((int)__float_as_uint(arow), m + k)) * t[k]; }
        for (; m < lrow; ++m) { const float s = __uint_as_float((unsigned)__builtin_amdgcn_readlane((int)__float_as_uint(arow), m)); acc -= s * sl[m * 65 + lane]; }
        sl[lrow * 65 + lane] = acc;
    }
#pragma unroll 4
    for (int it = 0; it < 32; ++it) { const int rowi = it * 2 + (lane >> 5), cj = (lane & 31) * 2; ((unsigned*)tout)[rowi * 32 + (lane & 31)] = pk2(sl[rowi * 65 + cj], sl[rowi * 65 + cj + 1]); }
}
template <class F> DI void gdn_compute2(CArgs& a, int l, int u, const GdnRaw<3>& rw, LAS unsigned char* lds, F&& prefetch) {
    const int tid = ltid(), wid = tid >> 6, lane = tid & 63; const int h = (u >> 6) & 3;
    LAS bf16_t* Kb = (LAS bf16_t*)lds; LAS bf16_t* Qb = (LAS bf16_t*)(lds + 17408); LAS bf16_t* SOL = (LAS bf16_t*)lds;
    LAS bf16_t* RT = (LAS bf16_t*)(lds + 34816); LAS bf16_t* KT = (LAS bf16_t*)(lds + 71680); LAS bf16_t* Tb = (LAS bf16_t*)(lds + 90112); LAS bf16_t* PB = (LAS bf16_t*)(lds + 99328);
    LAS float* SB = (LAS float*)(lds + 108544); LAS float* SC = (LAS float*)(lds + 108544 + 256); const LAS float* WT = (const LAS float*)(lds + 109056);
    char* ub = a.ws + WS_R1 + R1_SGDN + (size_t)u * GDN_UNIT;
    gdn_scalars_r(a, l, h, rw.ar, rw.br, SB, SC);
    float vq[2][8], vk[2][8], vv[2][8];
#pragma unroll
    for (int rep = 0; rep < 2; ++rep) { const int grp = (rep * NTHREADS + tid) & 15;
        conv8r(rw.t[0][rep], WT + grp * 8, 128, nullptr, vq[rep]); gdn_norm8(vq[rep], 0.08838834764831845f);
        conv8r(rw.t[1][rep], WT + 512 + grp * 8, 128, nullptr, vk[rep]); gdn_norm8(vk[rep], 1.f);
        conv8r(rw.t[2][rep], WT + 1024 + grp * 8, 128, nullptr, vv[rep]); }
    *(LAS u32x4*)(Tb + (tid >> 3) * 72 + (tid & 7) * 8) = rw.tb;
    prefetch();
    lds_barrier();
#pragma unroll
    for (int rep = 0; rep < 2; ++rep) { const int idx = rep * NTHREADS + tid, l_ = idx >> 4, grp = idx & 15; const float cl = SC[l_], c63 = SC[63], be = SB[l_];
        *(LAS u32x4*)(Qb + l_ * 136 + grp * 8) = (u32x4){pk2(vq[rep][0], vq[rep][1]), pk2(vq[rep][2], vq[rep][3]), pk2(vq[rep][4], vq[rep][5]), pk2(vq[rep][6], vq[rep][7])};
        { const float eq = __expf(cl); float qd[8];
#pragma unroll
          for (int i = 0; i < 8; ++i) qd[i] = vq[rep][i] * eq;
          frag_store8(ub + GDN_OQ, 8, l_, grp * 8, qd); }
        *(LAS u32x4*)(Kb + l_ * 136 + grp * 8) = (u32x4){pk2(vk[rep][0], vk[rep][1]), pk2(vk[rep][2], vk[rep][3]), pk2(vk[rep][4], vk[rep][5]), pk2(vk[rep][6], vk[rep][7])};
        { const float e1 = be * __expf(cl), e2 = __expf(c63 - cl);
#pragma unroll
          for (int i = 0; i < 8; ++i) { RT[(128 + grp * 8 + i) * 72 + l_] = f2bf(vk[rep][i] * e1); KT[(grp * 8 + i) * 72 + l_] = f2bf(vk[rep][i] * e2); RT[(grp * 8 + i) * 72 + l_] = f2bf(vv[rep][i] * be); } } }
    if (tid < 128) ((float*)(ub + GDN_OD))[tid] = __expf(SC[63]);
    lds_barrier();
#pragma unroll
    for (int t2 = 0; t2 < 2; ++t2) { const int t = wid * 2 + t2, mt = t >> 2, nt = t & 3; const f32x4 acc = mm16(Qb, 136, mt * 16, Kb, 136, nt * 16, 128, lane);
        const int r = lane & 15, q = lane >> 4, m = nt * 16 + r; const float cm = SC[m];
#pragma unroll
        for (int j = 0; j < 4; ++j) { const int lrow = mt * 16 + 4 * q + j; PB[lrow * 72 + m] = f2bf(m <= lrow ? acc[j] * __expf(SC[lrow] - cm) : 0.f); } }
    f32x4 sacc[8];
#pragma unroll
    for (int t2 = 0; t2 < 8; ++t2) { const int t = wid * 8 + t2, mt = t & 3, ntile = t >> 2; sacc[t2] = mm16(Tb, 72, mt * 16, RT, 72, ntile * 16, 64, lane); }
    lds_barrier();
#pragma unroll
    for (int t2 = 0; t2 < 8; ++t2) { const int t = wid * 8 + t2, mt = t & 3, ntile = t >> 2; const int r = lane & 15, q = lane >> 4, cc = ntile * 16 + r; const float sg = cc < 128 ? 1.f : -1.f;
#pragma unroll
        for (int j = 0; j < 4; ++j) SOL[(mt * 16 + 4 * q + j) * 264 + cc] = f2bf(sacc[t2][j] * sg); }
    lds_barrier();
    export_frags(ub + GDN_OP, PB, 72, 64, 64, 0);
    export_frags(ub + GDN_OK, KT, 72, 128, 64, 0);
    export_frags(ub + GDN_OW, SOL, 264, 64, 128, 128);
    export_acc(ub + GDN_OU, SOL, 264, 4);
    lds_barrier();
}
DI void phase_prep(CArgs& a, int l, LAS unsigned char* lds) {
    const int wid = ltid() >> 6, lane = ltid() & 63; const int w = lbid(), Gd = lgrid();
#ifndef REP_PGDN
#define REP_PGDN 1
#endif
#ifndef REP_PGLA
#define REP_PGLA 1
#endif
#ifndef REP_PSSD
#define REP_PSSD 1
#endif
    for (int rp_ = 0; rp_ < REP_PGDN; ++rp_)
    { const int upw = (2048 + Gd - 1) / Gd, u0 = w * upw, u1 = (u0 + upw < 2048) ? u0 + upw : 2048;
      LAS float* slots = (LAS float*)(lds + 20480);
      for (int ub = u0; ub < u1; ub += 8) { const int nb = (u1 - ub) < 8 ? (u1 - ub) : 8; int curh = -1;
#ifndef REP_G1
#define REP_G1 1
#endif
#ifndef REP_G2
#define REP_G2 1
#endif
          for (int rg1 = 0; rg1 < REP_G1; ++rg1) { curh = -1;
          GdnRaw<1> r1; gdn_load<1>(a, ub, r1, false);
          for (int j = 0; j < nb; ++j) { const int u = ub + j;
              if ((u >> 6) != curh) { curh = u >> 6; lds_barrier(); LAS float* WT = (LAS float*)(lds + 17920); for (int i = ltid(); i < 512; i += NTHREADS) WT[i] = a.gdn_conv_w[(size_t)l * 4 * 1536 + (i >> 7) * 1536 + 512 + (curh & 3) * 128 + (i & 127)]; lds_barrier(); }
              GdnRaw<1> rn = r1;
              gdn_compute1(a, l, u, r1, lds, slots + j * 4160, [&]() { if (j + 1 < nb) gdn_load<1>(a, u + 1, rn, false); }); r1 = rn; }
          if (wid < nb) gdn_invert(slots + wid * 4160, (bf16_t*)(a.ws + WS_TSCR) + (size_t)(ub + wid) * 4096, lane);
          asm volatile("s_waitcnt vmcnt(0)" ::: "memory");
          __syncthreads(); }
          for (int rg2 = 0; rg2 < REP_G2; ++rg2) {
          curh = -1;
          GdnRaw<3> r3; gdn_load<3>(a, ub, r3, true);
          for (int j = 0; j < nb; ++j) { const int u = ub + j;
              if ((u >> 6) != curh) { curh = u >> 6; lds_barrier(); gdn_table(a, l, curh & 3, (LAS float*)(lds + 109056)); lds_barrier(); }
              GdnRaw<3> rn = r3;
              gdn_compute2(a, l, u, r3, lds, [&]() { if (j + 1 < nb) gdn_load<3>(a, u + 1, rn, true); }); r3 = rn; } } } }
    for (int rp_ = 0; rp_ < REP_PGLA; ++rp_)
    { const int upw = (2048 + Gd - 1) / Gd, u0 = w * upw, u1 = (u0 + upw < 2048) ? u0 + upw : 2048; int curh = -1;
      if (u0 < u1) { GlaRaw r; gla_load(a, u0, r);
          for (int u = u0; u < u1; ++u) {
              if ((u >> 6) != curh) { curh = u >> 6; lds_barrier(); gla_table(a, l, curh & 3, (LAS float*)(lds + 72960)); lds_barrier(); }
              GlaRaw rn = r;
              gla_compute(a, u, r, lds, [&]() { if (u + 1 < u1) gla_load(a, u + 1, rn); }); r = rn; } } }
    for (int rp_ = 0; rp_ < REP_PSSD; ++rp_)
    { const int upw = (4096 + Gd - 1) / Gd, u0 = w * upw, u1 = (u0 + upw < 4096) ? u0 + upw : 4096; int curh = -1;
      if (u0 < u1) { SsdRaw r; ssd_load(a, u0, r);
          for (int u = u0; u < u1; ++u) {
              if ((u >> 6) != curh) { curh = u >> 6; lds_barrier(); ssd_table(a, l, curh & 7, (LAS float*)(lds + 47104)); lds_barrier(); }
              SsdRaw rn = r;
              ssd_compute(a, l, u, r, lds, [&]() { if (u + 1 < u1) ssd_load(a, u + 1, rn); }); r = rn; } } }
}
DI bf16x8 pack16(const f32x16& x, int s) {
    u32x4 p; p.x = pk2(x[8 * s], x[8 * s + 1]); p.y = pk2(x[8 * s + 2], x[8 * s + 3]); p.z = pk2(x[8 * s + 4], x[8 * s + 5]); p.w = pk2(x[8 * s + 6], x[8 * s + 7]);
    return __builtin_bit_cast(bf16x8, p);
}
#define MFMA32(a, b, c) __builtin_amdgcn_mfma_f32_32x32x16_bf16((a), (b), (c), 0, 0, 0)
template <int DK, bool HAS_W, int NH, int NCT, int UNIT, int OQ, int OW, int OP, int OK, int OU, int OD>
DI void scan_wg(const char* ops0, const char* ops1, char* ob0, char* ob1, LAS unsigned char* lds) {
    constexpr int NKB = DK / 16, NDT = DK / 32, BUF = NH * UNIT, OUNIT = NCT * 2 * 2048;
    static_assert(2 * BUF <= LDS_CTRL, "scan LDS");
    const int tid = ltid(), wid = __builtin_amdgcn_readfirstlane(tid >> 6), lane = tid & 63, h = lane >> 5;
    const int hd = (NH == 2) ? (wid >> 1) & 1 : 0, ct = (NH == 2) ? (wid & 1) : (wid & 3);
    static_assert(UNIT % 1024 == 0, "unit = whole 1 KiB chunks");
    auto load_step = [&](int n, int buf) {
        const int lw = wid - 4;
#pragma unroll
        for (int k = 0; k < NH; ++k) { const char* src = (k == 0 ? ops0 : ops1) + (size_t)n * UNIT + lane * 16 + lw * 1024; unsigned dst = (unsigned)(buf * BUF + k * UNIT + lw * 1024);
#pragma unroll 1
            for (int ch = lw; ch < UNIT / 1024; ch += 4) { __builtin_amdgcn_global_load_lds((const unsigned*)src, (LAS unsigned*)(lds + dst), 16, 0, 0); src += 4096; dst += 4096u; } }
        asm volatile("s_waitcnt vmcnt(0)" ::: "memory");
    };
    f32x16 S[NDT]; bf16x8 Sb[NKB];
#pragma unroll
    for (int d = 0; d < NDT; ++d)
#pragma unroll
        for (int i = 0; i < 16; ++i) S[d][i] = 0.f;
#pragma unroll
    for (int k = 0; k < NKB; ++k) Sb[k] = (bf16x8){0, 0, 0, 0, 0, 0, 0, 0};
    if (wid >= 4) load_step(0, 0);
    __syncthreads();
    char* ob = (hd == 0 ? ob0 : ob1);
    for (int n = 0; n < 64; ++n) {
        if (wid >= 4) { if (n + 1 < 64) load_step(n + 1, (n + 1) & 1); }
        else {
            const LAS unsigned char* lb = lds + (n & 1) * BUF + hd * UNIT;
            f32x16 U[2];
#pragma unroll
            for (int rt = 0; rt < 2; ++rt) { const LAS unsigned char* up = lb + OU + ((ct * 2 + rt) * 64 + lane) * 32; const u32x4 w0 = *(const LAS u32x4*)up, w1 = *(const LAS u32x4*)(up + 16);
                U[rt][0] = bflo(w0.x); U[rt][1] = bfhi(w0.x); U[rt][2] = bflo(w0.y); U[rt][3] = bfhi(w0.y); U[rt][4] = bflo(w0.z); U[rt][5] = bfhi(w0.z); U[rt][6] = bflo(w0.w); U[rt][7] = bfhi(w0.w);
                U[rt][8] = bflo(w1.x); U[rt][9] = bfhi(w1.x); U[rt][10] = bflo(w1.y); U[rt][11] = bfhi(w1.y); U[rt][12] = bflo(w1.z); U[rt][13] = bfhi(w1.z); U[rt][14] = bflo(w1.w); U[rt][15] = bfhi(w1.w); }
            if constexpr (HAS_W) {
#pragma unroll
                for (int rt = 0; rt < 2; ++rt)
#pragma unroll
                    for (int k4 = 0; k4 < NKB; k4 += 4) { bf16x8 fw[4];
#pragma unroll
                        for (int kb = 0; kb < 4; ++kb) fw[kb] = *(const LAS bf16x8*)(lb + OW + ((rt * NKB + k4 + kb) * 64 + lane) * 16);
#pragma unroll
                        for (int kb = 0; kb < 4; ++kb) U[rt] = MFMA32(fw[kb], Sb[k4 + kb], U[rt]); }
            }
            bf16x8 Ub[4];
            Ub[0] = pack16(U[0], 0); Ub[1] = pack16(U[0], 1); Ub[2] = pack16(U[1], 0); Ub[3] = pack16(U[1], 1);
#pragma unroll
            for (int rt = 0; rt < 2; ++rt) { f32x16 O;
#pragma unroll
                for (int i = 0; i < 16; ++i) O[i] = 0.f;
                { bf16x8 fp[4];
#pragma unroll
                  for (int kb = 0; kb < 4; ++kb) fp[kb] = *(const LAS bf16x8*)(lb + OP + ((rt * 4 + kb) * 64 + lane) * 16);
#pragma unroll
                  for (int kb = 0; kb < 4; ++kb) O = MFMA32(fp[kb], Ub[kb], O); }
#pragma unroll
                for (int k4 = 0; k4 < NKB; k4 += 4) { bf16x8 fq[4];
#pragma unroll
                    for (int kb = 0; kb < 4; ++kb) fq[kb] = *(const LAS bf16x8*)(lb + OQ + ((rt * NKB + k4 + kb) * 64 + lane) * 16);
#pragma unroll
                    for (int kb = 0; kb < 4; ++kb) O = MFMA32(fq[kb], Sb[k4 + kb], O); }
                char* op = ob + (size_t)n * OUNIT + ((ct * 2 + rt) * 64 + lane) * 32;
                *(u32x4*)op = (u32x4){pk2(O[0], O[1]), pk2(O[2], O[3]), pk2(O[4], O[5]), pk2(O[6], O[7])};
                *(u32x4*)(op + 16) = (u32x4){pk2(O[8], O[9]), pk2(O[10], O[11]), pk2(O[12], O[13]), pk2(O[14], O[15])}; }
#pragma unroll
            for (int d = 0; d < NDT; ++d) {
#pragma unroll
                for (int g = 0; g < 4; ++g) { const f32x4 dv = *(const LAS f32x4*)(lb + OD + (d * 32 + 8 * g + 4 * h) * 4);
                    S[d][4 * g] *= dv[0]; S[d][4 * g + 1] *= dv[1]; S[d][4 * g + 2] *= dv[2]; S[d][4 * g + 3] *= dv[3]; }
                bf16x8 fk[4];
#pragma unroll
                for (int kb = 0; kb < 4; ++kb) fk[kb] = *(const LAS bf16x8*)(lb + OK + ((d * 4 + kb) * 64 + lane) * 16);
#pragma unroll
                for (int kb = 0; kb < 4; ++kb) S[d] = MFMA32(fk[kb], Ub[kb], S[d]);
                Sb[2 * d] = pack16(S[d], 0); Sb[2 * d + 1] = pack16(S[d], 1); }
        }
        __syncthreads();
    }
}
DI void phase_scan(CArgs& a, LAS unsigned char* lds) {
    char* r1 = a.ws + WS_R1; char* obuf = r1 + R1_OBUF;
    for (int it = lbid(); it < 96; it += lgrid()) {
        if (it < 32) { const char* ops = r1 + R1_SGDN + (size_t)it * 64 * GDN_UNIT; char* ob = obuf + OB_GDN + (size_t)it * 64 * 16384;
            scan_wg<128, true, 1, 4, GDN_UNIT, GDN_OQ, GDN_OW, GDN_OP, GDN_OK, GDN_OU, GDN_OD>(ops, ops, ob, ob, lds); }
        else if (it < 64) { const int i2 = it - 32; const char* ops = r1 + R1_SGLA + (size_t)i2 * 64 * GLA_UNIT; char* ob = obuf + OB_GLA + (size_t)i2 * 64 * 16384;
            scan_wg<64, false, 1, 4, GLA_UNIT, GLA_OQ, 0, GLA_OP, GLA_OK, GLA_OU, GLA_OD>(ops, ops, ob, ob, lds); }
        else { const int i2 = (it - 64) * 2; const char* ops = r1 + R1_SSSD + (size_t)i2 * 64 * SSD_UNIT; char* ob = obuf + OB_SSD + (size_t)i2 * 64 * 8192;
            scan_wg<64, false, 2, 2, SSD_UNIT, SSD_OQ, 0, SSD_OP, SSD_OK, SSD_OU, SSD_OD>(ops, ops + (size_t)64 * SSD_UNIT, ob, ob + (size_t)64 * 8192, lds); }
    }
}

DI float otile_ld(const LAS unsigned char* tl, int l_, int e) {
    const int ct = e >> 5, r = e & 31, rt = l_ >> 5, lr = l_ & 31, h = (lr >> 2) & 1, i = (lr & 3) + 4 * (lr >> 3);
    return bf2f(*(const LAS bf16_t*)(tl + ((ct * 2 + rt) * 64 + h * 32 + r) * 32 + i * 2));
}
DI void phase_post(CArgs& a, int l, LAS unsigned char* lds) {
    const int tid = ltid(); char* r1 = a.ws + WS_R1; const bf16_t* P = (const bf16_t*)(r1 + R1_PROJ); const char* obuf = r1 + R1_OBUF; bf16_t* Y = (bf16_t*)(r1 + R1_YMIX);
    const int l_ = tid >> 3, sub = tid & 7;
    for (int u = lbid(); u < 5120; u += lgrid()) {
        if (u < 4096) {
            const int ty = u >> 11, uu = u & 2047, n = uu & 63, bh = uu >> 6, b = bh >> 2, h = bh & 3; const size_t T = (size_t)b * SEQ + n * 64 + l_;
            const char* src = obuf + (ty ? OB_GDN : OB_GLA) + (size_t)uu * 16384;
#pragma unroll
            for (int rep = 0; rep < 2; ++rep) { const int i = rep * NTHREADS + tid; *(LAS u32x4*)(lds + i * 16) = *(const u32x4*)(src + (size_t)i * 16); }
            __syncthreads();
            float o[16]; float ss = 0.f;
#pragma unroll
            for (int j = 0; j < 16; ++j) { o[j] = otile_ld(lds, l_, sub * 16 + j); ss += o[j] * o[j]; }
            ss += __shfl_xor(ss, 1); ss += __shfl_xor(ss, 2); ss += __shfl_xor(ss, 4);
            const float rs = rsqrtf(ss * (1.f / 128.f) + 1e-6f);
            const float* ng = (ty ? a.gdn_norm : a.gla_norm) + l * 128 + sub * 16;
            const bf16_t* gp = P + T * NP + (ty ? PC_GDN_G : PC_GLA_R) + h * 128 + sub * 16;
            const u32x4 g0 = *(const u32x4*)gp, g1 = *(const u32x4*)(gp + 8);
            const float gv[16] = {bflo(g0.x), bfhi(g0.x), bflo(g0.y), bfhi(g0.y), bflo(g0.z), bfhi(g0.z), bflo(g0.w), bfhi(g0.w), bflo(g1.x), bfhi(g1.x), bflo(g1.y), bfhi(g1.y), bflo(g1.z), bfhi(g1.z), bflo(g1.w), bfhi(g1.w)};
            float y[16];
#pragma unroll
            for (int j = 0; j < 16; ++j) y[j] = o[j] * rs * ng[j] * silu_(gv[j]);
            bf16_t* yp = Y + ((size_t)ty * NTOK + T) * 512 + h * 128 + sub * 16;
            *(u32x4*)yp = (u32x4){pk2(y[0], y[1]), pk2(y[2], y[3]), pk2(y[4], y[5]), pk2(y[6], y[7])};
            *(u32x4*)(yp + 8) = (u32x4){pk2(y[8], y[9]), pk2(y[10], y[11]), pk2(y[12], y[13]), pk2(y[14], y[15])};
            __syncthreads();
        } else {
            const int uu = u - 4096, n = uu & 63, bg = uu >> 6, b = bg >> 1, g = bg & 1; const size_t T = (size_t)b * SEQ + n * 64 + l_;
#pragma unroll
            for (int rep = 0; rep < 4; ++rep) { const int i = rep * NTHREADS + tid, hq = i >> 9, ii = i & 511;
                *(LAS u32x4*)(lds + i * 16) = *(const u32x4*)(obuf + OB_SSD + ((size_t)((b * 8 + g * 4 + hq) * 64 + n)) * 8192 + (size_t)ii * 16); }
            __syncthreads();
            const int hq = sub >> 1, hh = g * 4 + hq, p0 = (sub & 1) * 32; const float dsk = a.ssd_d[l * 8 + hh];
            float y[32]; float ss = 0.f;
#pragma unroll
            for (int c8 = 0; c8 < 4; ++c8) { const int ch = hh * 64 + p0 + c8 * 8; float xc[8];
                conv8(P + T * NP + PC_SSD_XBC + ch, n * 64 + l_, a.ssd_conv_w + (size_t)l * 4 * 768 + ch, 768, a.ssd_conv_b + l * 768 + ch, xc);
                const u32x4 z8 = *(const u32x4*)(P + T * NP + PC_SSD_Z + ch);
                const float zf[8] = {bflo(z8.x), bfhi(z8.x), bflo(z8.y), bfhi(z8.y), bflo(z8.z), bfhi(z8.z), bflo(z8.w), bfhi(z8.w)};
#pragma unroll
                for (int j = 0; j < 8; ++j) { const float ov = otile_ld(lds + hq * 8192, l_, p0 + c8 * 8 + j); const float yv = (ov + dsk * xc[j]) * silu_(zf[j]); y[c8 * 8 + j] = yv; ss += yv * yv; } }
            ss += __shfl_xor(ss, 1); ss += __shfl_xor(ss, 2); ss += __shfl_xor(ss, 4);
            const float rs = rsqrtf(ss * (1.f / 256.f) + 1e-6f);
            const float* ng = a.ssd_norm + l * 512 + hh * 64 + p0;
            bf16_t* yp = Y + ((size_t)2 * NTOK + T) * 512 + hh * 64 + p0;
#pragma unroll
            for (int c8 = 0; c8 < 4; ++c8) { float t[8];
#pragma unroll
                for (int j = 0; j < 8; ++j) t[j] = y[c8 * 8 + j] * rs * ng[c8 * 8 + j];
                *(u32x4*)(yp + c8 * 8) = (u32x4){pk2(t[0], t[1]), pk2(t[2], t[3]), pk2(t[4], t[5]), pk2(t[6], t[7])}; }
            __syncthreads();
        }
    }
}
DI CArgs& load_args() { CArgs* p = (CArgs*)__builtin_amdgcn_kernarg_segment_ptr(); asm volatile("" : "+s"(p)); return *p; }
DI void grid_sync(LAS unsigned char* lds) {
    CArgs& a = load_args(); XcdBarrier b; b.bar = (unsigned*)(a.ws + WS_CTL); b.x = xb_xcc_id(); b.st = (volatile LAS unsigned*)(lds + LDS_CTRL); xcd_barrier(b); }
__global__ void __launch_bounds__(NTHREADS, 2) fwd_kernel(Args a_unused) {
    extern __shared__ __attribute__((aligned(16))) unsigned char lds_raw[];
    LAS unsigned char* lds = (LAS unsigned char*)lds_raw;
    const int tid = ltid();
    if (tid < 256) ((LAS unsigned*)(lds + LDS_CTRL))[tid] = 0u;
    __syncthreads();
    { CArgs& a = load_args(); (void)xcd_barrier_post((unsigned*)(a.ws + WS_CTL), (volatile LAS unsigned*)(lds + LDS_CTRL)); }
    const int G = lgrid(), c = lbid();
#ifndef REP_CVT
#define REP_CVT 1
#endif
#ifndef REP_INPROJ
#define REP_INPROJ 1
#endif
#ifndef REP_PREP
#define REP_PREP 1
#endif
#ifndef REP_SCAN
#define REP_SCAN 1
#endif
#ifndef REP_POST
#define REP_POST 1
#endif
#ifndef REP_BR
#define REP_BR 1
#endif
#ifndef REP_OUT
#define REP_OUT 1
#endif
#ifndef REP_GU
#define REP_GU 1
#endif
#ifndef REP_DN
#define REP_DN 1
#endif
#ifndef REP_COMB
#define REP_COMB 1
#endif
#define REPEAT(n) for (int rep_ = 0; rep_ < (n); ++rep_)
    { CArgs& a = load_args(); phase_mod(a, lds); }
    REPEAT(REP_CVT) { CArgs& a = load_args(); phase_cvt(a, lds); }
    grid_sync(lds);
    { CArgs& a = load_args(); phase_norm0(a); }
#if INPROJ_I8
    { CArgs& a = load_args(); phase_cvt_win_i8(a, lds); }
#endif
    grid_sync(lds);
    for (int l = 0; l < 2; ++l) {
        REPEAT(REP_INPROJ) {
        { CArgs& a = load_args(); char* r1 = a.ws + WS_R1;
#if INPROJ_I8
          pg8::StaticOrder S; S.init(NTOK, NP, DM / 2, G, c, a.ws + WS_H, a.ws + WS_WIN + (size_t)l * NP * DM);
          EpiProj E{(bf16_t*)(r1 + R1_PROJ), (float*)(a.ws + WS_SMALL), (const float*)(a.ws + WS_SA), (const float*)(a.ws + WS_COLMAX) + l * NP};
          pg8::gemm_phase<EpiProj, pg8::StaticOrder, 2>(lds, DM / 2, S, E);
#else
          pg8::StaticOrder S; S.init(NTOK, NP, DM, G, c, a.ws + WS_H, a.ws + WS_WIN + (size_t)l * NP * DM * 2);
          EpiProj E{(bf16_t*)(r1 + R1_PROJ), (float*)(a.ws + WS_SMALL), nullptr, nullptr};
          pg8::gemm_phase<EpiProj, pg8::StaticOrder>(lds, DM, S, E);
#endif
        }
        grid_sync(lds); }
        REPEAT(REP_PREP) { { CArgs& a = load_args(); phase_prep(a, l, lds); }
        grid_sync(lds); }
        REPEAT(REP_SCAN) { { CArgs& a = load_args(); phase_scan(a, lds); }
        grid_sync(lds); }
        REPEAT(REP_POST) { { CArgs& a = load_args(); phase_post(a, l, lds); }
        grid_sync(lds); }
        REPEAT(REP_BR) {
        { CArgs& a = load_args(); char* r1 = a.ws + WS_R1;
          pg8::BranchOrder S; S.init(NTOK, DM, 512, G, c, r1 + R1_YMIX, a.ws + WS_WBR + (size_t)l * 3 * DM * 512 * 2); S.pn_per_a = 4; S.a_pnstride = (size_t)NTOK * 512 * 2;
          EpiGate E{(const bf16_t*)(r1 + R1_PROJ), a.b_merge + l * 3072, (bf16_t*)(r1 + R1_GATED), (bf16_t*)(r1 + R1_MERGED)};
          pg8::gemm_phase<EpiGate, pg8::BranchOrder>(lds, 512, S, E); }
        grid_sync(lds); }
        REPEAT(REP_OUT) {
        { CArgs& a = load_args(); char* r1 = a.ws + WS_R1;
          pg8::StaticOrder S; S.init(NTOK, DM, DM, G, c, r1 + R1_MERGED, a.ws + WS_WOUT + (size_t)l * DM * DM * 2);
          EpiResid E{(l == 0) ? a.x : (const float*)(a.ws + WS_XB), (float*)(a.ws + WS_XA), (const float*)(a.ws + WS_MOD) + (size_t)l * 8 * 6144 + 2048};
          pg8::gemm_phase<EpiResid, pg8::StaticOrder>(lds, DM, S, E); }
        grid_sync(lds); }
        { CArgs& a = load_args(); phase_router(a, l, (const float*)(a.ws + WS_XA), lds); }
        grid_sync(lds);
        REPEAT(REP_GU) {
        { CArgs& a = load_args(); char* r1 = a.ws + WS_R1;
          moe_tables((const int*)(a.ws + WS_CNT) + l * 32 * 64, lds);
          MoeOrder<true> S{8, G, c, (const LAS int*)(lds + LDS_CTRL + 64), (const LAS int*)(lds + LDS_CTRL + 256), (const char*)(a.ws + WS_H), a.ws + WS_WGU + (size_t)l * NEXP * 2048 * DM,
                           (size_t)2048 * DM, (size_t)256 * DM, (const int*)(a.ws + WS_ROWTOK)};
          EpiSwiglu E{(unsigned char*)(r1 + R1_ACT), a.b_gu + (size_t)l * NEXP * 2048};
          pg8::gemm_phase<EpiSwiglu, MoeOrder<true>, 1>(lds, DM / 2, S, E); }
        grid_sync(lds); }
        REPEAT(REP_DN) {
        { CArgs& a = load_args(); char* r1 = a.ws + WS_R1;
          MoeOrder<false> S{4, G, c, (const LAS int*)(lds + LDS_CTRL + 64), (const LAS int*)(lds + LDS_CTRL + 256), (const char*)(r1 + R1_ACT), a.ws + WS_WDN + (size_t)l * NEXP * DM * DM,
                            (size_t)DM * DM, (size_t)256 * DM, nullptr};
          EpiDown E{(bf16_t*)(r1 + R1_YS), a.b_dn + (size_t)l * NEXP * DM};
          pg8::gemm_phase<EpiDown, MoeOrder<false>, 1>(lds, DM / 2, S, E); }
        grid_sync(lds); }
        REPEAT(REP_COMB) { { CArgs& a = load_args(); phase_combine(a, l, (const float*)(a.ws + WS_XA), (float*)(a.ws + WS_XB), lds); }
        grid_sync(lds); }
    }
}

extern "C" void kernel_launch(void* const* d_in, const int* in_sizes, int n_in, void* d_out, int out_size, void* d_ws, size_t ws_size, hipStream_t stream) {
    static int grid = 0;
    if (grid == 0) {
        if (n_in != 32 || ws_size < WS_END) { fprintf(stderr, "kernel_launch: unexpected inputs (n_in %d, ws %zu, need %zu)\n", n_in, ws_size, (size_t)WS_END); grid = -1; return; }
        int dev = 0, cus = 0, per_cu = 0;
        if (hipGetDevice(&dev) != hipSuccess || hipDeviceGetAttribute(&cus, hipDeviceAttributeMultiprocessorCount, dev) != hipSuccess) { grid = -1; return; }
        if (hipFuncSetAttribute((const void*)fwd_kernel, hipFuncAttributeMaxDynamicSharedMemorySize, LDS_BYTES) != hipSuccess) { fprintf(stderr, "kernel_launch: hipFuncSetAttribute failed\n"); grid = -1; return; }
        if (hipOccupancyMaxActiveBlocksPerMultiprocessor(&per_cu, (const void*)fwd_kernel, NTHREADS, LDS_BYTES) != hipSuccess || per_cu < 1) { fprintf(stderr, "kernel_launch: occupancy query says %d\n", per_cu); grid = -1; return; }
        grid = cus;
    }
    if (grid < 0) return;
    (void)hipMemsetAsync((char*)d_ws + WS_CTL, 0, 65536, stream);
    (void)hipMemsetAsync((char*)d_ws + WS_COLMAX, 0, 65536, stream);
    Args a{};
    const float** pp = (const float**)&a;
    for (int i = 0; i < 32; ++i) pp[i] = (const float*)d_in[i];
    a.out = (float*)d_out; a.ws = (char*)d_ws;
    hipLaunchKernelGGL(fwd_kernel, dim3(grid), dim3(NTHREADS), LDS_BYTES, stream, a);
}
```

```cpp
#include <hip/hip_runtime.h>
#include <cstdio>
#include <cstdint>
#define DI __device__ __forceinline__
#define LAS __attribute__((address_space(3)))
typedef unsigned short bf16_t;
typedef short bf16x8 __attribute__((ext_vector_type(8)));
typedef float f32x4 __attribute__((ext_vector_type(4)));
typedef float f32x2 __attribute__((ext_vector_type(2)));
typedef float f32x16 __attribute__((ext_vector_type(16)));
typedef unsigned u32x4 __attribute__((ext_vector_type(4)));
typedef unsigned u32x2 __attribute__((ext_vector_type(2)));
typedef __bf16 hbf16x2 __attribute__((ext_vector_type(2)));

DI int ltid() { int t = threadIdx.x; asm volatile("" : "+v"(t)); return t; }
DI int lbid() { int t = blockIdx.x; asm volatile("" : "+s"(t)); return t; }
DI int lgrid() { int t = gridDim.x; asm volatile("" : "+s"(t)); return t; }
DI void lds_barrier() { asm volatile("s_waitcnt lgkmcnt(0)" ::: "memory"); __builtin_amdgcn_s_barrier(); asm volatile("" ::: "memory"); }
DI unsigned pk2(float a, float b) { f32x2 v = {a, b}; hbf16x2 r = __builtin_convertvector(v, hbf16x2); return __builtin_bit_cast(unsigned, r); }
DI float bflo(unsigned w) { return __uint_as_float(w << 16); }
DI float bfhi(unsigned w) { return __uint_as_float(w & 0xffff0000u); }
DI float bf2f(bf16_t v) { return __uint_as_float(((unsigned)v) << 16); }
DI bf16_t f2bf(float a) { return (bf16_t)(pk2(a, 0.f) & 0xffffu); }
DI float sigmoid_(float x) { return 1.f / (1.f + __expf(-x)); }
DI float silu_(float x) { return x / (1.f + __expf(-x)); }
DI float softplus_(float x) { return fmaxf(x, 0.f) + log1pf(__expf(-fabsf(x))); }

namespace pg8 {
constexpr int BM = 256, BK = 64, HALF = 128, HTB = HALF * BK * 2, STAGE_BYTES = 8 * HTB, NXCD = 8, WGM = 8;
__host__ __device__ __forceinline__ int lds_byte(int r, int c) { const int st = (r >> 4) * 2 + (c >> 5), rr = r & 15, cc = c & 31, ob = rr * 64 + cc * 2; return st * 1024 + (ob ^ (((ob >> 9) & 1) << 5)); }
__host__ __device__ __forceinline__ void stage_rc(int b, int& R, int& C) { const int st = b / 1024, sb = b % 1024, swz = sb ^ (((sb >> 9) & 1) << 5); R = (st >> 1) * 16 + swz / 64; C = (st & 1) * 32 + (swz % 64) / 2; }
__host__ __device__ __forceinline__ int perm32(int rho) { const int n = rho >> 4, i = rho & 15; return 8 * (i >> 2) + 4 * n + (i & 3); }

struct Unit { int pm, pn, e, cnt; };

struct StaticOrder {
    static constexpr bool GATHER = false;
    int nM, nN, nwg, G, c;
    const char* A; const char* Bt; size_t a_tstep, b_tstep, a_pnstride; int pn_per_a;
    DI void init(int M, int N, int K, int G_, int c_, const void* A_, const void* Bt_) { nM = M / BM; nN = N / BM; nwg = nM * nN; G = G_; c = c_; A = (const char*)A_; Bt = (const char*)Bt_; a_tstep = (size_t)BM * K * 2; b_tstep = (size_t)BM * K * 2; a_pnstride = 0; pn_per_a = 1 << 30; }
    DI bool next(int i, Unit& u) const {
        const long L = (long)i * G + c; if (L >= nwg) return false;
        int wgid = (int)L; { const int q = nwg / NXCD, r = nwg % NXCD, xcd = wgid % NXCD, off = wgid / NXCD; wgid = (xcd < r ? xcd * (q + 1) : r * (q + 1) + (xcd - r) * q) + off; }
        const int nig = WGM * nN, gid = wgid / nig, fm = gid * WGM, gsz = (nM - fm) < WGM ? (nM - fm) : WGM;
        u.pm = fm + ((wgid % nig) % gsz); u.pn = (wgid % nig) / gsz; u.e = 0; u.cnt = 256; return true;
    }
    DI const char* a_ptr(const Unit& u) const { return A + (size_t)(u.pn / pn_per_a) * a_pnstride + (size_t)u.pm * a_tstep; }
    DI const char* b_ptr(const Unit& u) const { return Bt + (size_t)u.pn * b_tstep; }
    DI int a_row(const Unit&, int) const { return 0; }
};

typedef int i32x4 __attribute__((ext_vector_type(4)));
typedef int i32x8 __attribute__((ext_vector_type(8)));
struct BranchOrder : StaticOrder {
    DI bool next(int i, Unit& u) const { if (!StaticOrder::next(i / 3, u)) return false; u.pn += 4 * (i % 3); return true; }
};
template <class Epi, class Sched, int MODE = 0  , bool ALIGN_EPI = true>
DI void gemm_phase(LAS unsigned char* lds, const int K, const Sched& S, const Epi& E) {
    constexpr bool GATHER = Sched::GATHER; constexpr bool FP8 = (MODE == 1);
    const int tid = ltid(), wid = __builtin_amdgcn_readfirstlane(tid >> 6), lane = tid & 63, wr = wid >> 2, wc = wid & 3, fr = lane & 15, fq = lane >> 4;
    const int nt = K / BK;
    unsigned voffA[2], voffB[2]; int RA[2], CA[2];
#pragma unroll
    for (int i = 0; i < 2; ++i) { int R, C; stage_rc(tid * 16 + i * 8192, R, C); const int Rb = Epi::PERM ? ((R & ~31) + perm32(R & 31)) : R; RA[i] = R; CA[i] = C;
        voffA[i] = (unsigned)(R * K + C) * 2u; voffB[i] = (unsigned)(Rb * K + C) * 2u; }
    const size_t kstep = (size_t)(BK * 2);
    const size_t hstepB = (size_t)HALF * K * 2;
    const size_t hstepA = GATHER ? 0 : hstepB;
    const unsigned ldsw = (unsigned)wid * 1024u;
    const int aoff = lds_byte(wr * 64 + fr, fq * 8), boff = lds_byte(wc * 32 + fr, fq * 8);
#define PG8_SA(b, h) (((b) * 2 + (h)) * HTB)
#define PG8_SB(b, h) ((4 + (b) * 2 + (h)) * HTB)
#define PG8_STAGE(bufoff, gbase, voff) do { _Pragma("unroll") for (int _i = 0; _i < 2; ++_i) \
        __builtin_amdgcn_global_load_lds((const unsigned*)((const char*)(gbase) + (voff)[_i]), (LAS unsigned*)(lds + (bufoff) + ldsw + _i * 8192), 16, 0, 0); } while (0)
#define PG8_CAT(x, y) __builtin_shufflevector(__builtin_bit_cast(i32x4, x), __builtin_bit_cast(i32x4, y), 0, 1, 2, 3, 4, 5, 6, 7)
#define PG8_LDA8(dst, b, h) do { _Pragma("unroll") for (int m = 0; m < 4; ++m) dst[m] = PG8_CAT(*(const LAS bf16x8*)(lds + PG8_SA(b, h) + aoff + m * 2048), *(const LAS bf16x8*)(lds + PG8_SA(b, h) + aoff + m * 2048 + 1024)); } while (0)
#define PG8_LDB8(dst, b, h) do { _Pragma("unroll") for (int n = 0; n < 2; ++n) dst[n] = PG8_CAT(*(const LAS bf16x8*)(lds + PG8_SB(b, h) + boff + n * 2048), *(const LAS bf16x8*)(lds + PG8_SB(b, h) + boff + n * 2048 + 1024)); } while (0)
#define PG8_MMA8(ai, bj, At, Bt) do { __builtin_amdgcn_s_setprio(1); _Pragma("unroll") for (int m = 0; m < 4; ++m) _Pragma("unroll") for (int n = 0; n < 2; ++n) \
        asm volatile("v_mfma_scale_f32_16x16x128_f8f6f4 %0, %1, %2, %0, %3, %3 op_sel_hi:[0,0,0]" : "+v"(acc[ai][bj][m][n]) : "v"(Bt[n]), "v"(At[m]), "v"(one_scale)); __builtin_amdgcn_s_setprio(0); } while (0)
#define PG8_LDA(dst, b, h) do { _Pragma("unroll") for (int m = 0; m < 4; ++m) _Pragma("unroll") for (int k = 0; k < 2; ++k) dst[m][k] = *(const LAS bf16x8*)(lds + PG8_SA(b, h) + aoff + m * 2048 + k * 1024); } while (0)
#define PG8_LDB(dst, b, h) do { _Pragma("unroll") for (int n = 0; n < 2; ++n) _Pragma("unroll") for (int k = 0; k < 2; ++k) dst[n][k] = *(const LAS bf16x8*)(lds + PG8_SB(b, h) + boff + n * 2048 + k * 1024); } while (0)
#define PG8_MMA(ai, bj, At, Bt) do { __builtin_amdgcn_s_setprio(1); _Pragma("unroll") for (int m = 0; m < 4; ++m) _Pragma("unroll") for (int n = 0; n < 2; ++n) _Pragma("unroll") for (int k = 0; k < 2; ++k) { \
        if constexpr (MODE == 2) acc[ai][bj][m][n] = __builtin_bit_cast(f32x4, __builtin_amdgcn_mfma_i32_16x16x64_i8(__builtin_bit_cast(i32x4, Bt[n][k]), __builtin_bit_cast(i32x4, At[m][k]), __builtin_bit_cast(i32x4, acc[ai][bj][m][n]), 0, 0, 0)); \
        else acc[ai][bj][m][n] = __builtin_amdgcn_mfma_f32_16x16x32_bf16(Bt[n][k], At[m][k], acc[ai][bj][m][n], 0, 0, 0); } __builtin_amdgcn_s_setprio(0); } while (0)
#define PG8_WAIT_V(n) asm volatile("s_waitcnt vmcnt(" #n ")" ::: "memory")
#define PG8_WAIT_L(n) asm volatile("s_waitcnt lgkmcnt(" #n ")" ::: "memory")
#define PG8_BAR __builtin_amdgcn_s_barrier()
#define PG8_SCHED __builtin_amdgcn_sched_barrier(0)
    Unit cur, nxt; int ui = 0;
    if (!S.next(0, cur)) return;
    f32x4 acc[2][2][4][2];
#pragma unroll
    for (int a = 0; a < 2; ++a)
#pragma unroll
        for (int b = 0; b < 2; ++b)
#pragma unroll
            for (int m = 0; m < 4; ++m)
#pragma unroll
                for (int n = 0; n < 2; ++n) acc[a][b][m][n] = (f32x4){0.f, 0.f, 0.f, 0.f};
    bf16x8 At[4][2], B0[2][2], B1[2][2]; i32x8 Ct[4], C0[2], C1[2]; const int one_scale = 0x7f7f7f7f;
    const char* cA = S.a_ptr(cur); const char* cB = S.b_ptr(cur);
    unsigned vC0[2], vC1[2], vN0[2], vN1[2];
    if constexpr (GATHER) {
#pragma unroll
        for (int i = 0; i < 2; ++i) { vC0[i] = (unsigned)(S.a_row(cur, RA[i]) * K + CA[i]) * 2u; vC1[i] = (unsigned)(S.a_row(cur, HALF + RA[i]) * K + CA[i]) * 2u; vN0[i] = vC0[i]; vN1[i] = vC1[i]; }
    } else {
#pragma unroll
        for (int i = 0; i < 2; ++i) { vC0[i] = voffA[i]; vC1[i] = voffA[i]; vN0[i] = voffA[i]; vN1[i] = voffA[i]; }
    }
    PG8_STAGE(PG8_SB(0, 0), cB, voffB); PG8_STAGE(PG8_SB(0, 1), cB + hstepB, voffB); PG8_STAGE(PG8_SA(0, 0), cA, vC0); PG8_STAGE(PG8_SA(0, 1), cA + hstepA, vC1);
    if (wr == 1) PG8_BAR;
    PG8_WAIT_V(2); PG8_BAR;
    PG8_STAGE(PG8_SB(1, 0), cB + kstep, voffB); PG8_STAGE(PG8_SA(1, 0), cA + kstep, vC0); PG8_STAGE(PG8_SB(1, 1), cB + hstepB + kstep, voffB);
    PG8_WAIT_V(6); PG8_BAR;
    for (;;) {
        const bool has_next = S.next(ui + 1, nxt);
        const char* nA = has_next ? S.a_ptr(nxt) : cA; const char* nB = has_next ? S.b_ptr(nxt) : cB;
        if constexpr (GATHER) { if (has_next) {
#pragma unroll
            for (int i = 0; i < 2; ++i) { vN0[i] = (unsigned)(S.a_row(nxt, RA[i]) * K + CA[i]) * 2u; vN1[i] = (unsigned)(S.a_row(nxt, HALF + RA[i]) * K + CA[i]) * 2u; } } }
#pragma unroll 1
        for (int t = 0; t < nt; t += 2) {
            const bool last = (t == nt - 2);
            const char* a1 = cA + (size_t)(t + 1) * kstep;
            const char* a2 = last ? nA : cA + (size_t)(t + 2) * kstep; const char* b2 = last ? nB : cB + (size_t)(t + 2) * kstep;
            const char* a3 = a2 + kstep; const char* b3 = b2 + kstep;
            unsigned w0[2], w1[2];
            if constexpr (GATHER) { w0[0] = last ? vN0[0] : vC0[0]; w0[1] = last ? vN0[1] : vC0[1]; w1[0] = last ? vN1[0] : vC1[0]; w1[1] = last ? vN1[1] : vC1[1]; }
            else { w0[0] = voffA[0]; w0[1] = voffA[1]; w1[0] = voffA[0]; w1[1] = voffA[1]; }
            if constexpr (FP8) {
            PG8_LDB8(C0, 0, 0); PG8_LDB8(C1, 0, 1); PG8_SCHED; PG8_LDA8(Ct, 0, 0); PG8_STAGE(PG8_SA(1, 1), a1 + hstepA, vC1);
            PG8_WAIT_V(8); PG8_WAIT_L(0); PG8_BAR; PG8_MMA8(0, 0, Ct, C0); PG8_MMA8(0, 1, Ct, C1); PG8_BAR; PG8_SCHED;
            PG8_LDA8(Ct, 0, 1); PG8_STAGE(PG8_SB(0, 0), b2, voffB); PG8_STAGE(PG8_SB(0, 1), b2 + hstepB, voffB); PG8_STAGE(PG8_SA(0, 0), a2, w0);
            PG8_WAIT_V(8); PG8_WAIT_L(0); PG8_BAR; PG8_MMA8(1, 0, Ct, C0); PG8_MMA8(1, 1, Ct, C1); PG8_BAR; PG8_SCHED;
            PG8_LDB8(C0, 1, 0); PG8_LDB8(C1, 1, 1); PG8_SCHED; PG8_LDA8(Ct, 1, 0); PG8_STAGE(PG8_SA(0, 1), a2 + hstepA, w1);
            PG8_WAIT_V(8); PG8_WAIT_L(0); PG8_BAR; PG8_MMA8(0, 0, Ct, C0); PG8_MMA8(0, 1, Ct, C1); PG8_BAR; PG8_SCHED;
            PG8_LDA8(Ct, 1, 1); PG8_STAGE(PG8_SB(1, 0), b3, voffB); PG8_STAGE(PG8_SB(1, 1), b3 + hstepB, voffB); PG8_STAGE(PG8_SA(1, 0), a3, w0);
            PG8_WAIT_V(8); PG8_WAIT_L(0); PG8_BAR; PG8_MMA8(1, 0, Ct, C0); PG8_MMA8(1, 1, Ct, C1); PG8_BAR; PG8_SCHED;
                    } else {
            PG8_LDB(B0, 0, 0); PG8_LDB(B1, 0, 1); PG8_SCHED; PG8_LDA(At, 0, 0); PG8_STAGE(PG8_SA(1, 1), a1 + hstepA, vC1);
            PG8_WAIT_V(8); PG8_WAIT_L(0); PG8_BAR; PG8_MMA(0, 0, At, B0); PG8_MMA(0, 1, At, B1); PG8_BAR; PG8_SCHED;
            PG8_LDA(At, 0, 1); PG8_STAGE(PG8_SB(0, 0), b2, voffB); PG8_STAGE(PG8_SB(0, 1), b2 + hstepB, voffB); PG8_STAGE(PG8_SA(0, 0), a2, w0);
            PG8_WAIT_V(8); PG8_WAIT_L(0); PG8_BAR; PG8_MMA(1, 0, At, B0); PG8_MMA(1, 1, At, B1); PG8_BAR; PG8_SCHED;
            PG8_LDB(B0, 1, 0); PG8_LDB(B1, 1, 1); PG8_SCHED; PG8_LDA(At, 1, 0); PG8_STAGE(PG8_SA(0, 1), a2 + hstepA, w1);
            PG8_WAIT_V(8); PG8_WAIT_L(0); PG8_BAR; PG8_MMA(0, 0, At, B0); PG8_MMA(0, 1, At, B1); PG8_BAR; PG8_SCHED;
            PG8_LDA(At, 1, 1); PG8_STAGE(PG8_SB(1, 0), b3, voffB); PG8_STAGE(PG8_SB(1, 1), b3 + hstepB, voffB); PG8_STAGE(PG8_SA(1, 0), a3, w0);
            PG8_WAIT_V(8); PG8_WAIT_L(0); PG8_BAR; PG8_MMA(1, 0, At, B0); PG8_MMA(1, 1, At, B1); PG8_BAR; PG8_SCHED;
                    }
        }
        if constexpr (FP8) asm volatile("s_nop 15\n\ts_nop 15" ::: "memory");
        if constexpr (ALIGN_EPI) { if (wr == 0) PG8_BAR; }
        E(acc, cur, wr, wc, fr, fq);
        if (!has_next) break;
#pragma unroll
        for (int a = 0; a < 2; ++a)
#pragma unroll
            for (int b = 0; b < 2; ++b)
#pragma unroll
                for (int m = 0; m < 4; ++m)
#pragma unroll
                    for (int n = 0; n < 2; ++n) acc[a][b][m][n] = (f32x4){0.f, 0.f, 0.f, 0.f};
        cur = nxt; cA = nA; cB = nB; ++ui;
        if constexpr (GATHER) { vC0[0] = vN0[0]; vC0[1] = vN0[1]; vC1[0] = vN1[0]; vC1[1] = vN1[1]; }
        if constexpr (ALIGN_EPI) { if (wr == 1) PG8_BAR; }
    }
    PG8_WAIT_V(0);
    if constexpr (!ALIGN_EPI) { if (wr == 0) PG8_BAR; }
    PG8_BAR;
#undef PG8_SA
#undef PG8_SB
#undef PG8_STAGE
#undef PG8_LDA
#undef PG8_LDA8
#undef PG8_LDB8
#undef PG8_MMA8
#undef PG8_CAT
#undef PG8_LDB
#undef PG8_MMA
#undef PG8_WAIT_V
#undef PG8_WAIT_L
#undef PG8_BAR
#undef PG8_SCHED
}
}
using pg8::Unit;

#define XB_TMO      128
#define XB_XCNT(j)  (256  + 64 * (j))
#define XB_XSUB(j)  (1280 + 64 * (j))
#define XB_XGEN(j)  (2304 + 64 * (j))
#define XB_TOP      3328
#define XB_TOPGEN   3392
#define XCD_BAR_WORDS 3456
#define XB_SPIN_CAP (1u << 18)
DI unsigned xb_ld(unsigned* p)              { return __hip_atomic_load(p, __ATOMIC_RELAXED, __HIP_MEMORY_SCOPE_AGENT); }
DI unsigned xb_add(unsigned* p, unsigned v) { return __hip_atomic_fetch_add(p, v, __ATOMIC_RELAXED, __HIP_MEMORY_SCOPE_AGENT); }
DI unsigned xb_xcc_id() { return (unsigned)__builtin_amdgcn_s_getreg((3 << 11) | 20) & 0xFu; }
#define XB_SPIN(cond, bar) do { unsigned _sp = 0; while (cond) { __builtin_amdgcn_s_sleep(1); \
    if ((++_sp & 255u) == 0u) { if (xb_ld(&(bar)[XB_TMO])) break; if (_sp > XB_SPIN_CAP) { atomicAdd(&(bar)[XB_TMO], 1u); break; } } } } while (0)
struct XcdBarrier { unsigned* bar; unsigned x; volatile LAS unsigned* st; };
DI XcdBarrier xcd_barrier_post(unsigned* bar, volatile LAS unsigned* st) {
    XcdBarrier b; b.bar = bar; b.x = xb_xcc_id(); b.st = st;
    if (threadIdx.x == 0) (void)xb_add(&bar[XB_XCNT(b.x)], 1u);
    return b;
}
DI void xcd_barrier_complete(unsigned* bar, unsigned x, unsigned& nloc, unsigned& nx) {
    const unsigned G = gridDim.x * gridDim.y * gridDim.z;
    unsigned sum, cnt, mine, sp = 0u;
    for (;;) {
        sum = 0u; cnt = 0u; mine = 0u;
#pragma unroll
        for (unsigned j = 0; j < 16; ++j) { const unsigned c = xb_ld(&bar[XB_XCNT(j)]); sum += c; cnt += (c > 0u) ? 1u : 0u; mine = (j == x) ? c : mine; }
        if (sum == G) break;
        __builtin_amdgcn_s_sleep(1);
        if ((++sp & 255u) == 0u) { if (xb_ld(&bar[XB_TMO])) break; if (sp > XB_SPIN_CAP) { atomicAdd(&bar[XB_TMO], 1u); break; } }
    }
    nloc = mine > 0u ? mine : 1u; nx = cnt > 0u ? cnt : 1u;
}
DI void xcd_barrier(const XcdBarrier& b) {
    asm volatile("s_waitcnt vmcnt(0)" ::: "memory");
    __syncthreads();
    if (threadIdx.x == 0) {
        unsigned* bar = b.bar;
        __builtin_amdgcn_s_waitcnt(0);
        unsigned nloc = b.st[0], nx = b.st[1];
        if (nloc == 0u) { xcd_barrier_complete(bar, b.x, nloc, nx); b.st[0] = nloc; b.st[1] = nx; }
        const unsigned old = xb_add(&bar[XB_XSUB(b.x)], 1u);
        const unsigned gen = old / nloc;
        if (old + 1u == (gen + 1u) * nloc) {
            __builtin_amdgcn_fence(__ATOMIC_RELEASE, "agent");
            asm volatile("s_waitcnt vmcnt(0)" ::: "memory");
            const unsigned og = xb_add(&bar[XB_TOP], 1u);
            const unsigned tg = og / nx;
            if (og + 1u == (tg + 1u) * nx) xb_add(&bar[XB_TOPGEN], 1u);
            else XB_SPIN(xb_ld(&bar[XB_TOPGEN]) == tg, bar);
            __builtin_amdgcn_fence(__ATOMIC_ACQUIRE, "agent");
            xb_add(&bar[XB_XGEN(b.x)], 1u);
            asm volatile("s_waitcnt vmcnt(0)" ::: "memory");
        } else {
            XB_SPIN(xb_ld(&bar[XB_XGEN(b.x)]) == gen, bar);
            __builtin_amdgcn_fence(__ATOMIC_ACQUIRE, "agent");
            asm volatile("s_waitcnt vmcnt(0)" ::: "memory");
        }
    }
    __syncthreads();
}
constexpr int DM = 1024, NB = 8, SEQ = 4096, NTOK = NB * SEQ, NCHUNK = 64, NP = 8192, NEXP = 32;
constexpr int PC_GLA_Q = 0, PC_GLA_K = 256, PC_GLA_V = 512, PC_GLA_R = 1024, PC_GDN_QKV = 1536, PC_GDN_G = 3072, PC_SSD_Z = 3584, PC_SSD_XBC = 4096, PC_MERGE = 4864, PC_SMALL = 7936;
constexpr int IN_COLS = 7968;
constexpr int NTHREADS = 512;
#ifndef INPROJ_I8
#define INPROJ_I8 1
#endif
constexpr int LDS_BYTES = 155648;
constexpr int LDS_CTRL = LDS_BYTES - 1024;
constexpr int GLA_UNIT = 41984, GDN_UNIT = 74752, SSD_UNIT = 33792;
constexpr int GLA_OQ = 0, GLA_OP = 8192, GLA_OK = 16384, GLA_OU = 24576, GLA_OD = 40960;
constexpr int GDN_OQ = 0, GDN_OW = 16384, GDN_OP = 32768, GDN_OK = 40960, GDN_OU = 57344, GDN_OD = 73728;
constexpr int SSD_OQ = 0, SSD_OP = 8192, SSD_OK = 16384, SSD_OU = 24576, SSD_OD = 32768;
constexpr size_t WS_CTL = 0, WS_CNT = 16384, WS_MOD = 65536;
constexpr size_t WS_WIN = 458752, WS_WBR = WS_WIN + 33554432ull, WS_WOUT = WS_WBR + 6291456ull, WS_WGU = WS_WOUT + 12582912ull, WS_WDN = WS_WGU + 268435456ull;
constexpr size_t WS_H = WS_WDN + 134217728ull, WS_SMALL = WS_H + 67108864ull, WS_XA = WS_SMALL + 4194304ull, WS_XB = WS_XA + 134217728ull;
constexpr size_t WS_ROWTOK = WS_XB + 134217728ull, WS_TOKSLOT = WS_ROWTOK + 4194304ull, WS_GATES = WS_TOKSLOT + 524288ull, WS_TSCR = WS_GATES + 524288ull, WS_R1 = WS_TSCR + 16777216ull;
constexpr size_t R1_PROJ = 0, R1_SGLA = 536870912ull, R1_SGDN = R1_SGLA + 2048ull * GLA_UNIT, R1_SSSD = R1_SGDN + 2048ull * GDN_UNIT, R1_OBUF = R1_SSSD + 4096ull * SSD_UNIT;
constexpr size_t R1_YMIX = R1_OBUF + 100663296ull, R1_MERGED = R1_YMIX + 100663296ull, R1_END = R1_MERGED + 67108864ull, R1_GATED = R1_SGLA, R1_ACT = 0, R1_YS = 285212672ull;
constexpr size_t WS_COLMAX = WS_R1 + R1_END, WS_SA = WS_COLMAX + 65536, WS_END = WS_SA + 131072;
constexpr size_t OB_GLA = 0, OB_GDN = 33554432ull, OB_SSD = 67108864ull;

struct Args {
    const float *x, *c, *w_mod, *b_mod, *norm_mix, *norm_ffn, *norm_final, *w_in, *gla_w2, *gla_b2, *gla_norm, *gdn_conv_w, *gdn_a_log, *gdn_dt_bias, *gdn_norm,
        *ssd_conv_w, *ssd_conv_b, *ssd_a_log, *ssd_dt_bias, *ssd_d, *ssd_norm, *w_br_gla, *w_br_gdn, *w_br_ssd, *b_merge, *w_out, *w_router, *b_router, *w_gu, *b_gu, *w_dn, *b_dn;
    float* out; char* ws;
};
typedef const Args __attribute__((address_space(4))) CArgs;

DI void phase_mod(CArgs& a, LAS unsigned char* lds) {
    LAS float* cact = (LAS float*)lds;
    LAS float* red = (LAS float*)(lds + 32768);
    const int tid = ltid();
    for (int i = tid; i < 8192; i += NTHREADS) cact[i] = silu_(a.c[i]);
    __syncthreads();
    float* mod = (float*)(a.ws + WS_MOD);
    for (int blk = lbid(); blk < 256; blk += lgrid()) {
        const int jj = tid & 63, ks = tid >> 6, col = blk * 48 + jj;
        float s[8];
#pragma unroll
        for (int b = 0; b < 8; ++b) s[b] = 0.f;
        if (jj < 48) {
            const int l = col / 6144, j = col % 6144;
            const float* w = a.w_mod + (size_t)l * DM * 6144 + j;
            for (int k = ks * 128; k < ks * 128 + 128; ++k) { const float wv = w[(size_t)k * 6144];
#pragma unroll
                for (int b = 0; b < 8; ++b) s[b] += cact[b * 1024 + k] * wv; }
        }
#pragma unroll
        for (int b = 0; b < 8; ++b) red[(ks * 64 + jj) * 8 + b] = s[b];
        __syncthreads();
        if (tid < 48 * 8) { const int j2 = tid >> 3, b = tid & 7, col2 = blk * 48 + j2, l = col2 / 6144, j = col2 % 6144; float t = 0.f;
#pragma unroll
            for (int k2 = 0; k2 < 8; ++k2) t += red[(k2 * 64 + j2) * 8 + b];
            mod[((size_t)l * 8 + b) * 6144 + j] = t + a.b_mod[l * 6144 + j]; }
        __syncthreads();
    }
}
DI int win_dst(int c) {
    if (c < 1024) return c;
    if (c < 1040) return PC_SMALL + (c - 1024);
    if (c < 1552) return PC_GLA_R + (c - 1040);
    if (c < 3088) return PC_GDN_QKV + (c - 1552);
    if (c < 3092) return PC_SMALL + 16 + (c - 3088);
    if (c < 3096) return PC_SMALL + 20 + (c - 3092);
    if (c < 3608) return PC_GDN_G + (c - 3096);
    if (c < 4120) return PC_SSD_Z + (c - 3608);
    if (c < 4888) return PC_SSD_XBC + (c - 4120);
    if (c < 4896) return PC_SMALL + 24 + (c - 4888);
    return PC_MERGE + (c - 4896);
}
DI unsigned pk4_fp8(float a, float b, float c, float d) { int w = 0; w = __builtin_amdgcn_cvt_pk_fp8_f32(a, b, w, false); w = __builtin_amdgcn_cvt_pk_fp8_f32(c, d, w, true); return (unsigned)w; }
DI unsigned pk4_i8(float a, float b, float c, float d) { const int x = (int)__builtin_rintf(a), y = (int)__builtin_rintf(b), z = (int)__builtin_rintf(c), w = (int)__builtin_rintf(d);
    return (unsigned)(x & 255) | ((unsigned)(y & 255) << 8) | ((unsigned)(z & 255) << 16) | ((unsigned)w << 24); }
DI float wave_max(float v) {
#pragma unroll
    for (int o = 32; o > 0; o >>= 1) v = fmaxf(v, __shfl_xor(v, o));
    return v;
}
constexpr float W8_SCALE = 32.f, W8_INV = 1.f / 32.f;
template <int KIND, int OUT> DI void cvt_tile(const float* src, int ld_src, int ncols, int k0, int n0, unsigned char* dst, int ld_dst, int kd0, LAS float* T, float* cmax = nullptr) {
    const int tid = ltid();
    { const int jj = tid & 255, kk = tid >> 8; const bool ok = (n0 + jj) < ncols;
#pragma unroll
      for (int i = 0; i < 32; ++i) { const int k = kk + 2 * i; T[k * 257 + jj] = ok ? src[(size_t)(k0 + k) * ld_src + n0 + jj] : 0.f; } }
    __syncthreads();
    { const int j = tid >> 1, kq = tid & 1, c = n0 + j;
      if (c < ncols) {
        const int drow = KIND == 0 ? c : KIND == 1 ? (c & ~255) + (c & 1) * 128 + ((c & 255) >> 1) : win_dst(c);
        float v[32];
#pragma unroll
        for (int i = 0; i < 32; ++i) v[i] = T[(kq * 32 + i) * 257 + j];
        if constexpr (OUT == 2) { float mx = 0.f;
#pragma unroll
            for (int i = 0; i < 32; ++i) mx = fmaxf(mx, fabsf(v[i]));
            atomicMax((unsigned*)cmax + drow, __float_as_uint(mx)); }
        else if constexpr (OUT == 0) { bf16_t* d = (bf16_t*)dst + (size_t)drow * ld_dst + kd0 + k0 + kq * 32;
#pragma unroll
            for (int h = 0; h < 4; ++h) *(u32x4*)(d + 8 * h) = (u32x4){pk2(v[8 * h], v[8 * h + 1]), pk2(v[8 * h + 2], v[8 * h + 3]), pk2(v[8 * h + 4], v[8 * h + 5]), pk2(v[8 * h + 6], v[8 * h + 7])}; }
        else { unsigned char* d8 = dst + (size_t)drow * ld_dst + kd0 + k0 + kq * 32; float sc = W8_SCALE;
            if constexpr (OUT == 3) { const float cm = cmax[drow]; sc = cm > 0.f ? 127.f / cm : 0.f; }
#pragma unroll
            for (int h = 0; h < 2; ++h) { u32x4 w;
                if constexpr (OUT == 1) w = (u32x4){pk4_fp8(v[16 * h] * sc, v[16 * h + 1] * sc, v[16 * h + 2] * sc, v[16 * h + 3] * sc), pk4_fp8(v[16 * h + 4] * sc, v[16 * h + 5] * sc, v[16 * h + 6] * sc, v[16 * h + 7] * sc),
                                                  pk4_fp8(v[16 * h + 8] * sc, v[16 * h + 9] * sc, v[16 * h + 10] * sc, v[16 * h + 11] * sc), pk4_fp8(v[16 * h + 12] * sc, v[16 * h + 13] * sc, v[16 * h + 14] * sc, v[16 * h + 15] * sc)};
                else w = (u32x4){pk4_i8(v[16 * h] * sc, v[16 * h + 1] * sc, v[16 * h + 2] * sc, v[16 * h + 3] * sc), pk4_i8(v[16 * h + 4] * sc, v[16 * h + 5] * sc, v[16 * h + 6] * sc, v[16 * h + 7] * sc),
                                 pk4_i8(v[16 * h + 8] * sc, v[16 * h + 9] * sc, v[16 * h + 10] * sc, v[16 * h + 11] * sc), pk4_i8(v[16 * h + 12] * sc, v[16 * h + 13] * sc, v[16 * h + 14] * sc, v[16 * h + 15] * sc)};
                *(u32x4*)(d8 + 16 * h) = w; } } } }
    __syncthreads();
}
constexpr int T_IN = 16 * 32, T_BR = 3 * 8 * 4, T_OUT = 16 * 4, T_GU = 32 * 16 * 8, T_DN = 32 * 16 * 4, T_L = T_IN + T_BR + T_OUT + T_GU + T_DN;
DI void phase_cvt(CArgs& a, LAS unsigned char* lds) {
    LAS float* T = (LAS float*)lds;
    for (int g = lbid(); g < 2 * T_L; g += lgrid()) {
        const int l = g / T_L; int r = g % T_L;
        if (r < T_IN) { const int kt = r % 16, ntile = r / 16;
            cvt_tile<2, INPROJ_I8 ? 2 : 0>(a.w_in + (size_t)l * DM * IN_COLS, IN_COLS, IN_COLS, kt * 64, ntile * 256, (unsigned char*)(a.ws + WS_WIN + (size_t)l * NP * DM * (INPROJ_I8 ? 1 : 2)), DM, 0, T, (float*)(a.ws + WS_COLMAX) + l * NP); continue; }
        r -= T_IN;
        if (r < T_BR) { const int br = r / 32, kt = (r % 32) % 8, ntile = (r % 32) / 8; const float* src = (br == 0 ? a.w_br_gla : br == 1 ? a.w_br_gdn : a.w_br_ssd) + (size_t)l * 512 * DM;
            cvt_tile<0, 0>(src, DM, DM, kt * 64, ntile * 256, (unsigned char*)(a.ws + WS_WBR + ((size_t)l * 3 + br) * DM * 512 * 2), 512, 0, T); continue; }
        r -= T_BR;
        if (r < T_OUT) { const int kt = r % 16, ntile = r / 16;
            cvt_tile<0, 0>(a.w_out + (size_t)l * DM * DM, DM, DM, kt * 64, ntile * 256, (unsigned char*)(a.ws + WS_WOUT + (size_t)l * DM * DM * 2), DM, 0, T); continue; }
        r -= T_OUT;
        if (r < T_GU) { const int e = r / 128, kt = (r % 128) % 16, ntile = (r % 128) / 16;
            cvt_tile<1, 1>(a.w_gu + ((size_t)l * NEXP + e) * DM * 2048, 2048, 2048, kt * 64, ntile * 256, (unsigned char*)(a.ws + WS_WGU + ((size_t)l * NEXP + e) * 2048 * DM), DM, 0, T); continue; }
        r -= T_GU;
        { const int e = r / 64, kt = (r % 64) % 16, ntile = (r % 64) / 16;
            cvt_tile<0, 1>(a.w_dn + ((size_t)l * NEXP + e) * DM * DM, DM, DM, kt * 64, ntile * 256, (unsigned char*)(a.ws + WS_WDN + ((size_t)l * NEXP + e) * DM * DM), DM, 0, T); }
    }
    { constexpr size_t RB = (size_t)DM * (INPROJ_I8 ? 1 : 2), NV = 224 * RB / 16;
      for (size_t i = (size_t)lbid() * NTHREADS + ltid(); i < 2 * NV; i += (size_t)lgrid() * NTHREADS) { const size_t l = i / NV, rr = i % NV;
          *(u32x4*)(a.ws + WS_WIN + (l * NP + IN_COLS) * RB + rr * 16) = (u32x4){0u, 0u, 0u, 0u}; } }
}

DI void phase_cvt_win_i8(CArgs& a, LAS unsigned char* lds) {
    LAS float* T = (LAS float*)lds;
    for (int g = lbid(); g < 2 * T_IN; g += lgrid()) { const int l = g / T_IN, r = g % T_IN, kt = r % 16, ntile = r / 16;
        cvt_tile<2, 3>(a.w_in + (size_t)l * DM * IN_COLS, IN_COLS, IN_COLS, kt * 64, ntile * 256, (unsigned char*)(a.ws + WS_WIN + (size_t)l * NP * DM), DM, 0, T, (float*)(a.ws + WS_COLMAX) + l * NP); }
}
DI float wave_sum(float v) {
#pragma unroll
    for (int o = 32; o > 0; o >>= 1) v += __shfl_xor(v, o);
    return v;
}
DI void store_h_row(CArgs& a, int row, int lane, const float (&o)[16]) {
#if INPROJ_I8
    float mx = 0.f;
#pragma unroll
    for (int j = 0; j < 16; ++j) mx = fmaxf(mx, fabsf(o[j]));
    mx = wave_max(mx); const float inv = mx > 0.f ? 127.f / mx : 0.f;
    if (lane == 0) ((float*)(a.ws + WS_SA))[row] = mx * (1.f / 127.f);
#pragma unroll
    for (int i = 0; i < 2; ++i) *(u32x2*)((unsigned char*)(a.ws + WS_H) + (size_t)row * DM + lane * 8 + 512 * i) =
        (u32x2){pk4_i8(o[8 * i] * inv, o[8 * i + 1] * inv, o[8 * i + 2] * inv, o[8 * i + 3] * inv), pk4_i8(o[8 * i + 4] * inv, o[8 * i + 5] * inv, o[8 * i + 6] * inv, o[8 * i + 7] * inv)};
#else
#pragma unroll
    for (int i = 0; i < 2; ++i) { u32x4 w; w.x = pk2(o[8 * i], o[8 * i + 1]); w.y = pk2(o[8 * i + 2], o[8 * i + 3]); w.z = pk2(o[8 * i + 4], o[8 * i + 5]); w.w = pk2(o[8 * i + 6], o[8 * i + 7]);
        *(u32x4*)((bf16_t*)(a.ws + WS_H) + (size_t)row * DM + lane * 8 + 512 * i) = w; }
#endif
}
DI void phase_norm0(CArgs& a) {
    const int lane = ltid() & 63, gw = lbid() * 8 + (ltid() >> 6), nw = lgrid() * 8;
    const float* mod = (const float*)(a.ws + WS_MOD);
    bf16_t* H = (bf16_t*)(a.ws + WS_H);
    for (int row = gw; row < NTOK; row += nw) {
        const int b = row >> 12; const float* xr = a.x + (size_t)row * DM; const float* mb = mod + (size_t)b * 6144;
        f32x4 v[4]; float ss = 0.f;
#pragma unroll
        for (int i = 0; i < 2; ++i) { v[2 * i] = *(const f32x4*)(xr + lane * 8 + 512 * i); v[2 * i + 1] = *(const f32x4*)(xr + lane * 8 + 512 * i + 4); }
#pragma unroll
        for (int i = 0; i < 4; ++i) ss += v[i][0] * v[i][0] + v[i][1] * v[i][1] + v[i][2] * v[i][2] + v[i][3] * v[i][3];
        ss = wave_sum(ss); const float rs = rsqrtf(ss * (1.f / 1024.f) + 1e-6f);
        float o[16];
#pragma unroll
        for (int i = 0; i < 2; ++i) { const int c0 = lane * 8 + 512 * i;
#pragma unroll
            for (int j = 0; j < 8; ++j) { const float xv = v[2 * i + (j >> 2)][j & 3]; o[8 * i + j] = xv * rs * a.norm_mix[c0 + j] * (1.f + mb[1024 + c0 + j]) + mb[c0 + j]; } }
        store_h_row(a, row, lane, o);
    }
}

struct EpiProj { static constexpr bool PERM = true; bf16_t* P; float* small; const float* sa; const float* cmax;
    DI void operator()(const f32x4 (&acc)[2][2][4][2], const Unit& u, int wr, int wc, int fr, int fq) const {
        const int row0 = u.pm * 256 + wr * 64 + fr, col0 = u.pn * 256 + wc * 32 + 8 * fq;
        float sw[2][8];
#pragma unroll
        for (int bj = 0; bj < 2; ++bj)
#pragma unroll
            for (int j = 0; j < 8; ++j) sw[bj][j] = INPROJ_I8 ? cmax[col0 + bj * 128 + j] * (1.f / 127.f) : 1.f;
#pragma unroll
        for (int ai = 0; ai < 2; ++ai)
#pragma unroll
            for (int m = 0; m < 4; ++m) { const int row = row0 + ai * 128 + m * 16; bf16_t* rowp = P + (size_t)row * NP + col0; const float sr = INPROJ_I8 ? sa[row] : 1.f;
                float v[2][8];
#pragma unroll
                for (int bj = 0; bj < 2; ++bj)
#pragma unroll
                    for (int j = 0; j < 8; ++j) { const f32x4 t = acc[ai][bj][m][j >> 2]; v[bj][j] = INPROJ_I8 ? (float)__builtin_bit_cast(pg8::i32x4, t)[j & 3] * sr * sw[bj][j] : t[j & 3]; }
#pragma unroll
                for (int bj = 0; bj < 2; ++bj) { u32x4 w; w.x = pk2(v[bj][0], v[bj][1]); w.y = pk2(v[bj][2], v[bj][3]); w.z = pk2(v[bj][4], v[bj][5]); w.w = pk2(v[bj][6], v[bj][7]);
                    *(u32x4*)(rowp + bj * 128) = w; }
                if (u.pn == 31 && wc == 0) { float* sp = small + (size_t)row * 32 + 8 * fq; *(f32x4*)sp = (f32x4){v[0][0], v[0][1], v[0][2], v[0][3]}; *(f32x4*)(sp + 4) = (f32x4){v[0][4], v[0][5], v[0][6], v[0][7]}; } }
    } };
struct EpiGate { static constexpr bool PERM = true; const bf16_t* P; const float* bmerge; bf16_t* G; bf16_t* M;
    DI void operator()(const f32x4 (&acc)[2][2][4][2], const Unit& u, int wr, int wc, int fr, int fq) const {
        const int row0 = u.pm * 256 + wr * 64 + fr, col0 = u.pn * 256 + wc * 32 + 8 * fq; const bool fin = u.pn >= 8;
        f32x4 bv[2][2];
#pragma unroll
        for (int bj = 0; bj < 2; ++bj) { bv[bj][0] = *(const f32x4*)(bmerge + col0 + bj * 128); bv[bj][1] = *(const f32x4*)(bmerge + col0 + bj * 128 + 4); }
#pragma unroll
        for (int ai = 0; ai < 2; ++ai)
#pragma unroll
            for (int m = 0; m < 4; ++m) { const size_t row = row0 + ai * 128 + m * 16;
#pragma unroll
                for (int bj = 0; bj < 2; ++bj) { const u32x4 mr = *(const u32x4*)(P + row * NP + PC_MERGE + col0 + bj * 128); const f32x4 v0 = acc[ai][bj][m][0], v1 = acc[ai][bj][m][1];
                    float o[8];
                    o[0] = v0[0] * sigmoid_(bflo(mr.x) + bv[bj][0][0]); o[1] = v0[1] * sigmoid_(bfhi(mr.x) + bv[bj][0][1]); o[2] = v0[2] * sigmoid_(bflo(mr.y) + bv[bj][0][2]); o[3] = v0[3] * sigmoid_(bfhi(mr.y) + bv[bj][0][3]);
                    o[4] = v1[0] * sigmoid_(bflo(mr.z) + bv[bj][1][0]); o[5] = v1[1] * sigmoid_(bfhi(mr.z) + bv[bj][1][1]); o[6] = v1[2] * sigmoid_(bflo(mr.w) + bv[bj][1][2]); o[7] = v1[3] * sigmoid_(bfhi(mr.w) + bv[bj][1][3]);
                    if (fin) { const int cm = col0 - 2048 + bj * 128;
                        const u32x4 g0 = *(const u32x4*)(G + row * 3072 + cm), g1 = *(const u32x4*)(G + row * 3072 + 1024 + cm);
                        o[0] += bflo(g0.x) + bflo(g1.x); o[1] += bfhi(g0.x) + bfhi(g1.x); o[2] += bflo(g0.y) + bflo(g1.y); o[3] += bfhi(g0.y) + bfhi(g1.y);
                        o[4] += bflo(g0.z) + bflo(g1.z); o[5] += bfhi(g0.z) + bfhi(g1.z); o[6] += bflo(g0.w) + bflo(g1.w); o[7] += bfhi(g0.w) + bfhi(g1.w);
                        u32x4 w; w.x = pk2(o[0], o[1]); w.y = pk2(o[2], o[3]); w.z = pk2(o[4], o[5]); w.w = pk2(o[6], o[7]);
                        *(u32x4*)(M + row * DM + cm) = w; }
                    else { u32x4 w; w.x = pk2(o[0], o[1]); w.y = pk2(o[2], o[3]); w.z = pk2(o[4], o[5]); w.w = pk2(o[6], o[7]);
                        *(u32x4*)(G + row * 3072 + col0 + bj * 128) = w; } } }
    } };
struct EpiResid { static constexpr bool PERM = false; const float* xin; float* xout; const float* gm;
    DI void operator()(const f32x4 (&acc)[2][2][4][2], const Unit& u, int wr, int wc, int fr, int fq) const {
        const int row0 = u.pm * 256 + wr * 64 + fr, col0 = u.pn * 256 + wc * 32 + 4 * fq; const int b = (u.pm * 256) >> 12;
        f32x4 gv[2][2];
#pragma unroll
        for (int bj = 0; bj < 2; ++bj)
#pragma unroll
            for (int n = 0; n < 2; ++n) gv[bj][n] = *(const f32x4*)(gm + (size_t)b * 6144 + col0 + bj * 128 + n * 16);
#pragma unroll
        for (int ai = 0; ai < 2; ++ai)
#pragma unroll
            for (int m = 0; m < 4; ++m) { const size_t off = (size_t)(row0 + ai * 128 + m * 16) * DM + col0;
#pragma unroll
                for (int bj = 0; bj < 2; ++bj)
#pragma unroll
                    for (int n = 0; n < 2; ++n) { const f32x4 xi = *(const f32x4*)(xin + off + bj * 128 + n * 16); *(f32x4*)(xout + off + bj * 128 + n * 16) = xi + gv[bj][n] * acc[ai][bj][m][n]; } }
    } };
struct EpiSwiglu { static constexpr bool PERM = true; unsigned char* act; const float* bgu;
    DI void operator()(const f32x4 (&acc)[2][2][4][2], const Unit& u, int wr, int wc, int fr, int fq) const {
        const int row0 = u.pm * 256 + wr * 64 + fr, x0 = u.pn * 128 + wc * 32 + 8 * fq;
        const float* bb = bgu + (size_t)u.e * 2048 + 2 * x0;
        float bg[8], bu[8];
#pragma unroll
        for (int i = 0; i < 4; ++i) { const f32x4 t = *(const f32x4*)(bb + 4 * i); bg[2 * i] = t[0]; bu[2 * i] = t[1]; bg[2 * i + 1] = t[2]; bu[2 * i + 1] = t[3]; }
#pragma unroll
        for (int ai = 0; ai < 2; ++ai)
#pragma unroll
            for (int m = 0; m < 4; ++m) { const size_t row = row0 + ai * 128 + m * 16; float o[8];
#pragma unroll
                for (int j = 0; j < 8; ++j) { float g = acc[ai][0][m][j >> 2][j & 3] * W8_INV + bg[j], up = acc[ai][1][m][j >> 2][j & 3] * W8_INV + bu[j];
                    g = fminf(g, 7.f); up = fminf(fmaxf(up, -7.f), 7.f); o[j] = (up + 1.f) * g * sigmoid_(1.702f * g); }
                *(u32x2*)(act + row * DM + x0) = (u32x2){pk4_fp8(o[0], o[1], o[2], o[3]), pk4_fp8(o[4], o[5], o[6], o[7])}; }
    } };
struct EpiDown { static constexpr bool PERM = true; bf16_t* ys; const float* bdn;
    DI void operator()(const f32x4 (&acc)[2][2][4][2], const Unit& u, int wr, int wc, int fr, int fq) const {
        const int row0 = u.pm * 256 + wr * 64 + fr, col0 = u.pn * 256 + wc * 32 + 8 * fq;
        f32x4 bv[2][2];
#pragma unroll
        for (int bj = 0; bj < 2; ++bj) { bv[bj][0] = *(const f32x4*)(bdn + (size_t)u.e * DM + col0 + bj * 128); bv[bj][1] = *(const f32x4*)(bdn + (size_t)u.e * DM + col0 + bj * 128 + 4); }
#pragma unroll
        for (int ai = 0; ai < 2; ++ai)
#pragma unroll
            for (int m = 0; m < 4; ++m) { const size_t row = row0 + ai * 128 + m * 16;
#pragma unroll
                for (int bj = 0; bj < 2; ++bj) { const f32x4 v0 = acc[ai][bj][m][0] * W8_INV + bv[bj][0], v1 = acc[ai][bj][m][1] * W8_INV + bv[bj][1];
                    u32x4 w; w.x = pk2(v0[0], v0[1]); w.y = pk2(v0[2], v0[3]); w.z = pk2(v1[0], v1[1]); w.w = pk2(v1[2], v1[3]);
                    *(u32x4*)(ys + row * DM + col0 + bj * 128) = w; } }
    } };

DI void moe_tables(const int* cnt  , LAS unsigned char* lds) {
    LAS int* tstart = (LAS int*)(lds + LDS_CTRL + 64); LAS int* lcnt = (LAS int*)(lds + LDS_CTRL + 256);
    if (ltid() < 64) { const int t = ltid(); const int c = t < 32 ? cnt[t * 64] : 0; int v = (c + 255) >> 8;
#pragma unroll
        for (int o = 1; o < 32; o <<= 1) { const int y = __shfl_up(v, o); if ((t & 31) >= o) v += y; }
        if (t < 32) { tstart[t + 1] = v; lcnt[t] = c; } if (t == 0) tstart[0] = 0; }
    __syncthreads();
}
template <bool G_> struct MoeOrder {
    static constexpr bool GATHER = G_;
    int nN, G, c; const LAS int* tstart; const LAS int* lcnt; const char* A; const char* Bt; size_t b_estride, tstep; const int* rowtok;
    DI bool next(int i, Unit& u) const {
        const int L = i * G + c, rt = L / nN; if (rt >= tstart[32]) return false;
        int e = 0; while (tstart[e + 1] <= rt) ++e;
        u.pm = rt; u.pn = L % nN; u.e = e; const int rem = lcnt[e] - (rt - tstart[e]) * 256; u.cnt = rem < 256 ? rem : 256; return true; }
    DI const char* a_ptr(const Unit& u) const { return GATHER ? A : A + (size_t)u.pm * tstep; }
    DI const char* b_ptr(const Unit& u) const { return Bt + (size_t)u.e * b_estride + (size_t)u.pn * tstep; }
    DI int a_row(const Unit& u, int R) const { return R < u.cnt ? rowtok[u.e * 32768 + (u.pm - tstart[u.e]) * 256 + R] : 0; }
};
DI void phase_router(CArgs& a, int l, const float* xmid, LAS unsigned char* lds) {
    const int tid = ltid(), wid = tid >> 6, lane = tid & 63, r = lane & 15, q = lane >> 4;
    LAS bf16_t* Whi = (LAS bf16_t*)lds; LAS bf16_t* Wlo = (LAS bf16_t*)(lds + 66048);
    LAS float* scr = (LAS float*)(lds + 132096 + wid * 2112);
    LAS int* hist = (LAS int*)(lds + 148992); LAS int* basep = (LAS int*)(lds + 148992 + 128);
    const float* wr_ = a.w_router + (size_t)l * DM * NEXP;
    for (int i = tid; i < DM * NEXP; i += NTHREADS) { const int k = i >> 5, e = i & 31; const float v = wr_[i]; const bf16_t hi = f2bf(v); Whi[e * 1032 + k] = hi; Wlo[e * 1032 + k] = f2bf(v - bf2f(hi)); }
    __syncthreads();
    const float* mod = (const float*)(a.ws + WS_MOD) + (size_t)l * 8 * 6144;
    const float* nf = a.norm_ffn + l * DM;
    bf16_t* H = (bf16_t*)(a.ws + WS_H);
    int* cntg = (int*)(a.ws + WS_CNT) + l * 32 * 64;
    int* rowtok = (int*)(a.ws + WS_ROWTOK); int* tokslot = (int*)(a.ws + WS_TOKSLOT); float* gates = (float*)(a.ws + WS_GATES);
    for (int blk = lbid(); blk < NTOK / 128; blk += lgrid()) {
        if (tid < 32) hist[tid] = 0;
        const int row = blk * 128 + wid * 16 + r, b = row >> 12;
        const float* xr = xmid + (size_t)row * DM; const float* mb = mod + (size_t)b * 6144;
        float ss = 0.f;
#pragma unroll 1
        for (int kc = 0; kc < 4; ++kc) { f32x4 xa[16];
#pragma unroll
            for (int s = 0; s < 8; ++s) { xa[2 * s] = *(const f32x4*)(xr + (kc * 8 + s) * 32 + 8 * q); xa[2 * s + 1] = *(const f32x4*)(xr + (kc * 8 + s) * 32 + 8 * q + 4); }
#pragma unroll
            for (int s = 0; s < 16; ++s) ss += xa[s][0] * xa[s][0] + xa[s][1] * xa[s][1] + xa[s][2] * xa[s][2] + xa[s][3] * xa[s][3]; }
        ss += __shfl_xor(ss, 16); ss += __shfl_xor(ss, 32);
        const float rs = rsqrtf(ss * (1.f / 1024.f) + 1e-6f);
        f32x4 acc0 = {0.f, 0.f, 0.f, 0.f}, acc1 = {0.f, 0.f, 0.f, 0.f};
#pragma unroll 1
        for (int kc = 0; kc < 8; ++kc) { f32x4 xa[8], ga[8], ca[8], ha[8];
#pragma unroll
            for (int s = 0; s < 4; ++s) { const int k0 = (kc * 4 + s) * 32 + 8 * q;
                xa[2 * s] = *(const f32x4*)(xr + k0); xa[2 * s + 1] = *(const f32x4*)(xr + k0 + 4); ga[2 * s] = *(const f32x4*)(nf + k0); ga[2 * s + 1] = *(const f32x4*)(nf + k0 + 4);
                ca[2 * s] = *(const f32x4*)(mb + 4096 + k0); ca[2 * s + 1] = *(const f32x4*)(mb + 4096 + k0 + 4); ha[2 * s] = *(const f32x4*)(mb + 3072 + k0); ha[2 * s + 1] = *(const f32x4*)(mb + 3072 + k0 + 4); }
#pragma unroll
            for (int s = 0; s < 4; ++s) { const int k0 = (kc * 4 + s) * 32 + 8 * q;
                float hv[8];
#pragma unroll
                for (int j = 0; j < 8; ++j) { const int v2 = 2 * s + (j >> 2), e2 = j & 3; hv[j] = xa[v2][e2] * rs * ga[v2][e2] * (1.f + ca[v2][e2]) + ha[v2][e2]; }
                u32x4 hi; hi.x = pk2(hv[0], hv[1]); hi.y = pk2(hv[2], hv[3]); hi.z = pk2(hv[4], hv[5]); hi.w = pk2(hv[6], hv[7]);
                *(u32x2*)((unsigned char*)H + (size_t)row * DM + k0) = (u32x2){pk4_fp8(hv[0], hv[1], hv[2], hv[3]), pk4_fp8(hv[4], hv[5], hv[6], hv[7])};
                u32x4 lo; lo.x = pk2(hv[0] - bflo(hi.x), hv[1] - bfhi(hi.x)); lo.y = pk2(hv[2] - bflo(hi.y), hv[3] - bfhi(hi.y)); lo.z = pk2(hv[4] - bflo(hi.z), hv[5] - bfhi(hi.z)); lo.w = pk2(hv[6] - bflo(hi.w), hv[7] - bfhi(hi.w));
                const bf16x8 ah = __builtin_bit_cast(bf16x8, hi), al = __builtin_bit_cast(bf16x8, lo);
                const bf16x8 b0h = *(const LAS bf16x8*)(Whi + r * 1032 + k0), b0l = *(const LAS bf16x8*)(Wlo + r * 1032 + k0);
                const bf16x8 b1h = *(const LAS bf16x8*)(Whi + (16 + r) * 1032 + k0), b1l = *(const LAS bf16x8*)(Wlo + (16 + r) * 1032 + k0);
                acc0 = __builtin_amdgcn_mfma_f32_16x16x32_bf16(ah, b0h, acc0, 0, 0, 0); acc0 = __builtin_amdgcn_mfma_f32_16x16x32_bf16(ah, b0l, acc0, 0, 0, 0); acc0 = __builtin_amdgcn_mfma_f32_16x16x32_bf16(al, b0h, acc0, 0, 0, 0);
                acc1 = __builtin_amdgcn_mfma_f32_16x16x32_bf16(ah, b1h, acc1, 0, 0, 0); acc1 = __builtin_amdgcn_mfma_f32_16x16x32_bf16(ah, b1l, acc1, 0, 0, 0); acc1 = __builtin_amdgcn_mfma_f32_16x16x32_bf16(al, b1h, acc1, 0, 0, 0); } }
        const float br0 = a.b_router[l * 32 + r], br1 = a.b_router[l * 32 + 16 + r];
#pragma unroll
        for (int j = 0; j < 4; ++j) { scr[(4 * q + j) * 33 + r] = acc0[j] + br0; scr[(4 * q + j) * 33 + 16 + r] = acc1[j] + br1; }
        __syncthreads();
        int te[4] = {0, 0, 0, 0}; float tg[4] = {0.f, 0.f, 0.f, 0.f}; int rk[4] = {0, 0, 0, 0};
        if (lane < 16) {
            float v[32];
#pragma unroll
            for (int e = 0; e < 32; ++e) v[e] = scr[lane * 33 + e];
            float tv[4];
#pragma unroll
            for (int k = 0; k < 4; ++k) { float best = -3.0e38f; int bi = 0;
#pragma unroll
                for (int e = 0; e < 32; ++e) { if (v[e] > best) { best = v[e]; bi = e; } }
                tv[k] = best; te[k] = bi;
#pragma unroll
                for (int e = 0; e < 32; ++e) v[e] = (e == bi) ? -3.0e38f : v[e]; }
            const float e1 = __expf(tv[1] - tv[0]), e2 = __expf(tv[2] - tv[0]), e3 = __expf(tv[3] - tv[0]); const float inv = 1.f / (1.f + e1 + e2 + e3);
            tg[0] = inv; tg[1] = e1 * inv; tg[2] = e2 * inv; tg[3] = e3 * inv;
#pragma unroll
            for (int k = 0; k < 4; ++k) rk[k] = atomicAdd((int*)&hist[te[k]], 1);
        }
        __syncthreads();
        if (tid < 32) basep[tid] = atomicAdd(&cntg[tid * 64], hist[tid]);
        __syncthreads();
        if (lane < 16) { const int tok = blk * 128 + wid * 16 + lane;
#pragma unroll
            for (int k = 0; k < 4; ++k) { const int pos = basep[te[k]] + rk[k]; rowtok[te[k] * 32768 + pos] = tok; tokslot[tok * 4 + k] = te[k] * 32768 + pos; gates[tok * 4 + k] = tg[k]; } }
        __syncthreads();
    }
}

DI void phase_combine(CArgs& a, int l, const float* xmid, float* xnew, LAS unsigned char* lds) {
    const LAS int* tstart = (const LAS int*)(lds + LDS_CTRL + 64);
    const int lane = ltid() & 63, gw = lbid() * 8 + (ltid() >> 6), nw = lgrid() * 8;
    const float* mod = (const float*)(a.ws + WS_MOD);
    const bf16_t* YS = (const bf16_t*)(a.ws + WS_R1 + R1_YS);
    const int* tokslot = (const int*)(a.ws + WS_TOKSLOT); const float* gates = (const float*)(a.ws + WS_GATES);
    bf16_t* H = (bf16_t*)(a.ws + WS_H);
    for (int row = gw; row < NTOK; row += nw) {
        const int b = row >> 12; const float* mb = mod + ((size_t)l * 8 + b) * 6144;
        size_t pr[4]; float gt[4];
#pragma unroll
        for (int k = 0; k < 4; ++k) { const int s = tokslot[row * 4 + k]; pr[k] = (size_t)(tstart[s >> 15] * 256 + (s & 32767)); gt[k] = gates[row * 4 + k]; }
        float xn[16]; float ss = 0.f;
#pragma unroll
        for (int i = 0; i < 2; ++i) { const int c0 = lane * 8 + 512 * i; float f[8];
#pragma unroll
            for (int j = 0; j < 8; ++j) f[j] = 0.f;
#pragma unroll
            for (int k = 0; k < 4; ++k) { const u32x4 y = *(const u32x4*)(YS + pr[k] * DM + c0);
                f[0] += gt[k] * bflo(y.x); f[1] += gt[k] * bfhi(y.x); f[2] += gt[k] * bflo(y.y); f[3] += gt[k] * bfhi(y.y); f[4] += gt[k] * bflo(y.z); f[5] += gt[k] * bfhi(y.z); f[6] += gt[k] * bflo(y.w); f[7] += gt[k] * bfhi(y.w); }
            const f32x4 x0 = *(const f32x4*)(xmid + (size_t)row * DM + c0), x1 = *(const f32x4*)(xmid + (size_t)row * DM + c0 + 4);
#pragma unroll
            for (int j = 0; j < 8; ++j) { const float xv = (j < 4 ? x0[j & 3] : x1[j & 3]) + mb[5120 + c0 + j] * f[j]; xn[8 * i + j] = xv; ss += xv * xv; } }
        ss = wave_sum(ss); const float rs = rsqrtf(ss * (1.f / 1024.f) + 1e-6f);
        if (l == 0) {
            const float* mb2 = mod + ((size_t)8 + b) * 6144; const float* g = a.norm_mix + DM;
            float o[16];
#pragma unroll
            for (int i = 0; i < 2; ++i) { const int c0 = lane * 8 + 512 * i;
                *(f32x4*)(xnew + (size_t)row * DM + c0) = (f32x4){xn[8 * i], xn[8 * i + 1], xn[8 * i + 2], xn[8 * i + 3]};
                *(f32x4*)(xnew + (size_t)row * DM + c0 + 4) = (f32x4){xn[8 * i + 4], xn[8 * i + 5], xn[8 * i + 6], xn[8 * i + 7]};
#pragma unroll
                for (int j = 0; j < 8; ++j) o[8 * i + j] = xn[8 * i + j] * rs * g[c0 + j] * (1.f + mb2[1024 + c0 + j]) + mb2[c0 + j]; }
            store_h_row(a, row, lane, o);
        } else {
#pragma unroll
            for (int i = 0; i < 2; ++i) { const int c0 = lane * 8 + 512 * i; float o[8];
#pragma unroll
                for (int j = 0; j < 8; ++j) o[j] = xn[8 * i + j] * rs * a.norm_final[c0 + j];
                *(f32x4*)(a.out + (size_t)row * DM + c0) = (f32x4){o[0], o[1], o[2], o[3]}; *(f32x4*)(a.out + (size_t)row * DM + c0 + 4) = (f32x4){o[4], o[5], o[6], o[7]}; }
        }
    }
}

DI float wave_incl_scan(float v, int lane) {
#pragma unroll
    for (int o = 1; o < 64; o <<= 1) { const float y = __shfl_up(v, o); if (lane >= o) v += y; }
    return v;
}
DI void conv8(const bf16_t* p, int pos, const float* w, int chs, const float* bias, float (&out)[8]) {
    float acc[8];
    if (bias) { const f32x4 b0 = *(const f32x4*)bias, b1 = *(const f32x4*)(bias + 4); acc[0] = b0[0]; acc[1] = b0[1]; acc[2] = b0[2]; acc[3] = b0[3]; acc[4] = b1[0]; acc[5] = b1[1]; acc[6] = b1[2]; acc[7] = b1[3]; }
    else {
#pragma unroll
        for (int i = 0; i < 8; ++i) acc[i] = 0.f; }
#pragma unroll
    for (int j = 0; j < 4; ++j) {
        if (pos - 3 + j >= 0) { const u32x4 xv = *(const u32x4*)(p - (ptrdiff_t)(3 - j) * NP); const f32x4 w0 = *(const f32x4*)(w + j * chs), w1 = *(const f32x4*)(w + j * chs + 4);
            acc[0] += w0[0] * bflo(xv.x); acc[1] += w0[1] * bfhi(xv.x); acc[2] += w0[2] * bflo(xv.y); acc[3] += w0[3] * bfhi(xv.y);
            acc[4] += w1[0] * bflo(xv.z); acc[5] += w1[1] * bfhi(xv.z); acc[6] += w1[2] * bflo(xv.w); acc[7] += w1[3] * bfhi(xv.w); } }
#pragma unroll
    for (int i = 0; i < 8; ++i) out[i] = silu_(acc[i]);
}
DI int swz64(int row, int l) { return row * 72 + ((((l >> 3) + (row >> 3)) & 7) << 3) + (l & 7); }
template <int K, bool BSWZ = false> DI f32x4 mm16(const LAS bf16_t* A, int lda, int m0, const LAS bf16_t* Bt, int ldb, int n0, int lane) {
    f32x4 acc = {0.f, 0.f, 0.f, 0.f}; const int r = lane & 15, q = lane >> 4; bf16x8 av[K / 32], bv[K / 32];
#pragma unroll
    for (int s = 0; s < K / 32; ++s) { av[s] = *(const LAS bf16x8*)(A + (m0 + r) * lda + s * 32 + 8 * q);
        bv[s] = BSWZ ? *(const LAS bf16x8*)(Bt + (n0 + r) * ldb + (((s * 4 + q + ((n0 + r) >> 3)) & 7) << 3)) : *(const LAS bf16x8*)(Bt + (n0 + r) * ldb + s * 32 + 8 * q); }
#pragma unroll
    for (int s = 0; s < K / 32; ++s) acc = __builtin_amdgcn_mfma_f32_16x16x32_bf16(av[s], bv[s], acc, 0, 0, 0);
    return acc;
}
DI void frag_store8(char* base, int nkb, int row, int k0, const float (&v)[8]) {
    const int rt = row >> 5, r = row & 31, kb = k0 >> 4, aa = (k0 >> 3) & 1;
    char* p = base + ((size_t)((rt * nkb + kb) * 64 + r)) * 16 + aa * 8;
    *(u32x2*)p = (u32x2){pk2(v[0], v[1]), pk2(v[2], v[3])};
    *(u32x2*)(p + 512) = (u32x2){pk2(v[4], v[5]), pk2(v[6], v[7])};
}
template <bool SWZ = false> DI void export_frags(char* dst, const LAS bf16_t* M, int ld, int R, int KK, int coloff) {
    const int nkb = KK >> 4, pieces = (R >> 5) * nkb * 64;
    for (int p = ltid(); p < pieces; p += NTHREADS) { const int lane = p & 63, f = p >> 6, kb = f % nkb, rt = f / nkb, r = lane & 31, h = lane >> 5, row = rt * 32 + r;
        const LAS bf16_t* s0 = SWZ ? M + swz64(row, kb * 16 + 4 * h) : M + row * ld + coloff + kb * 16 + 4 * h;
        const LAS bf16_t* s1 = SWZ ? M + swz64(row, kb * 16 + 8 + 4 * h) : s0 + 8;
        const u32x2 lo = *(const LAS u32x2*)s0, hi = *(const LAS u32x2*)s1;
        *(u32x4*)(dst + (size_t)p * 16) = (u32x4){lo.x, lo.y, hi.x, hi.y}; }
}
DI void export_acc(char* dst, const LAS bf16_t* M, int ld, int nct) {
    const int pieces = nct * 2 * 64;
    for (int p = ltid(); p < pieces; p += NTHREADS) { const int lane = p & 63, tile = p >> 6, rt = tile & 1, ct = tile >> 1, r = lane & 31, h = lane >> 5;
        unsigned w[8];
#pragma unroll
        for (int i = 0; i < 8; ++i) { const int r0 = rt * 32 + ((2 * i) & 3) + 8 * ((2 * i) >> 2) + 4 * h;
            w[i] = (unsigned)M[r0 * ld + ct * 32 + r] | ((unsigned)M[(r0 + 1) * ld + ct * 32 + r] << 16); }
        *(u32x4*)(dst + (size_t)p * 32) = (u32x4){w[0], w[1], w[2], w[3]}; *(u32x4*)(dst + (size_t)p * 32 + 16) = (u32x4){w[4], w[5], w[6], w[7]}; }
}

DI u32x4 ldg_or0(const bf16_t* p, bool ok) { return ok ? *(const u32x4*)p : (u32x4){0u, 0u, 0u, 0u}; }
DI void conv8r(const u32x4 (&t)[4], const LAS float* wt, int ws, const LAS float* bias, float (&out)[8]) {
    float acc[8];
#pragma unroll
    for (int i = 0; i < 8; ++i) acc[i] = bias ? bias[i] : 0.f;
#pragma unroll
    for (int j = 0; j < 4; ++j) { const LAS float* w = wt + j * ws; const u32x4 xv = t[j];
        acc[0] += w[0] * bflo(xv.x); acc[1] += w[1] * bfhi(xv.x); acc[2] += w[2] * bflo(xv.y); acc[3] += w[3] * bfhi(xv.y);
        acc[4] += w[4] * bflo(xv.z); acc[5] += w[5] * bfhi(xv.z); acc[6] += w[6] * bflo(xv.w); acc[7] += w[7] * bfhi(xv.w); }
#pragma unroll
    for (int i = 0; i < 8; ++i) out[i] = silu_(acc[i]);
}
struct GlaRaw { f32x4 lr[4]; u32x4 q8, k8, v8[2]; };
DI void gla_load(CArgs& a, int u, GlaRaw& r) {
    const int tid = ltid(); const int n = u & 63, bh = u >> 6, b = bh >> 2, h = bh & 3, T0 = b * SEQ + n * 64;
    const bf16_t* P = (const bf16_t*)(a.ws + WS_R1 + R1_PROJ); const float* small = (const float*)(a.ws + WS_SMALL);
    const int l_ = tid >> 3, d0 = (tid & 7) * 8; const size_t T = (size_t)(T0 + l_);
#pragma unroll
    for (int i = 0; i < 4; ++i) r.lr[i] = *(const f32x4*)(small + T * 32 + 4 * i);
    r.q8 = *(const u32x4*)(P + T * NP + PC_GLA_Q + h * 64 + d0); r.k8 = *(const u32x4*)(P + T * NP + PC_GLA_K + h * 64 + d0);
#pragma unroll
    for (int rep = 0; rep < 2; ++rep) { const int idx = rep * NTHREADS + tid, lr_ = idx >> 4, c0 = (idx & 15) * 8; r.v8[rep] = *(const u32x4*)(P + (size_t)(T0 + lr_) * NP + PC_GLA_V + h * 128 + c0); }
}
DI void gla_table(CArgs& a, int l, int h, LAS float* WT) {
    for (int i = ltid(); i < 17 * 64; i += NTHREADS) { const int j = i >> 6, d = i & 63; WT[i] = j < 16 ? a.gla_w2[(size_t)l * 16 * 256 + j * 256 + h * 64 + d] : a.gla_b2[l * 256 + h * 64 + d]; }
}
template <class F> DI void gla_compute(CArgs& a, int u, const GlaRaw& rw, LAS unsigned char* lds, F&& prefetch) {
    const int tid = ltid(), wid = tid >> 6, lane = tid & 63;
    LAS float* G = (LAS float*)lds; LAS bf16_t* QD = (LAS bf16_t*)(lds + 16640); LAS bf16_t* KI = (LAS bf16_t*)(lds + 25856); LAS bf16_t* KT = (LAS bf16_t*)(lds + 35072);
    LAS bf16_t* PB = (LAS bf16_t*)(lds + 44288); LAS bf16_t* V = (LAS bf16_t*)(lds + 53504); LAS float* SEG = (LAS float*)(lds + 70912); const LAS float* WT = (const LAS float*)(lds + 72960);
    char* ub = a.ws + WS_R1 + R1_SGLA + (size_t)u * GLA_UNIT;
    const int l_ = tid >> 3, d0 = (tid & 7) * 8;
    { float s[8];
#pragma unroll
      for (int i = 0; i < 8; ++i) s[i] = WT[16 * 64 + d0 + i];
#pragma unroll
      for (int j = 0; j < 16; ++j) { const float lv = rw.lr[j >> 2][j & 3];
#pragma unroll
          for (int i = 0; i < 8; ++i) s[i] += lv * WT[j * 64 + d0 + i]; }
#pragma unroll
      for (int i = 0; i < 8; ++i) G[l_ * 65 + d0 + i] = -softplus_(-s[i]) * (1.f / 16.f); }
#pragma unroll
    for (int rep = 0; rep < 2; ++rep) { const int idx = rep * NTHREADS + tid, lr_ = idx >> 4, c0 = (idx & 15) * 8; *(LAS u32x4*)(V + lr_ * 136 + c0) = rw.v8[rep]; }
    const u32x4 q8 = rw.q8, k8 = rw.k8;
    prefetch();
    lds_barrier();
    { const int d = tid & 63, sg = tid >> 6; float run = 0.f, vv[8];
#pragma unroll
      for (int i = 0; i < 8; ++i) { run += G[(sg * 8 + i) * 65 + d]; vv[i] = run; }
      SEG[sg * 64 + d] = run;
      lds_barrier();
      float pre = 0.f;
#pragma unroll
      for (int s2 = 0; s2 < 8; ++s2) pre += (s2 < sg) ? SEG[s2 * 64 + d] : 0.f;
#pragma unroll
      for (int i = 0; i < 8; ++i) G[(sg * 8 + i) * 65 + d] = vv[i] + pre; }
    lds_barrier();
    { const float qf[8] = {bflo(q8.x), bfhi(q8.x), bflo(q8.y), bfhi(q8.y), bflo(q8.z), bfhi(q8.z), bflo(q8.w), bfhi(q8.w)};
      const float kf[8] = {bflo(k8.x), bfhi(k8.x), bflo(k8.y), bfhi(k8.y), bflo(k8.z), bfhi(k8.z), bflo(k8.w), bfhi(k8.w)};
      float qd[8], ki[8];
#pragma unroll
      for (int i = 0; i < 8; ++i) { const float bc = G[l_ * 65 + d0 + i], bl = G[63 * 65 + d0 + i]; qd[i] = qf[i] * 0.125f * __expf(bc); ki[i] = kf[i] * __expf(-bc);
          KT[swz64(d0 + i, l_)] = f2bf(kf[i] * __expf(bl - bc)); }
      *(LAS u32x4*)(QD + l_ * 72 + d0) = (u32x4){pk2(qd[0], qd[1]), pk2(qd[2], qd[3]), pk2(qd[4], qd[5]), pk2(qd[6], qd[7])};
      *(LAS u32x4*)(KI + l_ * 72 + d0) = (u32x4){pk2(ki[0], ki[1]), pk2(ki[2], ki[3]), pk2(ki[4], ki[5]), pk2(ki[6], ki[7])};
      frag_store8(ub + GLA_OQ, 4, l_, d0, qd); }
    if (tid < 64) ((float*)(ub + GLA_OD))[tid] = __expf(G[63 * 65 + tid]);
    lds_barrier();
#pragma unroll
    for (int t2 = 0; t2 < 2; ++t2) { const int t = wid * 2 + t2, mt = t >> 2, nt = t & 3; const f32x4 acc = mm16<64>(QD, 72, mt * 16, KI, 72, nt * 16, lane);
        const int r = lane & 15, q = lane >> 4, m = nt * 16 + r;
#pragma unroll
        for (int j = 0; j < 4; ++j) { const int lrow = mt * 16 + 4 * q + j; PB[lrow * 72 + m] = f2bf(m <= lrow ? acc[j] : 0.f); } }
    lds_barrier();
    export_frags(ub + GLA_OP, PB, 72, 64, 64, 0);
    export_frags<true>(ub + GLA_OK, KT, 72, 64, 64, 0);
    export_acc(ub + GLA_OU, V, 136, 4);
    lds_barrier();
}
struct SsdRaw { u32x4 t[3][4]; float dtr, p0, p1, p2; };
DI void ssd_load(CArgs& a, int u, SsdRaw& r) {
    const int tid = ltid(); const int n = u & 63, bh = u >> 6, b = bh >> 3, hh = bh & 7, g = hh >> 2, T0 = b * SEQ + n * 64;
    const bf16_t* P = (const bf16_t*)(a.ws + WS_R1 + R1_PROJ); const float* small = (const float*)(a.ws + WS_SMALL);
    const int l_ = tid >> 3, c8 = (tid & 7) * 8, pos = n * 64 + l_; const bf16_t* pr = P + (size_t)(T0 + l_) * NP + PC_SSD_XBC + c8;
    const int cb[3] = {hh * 64, 512 + g * 64, 640 + g * 64};
#pragma unroll
    for (int p = 0; p < 3; ++p)
#pragma unroll
        for (int j = 0; j < 4; ++j) r.t[p][j] = ldg_or0(pr + cb[p] - (ptrdiff_t)(3 - j) * NP, pos - 3 + j >= 0);
    r.dtr = tid < 64 ? small[(size_t)(T0 + tid) * 32 + 24 + hh] : 0.f; r.p0 = 0.f; r.p1 = 0.f; r.p2 = 0.f;
}
DI void ssd_table(CArgs& a, int l, int hh, LAS float* WT) {
    const int g = hh >> 2;
    for (int i = ltid(); i < 3 * 5 * 64; i += NTHREADS) { const int p = i / 320, j = (i % 320) >> 6, ch = i & 63; const int col = (p == 0 ? hh * 64 : p == 1 ? 512 + g * 64 : 640 + g * 64) + ch;
        WT[i] = j < 4 ? a.ssd_conv_w[(size_t)l * 4 * 768 + j * 768 + col] : a.ssd_conv_b[l * 768 + col]; }
}
template <class F> DI void ssd_compute(CArgs& a, int l, int u, const SsdRaw& rw, LAS unsigned char* lds, F&& prefetch) {
    const int tid = ltid(), wid = tid >> 6, lane = tid & 63;
    const int bh = u >> 6, hh = bh & 7;
    LAS bf16_t* CC = (LAS bf16_t*)lds; LAS bf16_t* CBm = (LAS bf16_t*)(lds + 9216); LAS bf16_t* KT = (LAS bf16_t*)(lds + 18432); LAS bf16_t* PB = (LAS bf16_t*)(lds + 27648);
    LAS bf16_t* V = (LAS bf16_t*)(lds + 36864); LAS float* SDT = (LAS float*)(lds + 46080); LAS float* SCUM = (LAS float*)(lds + 46080 + 256); const LAS float* WT = (const LAS float*)(lds + 47104);
    char* ub = a.ws + WS_R1 + R1_SSSD + (size_t)u * SSD_UNIT;
    if (tid < 64) { const float dt = softplus_(rw.dtr + a.ssd_dt_bias[l * 8 + hh]); const float aa = -__expf(a.ssd_a_log[l * 8 + hh]);
        const float cum = wave_incl_scan(dt * aa, lane); SDT[tid] = dt; SCUM[tid] = cum; }
    float vx[8], vb[8], vc[8];
    { const int c8 = (tid & 7) * 8;
      conv8r(rw.t[0], WT + c8, 64, WT + 4 * 64 + c8, vx); conv8r(rw.t[1], WT + 320 + c8, 64, WT + 320 + 4 * 64 + c8, vb); conv8r(rw.t[2], WT + 640 + c8, 64, WT + 640 + 4 * 64 + c8, vc); }
    prefetch();
    lds_barrier();
    { const int l_ = tid >> 3, c8 = (tid & 7) * 8; const float cl = SCUM[l_], c63 = SCUM[63], dtl = SDT[l_];
      *(LAS u32x4*)(V + l_ * 72 + c8) = (u32x4){pk2(vx[0] * dtl, vx[1] * dtl), pk2(vx[2] * dtl, vx[3] * dtl), pk2(vx[4] * dtl, vx[5] * dtl), pk2(vx[6] * dtl, vx[7] * dtl)};
      *(LAS u32x4*)(CBm + l_ * 72 + c8) = (u32x4){pk2(vb[0], vb[1]), pk2(vb[2], vb[3]), pk2(vb[4], vb[5]), pk2(vb[6], vb[7])};
      const float ek = __expf(c63 - cl);
#pragma unroll
      for (int i = 0; i < 8; ++i) KT[swz64(c8 + i, l_)] = f2bf(vb[i] * ek);
      *(LAS u32x4*)(CC + l_ * 72 + c8) = (u32x4){pk2(vc[0], vc[1]), pk2(vc[2], vc[3]), pk2(vc[4], vc[5]), pk2(vc[6], vc[7])};
      const float eq = __expf(cl); float qd[8];
#pragma unroll
      for (int i = 0; i < 8; ++i) qd[i] = vc[i] * eq;
      frag_store8(ub + SSD_OQ, 4, l_, c8, qd); }
    if (tid < 64) ((float*)(ub + SSD_OD))[tid] = __expf(SCUM[63]);
    lds_barrier();
#pragma unroll
    for (int t2 = 0; t2 < 2; ++t2) { const int t = wid * 2 + t2, mt = t >> 2, nt = t & 3; const f32x4 acc = mm16<64>(CC, 72, mt * 16, CBm, 72, nt * 16, lane);
        const int r = lane & 15, q = lane >> 4, m = nt * 16 + r; const float cm = SCUM[m];
#pragma unroll
        for (int j = 0; j < 4; ++j) { const int lrow = mt * 16 + 4 * q + j; PB[lrow * 72 + m] = f2bf(m <= lrow ? acc[j] * __expf(SCUM[lrow] - cm) : 0.f); } }
    lds_barrier();
    export_frags(ub + SSD_OP, PB, 72, 64, 64, 0);
    export_frags<true>(ub + SSD_OK, KT, 72, 64, 64, 0);
    export_acc(ub + SSD_OU, V, 72, 2);
    lds_barrier();
}
template <int NP_> struct GdnRaw { u32x4 t[NP_][2][4]; u32x4 tb; float ar, br, p0, p1; };
template <int NP_> DI void gdn_load(CArgs& a, int u, GdnRaw<NP_>& r, bool with_t) {
    const int tid = ltid(); const int n = u & 63, bh = u >> 6, b = bh >> 2, h = bh & 3, T0 = b * SEQ + n * 64;
    const bf16_t* P = (const bf16_t*)(a.ws + WS_R1 + R1_PROJ); const float* small = (const float*)(a.ws + WS_SMALL);
#pragma unroll
    for (int rep = 0; rep < 2; ++rep) { const int idx = rep * NTHREADS + tid, l_ = idx >> 4, grp = idx & 15, pos = n * 64 + l_; const bf16_t* pr = P + (size_t)(T0 + l_) * NP + PC_GDN_QKV + h * 128 + grp * 8;
#pragma unroll
        for (int p = 0; p < NP_; ++p) { const int part = NP_ == 1 ? 1 : p;
#pragma unroll
            for (int j = 0; j < 4; ++j) r.t[p][rep][j] = ldg_or0(pr + part * 512 - (ptrdiff_t)(3 - j) * NP, pos - 3 + j >= 0); } }
    r.ar = tid < 64 ? small[(size_t)(T0 + tid) * 32 + 16 + h] : 0.f; r.br = tid < 64 ? small[(size_t)(T0 + tid) * 32 + 20 + h] : 0.f; r.p0 = 0.f; r.p1 = 0.f;
    if (with_t) { const bf16_t* tsrc = (const bf16_t*)(a.ws + WS_TSCR) + (size_t)u * 4096; r.tb = *(const u32x4*)(tsrc + (tid >> 3) * 64 + (tid & 7) * 8); } else r.tb = (u32x4){0u, 0u, 0u, 0u};
}
DI void gdn_table(CArgs& a, int l, int h, LAS float* WT) {
    for (int i = ltid(); i < 3 * 4 * 128; i += NTHREADS) { const int p = i >> 9, j = (i >> 7) & 3, d = i & 127; WT[i] = a.gdn_conv_w[(size_t)l * 4 * 1536 + j * 1536 + p * 512 + h * 128 + d]; }
}
DI void gdn_scalars_r(CArgs& a, int l, int h, float ar, float br, LAS float* SB, LAS float* SC) {
    const int tid = ltid();
    if (tid < 64) { const float beta = sigmoid_(br); const float gg = -__expf(a.gdn_a_log[l * 4 + h]) * softplus_(ar + a.gdn_dt_bias[l * 4 + h]);
        const float cum = wave_incl_scan(gg, tid); SB[tid] = beta; SC[tid] = cum; }
}
DI void gdn_norm8(float (&v)[8], float post) {
    float ss = 0.f;
#pragma unroll
    for (int i = 0; i < 8; ++i) ss += v[i] * v[i];
    ss += __shfl_xor(ss, 1); ss += __shfl_xor(ss, 2); ss += __shfl_xor(ss, 4); ss += __shfl_xor(ss, 8);
    const float rn = rsqrtf(ss + 1e-6f) * post;
#pragma unroll
    for (int i = 0; i < 8; ++i) v[i] *= rn;
}
template <class F> DI void gdn_compute1(CArgs& a, int l, int u, const GdnRaw<1>& rw, LAS unsigned char* lds, LAS float* slot, F&& prefetch) {
    const int tid = ltid(), wid = tid >> 6, lane = tid & 63; const int h = (u >> 6) & 3;
    LAS bf16_t* Kb = (LAS bf16_t*)lds; LAS float* SB = (LAS float*)(lds + 17408); LAS float* SC = (LAS float*)(lds + 17408 + 256); const LAS float* WT = (const LAS float*)(lds + 17920);
    gdn_scalars_r(a, l, h, rw.ar, rw.br, SB, SC);
#pragma unroll
    for (int rep = 0; rep < 2; ++rep) { const int idx = rep * NTHREADS + tid, l_ = idx >> 4, grp = idx & 15; float v[8]; conv8r(rw.t[0][rep], WT + grp * 8, 128, nullptr, v); gdn_norm8(v, 1.f);
        *(LAS u32x4*)(Kb + l_ * 136 + grp * 8) = (u32x4){pk2(v[0], v[1]), pk2(v[2], v[3]), pk2(v[4], v[5]), pk2(v[6], v[7])}; }
    prefetch();
    lds_barrier();
#pragma unroll
    for (int t2 = 0; t2 < 2; ++t2) { const int t = wid * 2 + t2, mt = t >> 2, nt = t & 3; const f32x4 acc = mm16<128>(Kb, 136, mt * 16, Kb, 136, nt * 16, lane);
        const int r = lane & 15, q = lane >> 4, m = nt * 16 + r; const float cm = SC[m];
#pragma unroll
        for (int j = 0; j < 4; ++j) { const int lrow = mt * 16 + 4 * q + j; slot[lrow * 65 + m] = (m < lrow) ? SB[lrow] * acc[j] * __expf(SC[lrow] - cm) : 0.f; } }
    lds_barrier();
}
DI float rdl(float v, int l) { return __uint_as_float((unsigned)__builtin_amdgcn_readlane((int)__float_as_uint(v), l)); }
DI void gdn_invert(LAS float* sl, bf16_t* tout, int lane) {
#pragma unroll 1
    for (int I = 0; I < 4; ++I) {
        float ar[16], x[16], tn[16];
#pragma unroll
        for (int r = 0; r < 16; ++r) { ar[r] = sl[(16 * I + r) * 65 + lane]; x[r] = 0.f; }
#pragma unroll 2
        for (int m = 0; m < 16 * I; ++m) { const float t = sl[m * 65 + lane];
#pragma unroll
            for (int r = 0; r < 16; ++r) x[r] += rdl(ar[r], m) * t; }
#pragma unroll
        for (int r = 0; r < 16; ++r) { float acc = ((lane == 16 * I + r) ? 1.f : 0.f) - x[r];
#pragma unroll
            for (int m2 = 0; m2 < r; ++m2) acc -= rdl(ar[r], 16 * I + m2) * tn[m2];
            tn[r] = acc; }
#pragma unroll
        for (int r = 0; r < 16; ++r) sl[(16 * I + r) * 65 + lane] = tn[r];
    }
#pragma unroll 4
    for (int it = 0; it < 32; ++it) { const int rowi = it * 2 + (lane >> 5), cj = (lane & 31) * 2; ((unsigned*)tout)[rowi * 32 + (lane & 31)] = pk2(sl[rowi * 65 + cj], sl[rowi * 65 + cj + 1]); }
}
template <class F> DI void gdn_compute2(CArgs& a, int l, int u, const GdnRaw<3>& rw, LAS unsigned char* lds, F&& prefetch) {
    const int tid = ltid(), wid = tid >> 6, lane = tid & 63; const int h = (u >> 6) & 3;
    LAS bf16_t* Kb = (LAS bf16_t*)lds; LAS bf16_t* Qb = (LAS bf16_t*)(lds + 17408); LAS bf16_t* SOL = (LAS bf16_t*)lds;
    LAS bf16_t* RT = (LAS bf16_t*)(lds + 34816); LAS bf16_t* KT = (LAS bf16_t*)(lds + 71680); LAS bf16_t* Tb = (LAS bf16_t*)(lds + 90112); LAS bf16_t* PB = (LAS bf16_t*)(lds + 99328);
    LAS float* SB = (LAS float*)(lds + 108544); LAS float* SC = (LAS float*)(lds + 108544 + 256); const LAS float* WT = (const LAS float*)(lds + 109056);
    char* ub = a.ws + WS_R1 + R1_SGDN + (size_t)u * GDN_UNIT;
    gdn_scalars_r(a, l, h, rw.ar, rw.br, SB, SC);
    float vq[2][8], vk[2][8], vv[2][8];
#pragma unroll
    for (int rep = 0; rep < 2; ++rep) { const int grp = (rep * NTHREADS + tid) & 15;
        conv8r(rw.t[0][rep], WT + grp * 8, 128, nullptr, vq[rep]); gdn_norm8(vq[rep], 0.08838834764831845f);
        conv8r(rw.t[1][rep], WT + 512 + grp * 8, 128, nullptr, vk[rep]); gdn_norm8(vk[rep], 1.f);
        conv8r(rw.t[2][rep], WT + 1024 + grp * 8, 128, nullptr, vv[rep]); }
    *(LAS u32x4*)(Tb + (tid >> 3) * 72 + (tid & 7) * 8) = rw.tb;
    prefetch();
    lds_barrier();
#pragma unroll
    for (int rep = 0; rep < 2; ++rep) { const int idx = rep * NTHREADS + tid, l_ = idx >> 4, grp = idx & 15; const float cl = SC[l_], c63 = SC[63], be = SB[l_];
        *(LAS u32x4*)(Qb + l_ * 136 + grp * 8) = (u32x4){pk2(vq[rep][0], vq[rep][1]), pk2(vq[rep][2], vq[rep][3]), pk2(vq[rep][4], vq[rep][5]), pk2(vq[rep][6], vq[rep][7])};
        { const float eq = __expf(cl); float qd[8];
#pragma unroll
          for (int i = 0; i < 8; ++i) qd[i] = vq[rep][i] * eq;
          frag_store8(ub + GDN_OQ, 8, l_, grp * 8, qd); }
        *(LAS u32x4*)(Kb + l_ * 136 + grp * 8) = (u32x4){pk2(vk[rep][0], vk[rep][1]), pk2(vk[rep][2], vk[rep][3]), pk2(vk[rep][4], vk[rep][5]), pk2(vk[rep][6], vk[rep][7])};
        { const float e1 = be * __expf(cl), e2 = __expf(c63 - cl);
#pragma unroll
          for (int i = 0; i < 8; ++i) { RT[swz64(128 + grp * 8 + i, l_)] = f2bf(vk[rep][i] * e1); KT[swz64(grp * 8 + i, l_)] = f2bf(vk[rep][i] * e2); RT[swz64(grp * 8 + i, l_)] = f2bf(vv[rep][i] * be); } } }
    if (tid < 128) ((float*)(ub + GDN_OD))[tid] = __expf(SC[63]);
    lds_barrier();
#pragma unroll
    for (int t2 = 0; t2 < 2; ++t2) { const int t = wid * 2 + t2, mt = t >> 2, nt = t & 3; const f32x4 acc = mm16<128>(Qb, 136, mt * 16, Kb, 136, nt * 16, lane);
        const int r = lane & 15, q = lane >> 4, m = nt * 16 + r; const float cm = SC[m];
#pragma unroll
        for (int j = 0; j < 4; ++j) { const int lrow = mt * 16 + 4 * q + j; PB[lrow * 72 + m] = f2bf(m <= lrow ? acc[j] * __expf(SC[lrow] - cm) : 0.f); } }
    f32x4 sacc[8];
#pragma unroll
    for (int t2 = 0; t2 < 8; ++t2) { const int t = wid * 8 + t2, mt = t & 3, ntile = t >> 2; sacc[t2] = mm16<64, true>(Tb, 72, mt * 16, RT, 72, ntile * 16, lane); }
    lds_barrier();
#pragma unroll
    for (int t2 = 0; t2 < 8; ++t2) { const int t = wid * 8 + t2, mt = t & 3, ntile = t >> 2; const int r = lane & 15, q = lane >> 4, cc = ntile * 16 + r; const float sg = cc < 128 ? 1.f : -1.f;
#pragma unroll
        for (int j = 0; j < 4; ++j) SOL[(mt * 16 + 4 * q + j) * 264 + cc] = f2bf(sacc[t2][j] * sg); }
    lds_barrier();
    export_frags(ub + GDN_OP, PB, 72, 64, 64, 0);
    export_frags<true>(ub + GDN_OK, KT, 72, 128, 64, 0);
    export_frags(ub + GDN_OW, SOL, 264, 64, 128, 128);
    export_acc(ub + GDN_OU, SOL, 264, 4);
    lds_barrier();
}
DI void phase_prep(CArgs& a, int l, LAS unsigned char* lds) {
    const int wid = ltid() >> 6, lane = ltid() & 63; const int w = lbid(), Gd = lgrid();
#ifndef REP_PGDN
#define REP_PGDN 1
#endif
#ifndef REP_PGLA
#define REP_PGLA 1
#endif
#ifndef REP_PSSD
#define REP_PSSD 1
#endif
    for (int rp_ = 0; rp_ < REP_PGDN; ++rp_)
    { const int upw = (2048 + Gd - 1) / Gd, u0 = w * upw, u1 = (u0 + upw < 2048) ? u0 + upw : 2048;
      LAS float* slots = (LAS float*)(lds + 20480);
      for (int ub = u0; ub < u1; ub += 8) { const int nb = (u1 - ub) < 8 ? (u1 - ub) : 8; int curh = -1;
#ifndef REP_G1
#define REP_G1 1
#endif
#ifndef REP_G2
#define REP_G2 1
#endif
          for (int rg1 = 0; rg1 < REP_G1; ++rg1) { curh = -1;
          GdnRaw<1> r1; gdn_load<1>(a, ub, r1, false);
          for (int j = 0; j < nb; ++j) { const int u = ub + j;
              if ((u >> 6) != curh) { curh = u >> 6; lds_barrier(); LAS float* WT = (LAS float*)(lds + 17920); for (int i = ltid(); i < 512; i += NTHREADS) WT[i] = a.gdn_conv_w[(size_t)l * 4 * 1536 + (i >> 7) * 1536 + 512 + (curh & 3) * 128 + (i & 127)]; lds_barrier(); }
              GdnRaw<1> rn = r1;
              gdn_compute1(a, l, u, r1, lds, slots + j * 4160, [&]() { if (j + 1 < nb) gdn_load<1>(a, u + 1, rn, false); }); r1 = rn; }
          if (wid < nb) gdn_invert(slots + wid * 4160, (bf16_t*)(a.ws + WS_TSCR) + (size_t)(ub + wid) * 4096, lane);
          asm volatile("s_waitcnt vmcnt(0)" ::: "memory");
          __syncthreads(); }
          for (int rg2 = 0; rg2 < REP_G2; ++rg2) {
          curh = -1;
          GdnRaw<3> r3; gdn_load<3>(a, ub, r3, true);
          for (int j = 0; j < nb; ++j) { const int u = ub + j;
              if ((u >> 6) != curh) { curh = u >> 6; lds_barrier(); gdn_table(a, l, curh & 3, (LAS float*)(lds + 109056)); lds_barrier(); }
              GdnRaw<3> rn = r3;
              gdn_compute2(a, l, u, r3, lds, [&]() { if (j + 1 < nb) gdn_load<3>(a, u + 1, rn, true); }); r3 = rn; } } } }
    for (int rp_ = 0; rp_ < REP_PGLA; ++rp_)
    { const int upw = (2048 + Gd - 1) / Gd, u0 = w * upw, u1 = (u0 + upw < 2048) ? u0 + upw : 2048; int curh = -1;
      if (u0 < u1) { GlaRaw r; gla_load(a, u0, r);
          for (int u = u0; u < u1; ++u) {
              if ((u >> 6) != curh) { curh = u >> 6; lds_barrier(); gla_table(a, l, curh & 3, (LAS float*)(lds + 72960)); lds_barrier(); }
              GlaRaw rn = r;
              gla_compute(a, u, r, lds, [&]() { if (u + 1 < u1) gla_load(a, u + 1, rn); }); r = rn; } } }
    for (int rp_ = 0; rp_ < REP_PSSD; ++rp_)
    { const int upw = (4096 + Gd - 1) / Gd, u0 = w * upw, u1 = (u0 + upw < 4096) ? u0 + upw : 4096; int curh = -1;
      if (u0 < u1) { SsdRaw r; ssd_load(a, u0, r);
          for (int u = u0; u < u1; ++u) {
              if ((u >> 6) != curh) { curh = u >> 6; lds_barrier(); ssd_table(a, l, curh & 7, (LAS float*)(lds + 47104)); lds_barrier(); }
              SsdRaw rn = r;
              ssd_compute(a, l, u, r, lds, [&]() { if (u + 1 < u1) ssd_load(a, u + 1, rn); }); r = rn; } } }
}
DI bf16x8 pack16(const f32x16& x, int s) {
    u32x4 p; p.x = pk2(x[8 * s], x[8 * s + 1]); p.y = pk2(x[8 * s + 2], x[8 * s + 3]); p.z = pk2(x[8 * s + 4], x[8 * s + 5]); p.w = pk2(x[8 * s + 6], x[8 * s + 7]);
    return __builtin_bit_cast(bf16x8, p);
}
#define MFMA32(a, b, c) __builtin_amdgcn_mfma_f32_32x32x16_bf16((a), (b), (c), 0, 0, 0)
template <int DK, bool HAS_W, int NH, int NCT, int UNIT, int OQ, int OW, int OP, int OK, int OU, int OD>
DI void scan_wg(const char* ops0, const char* ops1, char* ob0, char* ob1, LAS unsigned char* lds) {
    constexpr int NKB = DK / 16, NDT = DK / 32, BUF = NH * UNIT, OUNIT = NCT * 2 * 2048;
    static_assert(2 * BUF <= LDS_CTRL, "scan LDS");
    const int tid = ltid(), wid = __builtin_amdgcn_readfirstlane(tid >> 6), lane = tid & 63, h = lane >> 5;
    const int hd = (NH == 2) ? (wid >> 1) & 1 : 0, ct = (NH == 2) ? (wid & 1) : (wid & 3);
    static_assert(UNIT % 1024 == 0, "unit = whole 1 KiB chunks");
    auto load_step = [&](int n, int buf) {
        const int lw = wid - 4;
#pragma unroll
        for (int k = 0; k < NH; ++k) { const char* src = (k == 0 ? ops0 : ops1) + (size_t)n * UNIT + lane * 16 + lw * 1024; unsigned dst = (unsigned)(buf * BUF + k * UNIT + lw * 1024);
#pragma unroll 1
            for (int ch = lw; ch < UNIT / 1024; ch += 4) { __builtin_amdgcn_global_load_lds((const unsigned*)src, (LAS unsigned*)(lds + dst), 16, 0, 0); src += 4096; dst += 4096u; } }
        asm volatile("s_waitcnt vmcnt(0)" ::: "memory");
    };
    f32x16 S[NDT]; bf16x8 Sb[NKB];
#pragma unroll
    for (int d = 0; d < NDT; ++d)
#pragma unroll
        for (int i = 0; i < 16; ++i) S[d][i] = 0.f;
#pragma unroll
    for (int k = 0; k < NKB; ++k) Sb[k] = (bf16x8){0, 0, 0, 0, 0, 0, 0, 0};
    if (wid >= 4) load_step(0, 0);
    __syncthreads();
    char* ob = (hd == 0 ? ob0 : ob1);
    for (int n = 0; n < 64; ++n) {
        if (wid >= 4) { if (n + 1 < 64) load_step(n + 1, (n + 1) & 1); }
        else {
            const LAS unsigned char* lb = lds + (n & 1) * BUF + hd * UNIT;
            f32x16 U[2];
#pragma unroll
            for (int rt = 0; rt < 2; ++rt) { const LAS unsigned char* up = lb + OU + ((ct * 2 + rt) * 64 + lane) * 32; const u32x4 w0 = *(const LAS u32x4*)up, w1 = *(const LAS u32x4*)(up + 16);
                U[rt][0] = bflo(w0.x); U[rt][1] = bfhi(w0.x); U[rt][2] = bflo(w0.y); U[rt][3] = bfhi(w0.y); U[rt][4] = bflo(w0.z); U[rt][5] = bfhi(w0.z); U[rt][6] = bflo(w0.w); U[rt][7] = bfhi(w0.w);
                U[rt][8] = bflo(w1.x); U[rt][9] = bfhi(w1.x); U[rt][10] = bflo(w1.y); U[rt][11] = bfhi(w1.y); U[rt][12] = bflo(w1.z); U[rt][13] = bfhi(w1.z); U[rt][14] = bflo(w1.w); U[rt][15] = bfhi(w1.w); }
            if constexpr (HAS_W) {
#pragma unroll
                for (int rt = 0; rt < 2; ++rt)
#pragma unroll
                    for (int k4 = 0; k4 < NKB; k4 += 4) { bf16x8 fw[4];
#pragma unroll
                        for (int kb = 0; kb < 4; ++kb) fw[kb] = *(const LAS bf16x8*)(lb + OW + ((rt * NKB + k4 + kb) * 64 + lane) * 16);
#pragma unroll
                        for (int kb = 0; kb < 4; ++kb) U[rt] = MFMA32(fw[kb], Sb[k4 + kb], U[rt]); }
            }
            bf16x8 Ub[4];
            Ub[0] = pack16(U[0], 0); Ub[1] = pack16(U[0], 1); Ub[2] = pack16(U[1], 0); Ub[3] = pack16(U[1], 1);
#pragma unroll
            for (int rt = 0; rt < 2; ++rt) { f32x16 O;
#pragma unroll
                for (int i = 0; i < 16; ++i) O[i] = 0.f;
                { bf16x8 fp[4];
#pragma unroll
                  for (int kb = 0; kb < 4; ++kb) fp[kb] = *(const LAS bf16x8*)(lb + OP + ((rt * 4 + kb) * 64 + lane) * 16);
#pragma unroll
                  for (int kb = 0; kb < 4; ++kb) O = MFMA32(fp[kb], Ub[kb], O); }
#pragma unroll
                for (int k4 = 0; k4 < NKB; k4 += 4) { bf16x8 fq[4];
#pragma unroll
                    for (int kb = 0; kb < 4; ++kb) fq[kb] = *(const LAS bf16x8*)(lb + OQ + ((rt * NKB + k4 + kb) * 64 + lane) * 16);
#pragma unroll
                    for (int kb = 0; kb < 4; ++kb) O = MFMA32(fq[kb], Sb[k4 + kb], O); }
                char* op = ob + (size_t)n * OUNIT + ((ct * 2 + rt) * 64 + lane) * 32;
                *(u32x4*)op = (u32x4){pk2(O[0], O[1]), pk2(O[2], O[3]), pk2(O[4], O[5]), pk2(O[6], O[7])};
                *(u32x4*)(op + 16) = (u32x4){pk2(O[8], O[9]), pk2(O[10], O[11]), pk2(O[12], O[13]), pk2(O[14], O[15])}; }
#pragma unroll
            for (int d = 0; d < NDT; ++d) {
#pragma unroll
                for (int g = 0; g < 4; ++g) { const f32x4 dv = *(const LAS f32x4*)(lb + OD + (d * 32 + 8 * g + 4 * h) * 4);
                    S[d][4 * g] *= dv[0]; S[d][4 * g + 1] *= dv[1]; S[d][4 * g + 2] *= dv[2]; S[d][4 * g + 3] *= dv[3]; }
                bf16x8 fk[4];
#pragma unroll
                for (int kb = 0; kb < 4; ++kb) fk[kb] = *(const LAS bf16x8*)(lb + OK + ((d * 4 + kb) * 64 + lane) * 16);
#pragma unroll
                for (int kb = 0; kb < 4; ++kb) S[d] = MFMA32(fk[kb], Ub[kb], S[d]);
                Sb[2 * d] = pack16(S[d], 0); Sb[2 * d + 1] = pack16(S[d], 1); }
        }
        __syncthreads();
    }
}
DI void phase_scan(CArgs& a, LAS unsigned char* lds) {
    char* r1 = a.ws + WS_R1; char* obuf = r1 + R1_OBUF;
    for (int it = lbid(); it < 96; it += lgrid()) {
        if (it < 32) { const char* ops = r1 + R1_SGDN + (size_t)it * 64 * GDN_UNIT; char* ob = obuf + OB_GDN + (size_t)it * 64 * 16384;
            scan_wg<128, true, 1, 4, GDN_UNIT, GDN_OQ, GDN_OW, GDN_OP, GDN_OK, GDN_OU, GDN_OD>(ops, ops, ob, ob, lds); }
        else if (it < 64) { const int i2 = it - 32; const char* ops = r1 + R1_SGLA + (size_t)i2 * 64 * GLA_UNIT; char* ob = obuf + OB_GLA + (size_t)i2 * 64 * 16384;
            scan_wg<64, false, 1, 4, GLA_UNIT, GLA_OQ, 0, GLA_OP, GLA_OK, GLA_OU, GLA_OD>(ops, ops, ob, ob, lds); }
        else { const int i2 = (it - 64) * 2; const char* ops = r1 + R1_SSSD + (size_t)i2 * 64 * SSD_UNIT; char* ob = obuf + OB_SSD + (size_t)i2 * 64 * 8192;
            scan_wg<64, false, 2, 2, SSD_UNIT, SSD_OQ, 0, SSD_OP, SSD_OK, SSD_OU, SSD_OD>(ops, ops + (size_t)64 * SSD_UNIT, ob, ob + (size_t)64 * 8192, lds); }
    }
}

DI float otile_ld(const LAS unsigned char* tl, int l_, int e) {
    const int ct = e >> 5, r = e & 31, rt = l_ >> 5, lr = l_ & 31, h = (lr >> 2) & 1, i = (lr & 3) + 4 * (lr >> 3);
    return bf2f(*(const LAS bf16_t*)(tl + ((ct * 2 + rt) * 64 + h * 32 + r) * 32 + i * 2));
}
DI void phase_post(CArgs& a, int l, LAS unsigned char* lds) {
    const int tid = ltid(); char* r1 = a.ws + WS_R1; const bf16_t* P = (const bf16_t*)(r1 + R1_PROJ); const char* obuf = r1 + R1_OBUF; bf16_t* Y = (bf16_t*)(r1 + R1_YMIX);
    const int l_ = tid >> 3, sub = tid & 7;
    for (int u = lbid(); u < 5120; u += lgrid()) {
        if (u < 4096) {
            const int ty = u >> 11, uu = u & 2047, n = uu & 63, bh = uu >> 6, b = bh >> 2, h = bh & 3; const size_t T = (size_t)b * SEQ + n * 64 + l_;
            const char* src = obuf + (ty ? OB_GDN : OB_GLA) + (size_t)uu * 16384;
#pragma unroll
            for (int rep = 0; rep < 2; ++rep) { const int i = rep * NTHREADS + tid; *(LAS u32x4*)(lds + i * 16) = *(const u32x4*)(src + (size_t)i * 16); }
            __syncthreads();
            float o[16]; float ss = 0.f;
#pragma unroll
            for (int j = 0; j < 16; ++j) { o[j] = otile_ld(lds, l_, sub * 16 + j); ss += o[j] * o[j]; }
            ss += __shfl_xor(ss, 1); ss += __shfl_xor(ss, 2); ss += __shfl_xor(ss, 4);
            const float rs = rsqrtf(ss * (1.f / 128.f) + 1e-6f);
            const float* ng = (ty ? a.gdn_norm : a.gla_norm) + l * 128 + sub * 16;
            const bf16_t* gp = P + T * NP + (ty ? PC_GDN_G : PC_GLA_R) + h * 128 + sub * 16;
            const u32x4 g0 = *(const u32x4*)gp, g1 = *(const u32x4*)(gp + 8);
            const float gv[16] = {bflo(g0.x), bfhi(g0.x), bflo(g0.y), bfhi(g0.y), bflo(g0.z), bfhi(g0.z), bflo(g0.w), bfhi(g0.w), bflo(g1.x), bfhi(g1.x), bflo(g1.y), bfhi(g1.y), bflo(g1.z), bfhi(g1.z), bflo(g1.w), bfhi(g1.w)};
            float y[16];
#pragma unroll
            for (int j = 0; j < 16; ++j) y[j] = o[j] * rs * ng[j] * silu_(gv[j]);
            bf16_t* yp = Y + ((size_t)ty * NTOK + T) * 512 + h * 128 + sub * 16;
            *(u32x4*)yp = (u32x4){pk2(y[0], y[1]), pk2(y[2], y[3]), pk2(y[4], y[5]), pk2(y[6], y[7])};
            *(u32x4*)(yp + 8) = (u32x4){pk2(y[8], y[9]), pk2(y[10], y[11]), pk2(y[12], y[13]), pk2(y[14], y[15])};
            __syncthreads();
        } else {
            const int uu = u - 4096, n = uu & 63, bg = uu >> 6, b = bg >> 1, g = bg & 1; const size_t T = (size_t)b * SEQ + n * 64 + l_;
#pragma unroll
            for (int rep = 0; rep < 4; ++rep) { const int i = rep * NTHREADS + tid, hq = i >> 9, ii = i & 511;
                *(LAS u32x4*)(lds + i * 16) = *(const u32x4*)(obuf + OB_SSD + ((size_t)((b * 8 + g * 4 + hq) * 64 + n)) * 8192 + (size_t)ii * 16); }
            __syncthreads();
            const int hq = sub >> 1, hh = g * 4 + hq, p0 = (sub & 1) * 32; const float dsk = a.ssd_d[l * 8 + hh];
            float y[32]; float ss = 0.f;
#pragma unroll
            for (int c8 = 0; c8 < 4; ++c8) { const int ch = hh * 64 + p0 + c8 * 8; float xc[8];
                conv8(P + T * NP + PC_SSD_XBC + ch, n * 64 + l_, a.ssd_conv_w + (size_t)l * 4 * 768 + ch, 768, a.ssd_conv_b + l * 768 + ch, xc);
                const u32x4 z8 = *(const u32x4*)(P + T * NP + PC_SSD_Z + ch);
                const float zf[8] = {bflo(z8.x), bfhi(z8.x), bflo(z8.y), bfhi(z8.y), bflo(z8.z), bfhi(z8.z), bflo(z8.w), bfhi(z8.w)};
#pragma unroll
                for (int j = 0; j < 8; ++j) { const float ov = otile_ld(lds + hq * 8192, l_, p0 + c8 * 8 + j); const float yv = (ov + dsk * xc[j]) * silu_(zf[j]); y[c8 * 8 + j] = yv; ss += yv * yv; } }
            ss += __shfl_xor(ss, 1); ss += __shfl_xor(ss, 2); ss += __shfl_xor(ss, 4);
            const float rs = rsqrtf(ss * (1.f / 256.f) + 1e-6f);
            const float* ng = a.ssd_norm + l * 512 + hh * 64 + p0;
            bf16_t* yp = Y + ((size_t)2 * NTOK + T) * 512 + hh * 64 + p0;
#pragma unroll
            for (int c8 = 0; c8 < 4; ++c8) { float t[8];
#pragma unroll
                for (int j = 0; j < 8; ++j) t[j] = y[c8 * 8 + j] * rs * ng[c8 * 8 + j];
                *(u32x4*)(yp + c8 * 8) = (u32x4){pk2(t[0], t[1]), pk2(t[2], t[3]), pk2(t[4], t[5]), pk2(t[6], t[7])}; }
            __syncthreads();
        }
    }
}
DI CArgs& load_args() { CArgs* p = (CArgs*)__builtin_amdgcn_kernarg_segment_ptr(); asm volatile("" : "+s"(p)); return *p; }
DI void grid_sync(LAS unsigned char* lds) {
    CArgs& a = load_args(); XcdBarrier b; b.bar = (unsigned*)(a.ws + WS_CTL); b.x = xb_xcc_id(); b.st = (volatile LAS unsigned*)(lds + LDS_CTRL); xcd_barrier(b); }
__global__ void __launch_bounds__(NTHREADS, 2) fwd_kernel(Args a_unused) {
    extern __shared__ __attribute__((aligned(16))) unsigned char lds_raw[];
    LAS unsigned char* lds = (LAS unsigned char*)lds_raw;
    const int tid = ltid();
    if (tid < 256) ((LAS unsigned*)(lds + LDS_CTRL))[tid] = 0u;
    __syncthreads();
    { CArgs& a = load_args(); (void)xcd_barrier_post((unsigned*)(a.ws + WS_CTL), (volatile LAS unsigned*)(lds + LDS_CTRL)); }
    const int G = lgrid(), c = lbid();
#ifndef REP_CVT
#define REP_CVT 1
#endif
#ifndef REP_INPROJ
#define REP_INPROJ 1
#endif
#ifndef REP_PREP
#define REP_PREP 1
#endif
#ifndef REP_SCAN
#define REP_SCAN 1
#endif
#ifndef REP_POST
#define REP_POST 1
#endif
#ifndef REP_BR
#define REP_BR 1
#endif
#ifndef REP_OUT
#define REP_OUT 1
#endif
#ifndef REP_GU
#define REP_GU 1
#endif
#ifndef REP_DN
#define REP_DN 1
#endif
#ifndef REP_COMB
#define REP_COMB 1
#endif
#define REPEAT(n) for (int rep_ = 0; rep_ < (n); ++rep_)
    { CArgs& a = load_args(); phase_mod(a, lds); }
    REPEAT(REP_CVT) { CArgs& a = load_args(); phase_cvt(a, lds); }
    grid_sync(lds);
    { CArgs& a = load_args(); phase_norm0(a); }
#if INPROJ_I8
    { CArgs& a = load_args(); phase_cvt_win_i8(a, lds); }
#endif
    grid_sync(lds);
    for (int l = 0; l < 2; ++l) {
        REPEAT(REP_INPROJ) {
        { CArgs& a = load_args(); char* r1 = a.ws + WS_R1;
#if INPROJ_I8
          pg8::StaticOrder S; S.init(NTOK, NP, DM / 2, G, c, a.ws + WS_H, a.ws + WS_WIN + (size_t)l * NP * DM);
          EpiProj E{(bf16_t*)(r1 + R1_PROJ), (float*)(a.ws + WS_SMALL), (const float*)(a.ws + WS_SA), (const float*)(a.ws + WS_COLMAX) + l * NP};
          pg8::gemm_phase<EpiProj, pg8::StaticOrder, 2>(lds, DM / 2, S, E);
#else
          pg8::StaticOrder S; S.init(NTOK, NP, DM, G, c, a.ws + WS_H, a.ws + WS_WIN + (size_t)l * NP * DM * 2);
          EpiProj E{(bf16_t*)(r1 + R1_PROJ), (float*)(a.ws + WS_SMALL), nullptr, nullptr};
          pg8::gemm_phase<EpiProj, pg8::StaticOrder>(lds, DM, S, E);
#endif
        }
        grid_sync(lds); }
        REPEAT(REP_PREP) { { CArgs& a = load_args(); phase_prep(a, l, lds); }
        grid_sync(lds); }
        REPEAT(REP_SCAN) { { CArgs& a = load_args(); phase_scan(a, lds); }
        grid_sync(lds); }
        REPEAT(REP_POST) { { CArgs& a = load_args(); phase_post(a, l, lds); }
        grid_sync(lds); }
        REPEAT(REP_BR) {
        { CArgs& a = load_args(); char* r1 = a.ws + WS_R1;
          pg8::BranchOrder S; S.init(NTOK, DM, 512, G, c, r1 + R1_YMIX, a.ws + WS_WBR + (size_t)l * 3 * DM * 512 * 2); S.pn_per_a = 4; S.a_pnstride = (size_t)NTOK * 512 * 2;
          EpiGate E{(const bf16_t*)(r1 + R1_PROJ), a.b_merge + l * 3072, (bf16_t*)(r1 + R1_GATED), (bf16_t*)(r1 + R1_MERGED)};
          pg8::gemm_phase<EpiGate, pg8::BranchOrder>(lds, 512, S, E); }
        grid_sync(lds); }
        REPEAT(REP_OUT) {
        { CArgs& a = load_args(); char* r1 = a.ws + WS_R1;
          pg8::StaticOrder S; S.init(NTOK, DM, DM, G, c, r1 + R1_MERGED, a.ws + WS_WOUT + (size_t)l * DM * DM * 2);
          EpiResid E{(l == 0) ? a.x : (const float*)(a.ws + WS_XB), (float*)(a.ws + WS_XA), (const float*)(a.ws + WS_MOD) + (size_t)l * 8 * 6144 + 2048};
          pg8::gemm_phase<EpiResid, pg8::StaticOrder>(lds, DM, S, E); }
        grid_sync(lds); }
        { CArgs& a = load_args(); phase_router(a, l, (const float*)(a.ws + WS_XA), lds); }
        grid_sync(lds);
        REPEAT(REP_GU) {
        { CArgs& a = load_args(); char* r1 = a.ws + WS_R1;
          moe_tables((const int*)(a.ws + WS_CNT) + l * 32 * 64, lds);
          MoeOrder<true> S{8, G, c, (const LAS int*)(lds + LDS_CTRL + 64), (const LAS int*)(lds + LDS_CTRL + 256), (const char*)(a.ws + WS_H), a.ws + WS_WGU + (size_t)l * NEXP * 2048 * DM,
                           (size_t)2048 * DM, (size_t)256 * DM, (const int*)(a.ws + WS_ROWTOK)};
          EpiSwiglu E{(unsigned char*)(r1 + R1_ACT), a.b_gu + (size_t)l * NEXP * 2048};
          pg8::gemm_phase<EpiSwiglu, MoeOrder<true>, 1>(lds, DM / 2, S, E); }
        grid_sync(lds); }
        REPEAT(REP_DN) {
        { CArgs& a = load_args(); char* r1 = a.ws + WS_R1;
          MoeOrder<false> S{4, G, c, (const LAS int*)(lds + LDS_CTRL + 64), (const LAS int*)(lds + LDS_CTRL + 256), (const char*)(r1 + R1_ACT), a.ws + WS_WDN + (size_t)l * NEXP * DM * DM,
                            (size_t)DM * DM, (size_t)256 * DM, nullptr};
          EpiDown E{(bf16_t*)(r1 + R1_YS), a.b_dn + (size_t)l * NEXP * DM};
          pg8::gemm_phase<EpiDown, MoeOrder<false>, 1>(lds, DM / 2, S, E); }
        grid_sync(lds); }
        REPEAT(REP_COMB) { { CArgs& a = load_args(); phase_combine(a, l, (const float*)(a.ws + WS_XA), (float*)(a.ws + WS_XB), lds); }
        grid_sync(lds); }
    }
}

extern "C" void kernel_launch(void* const* d_in, const int* in_sizes, int n_in, void* d_out, int out_size, void* d_ws, size_t ws_size, hipStream_t stream) {
    static int grid = 0;
    if (grid == 0) {
        if (n_in != 32 || ws_size < WS_END) { fprintf(stderr, "kernel_launch: unexpected inputs (n_in %d, ws %zu, need %zu)\n", n_in, ws_size, (size_t)WS_END); grid = -1; return; }
        int dev = 0, cus = 0, per_cu = 0;
        if (hipGetDevice(&dev) != hipSuccess || hipDeviceGetAttribute(&cus, hipDeviceAttributeMultiprocessorCount, dev) != hipSuccess) { grid = -1; return; }
        if (hipFuncSetAttribute((const void*)fwd_kernel, hipFuncAttributeMaxDynamicSharedMemorySize, LDS_BYTES) != hipSuccess) { fprintf(stderr, "kernel_launch: hipFuncSetAttribute failed\n"); grid = -1; return; }
        if (hipOccupancyMaxActiveBlocksPerMultiprocessor(&per_cu, (const void*)fwd_kernel, NTHREADS, LDS_BYTES) != hipSuccess || per_cu < 1) { fprintf(stderr, "kernel_launch: occupancy query says %d\n", per_cu); grid = -1; return; }
        grid = cus;
    }
    if (grid < 0) return;
    (void)hipMemsetAsync((char*)d_ws + WS_CTL, 0, 65536, stream);
    (void)hipMemsetAsync((char*)d_ws + WS_COLMAX, 0, 65536, stream);
    Args a{};
    const float** pp = (const float**)&a;
    for (int i = 0; i < 32; ++i) pp[i] = (const float*)d_in[i];
    a.out = (float*)d_out; a.ws = (char*)d_ws;
    hipLaunchKernelGGL(fwd_kernel, dim3(grid), dim3(NTHREADS), LDS_BYTES, stream, a);
}
```

```cpp
#include <hip/hip_runtime.h>
#include <cstdio>
#include <cstdint>
#define DI __device__ __forceinline__
#define LAS __attribute__((address_space(3)))
typedef unsigned short bf16_t;
typedef short bf16x8 __attribute__((ext_vector_type(8)));
typedef float f32x4 __attribute__((ext_vector_type(4)));
typedef float f32x2 __attribute__((ext_vector_type(2)));
typedef float f32x16 __attribute__((ext_vector_type(16)));
typedef unsigned u32x4 __attribute__((ext_vector_type(4)));
typedef unsigned u32x2 __attribute__((ext_vector_type(2)));
typedef __bf16 hbf16x2 __attribute__((ext_vector_type(2)));

DI int ltid() { int t = threadIdx.x; asm volatile("" : "+v"(t)); return t; }
constexpr int LDS_VID_OFF = 155648 - 1024 + 896;
DI int lbid() { extern __shared__ __attribute__((aligned(16))) unsigned char lds_vid_[]; int t = *(const volatile LAS int*)((LAS unsigned char*)lds_vid_ + LDS_VID_OFF); t = __builtin_amdgcn_readfirstlane(t); asm volatile("" : "+s"(t)); return t; }
DI int lgrid() { int t = gridDim.x; asm volatile("" : "+s"(t)); return t; }
DI void lds_barrier() { asm volatile("s_waitcnt lgkmcnt(0)" ::: "memory"); __builtin_amdgcn_s_barrier(); asm volatile("" ::: "memory"); }
DI unsigned pk2(float a, float b) { f32x2 v = {a, b}; hbf16x2 r = __builtin_convertvector(v, hbf16x2); return __builtin_bit_cast(unsigned, r); }
DI float bflo(unsigned w) { return __uint_as_float(w << 16); }
DI float bfhi(unsigned w) { return __uint_as_float(w & 0xffff0000u); }
DI float bf2f(bf16_t v) { return __uint_as_float(((unsigned)v) << 16); }
DI bf16_t f2bf(float a) { return (bf16_t)(pk2(a, 0.f) & 0xffffu); }
DI float sigmoid_(float x) { return __builtin_amdgcn_rcpf(1.f + __expf(-x)); }
DI float silu_(float x) { return x * __builtin_amdgcn_rcpf(1.f + __expf(-x)); }
DI float softplus_(float x) { return fmaxf(x, 0.f) + log1pf(__expf(-fabsf(x))); }

#ifndef GEMM_ALIGN
#define GEMM_ALIGN true
#endif
#ifndef PG8_WGM
#define PG8_WGM 4
#endif
namespace pg8 {
constexpr int BM = 256, BK = 64, HALF = 128, HTB = HALF * BK * 2, STAGE_BYTES = 8 * HTB, NXCD = 8, WGM = PG8_WGM;
__host__ __device__ __forceinline__ int lds_byte(int r, int c) { const int st = (r >> 4) * 2 + (c >> 5), rr = r & 15, cc = c & 31, ob = rr * 64 + cc * 2; return st * 1024 + (ob ^ (((ob >> 9) & 1) << 5)); }
__host__ __device__ __forceinline__ void stage_rc(int b, int& R, int& C) { const int st = b / 1024, sb = b % 1024, swz = sb ^ (((sb >> 9) & 1) << 5); R = (st >> 1) * 16 + swz / 64; C = (st & 1) * 32 + (swz % 64) / 2; }
__host__ __device__ __forceinline__ int perm32(int rho) { const int n = rho >> 4, i = rho & 15; return 8 * (i >> 2) + 4 * n + (i & 3); }

struct Unit { int pm, pn, e, cnt, skip; };

struct StaticOrder {
    static constexpr bool GATHER = false;
    int nM, nN, nwg, G, c;
    const char* A; const char* Bt; size_t a_tstep, b_tstep, a_pnstride; int pn_per_a;
    DI void init(int M, int N, int K, int G_, int c_, const void* A_, const void* Bt_) { nM = M / BM; nN = N / BM; nwg = nM * nN; G = G_; c = c_; A = (const char*)A_; Bt = (const char*)Bt_; a_tstep = (size_t)BM * K * 2; b_tstep = (size_t)BM * K * 2; a_pnstride = 0; pn_per_a = 1 << 30; }
    DI bool next(int i, Unit& u) const {
        const long L = (long)i * G + c; if (L >= nwg) return false;
        int wgid = (int)L; { const int q = nwg / NXCD, r = nwg % NXCD, xcd = wgid % NXCD, off = wgid / NXCD; wgid = (xcd < r ? xcd * (q + 1) : r * (q + 1) + (xcd - r) * q) + off; }
        const int nig = WGM * nN, gid = wgid / nig, fm = gid * WGM, gsz = (nM - fm) < WGM ? (nM - fm) : WGM;
        u.pm = fm + ((wgid % nig) % gsz); u.pn = (wgid % nig) / gsz; u.e = 0; u.cnt = 256; u.skip = 0; return true;
    }
    DI const char* a_ptr(const Unit& u) const { return A + (size_t)(u.pn / pn_per_a) * a_pnstride + (size_t)u.pm * a_tstep; }
    DI const char* b_ptr(const Unit& u) const { return Bt + (size_t)u.pn * b_tstep; }
    DI int a_row(const Unit&, int) const { return 0; }
    DI const char* a_rowsrc(const Unit&) const { return A; }
};

typedef int i32x4 __attribute__((ext_vector_type(4)));
typedef int i32x8 __attribute__((ext_vector_type(8)));
struct DupOrder : StaticOrder {
    DI bool next(int i, Unit& u) const { if (!StaticOrder::next(i / 2, u)) return false; u.skip = (i & 1) == 0; return true; }
};
struct BranchOrder : StaticOrder {
    DI bool next(int i, Unit& u) const { if (!StaticOrder::next(i / 3, u)) return false; u.pn += 4 * (i % 3); return true; }
};
template <class Epi, class Sched, int MODE = 0  , bool ALIGN_EPI = GEMM_ALIGN, bool TA = false, bool TB = false>
DI void gemm_phase(LAS unsigned char* lds, const int K, const Sched& S, const Epi& E) {
    constexpr bool GATHER = Sched::GATHER; constexpr bool FP8 = (MODE == 1);
#ifndef GEMM_RELAX
#define GEMM_RELAX 0
#endif
    const bool RELAX = GEMM_RELAX && (K / BK >= 4);
    const int tid = ltid(), wid = __builtin_amdgcn_readfirstlane(tid >> 6), lane = tid & 63, wr = wid >> 2, wc = wid & 3, fr = lane & 15, fq = lane >> 4;
    const int nt = K / BK;
    unsigned voffA[2], voffB[2]; int RA[2], CA[2];
#pragma unroll
    for (int i = 0; i < 2; ++i) { int R, C; stage_rc(tid * 16 + i * 8192, R, C); const int Rb = Epi::PERM ? ((R & ~31) + perm32(R & 31)) : R; RA[i] = R; CA[i] = C;
        voffA[i] = TA ? (unsigned)(R * 128 + C * 2) : (unsigned)(R * K + C) * 2u; voffB[i] = TB ? (unsigned)(Rb * 128 + C * 2) : (unsigned)(Rb * K + C) * 2u; }
    const size_t kstepA = TA ? (size_t)32768 : (size_t)(BK * 2), kstepB = TB ? (size_t)32768 : (size_t)(BK * 2);
    const size_t hstepB = TB ? (size_t)HALF * 128 : (size_t)HALF * K * 2;
    const size_t hstepA = GATHER ? 0 : (TA ? (size_t)HALF * 128 : (size_t)HALF * K * 2);
    const unsigned ldsw = (unsigned)wid * 1024u;
    const int aoff = lds_byte(wr * 64 + fr, fq * 8), boff = lds_byte(wc * 32 + fr, fq * 8);
#define PG8_SA(b, h) (((b) * 2 + (h)) * HTB)
#define PG8_SB(b, h) ((4 + (b) * 2 + (h)) * HTB)
#define PG8_STAGE(bufoff, gbase, voff) do { _Pragma("unroll") for (int _i = 0; _i < 2; ++_i) \
        __builtin_amdgcn_global_load_lds((const unsigned*)((const char*)(gbase) + (voff)[_i]), (LAS unsigned*)(lds + (bufoff) + ldsw + _i * 8192), 16, 0, 0); } while (0)
#define PG8_CAT(x, y) __builtin_shufflevector(__builtin_bit_cast(i32x4, x), __builtin_bit_cast(i32x4, y), 0, 1, 2, 3, 4, 5, 6, 7)
#define PG8_LDA8(dst, b, h) do { _Pragma("unroll") for (int m = 0; m < 4; ++m) dst[m] = PG8_CAT(*(const LAS bf16x8*)(lds + PG8_SA(b, h) + aoff + m * 2048), *(const LAS bf16x8*)(lds + PG8_SA(b, h) + aoff + m * 2048 + 1024)); } while (0)
#define PG8_LDB8(dst, b, h) do { _Pragma("unroll") for (int n = 0; n < 2; ++n) dst[n] = PG8_CAT(*(const LAS bf16x8*)(lds + PG8_SB(b, h) + boff + n * 2048), *(const LAS bf16x8*)(lds + PG8_SB(b, h) + boff + n * 2048 + 1024)); } while (0)
#define PG8_MMA8(ai, bj, At, Bt) do { __builtin_amdgcn_s_setprio(1); _Pragma("unroll") for (int m = 0; m < 4; ++m) _Pragma("unroll") for (int n = 0; n < 2; ++n) \
        asm volatile("v_mfma_scale_f32_16x16x128_f8f6f4 %0, %1, %2, %0, %3, %3 op_sel_hi:[0,0,0]" : "+v"(acc[ai][bj][m][n]) : "v"(Bt[n]), "v"(At[m]), "v"(one_scale)); __builtin_amdgcn_s_setprio(0); } while (0)
#define PG8_LDA(dst, b, h) do { _Pragma("unroll") for (int m = 0; m < 4; ++m) _Pragma("unroll") for (int k = 0; k < 2; ++k) dst[m][k] = *(const LAS bf16x8*)(lds + PG8_SA(b, h) + aoff + m * 2048 + k * 1024); } while (0)
#define PG8_LDB(dst, b, h) do { _Pragma("unroll") for (int n = 0; n < 2; ++n) _Pragma("unroll") for (int k = 0; k < 2; ++k) dst[n][k] = *(const LAS bf16x8*)(lds + PG8_SB(b, h) + boff + n * 2048 + k * 1024); } while (0)
#define PG8_MMA(ai, bj, At, Bt) do { __builtin_amdgcn_s_setprio(1); _Pragma("unroll") for (int m = 0; m < 4; ++m) _Pragma("unroll") for (int n = 0; n < 2; ++n) _Pragma("unroll") for (int k = 0; k < 2; ++k) { \
        if constexpr (MODE == 2) acc[ai][bj][m][n] = __builtin_bit_cast(f32x4, __builtin_amdgcn_mfma_i32_16x16x64_i8(__builtin_bit_cast(i32x4, Bt[n][k]), __builtin_bit_cast(i32x4, At[m][k]), __builtin_bit_cast(i32x4, acc[ai][bj][m][n]), 0, 0, 0)); \
        else acc[ai][bj][m][n] = __builtin_amdgcn_mfma_f32_16x16x32_bf16(Bt[n][k], At[m][k], acc[ai][bj][m][n], 0, 0, 0); } __builtin_amdgcn_s_setprio(0); } while (0)
#define PG8_WAIT_V(n) asm volatile("s_waitcnt vmcnt(" #n ")" ::: "memory")
#define PG8_WAIT_VI(N) asm volatile("s_waitcnt vmcnt(%0)" :: "n"(N) : "memory")
#define PG8_WAIT_SEL(N) do { if (first) PG8_WAIT_VI(N); else PG8_WAIT_V(8); } while (0)
#define PG8_WAIT_L(n) asm volatile("s_waitcnt lgkmcnt(" #n ")" ::: "memory")
#define PG8_BAR __builtin_amdgcn_s_barrier()
#define PG8_SCHED __builtin_amdgcn_sched_barrier(0)
    Unit cur, nxt; int ui = 0;
    if (!S.next(0, cur)) return;
#ifndef STAGGER_CYC
#define STAGGER_CYC 0
#endif
    if (STAGGER_CYC > 0) { const long long t0 = clock64(); const long long dl = (long long)((lbid() >> 3) & 7) * STAGGER_CYC;
        while (clock64() - t0 < dl) __builtin_amdgcn_s_sleep(4); }
    f32x4 acc[2][2][4][2];
#pragma unroll
    for (int a = 0; a < 2; ++a)
#pragma unroll
        for (int b = 0; b < 2; ++b)
#pragma unroll
            for (int m = 0; m < 4; ++m)
#pragma unroll
                for (int n = 0; n < 2; ++n) acc[a][b][m][n] = (f32x4){0.f, 0.f, 0.f, 0.f};
    bf16x8 At[4][2], B0[2][2], B1[2][2]; i32x8 Ct[4], C0[2], C1[2]; const int one_scale = 0x7f7f7f7f;
    const char* cA = S.a_ptr(cur); const char* cB = S.b_ptr(cur);
    unsigned vC0[2], vC1[2], vN0[2], vN1[2];
    if constexpr (GATHER) {
#pragma unroll
        for (int i = 0; i < 2; ++i) { vC0[i] = (unsigned)(S.a_row(cur, RA[i]) * K + CA[i]) * 2u; vC1[i] = (unsigned)(S.a_row(cur, HALF + RA[i]) * K + CA[i]) * 2u; vN0[i] = vC0[i]; vN1[i] = vC1[i]; }
    } else {
#pragma unroll
        for (int i = 0; i < 2; ++i) { vC0[i] = voffA[i]; vC1[i] = voffA[i]; vN0[i] = voffA[i]; vN1[i] = voffA[i]; }
    }
    PG8_STAGE(PG8_SB(0, 0), cB, voffB); PG8_STAGE(PG8_SB(0, 1), cB + hstepB, voffB); PG8_STAGE(PG8_SA(0, 0), cA, vC0); PG8_STAGE(PG8_SA(0, 1), cA + hstepA, vC1);
    if (wr == 1) PG8_BAR;
    PG8_WAIT_V(2); PG8_BAR;
    PG8_STAGE(PG8_SB(1, 0), cB + kstepB, voffB); PG8_STAGE(PG8_SA(1, 0), cA + kstepA, vC0); PG8_STAGE(PG8_SB(1, 1), cB + hstepB + kstepB, voffB);
    PG8_WAIT_V(6); PG8_BAR;
    for (;;) {
        const bool has_next = S.next(ui + 1, nxt);
        const char* nA = has_next ? S.a_ptr(nxt) : cA; const char* nB = has_next ? S.b_ptr(nxt) : cB;
#pragma unroll 1
        for (int t = 0; t < nt; t += 2) {
            const bool last = (t == nt - 2);
            const char* a1 = cA + (size_t)(t + 1) * kstepA;
            const char* a2 = last ? nA : cA + (size_t)(t + 2) * kstepA; const char* b2 = last ? nB : cB + (size_t)(t + 2) * kstepB;
            const char* a3 = a2 + kstepA; const char* b3 = b2 + kstepB;
            if constexpr (GATHER) { if (last && has_next) { const LAS int* tab = (const LAS int*)(lds + STAGE_BYTES + 4096 + ((ui + 1) & 1) * 1024);
#pragma unroll
                    for (int i = 0; i < 2; ++i) { const int r0 = RA[i] < nxt.cnt ? tab[RA[i]] : 0, r1 = (HALF + RA[i]) < nxt.cnt ? tab[HALF + RA[i]] : 0; vN0[i] = (unsigned)(r0 * K + CA[i]) * 2u; vN1[i] = (unsigned)(r1 * K + CA[i]) * 2u; } } }
            unsigned w0[2], w1[2];
            if constexpr (GATHER) { w0[0] = last ? vN0[0] : vC0[0]; w0[1] = last ? vN0[1] : vC0[1]; w1[0] = last ? vN1[0] : vC1[0]; w1[1] = last ? vN1[1] : vC1[1]; }
            else { w0[0] = voffA[0]; w0[1] = voffA[1]; w1[0] = voffA[0]; w1[1] = voffA[1]; }
            if constexpr (GATHER) { if (t == 0 && has_next && wid == 2) __builtin_amdgcn_global_load_lds((const unsigned*)(S.a_rowsrc(nxt) + lane * 16), (LAS unsigned*)(lds + STAGE_BYTES + 4096 + ((ui + 1) & 1) * 1024), 16, 0, 0);
}
            if (t == 0) { if (wid == 0) __builtin_amdgcn_global_load_lds((const unsigned*)(E.cvec(cur, 0) + lane * 16), (LAS unsigned*)(lds + STAGE_BYTES + (ui & 1) * 2048), 16, 0, 0);
                if (Epi::NC > 1 && wid == 1) __builtin_amdgcn_global_load_lds((const unsigned*)(E.cvec(cur, 1) + lane * 16), (LAS unsigned*)(lds + STAGE_BYTES + (ui & 1) * 2048 + 1024), 16, 0, 0); }
            const bool first = RELAX && (t == 0) && (ui > 0);
            if constexpr (FP8) {
            PG8_LDB8(C0, 0, 0); PG8_LDB8(C1, 0, 1); PG8_SCHED; PG8_LDA8(Ct, 0, 0); if (!first) PG8_STAGE(PG8_SA(1, 1), a1 + hstepA, vC1);
            PG8_WAIT_SEL(Epi::NST + 2); PG8_WAIT_L(0); PG8_BAR; PG8_MMA8(0, 0, Ct, C0); PG8_MMA8(0, 1, Ct, C1); PG8_BAR; PG8_SCHED;
            PG8_LDA8(Ct, 0, 1); PG8_STAGE(PG8_SB(0, 0), b2, voffB); PG8_STAGE(PG8_SB(0, 1), b2 + hstepB, voffB); PG8_STAGE(PG8_SA(0, 0), a2, w0);
            PG8_WAIT_SEL(Epi::NST + 8); PG8_WAIT_L(0); PG8_BAR; PG8_MMA8(1, 0, Ct, C0); PG8_MMA8(1, 1, Ct, C1); PG8_BAR; PG8_SCHED;
            PG8_LDB8(C0, 1, 0); PG8_LDB8(C1, 1, 1); PG8_SCHED; PG8_LDA8(Ct, 1, 0); PG8_STAGE(PG8_SA(0, 1), a2 + hstepA, w1);
            PG8_WAIT_SEL(Epi::NST + 8); PG8_WAIT_L(0); PG8_BAR; PG8_MMA8(0, 0, Ct, C0); PG8_MMA8(0, 1, Ct, C1); PG8_BAR; PG8_SCHED;
            PG8_LDA8(Ct, 1, 1); PG8_STAGE(PG8_SB(1, 0), b3, voffB); PG8_STAGE(PG8_SB(1, 1), b3 + hstepB, voffB); PG8_STAGE(PG8_SA(1, 0), a3, w0);
            PG8_WAIT_V(8); PG8_WAIT_L(0); PG8_BAR; PG8_MMA8(1, 0, Ct, C0); PG8_MMA8(1, 1, Ct, C1); PG8_BAR; PG8_SCHED;
                    } else {
            PG8_LDB(B0, 0, 0); PG8_LDB(B1, 0, 1); PG8_SCHED; PG8_LDA(At, 0, 0); if (!first) PG8_STAGE(PG8_SA(1, 1), a1 + hstepA, vC1);
            PG8_WAIT_SEL(Epi::NST + 2); PG8_WAIT_L(0); PG8_BAR; PG8_MMA(0, 0, At, B0); PG8_MMA(0, 1, At, B1); PG8_BAR; PG8_SCHED;
            PG8_LDA(At, 0, 1); PG8_STAGE(PG8_SB(0, 0), b2, voffB); PG8_STAGE(PG8_SB(0, 1), b2 + hstepB, voffB); PG8_STAGE(PG8_SA(0, 0), a2, w0);
            PG8_WAIT_SEL(Epi::NST + 8); PG8_WAIT_L(0); PG8_BAR; PG8_MMA(1, 0, At, B0); PG8_MMA(1, 1, At, B1); PG8_BAR; PG8_SCHED;
            PG8_LDB(B0, 1, 0); PG8_LDB(B1, 1, 1); PG8_SCHED; PG8_LDA(At, 1, 0); PG8_STAGE(PG8_SA(0, 1), a2 + hstepA, w1);
            PG8_WAIT_SEL(Epi::NST + 8); PG8_WAIT_L(0); PG8_BAR; PG8_MMA(0, 0, At, B0); PG8_MMA(0, 1, At, B1); PG8_BAR; PG8_SCHED;
            PG8_LDA(At, 1, 1); PG8_STAGE(PG8_SB(1, 0), b3, voffB); PG8_STAGE(PG8_SB(1, 1), b3 + hstepB, voffB); PG8_STAGE(PG8_SA(1, 0), a3, w0);
            PG8_WAIT_V(8); PG8_WAIT_L(0); PG8_BAR; PG8_MMA(1, 0, At, B0); PG8_MMA(1, 1, At, B1); PG8_BAR; PG8_SCHED;
                    }
            if (RELAX && last && has_next) PG8_STAGE(PG8_SA(1, 1), a3 + hstepA, w1);
        }
        if constexpr (FP8) asm volatile("s_nop 15\n\ts_nop 15" ::: "memory");
        if constexpr (ALIGN_EPI) { if (wr == 0) PG8_BAR; }
        if (!cur.skip) E(acc, cur, wr, wc, fr, fq, (const LAS float*)(lds + STAGE_BYTES + (ui & 1) * 2048));
#ifdef PROBE_EPI2
        E(acc, cur, wr, wc, fr, fq, (const LAS float*)(lds + STAGE_BYTES + (ui & 1) * 2048));
#endif
        if (!has_next) break;
        if (!Epi::keep(cur)) {
#pragma unroll
        for (int a = 0; a < 2; ++a)
#pragma unroll
            for (int b = 0; b < 2; ++b)
#pragma unroll
                for (int m = 0; m < 4; ++m)
#pragma unroll
                    for (int n = 0; n < 2; ++n) acc[a][b][m][n] = (f32x4){0.f, 0.f, 0.f, 0.f}; }
        cur = nxt; cA = nA; cB = nB; ++ui;
        if constexpr (GATHER) { vC0[0] = vN0[0]; vC0[1] = vN0[1]; vC1[0] = vN1[0]; vC1[1] = vN1[1]; }
        if constexpr (ALIGN_EPI) { if (wr == 1) PG8_BAR; }
    }
    PG8_WAIT_V(0);
    if constexpr (!ALIGN_EPI) { if (wr == 0) PG8_BAR; }
    PG8_BAR;
#undef PG8_SA
#undef PG8_SB
#undef PG8_STAGE
#undef PG8_LDA
#undef PG8_LDA8
#undef PG8_LDB8
#undef PG8_MMA8
#undef PG8_CAT
#undef PG8_LDB
#undef PG8_MMA
#undef PG8_WAIT_V
#undef PG8_WAIT_VI
#undef PG8_WAIT_SEL
#undef PG8_WAIT_L
#undef PG8_BAR
#undef PG8_SCHED
}
}
using pg8::Unit;

#define XB_TMO      128
#define XB_XCNT(j)  (256  + 64 * (j))
#define XB_XSUB(j)  (1280 + 64 * (j))
#define XB_XGEN(j)  (2304 + 64 * (j))
#define XB_TOP      3328
#define XB_TOPGEN   3392
#define XCD_BAR_WORDS 3456
#define XB_SPIN_CAP (1u << 18)
DI unsigned xb_ld(unsigned* p)              { return __hip_atomic_load(p, __ATOMIC_RELAXED, __HIP_MEMORY_SCOPE_AGENT); }
DI unsigned xb_add(unsigned* p, unsigned v) { return __hip_atomic_fetch_add(p, v, __ATOMIC_RELAXED, __HIP_MEMORY_SCOPE_AGENT); }
DI unsigned xb_xcc_id() { return (unsigned)__builtin_amdgcn_s_getreg((3 << 11) | 20) & 0xFu; }
#define XB_SPIN(cond, bar) do { unsigned _sp = 0; while (cond) { __builtin_amdgcn_s_sleep(1); \
    if ((++_sp & 255u) == 0u) { if (xb_ld(&(bar)[XB_TMO])) break; if (_sp > XB_SPIN_CAP) { atomicAdd(&(bar)[XB_TMO], 1u); break; } } } } while (0)
struct XcdBarrier { unsigned* bar; unsigned x; volatile LAS unsigned* st; };
DI XcdBarrier xcd_barrier_post(unsigned* bar, volatile LAS unsigned* st) {
    XcdBarrier b; b.bar = bar; b.x = xb_xcc_id(); b.st = st;
    if (threadIdx.x == 0) st[8] = xb_add(&bar[XB_XCNT(b.x)], 1u);
    return b;
}
DI void xcd_barrier_complete(unsigned* bar, unsigned x, unsigned& nloc, unsigned& nx) {
    const unsigned G = gridDim.x * gridDim.y * gridDim.z;
    unsigned sum, cnt, mine, sp = 0u;
    for (;;) {
        sum = 0u; cnt = 0u; mine = 0u;
#pragma unroll
        for (unsigned j = 0; j < 16; ++j) { const unsigned c = xb_ld(&bar[XB_XCNT(j)]); sum += c; cnt += (c > 0u) ? 1u : 0u; mine = (j == x) ? c : mine; }
        if (sum == G) break;
        __builtin_amdgcn_s_sleep(1);
        if ((++sp & 255u) == 0u) { if (xb_ld(&bar[XB_TMO])) break; if (sp > XB_SPIN_CAP) { atomicAdd(&bar[XB_TMO], 1u); break; } }
    }
    nloc = mine > 0u ? mine : 1u; nx = cnt > 0u ? cnt : 1u;
}
DI void xcd_barrier(const XcdBarrier& b) {
    asm volatile("s_waitcnt vmcnt(0)" ::: "memory");
    __syncthreads();
    if (threadIdx.x == 0) {
        unsigned* bar = b.bar;
        __builtin_amdgcn_s_waitcnt(0);
        unsigned nloc = b.st[0], nx = b.st[1];
        if (nloc == 0u) { xcd_barrier_complete(bar, b.x, nloc, nx); b.st[0] = nloc; b.st[1] = nx; }
        const unsigned old = xb_add(&bar[XB_XSUB(b.x)], 1u);
        const unsigned gen = old / nloc;
        if (old + 1u == (gen + 1u) * nloc) {
            __builtin_amdgcn_fence(__ATOMIC_RELEASE, "agent");
            asm volatile("s_waitcnt vmcnt(0)" ::: "memory");
            const unsigned og = xb_add(&bar[XB_TOP], 1u);
            const unsigned tg = og / nx;
            if (og + 1u == (tg + 1u) * nx) xb_add(&bar[XB_TOPGEN], 1u);
            else XB_SPIN(xb_ld(&bar[XB_TOPGEN]) == tg, bar);
            __builtin_amdgcn_fence(__ATOMIC_ACQUIRE, "agent");
            xb_add(&bar[XB_XGEN(b.x)], 1u);
            asm volatile("s_waitcnt vmcnt(0)" ::: "memory");
        } else {
            XB_SPIN(xb_ld(&bar[XB_XGEN(b.x)]) == gen, bar);
            __builtin_amdgcn_fence(__ATOMIC_ACQUIRE, "agent");
            asm volatile("s_waitcnt vmcnt(0)" ::: "memory");
        }
    }
    __syncthreads();
}
constexpr int DM = 1024, NB = 8, SEQ = 4096, NTOK = NB * SEQ, NCHUNK = 64, NP = 8192, NEXP = 32;
constexpr int PC_GLA_Q = 0, PC_GLA_K = 256, PC_GLA_V = 512, PC_GLA_R = 1024, PC_GDN_QKV = 1536, PC_GDN_G = 3072, PC_SSD_Z = 3584, PC_SSD_XBC = 4096, PC_MERGE = 4864, PC_SMALL = 7936;
constexpr int IN_COLS = 7968;
constexpr int NTHREADS = 512;
#ifndef INPROJ_I8
#define INPROJ_I8 1
#endif
#ifndef BRANCH_FP8
#define BRANCH_FP8 1
#endif
constexpr int LDS_BYTES = 155648;
constexpr int LDS_CTRL = LDS_BYTES - 1024;
static_assert(LDS_VID_OFF == LDS_CTRL + 896, "virtual workgroup id word");
constexpr int GLA_UNIT = 41984, GDN_UNIT = 74752, SSD_UNIT = 33792;
constexpr int GLA_OQ = 0, GLA_OP = 8192, GLA_OK = 16384, GLA_OU = 24576, GLA_OD = 40960;
constexpr int GDN_OQ = 0, GDN_OW = 16384, GDN_OP = 32768, GDN_OK = 40960, GDN_OU = 57344, GDN_OD = 73728;
constexpr int SSD_OQ = 0, SSD_OP = 8192, SSD_OK = 16384, SSD_OU = 24576, SSD_OD = 32768;
constexpr size_t WS_CTL = 0, WS_CNT = 16384, WS_COLMAX = 65536, WS_MOD = 131072;
constexpr size_t WS_WIN = 524288, WS_WBR = WS_WIN + 33554432ull, WS_WOUT = WS_WBR + 6291456ull, WS_WGU = WS_WOUT + 12582912ull, WS_WDN = WS_WGU + 268435456ull;
constexpr size_t WS_H = WS_WDN + 134217728ull, WS_SMALL = WS_H + 67108864ull, WS_XA = WS_SMALL + 4194304ull, WS_XB = WS_XA + 134217728ull;
constexpr size_t WS_ROWTOK = WS_XB + 134217728ull, WS_TOKSLOT = WS_ROWTOK + 4194304ull, WS_GATES = WS_TOKSLOT + 524288ull, WS_TSCR = WS_GATES + 524288ull, WS_R1 = WS_TSCR + 16777216ull;
constexpr size_t R1_PROJ = 0, R1_SGLA = 536870912ull, R1_SGDN = R1_SGLA + 2048ull * GLA_UNIT, R1_SSSD = R1_SGDN + 2048ull * GDN_UNIT, R1_OBUF = R1_SSSD + 4096ull * SSD_UNIT;
constexpr size_t R1_YMIX = R1_OBUF + 100663296ull, R1_MERGED = R1_YMIX + 100663296ull, R1_XCONV = R1_MERGED + 67108864ull, R1_MG8 = R1_XCONV + 33554432ull, R1_END = R1_MG8 + 100663296ull,
 R1_GATED = R1_SGLA, R1_ACT = 0, R1_YS = 285212672ull;
constexpr size_t WS_SA = WS_R1 + R1_END, WS_END = WS_SA + 131072;
constexpr size_t OB_GLA = 0, OB_GDN = 33554432ull, OB_SSD = 67108864ull;

struct Args {
    const float *x, *c, *w_mod, *b_mod, *norm_mix, *norm_ffn, *norm_final, *w_in, *gla_w2, *gla_b2, *gla_norm, *gdn_conv_w, *gdn_a_log, *gdn_dt_bias, *gdn_norm,
        *ssd_conv_w, *ssd_conv_b, *ssd_a_log, *ssd_dt_bias, *ssd_d, *ssd_norm, *w_br_gla, *w_br_gdn, *w_br_ssd, *b_merge, *w_out, *w_router, *b_router, *w_gu, *b_gu, *w_dn, *b_dn;
    float* out; char* ws;
};
typedef const Args __attribute__((address_space(4))) CArgs;

DI void phase_mod(CArgs& a, LAS unsigned char* lds) {
    LAS float* cact = (LAS float*)lds;
    LAS float* red = (LAS float*)(lds + 32768);
    const int tid = ltid();
    for (int i = tid; i < 8192; i += NTHREADS) cact[i] = silu_(a.c[i]);
    __syncthreads();
    float* mod = (float*)(a.ws + WS_MOD);
    for (int blk = lbid(); blk < 256; blk += lgrid()) {
        const int jj = tid & 63, ks = tid >> 6, col = blk * 48 + jj;
        float s[8];
#pragma unroll
        for (int b = 0; b < 8; ++b) s[b] = 0.f;
        if (jj < 48) {
            const int l = col / 6144, j = col % 6144;
            const float* w = a.w_mod + (size_t)l * DM * 6144 + j;
#pragma unroll 1
            for (int k0 = ks * 128; k0 < ks * 128 + 128; k0 += 16) { float wv[16];
#pragma unroll
                for (int i = 0; i < 16; ++i) wv[i] = w[(size_t)(k0 + i) * 6144];
#pragma unroll
                for (int i = 0; i < 16; ++i)
#pragma unroll
                    for (int b = 0; b < 8; ++b) s[b] += cact[b * 1024 + k0 + i] * wv[i]; }
        }
#pragma unroll
        for (int b = 0; b < 8; ++b) red[(ks * 64 + jj) * 8 + b] = s[b];
        __syncthreads();
        if (tid < 48 * 8) { const int j2 = tid >> 3, b = tid & 7, col2 = blk * 48 + j2, l = col2 / 6144, j = col2 % 6144; float t = 0.f;
#pragma unroll
            for (int k2 = 0; k2 < 8; ++k2) t += red[(k2 * 64 + j2) * 8 + b];
            mod[((size_t)l * 8 + b) * 6144 + j] = t + a.b_mod[l * 6144 + j]; }
        __syncthreads();
    }
}
DI int win_dst(int c) {
    if (c < 1024) return c;
    if (c < 1040) return PC_SMALL + (c - 1024);
    if (c < 1552) return PC_GLA_R + (c - 1040);
    if (c < 3088) return PC_GDN_QKV + (c - 1552);
    if (c < 3092) return PC_SMALL + 16 + (c - 3088);
    if (c < 3096) return PC_SMALL + 20 + (c - 3092);
    if (c < 3608) return PC_GDN_G + (c - 3096);
    if (c < 4120) return PC_SSD_Z + (c - 3608);
    if (c < 4888) return PC_SSD_XBC + (c - 4120);
    if (c < 4896) return PC_SMALL + 24 + (c - 4888);
    return PC_MERGE + (c - 4896);
}
DI unsigned pk4_fp8(float a, float b, float c, float d) { int w = 0; w = __builtin_amdgcn_cvt_pk_fp8_f32(a, b, w, false); w = __builtin_amdgcn_cvt_pk_fp8_f32(c, d, w, true); return (unsigned)w; }
DI unsigned pk4_i8(float a, float b, float c, float d) { const int x = (int)__builtin_rintf(a), y = (int)__builtin_rintf(b), z = (int)__builtin_rintf(c), w = (int)__builtin_rintf(d);
    return (unsigned)(x & 255) | ((unsigned)(y & 255) << 8) | ((unsigned)(z & 255) << 16) | ((unsigned)w << 24); }
DI float wave_max(float v) {
#pragma unroll
    for (int o = 32; o > 0; o >>= 1) v = fmaxf(v, __shfl_xor(v, o));
    return v;
}
DI void unpk4_fp8(unsigned w, float (&o)[4]) { const f32x2 a = __builtin_amdgcn_cvt_pk_f32_fp8((int)w, false), b = __builtin_amdgcn_cvt_pk_f32_fp8((int)w, true); o[0] = a.x; o[1] = a.y; o[2] = b.x; o[3] = b.y; }
constexpr float W8_SCALE = 32.f, W8_INV = 1.f / 32.f;
#ifndef MOE_TILED
#define MOE_TILED 1
#endif
constexpr int CVT_KT = 128;
template <int KIND, int OUT, bool TILED = false> DI void cvt_tile(const float* src, int ld_src, int ncols, int k0, int n0, unsigned char* dst, int ld_dst, int kd0, LAS float* T, float* cmax = nullptr) {
    const int tid = ltid(); constexpr int HK = CVT_KT / 2;
    { const int jj = tid & 255, kk = tid >> 8; const bool ok = (n0 + jj) < ncols;
#pragma unroll
      for (int i = 0; i < HK; ++i) { const int k = kk + 2 * i; const float v = src[(size_t)(k0 + k) * ld_src + (ok ? n0 + jj : 0)]; T[k * 257 + jj] = ok ? v : 0.f; } }
    __syncthreads();
    { const int j = tid >> 1, kq = tid & 1, c = n0 + j;
      if (c < ncols) {
        const int drow = KIND == 0 ? c : KIND == 1 ? (c & ~255) + (c & 1) * 128 + ((c & 255) >> 1) : win_dst(c);
        float v[HK];
#pragma unroll
        for (int i = 0; i < HK; ++i) v[i] = T[(kq * HK + i) * 257 + j];
        if constexpr (OUT == 2) { float mx = 0.f;
#pragma unroll
            for (int i = 0; i < HK; ++i) mx = fmaxf(mx, fabsf(v[i]));
            atomicMax((unsigned*)cmax + drow, __float_as_uint(mx)); }
        else if constexpr (OUT == 0) { bf16_t* d = (bf16_t*)dst + (size_t)drow * ld_dst + kd0 + k0 + kq * HK;
#pragma unroll
            for (int h = 0; h < HK / 8; ++h) *(u32x4*)(d + 8 * h) = (u32x4){pk2(v[8 * h], v[8 * h + 1]), pk2(v[8 * h + 2], v[8 * h + 3]), pk2(v[8 * h + 4], v[8 * h + 5]), pk2(v[8 * h + 6], v[8 * h + 7])}; }
        else { unsigned char* d8 = TILED ? dst + (size_t)(drow >> 8) * 256 * ld_dst + (size_t)((k0 + kq * HK) >> 7) * 32768 + (drow & 255) * 128 + ((k0 + kq * HK) & 127)
                                         : dst + (size_t)drow * ld_dst + kd0 + k0 + kq * HK; float sc = W8_SCALE;
            if constexpr (OUT == 3) { const float cm = cmax[drow]; sc = cm > 0.f ? 127.f / cm : 0.f; }
#pragma unroll
            for (int h = 0; h < HK / 16; ++h) { u32x4 w;
                if constexpr (OUT == 1) w = (u32x4){pk4_fp8(v[16 * h] * sc, v[16 * h + 1] * sc, v[16 * h + 2] * sc, v[16 * h + 3] * sc), pk4_fp8(v[16 * h + 4] * sc, v[16 * h + 5] * sc, v[16 * h + 6] * sc, v[16 * h + 7] * sc),
                                                  pk4_fp8(v[16 * h + 8] * sc, v[16 * h + 9] * sc, v[16 * h + 10] * sc, v[16 * h + 11] * sc), pk4_fp8(v[16 * h + 12] * sc, v[16 * h + 13] * sc, v[16 * h + 14] * sc, v[16 * h + 15] * sc)};
                else w = (u32x4){pk4_i8(v[16 * h] * sc, v[16 * h + 1] * sc, v[16 * h + 2] * sc, v[16 * h + 3] * sc), pk4_i8(v[16 * h + 4] * sc, v[16 * h + 5] * sc, v[16 * h + 6] * sc, v[16 * h + 7] * sc),
                                 pk4_i8(v[16 * h + 8] * sc, v[16 * h + 9] * sc, v[16 * h + 10] * sc, v[16 * h + 11] * sc), pk4_i8(v[16 * h + 12] * sc, v[16 * h + 13] * sc, v[16 * h + 14] * sc, v[16 * h + 15] * sc)};
                *(u32x4*)(d8 + 16 * h) = w; } } } }
    __syncthreads();
}
constexpr int KT1 = DM / CVT_KT, KT5 = 512 / CVT_KT;
constexpr int T_IN = KT1 * 32, T_BR = 3 * KT5 * 4, T_OUT = KT1 * 4, T_GU = 32 * KT1 * 8, T_DN = 32 * KT1 * 4, T_L = T_IN + T_BR + T_OUT + T_GU + T_DN;
DI void cvt_range(CArgs& a, LAS unsigned char* lds, int l, int rbeg, int first, int stride) {
    LAS float* T = (LAS float*)lds;
    for (int r0 = rbeg + first; r0 < T_L; r0 += stride) { int r = r0;
        if (r < T_IN) { const int kt = r % KT1, ntile = r / KT1;
            cvt_tile<2, INPROJ_I8 ? 2 : 0>(a.w_in + (size_t)l * DM * IN_COLS, IN_COLS, IN_COLS, kt * CVT_KT, ntile * 256, (unsigned char*)(a.ws + WS_WIN + (size_t)l * NP * DM * (INPROJ_I8 ? 1 : 2)), DM, 0, T, (float*)(a.ws + WS_COLMAX) + l * NP); continue; }
        r -= T_IN;
        if (r < T_BR) { const int br = r / (KT5 * 4), kt = (r % (KT5 * 4)) % KT5, ntile = (r % (KT5 * 4)) / KT5; const float* src = (br == 0 ? a.w_br_gla : br == 1 ? a.w_br_gdn : a.w_br_ssd) + (size_t)l * 512 * DM;
            cvt_tile<0, BRANCH_FP8 ? 1 : 0>(src, DM, DM, kt * CVT_KT, ntile * 256, (unsigned char*)(a.ws + WS_WBR + ((size_t)l * 3 + br) * DM * 512 * (BRANCH_FP8 ? 1 : 2)), 512, 0, T); continue; }
        r -= T_BR;
        if (r < T_OUT) { const int kt = r % KT1, ntile = r / KT1;
            cvt_tile<0, 0>(a.w_out + (size_t)l * DM * DM, DM, DM, kt * CVT_KT, ntile * 256, (unsigned char*)(a.ws + WS_WOUT + (size_t)l * DM * DM * 2), DM, 0, T); continue; }
        r -= T_OUT;
        if (r < T_GU) { const int e = r / (KT1 * 8), kt = (r % (KT1 * 8)) % KT1, ntile = (r % (KT1 * 8)) / KT1;
            cvt_tile<1, 1, MOE_TILED != 0>(a.w_gu + ((size_t)l * NEXP + e) * DM * 2048, 2048, 2048, kt * CVT_KT, ntile * 256, (unsigned char*)(a.ws + WS_WGU + ((size_t)l * NEXP + e) * 2048 * DM), DM, 0, T); continue; }
        r -= T_GU;
        { const int e = r / (KT1 * 4), kt = (r % (KT1 * 4)) % KT1, ntile = (r % (KT1 * 4)) / KT1;
            cvt_tile<0, 1, MOE_TILED != 0>(a.w_dn + ((size_t)l * NEXP + e) * DM * DM, DM, DM, kt * CVT_KT, ntile * 256, (unsigned char*)(a.ws + WS_WDN + ((size_t)l * NEXP + e) * DM * DM), DM, 0, T); }
    }
}
DI void phase_cvt(CArgs& a, LAS unsigned char* lds) {
    const int w = lbid(), Gd = lgrid();
    cvt_range(a, lds, 0, 0, w, Gd); cvt_range(a, lds, 1, 0, w, Gd);
    { constexpr size_t RB = (size_t)DM * (INPROJ_I8 ? 1 : 2), NV = 224 * RB / 16;
      for (size_t i = (size_t)lbid() * NTHREADS + ltid(); i < 2 * NV; i += (size_t)lgrid() * NTHREADS) { const size_t l = i / NV, rr = i % NV;
          *(u32x4*)(a.ws + WS_WIN + (l * NP + IN_COLS) * RB + rr * 16) = (u32x4){0u, 0u, 0u, 0u}; } }
}

DI void phase_cvt_win_i8(CArgs& a, LAS unsigned char* lds) {
    LAS float* T = (LAS float*)lds;
    for (int g = lbid(); g < 2 * T_IN; g += lgrid()) { const int l = g / T_IN, r = g % T_IN, kt = r % KT1, ntile = r / KT1;
        cvt_tile<2, 3>(a.w_in + (size_t)l * DM * IN_COLS, IN_COLS, IN_COLS, kt * CVT_KT, ntile * 256, (unsigned char*)(a.ws + WS_WIN + (size_t)l * NP * DM), DM, 0, T, (float*)(a.ws + WS_COLMAX) + l * NP); }
}
DI float wave_sum(float v) {
#pragma unroll
    for (int o = 32; o > 0; o >>= 1) v += __shfl_xor(v, o);
    return v;
}
DI void store_h_row(CArgs& a, int row, int lane, const float (&o)[16]) {
#if INPROJ_I8
    float mx = 0.f;
#pragma unroll
    for (int j = 0; j < 16; ++j) mx = fmaxf(mx, fabsf(o[j]));
    mx = wave_max(mx); const float inv = mx > 0.f ? 127.f / mx : 0.f;
    if (lane == 0) ((float*)(a.ws + WS_SA))[row] = mx * (1.f / 127.f);
#pragma unroll
    for (int i = 0; i < 2; ++i) *(u32x2*)((unsigned char*)(a.ws + WS_H) + (size_t)row * DM + lane * 8 + 512 * i) =
        (u32x2){pk4_i8(o[8 * i] * inv, o[8 * i + 1] * inv, o[8 * i + 2] * inv, o[8 * i + 3] * inv), pk4_i8(o[8 * i + 4] * inv, o[8 * i + 5] * inv, o[8 * i + 6] * inv, o[8 * i + 7] * inv)};
#else
#pragma unroll
    for (int i = 0; i < 2; ++i) { u32x4 w; w.x = pk2(o[8 * i], o[8 * i + 1]); w.y = pk2(o[8 * i + 2], o[8 * i + 3]); w.z = pk2(o[8 * i + 4], o[8 * i + 5]); w.w = pk2(o[8 * i + 6], o[8 * i + 7]);
        *(u32x4*)((bf16_t*)(a.ws + WS_H) + (size_t)row * DM + lane * 8 + 512 * i) = w; }
#endif
}
DI void phase_norm0(CArgs& a) {
    const int lane = ltid() & 63, gw = lbid() * 8 + (ltid() >> 6), nw = lgrid() * 8;
    const float* mod = (const float*)(a.ws + WS_MOD);
    bf16_t* H = (bf16_t*)(a.ws + WS_H);
    f32x4 vn[4];
    { const float* xr = a.x + (size_t)(gw < NTOK ? gw : 0) * DM;
#pragma unroll
      for (int i = 0; i < 2; ++i) { vn[2 * i] = *(const f32x4*)(xr + lane * 8 + 512 * i); vn[2 * i + 1] = *(const f32x4*)(xr + lane * 8 + 512 * i + 4); } }
    for (int row = gw; row < NTOK; row += nw) {
        const int b = row >> 12; const float* mb = mod + (size_t)b * 6144;
        f32x4 v[4]; float ss = 0.f;
#pragma unroll
        for (int i = 0; i < 4; ++i) v[i] = vn[i];
        { const int rn = row + nw < NTOK ? row + nw : row; const float* xr = a.x + (size_t)rn * DM;
#pragma unroll
          for (int i = 0; i < 2; ++i) { vn[2 * i] = *(const f32x4*)(xr + lane * 8 + 512 * i); vn[2 * i + 1] = *(const f32x4*)(xr + lane * 8 + 512 * i + 4); } }
#pragma unroll
        for (int i = 0; i < 4; ++i) ss += v[i][0] * v[i][0] + v[i][1] * v[i][1] + v[i][2] * v[i][2] + v[i][3] * v[i][3];
        ss = wave_sum(ss); const float rs = rsqrtf(ss * (1.f / 1024.f) + 1e-6f);
        float o[16];
#pragma unroll
        for (int i = 0; i < 2; ++i) { const int c0 = lane * 8 + 512 * i;
#pragma unroll
            for (int j = 0; j < 8; ++j) { const float xv = v[2 * i + (j >> 2)][j & 3]; o[8 * i + j] = xv * rs * a.norm_mix[c0 + j] * (1.f + mb[1024 + c0 + j]) + mb[c0 + j]; } }
        store_h_row(a, row, lane, o);
#pragma unroll
        for (int i = 0; i < 2; ++i) *(u32x4*)((bf16_t*)(a.ws + WS_XB) + (size_t)row * DM + lane * 8 + 512 * i) =
            (u32x4){pk2(v[2 * i][0], v[2 * i][1]), pk2(v[2 * i][2], v[2 * i][3]), pk2(v[2 * i + 1][0], v[2 * i + 1][1]), pk2(v[2 * i + 1][2], v[2 * i + 1][3])};
    }
}

#ifndef NT_EPI
#define NT_EPI 0
#endif
template <class T> DI void stg(T* p, T v) { if (NT_EPI) __builtin_nontemporal_store(v, p); else *p = v; }
struct EpiProj { static DI bool keep(const Unit&) { return false; } static constexpr int NC = 2;
    static constexpr bool PERM = true; static constexpr int NST = 16; bf16_t* P; float* small; const float* sa; const float* cmax; unsigned char* mg8;
    DI const char* cvec(const Unit& u, int i) const { if (!INPROJ_I8) return (const char*)P; return i == 0 ? (const char*)(cmax + u.pn * 256) : (const char*)(sa + u.pm * 256); }
    template <int KIND  > DI void body(const f32x4 (&acc)[2][2][4][2], const Unit& u, int wr, int wc, int fr, int fq, const LAS float* cl) const {
        const int row0 = u.pm * 256 + wr * 64 + fr, col0 = u.pn * 256 + wc * 32 + 8 * fq;
        f32x4 sw[2][2];
#pragma unroll
        for (int bj = 0; bj < 2; ++bj) { sw[bj][0] = *(const LAS f32x4*)(cl + wc * 32 + 8 * fq + bj * 128) * (1.f / 127.f); sw[bj][1] = *(const LAS f32x4*)(cl + wc * 32 + 8 * fq + bj * 128 + 4) * (1.f / 127.f); }
        float srv[8];
#pragma unroll
        for (int i = 0; i < 8; ++i) srv[i] = cl[256 + wr * 64 + fr + (i >> 2) * 128 + (i & 3) * 16];
#pragma unroll
        for (int ai = 0; ai < 2; ++ai)
#pragma unroll
            for (int m = 0; m < 4; ++m) { const int row = row0 + ai * 128 + m * 16; const float sr = srv[ai * 4 + m];
                float v[2][8];
#pragma unroll
                for (int bj = 0; bj < 2; ++bj)
#pragma unroll
                    for (int j = 0; j < 8; ++j) { const f32x4 t = acc[ai][bj][m][j >> 2];
                        if constexpr (INPROJ_I8 != 0) v[bj][j] = (float)__builtin_bit_cast(pg8::i32x4, t)[j & 3] * sr * sw[bj][j >> 2][j & 3]; else v[bj][j] = t[j & 3]; }
                if constexpr (KIND == 1) {
                    unsigned char* gp = mg8 + ((size_t)(u.pm * 12 + (u.pn - 19)) * 512 + ((wr * 4 + wc) * 64 + fq * 16 + fr)) * 128 + (ai * 4 + m) * 16;
                    stg((u32x4*)gp, (u32x4){pk4_fp8(v[0][0], v[0][1], v[0][2], v[0][3]), pk4_fp8(v[0][4], v[0][5], v[0][6], v[0][7]), pk4_fp8(v[1][0], v[1][1], v[1][2], v[1][3]), pk4_fp8(v[1][4], v[1][5], v[1][6], v[1][7])}); }
                else {
#pragma unroll
                for (int bj = 0; bj < 2; ++bj) stg((u32x4*)(P + (size_t)row * NP + col0 + bj * 128), (u32x4){pk2(v[bj][0], v[bj][1]), pk2(v[bj][2], v[bj][3]), pk2(v[bj][4], v[bj][5]), pk2(v[bj][6], v[bj][7])}); }
                if constexpr (KIND == 2) { if (wc == 0) { float* sp = small + (size_t)row * 32 + 8 * fq; *(f32x4*)sp = (f32x4){v[0][0], v[0][1], v[0][2], v[0][3]}; *(f32x4*)(sp + 4) = (f32x4){v[0][4], v[0][5], v[0][6], v[0][7]}; } } }
    }
    DI void operator()(const f32x4 (&acc)[2][2][4][2], const Unit& u, int wr, int wc, int fr, int fq, const LAS float* cl) const {
        if (u.pn < 19) body<0>(acc, u, wr, wc, fr, fq, cl); else if (u.pn < 31) body<1>(acc, u, wr, wc, fr, fq, cl); else body<2>(acc, u, wr, wc, fr, fq, cl);
    } };
struct EpiGate { static constexpr int NC = 2; static constexpr bool PERM = true; static constexpr int NST = 16; const unsigned char* P; const float* bmerge; bf16_t* M;
    static DI bool keep(const Unit& u) { return u.pn < 8; }
    DI const char* cvec(const Unit& u, int i) const { return (const char*)(bmerge + (u.pn + ((i && u.pn < 8) ? 4 : 0)) * 256); }
    DI void operator()(f32x4 (&acc)[2][2][4][2], const Unit& u, int wr, int wc, int fr, int fq, const LAS float* cl) const {
        const int row0 = u.pm * 256 + wr * 64 + fr, col0 = u.pn * 256 + wc * 32 + 8 * fq; const bool fin = u.pn >= 8;
        const unsigned char* g0 = P + ((size_t)(u.pm * 12 + u.pn) * 512 + ((wr * 4 + wc) * 64 + fq * 16 + fr)) * 128;
        const unsigned char* g1 = g0 + (fin ? (size_t)0 : (size_t)4 * 512 * 128);
        const float fsel = fin ? 1.f : 0.f, fmul = fin ? (BRANCH_FP8 ? W8_INV : 1.f) : 0.f;
#pragma unroll
        for (int ai = 0; ai < 2; ++ai) { u32x4 ga[4], gb[4];
#pragma unroll
            for (int m = 0; m < 4; ++m) { ga[m] = *(const u32x4*)(g0 + (ai * 4 + m) * 16); gb[m] = *(const u32x4*)(g1 + (ai * 4 + m) * 16); }
#pragma unroll
            for (int bj = 0; bj < 2; ++bj) { f32x2 bv[4], bn[4];
                { const f32x4 t0 = *(const LAS f32x4*)(cl + wc * 32 + 8 * fq + bj * 128), t1 = *(const LAS f32x4*)(cl + wc * 32 + 8 * fq + bj * 128 + 4);
                  bv[0] = (f32x2){t0[0], t0[1]}; bv[1] = (f32x2){t0[2], t0[3]}; bv[2] = (f32x2){t1[0], t1[1]}; bv[3] = (f32x2){t1[2], t1[3]}; }
                { const f32x4 n0 = *(const LAS f32x4*)(cl + 256 + wc * 32 + 8 * fq + bj * 128), n1 = *(const LAS f32x4*)(cl + 256 + wc * 32 + 8 * fq + bj * 128 + 4);
                  bn[0] = (f32x2){n0[0], n0[1]}; bn[1] = (f32x2){n0[2], n0[3]}; bn[2] = (f32x2){n1[0], n1[1]}; bn[3] = (f32x2){n1[2], n1[3]}; }
#pragma unroll
                for (int m = 0; m < 4; ++m) { const size_t row = row0 + ai * 128 + m * 16;
                    const u32x2 mr8 = bj ? (u32x2){ga[m].z, ga[m].w} : (u32x2){ga[m].x, ga[m].y}; const u32x2 nx8 = bj ? (u32x2){gb[m].z, gb[m].w} : (u32x2){gb[m].x, gb[m].y};
                    f32x2 o[4];
#pragma unroll
                    for (int jp = 0; jp < 4; ++jp) { const unsigned w = jp < 2 ? mr8.x : mr8.y; const f32x2 mg = (jp & 1) ? __builtin_amdgcn_cvt_pk_f32_fp8((int)w, true) : __builtin_amdgcn_cvt_pk_f32_fp8((int)w, false);
                        const f32x4 av = acc[ai][bj][m][jp >> 1]; const int e0 = 2 * (jp & 1);
                        f32x2 xa = mg + bv[jp]; xa.x = __builtin_amdgcn_fmed3f(xa.x, -60.f, 60.f); xa.y = __builtin_amdgcn_fmed3f(xa.y, -60.f, 60.f);
                        const f32x2 t = xa * (-1.4426950408889634f); f32x2 d; d.x = __builtin_amdgcn_exp2f(t.x); d.y = __builtin_amdgcn_exp2f(t.y); d = d + 1.f;
                        f32x2 r; r.x = __builtin_amdgcn_rcpf(d.x); r.y = __builtin_amdgcn_rcpf(d.y);
                        const unsigned wn = jp < 2 ? nx8.x : nx8.y; const f32x2 mn = (jp & 1) ? __builtin_amdgcn_cvt_pk_f32_fp8((int)wn, true) : __builtin_amdgcn_cvt_pk_f32_fp8((int)wn, false);
                        f32x2 xb = mn + bn[jp]; xb.x = __builtin_amdgcn_fmed3f(xb.x, -60.f, 60.f); xb.y = __builtin_amdgcn_fmed3f(xb.y, -60.f, 60.f);
                        const f32x2 tb = xb * (-1.4426950408889634f); f32x2 db; db.x = __builtin_amdgcn_exp2f(tb.x); db.y = __builtin_amdgcn_exp2f(tb.y); db = db + 1.f;
                        db = db * (1.f - fsel) + fmul;
                        o[jp] = ((f32x2){av[e0], av[e0 + 1]} * r) * db; }
                    if (fin) stg((u32x4*)(M + row * DM + col0 - 2048 + bj * 128), (u32x4){pk2(o[0].x, o[0].y), pk2(o[1].x, o[1].y), pk2(o[2].x, o[2].y), pk2(o[3].x, o[3].y)});
                    acc[ai][bj][m][0] = (f32x4){o[0].x, o[0].y, o[1].x, o[1].y}; acc[ai][bj][m][1] = (f32x4){o[2].x, o[2].y, o[3].x, o[3].y}; } }
            __builtin_amdgcn_sched_barrier(0); }
    } };
struct EpiResid { static DI bool keep(const Unit&) { return false; } static constexpr int NC = 1; static constexpr bool PERM = true; static constexpr int NST = 16; const bf16_t* xin; bf16_t* xout; const float* gm;
    DI const char* cvec(const Unit& u, int) const { return (const char*)(gm + (size_t)((u.pm * 256) >> 12) * 6144 + u.pn * 256); }
    DI void operator()(const f32x4 (&acc)[2][2][4][2], const Unit& u, int wr, int wc, int fr, int fq, const LAS float* cl) const {
        const int row0 = u.pm * 256 + wr * 64 + fr, col0 = u.pn * 256 + wc * 32 + 8 * fq;
        f32x4 gv[2][2];
#pragma unroll
        for (int bj = 0; bj < 2; ++bj) { gv[bj][0] = *(const LAS f32x4*)(cl + wc * 32 + 8 * fq + bj * 128); gv[bj][1] = *(const LAS f32x4*)(cl + wc * 32 + 8 * fq + bj * 128 + 4); }
#pragma unroll
        for (int ai = 0; ai < 2; ++ai) { u32x4 xt[4][2];
#pragma unroll
            for (int m = 0; m < 4; ++m)
#pragma unroll
                for (int bj = 0; bj < 2; ++bj) xt[m][bj] = *(const u32x4*)(xin + (size_t)(row0 + ai * 128 + m * 16) * DM + col0 + bj * 128);
#pragma unroll
            for (int m = 0; m < 4; ++m) { const size_t off = (size_t)(row0 + ai * 128 + m * 16) * DM + col0;
#pragma unroll
                for (int bj = 0; bj < 2; ++bj) { const u32x4 t = xt[m][bj]; const f32x4 x0 = (f32x4){bflo(t.x), bfhi(t.x), bflo(t.y), bfhi(t.y)}, x1 = (f32x4){bflo(t.z), bfhi(t.z), bflo(t.w), bfhi(t.w)};
                    const f32x4 v0 = x0 + gv[bj][0] * acc[ai][bj][m][0], v1 = x1 + gv[bj][1] * acc[ai][bj][m][1];
                    stg((u32x4*)(xout + off + bj * 128), (u32x4){pk2(v0[0], v0[1]), pk2(v0[2], v0[3]), pk2(v1[0], v1[1]), pk2(v1[2], v1[3])}); } }
            __builtin_amdgcn_sched_barrier(0); }
    } };
struct EpiSwiglu { static DI bool keep(const Unit&) { return false; } static constexpr int NC = 1; static constexpr bool PERM = true; static constexpr int NST = 8; unsigned char* act; const float* bgu;
    DI const char* cvec(const Unit& u, int) const { return (const char*)(bgu + (size_t)u.e * 2048 + u.pn * 256); }
    DI void operator()(const f32x4 (&acc)[2][2][4][2], const Unit& u, int wr, int wc, int fr, int fq, const LAS float* cl) const {
        const int row0 = u.pm * 256 + wr * 64 + fr, x0 = u.pn * 128 + wc * 32 + 8 * fq;
        const LAS float* bb = cl + 2 * (wc * 32 + 8 * fq);
        f32x2 bg[4], bu[4];
#pragma unroll
        for (int i = 0; i < 4; ++i) { const f32x4 t = *(const LAS f32x4*)(bb + 4 * i); bg[i] = (f32x2){t[0], t[2]}; bu[i] = (f32x2){t[1] + 1.f, t[3] + 1.f}; }
#pragma unroll
        for (int ai = 0; ai < 2; ++ai)
#pragma unroll
            for (int m = 0; m < 4; ++m) { const size_t row = row0 + ai * 128 + m * 16; f32x2 o[4];
#pragma unroll
                for (int jp = 0; jp < 4; ++jp) { const f32x4 ag = acc[ai][0][m][jp >> 1], au = acc[ai][1][m][jp >> 1]; const int e0 = 2 * (jp & 1);
                    f32x2 g = (f32x2){ag[e0], ag[e0 + 1]} * W8_INV + bg[jp], u1 = (f32x2){au[e0], au[e0 + 1]} * W8_INV + bu[jp];
                    g.x = fminf(g.x, 7.f); g.y = fminf(g.y, 7.f); u1.x = __builtin_amdgcn_fmed3f(u1.x, -6.f, 8.f); u1.y = __builtin_amdgcn_fmed3f(u1.y, -6.f, 8.f);
                    const f32x2 t = g * (-1.702f * 1.4426950408889634f); f32x2 d; d.x = __builtin_amdgcn_exp2f(t.x); d.y = __builtin_amdgcn_exp2f(t.y); d = d + 1.f;
                    f32x2 r; r.x = __builtin_amdgcn_rcpf(d.x); r.y = __builtin_amdgcn_rcpf(d.y);
                    o[jp] = (u1 * g) * r; }
                unsigned char* dp = MOE_TILED ? act + (size_t)u.pm * 262144 + (size_t)u.pn * 32768 + (row & 255) * 128 + (wc * 32 + 8 * fq) : act + row * DM + x0;
                stg((u32x2*)dp, (u32x2){pk4_fp8(o[0].x, o[0].y, o[1].x, o[1].y), pk4_fp8(o[2].x, o[2].y, o[3].x, o[3].y)}); }
    } };
struct EpiDown { static DI bool keep(const Unit&) { return false; } static constexpr int NC = 1; static constexpr bool PERM = true; static constexpr int NST = 16; bf16_t* ys; const float* bdn;
    DI const char* cvec(const Unit& u, int) const { return (const char*)(bdn + (size_t)u.e * DM + u.pn * 256); }
    DI void operator()(const f32x4 (&acc)[2][2][4][2], const Unit& u, int wr, int wc, int fr, int fq, const LAS float* cl) const {
        const int row0 = u.pm * 256 + wr * 64 + fr, col0 = u.pn * 256 + wc * 32 + 8 * fq;
        f32x4 bv[2][2];
#pragma unroll
        for (int bj = 0; bj < 2; ++bj) { bv[bj][0] = *(const LAS f32x4*)(cl + wc * 32 + 8 * fq + bj * 128); bv[bj][1] = *(const LAS f32x4*)(cl + wc * 32 + 8 * fq + bj * 128 + 4); }
#pragma unroll
        for (int ai = 0; ai < 2; ++ai)
#pragma unroll
            for (int m = 0; m < 4; ++m) { const size_t row = row0 + ai * 128 + m * 16;
#pragma unroll
                for (int bj = 0; bj < 2; ++bj) { const f32x4 v0 = acc[ai][bj][m][0] * W8_INV + bv[bj][0], v1 = acc[ai][bj][m][1] * W8_INV + bv[bj][1];
                    u32x4 w; w.x = pk2(v0[0], v0[1]); w.y = pk2(v0[2], v0[3]); w.z = pk2(v1[0], v1[1]); w.w = pk2(v1[2], v1[3]);
                    stg((u32x4*)(ys + row * DM + col0 + bj * 128), w); } }
    } };

DI void moe_tables(const int* cnt  , LAS unsigned char* lds) {
    LAS int* tstart = (LAS int*)(lds + LDS_CTRL + 64); LAS int* lcnt = (LAS int*)(lds + LDS_CTRL + 256);
    if (ltid() < 64) { const int t = ltid(); const int c = t < 32 ? cnt[t * 64] : 0; int v = (c + 255) >> 8;
#pragma unroll
        for (int o = 1; o < 32; o <<= 1) { const int y = __shfl_up(v, o); if ((t & 31) >= o) v += y; }
        if (t < 32) { tstart[t + 1] = v; lcnt[t] = c; } if (t == 0) tstart[0] = 0; }
    __syncthreads();
}
#ifndef MOE_DEAL
#define MOE_DEAL 1
#endif
template <bool G_> struct MoeOrder {
    static constexpr bool GATHER = G_;
    int nN, G, c; const LAS int* tstart; const LAS int* lcnt; const char* A; const char* Bt; size_t b_estride, tstep; const int* rowtok;
    DI bool next(int i, Unit& u) const {
#ifdef PROBE_DUPK_MOE
        int dupskip = 0; if (GATHER == (PROBE_DUPK_MOE == 1)) { dupskip = (i & 1) == 0; i >>= 1; }
#endif
        int rt, ct;
#if MOE_DEAL == 1
        if ((G & 7) == 0) { const int x = c & 7, j = i * (G >> 3) + (c >> 3), T = __builtin_amdgcn_readfirstlane(tstart[32]); rt = ((x * T) >> 3) + j / nN; ct = j % nN; if (rt >= (((x + 1) * T) >> 3)) return false; }
        else { const int L = i * G + c; rt = L / nN; ct = L % nN; if (rt >= tstart[32]) return false; }
#else
        if ((G & 7) == 0) { const int x = c & 7, j = i * (G >> 3) + (c >> 3); rt = (j / nN) * 8 + x; ct = j % nN; } else { const int L = i * G + c; rt = L / nN; ct = L % nN; }
        if (rt >= tstart[32]) return false;
#endif
        int e = 0;
#pragma unroll
        for (int s = 16; s >= 1; s >>= 1) { if (tstart[e + s] <= rt) e += s; }
        e = __builtin_amdgcn_readfirstlane(e);
        u.pm = rt; u.pn = ct; u.e = e; u.skip = 0;
#ifdef PROBE_DUPK_MOE
        u.skip = dupskip;
#endif
        const int rem = lcnt[e] - (rt - tstart[e]) * 256; u.cnt = rem < 256 ? rem : 256; return true; }
    DI const char* a_ptr(const Unit& u) const { return GATHER ? A : A + (size_t)u.pm * tstep; }
    DI const char* b_ptr(const Unit& u) const { return Bt + (size_t)u.e * b_estride + (size_t)u.pn * tstep; }
    DI int a_row(const Unit& u, int R) const { return R < u.cnt ? rowtok[u.e * 32768 + (u.pm - tstart[u.e]) * 256 + R] : 0; }
    DI const char* a_rowsrc(const Unit& u) const { return (const char*)(rowtok + u.e * 32768 + (u.pm - tstart[u.e]) * 256); }
};
DI void phase_router(CArgs& a, int l, const bf16_t* xmid, LAS unsigned char* lds) {
    const int tid = ltid(), wid = tid >> 6, lane = tid & 63, r = lane & 15, q = lane >> 4;
    LAS bf16_t* Whi = (LAS bf16_t*)lds; LAS bf16_t* Wlo = (LAS bf16_t*)(lds + 66048);
    LAS float* scr = (LAS float*)(lds + 132096 + wid * 2112);
    LAS int* hist = (LAS int*)(lds + 148992); LAS int* basep = (LAS int*)(lds + 148992 + 128);
    const float* wr_ = a.w_router + (size_t)l * DM * NEXP;
    { f32x4 wv[16];
#pragma unroll
      for (int j = 0; j < 16; ++j) wv[j] = *(const f32x4*)(wr_ + (size_t)(tid + NTHREADS * j) * 4);
#pragma unroll
      for (int j = 0; j < 16; ++j) { const int i = (tid + NTHREADS * j) * 4, k = i >> 5, e0 = i & 31;
#pragma unroll
          for (int t = 0; t < 4; ++t) { const float v = wv[j][t]; const bf16_t hi = f2bf(v); Whi[(e0 + t) * 1032 + k] = hi; Wlo[(e0 + t) * 1032 + k] = f2bf(v - bf2f(hi)); } } }
    __syncthreads();
    const float* mod = (const float*)(a.ws + WS_MOD) + (size_t)l * 8 * 6144;
    const float* nf = a.norm_ffn + l * DM;
    bf16_t* H = (bf16_t*)(a.ws + WS_H);
    int* cntg = (int*)(a.ws + WS_CNT) + l * 32 * 64;
    int* rowtok = (int*)(a.ws + WS_ROWTOK); int* tokslot = (int*)(a.ws + WS_TOKSLOT); float* gates = (float*)(a.ws + WS_GATES);
    for (int blk = lbid(); blk < NTOK / 128; blk += lgrid()) {
        if (tid < 32) hist[tid] = 0;
        const int row = blk * 128 + wid * 16 + r, b = row >> 12;
        const bf16_t* xr = xmid + (size_t)row * DM; const float* mb = mod + (size_t)b * 6144;
        float ss = 0.f;
#pragma unroll 1
        for (int kc = 0; kc < 2; ++kc) { u32x4 xa[16];
#pragma unroll
            for (int s = 0; s < 16; ++s) xa[s] = *(const u32x4*)(xr + (kc * 16 + s) * 32 + 8 * q);
#pragma unroll
            for (int s = 0; s < 16; ++s) { const u32x4 t = xa[s]; ss += bflo(t.x) * bflo(t.x) + bfhi(t.x) * bfhi(t.x) + bflo(t.y) * bflo(t.y) + bfhi(t.y) * bfhi(t.y) + bflo(t.z) * bflo(t.z) + bfhi(t.z) * bfhi(t.z) + bflo(t.w) * bflo(t.w) + bfhi(t.w) * bfhi(t.w); } }
        ss += __shfl_xor(ss, 16); ss += __shfl_xor(ss, 32);
        const float rs = rsqrtf(ss * (1.f / 1024.f) + 1e-6f);
        f32x4 acc0 = {0.f, 0.f, 0.f, 0.f}, acc1 = {0.f, 0.f, 0.f, 0.f};
#pragma unroll 1
        for (int kc = 0; kc < 8; ++kc) { u32x4 xb[4]; f32x4 ga[8], ca[8], ha[8];
#pragma unroll
            for (int s = 0; s < 4; ++s) { const int k0 = (kc * 4 + s) * 32 + 8 * q;
                xb[s] = *(const u32x4*)(xr + k0); ga[2 * s] = *(const f32x4*)(nf + k0); ga[2 * s + 1] = *(const f32x4*)(nf + k0 + 4);
                ca[2 * s] = *(const f32x4*)(mb + 4096 + k0); ca[2 * s + 1] = *(const f32x4*)(mb + 4096 + k0 + 4); ha[2 * s] = *(const f32x4*)(mb + 3072 + k0); ha[2 * s + 1] = *(const f32x4*)(mb + 3072 + k0 + 4); }
#pragma unroll
            for (int s = 0; s < 4; ++s) { const int k0 = (kc * 4 + s) * 32 + 8 * q;
                float hv[8]; const u32x4 xt = xb[s]; const float xf[8] = {bflo(xt.x), bfhi(xt.x), bflo(xt.y), bfhi(xt.y), bflo(xt.z), bfhi(xt.z), bflo(xt.w), bfhi(xt.w)};
#pragma unroll
                for (int j = 0; j < 8; ++j) { const int v2 = 2 * s + (j >> 2), e2 = j & 3; hv[j] = xf[j] * rs * ga[v2][e2] * (1.f + ca[v2][e2]) + ha[v2][e2]; }
                u32x4 hi; hi.x = pk2(hv[0], hv[1]); hi.y = pk2(hv[2], hv[3]); hi.z = pk2(hv[4], hv[5]); hi.w = pk2(hv[6], hv[7]);
                *(u32x2*)((unsigned char*)H + (size_t)row * DM + k0) = (u32x2){pk4_fp8(hv[0], hv[1], hv[2], hv[3]), pk4_fp8(hv[4], hv[5], hv[6], hv[7])};
                u32x4 lo; lo.x = pk2(hv[0] - bflo(hi.x), hv[1] - bfhi(hi.x)); lo.y = pk2(hv[2] - bflo(hi.y), hv[3] - bfhi(hi.y)); lo.z = pk2(hv[4] - bflo(hi.z), hv[5] - bfhi(hi.z)); lo.w = pk2(hv[6] - bflo(hi.w), hv[7] - bfhi(hi.w));
                const bf16x8 ah = __builtin_bit_cast(bf16x8, hi), al = __builtin_bit_cast(bf16x8, lo);
                const bf16x8 b0h = *(const LAS bf16x8*)(Whi + r * 1032 + k0), b0l = *(const LAS bf16x8*)(Wlo + r * 1032 + k0);
                const bf16x8 b1h = *(const LAS bf16x8*)(Whi + (16 + r) * 1032 + k0), b1l = *(const LAS bf16x8*)(Wlo + (16 + r) * 1032 + k0);
                acc0 = __builtin_amdgcn_mfma_f32_16x16x32_bf16(ah, b0h, acc0, 0, 0, 0); acc0 = __builtin_amdgcn_mfma_f32_16x16x32_bf16(ah, b0l, acc0, 0, 0, 0); acc0 = __builtin_amdgcn_mfma_f32_16x16x32_bf16(al, b0h, acc0, 0, 0, 0);
                acc1 = __builtin_amdgcn_mfma_f32_16x16x32_bf16(ah, b1h, acc1, 0, 0, 0); acc1 = __builtin_amdgcn_mfma_f32_16x16x32_bf16(ah, b1l, acc1, 0, 0, 0); acc1 = __builtin_amdgcn_mfma_f32_16x16x32_bf16(al, b1h, acc1, 0, 0, 0); } }
        const float br0 = a.b_router[l * 32 + r], br1 = a.b_router[l * 32 + 16 + r];
#pragma unroll
        for (int j = 0; j < 4; ++j) { scr[(4 * q + j) * 33 + r] = acc0[j] + br0; scr[(4 * q + j) * 33 + 16 + r] = acc1[j] + br1; }
        __syncthreads();
        int te[4] = {0, 0, 0, 0}; float tg[4] = {0.f, 0.f, 0.f, 0.f}; int rk[4] = {0, 0, 0, 0};
        if (lane < 16) {
            float v[32];
#pragma unroll
            for (int e = 0; e < 32; ++e) v[e] = scr[lane * 33 + e];
            float tv[4];
#pragma unroll
            for (int k = 0; k < 4; ++k) { float best = -3.0e38f; int bi = 0;
#pragma unroll
                for (int e = 0; e < 32; ++e) { if (v[e] > best) { best = v[e]; bi = e; } }
                tv[k] = best; te[k] = bi;
#pragma unroll
                for (int e = 0; e < 32; ++e) v[e] = (e == bi) ? -3.0e38f : v[e]; }
            const float e1 = __expf(tv[1] - tv[0]), e2 = __expf(tv[2] - tv[0]), e3 = __expf(tv[3] - tv[0]); const float inv = 1.f / (1.f + e1 + e2 + e3);
            tg[0] = inv; tg[1] = e1 * inv; tg[2] = e2 * inv; tg[3] = e3 * inv;
#pragma unroll
            for (int k = 0; k < 4; ++k) rk[k] = atomicAdd((int*)&hist[te[k]], 1);
        }
        __syncthreads();
        if (tid < 32) basep[tid] = atomicAdd(&cntg[tid * 64], hist[tid]);
        __syncthreads();
        if (lane < 16) { const int tok = blk * 128 + wid * 16 + lane;
#pragma unroll
            for (int k = 0; k < 4; ++k) { const int pos = basep[te[k]] + rk[k]; rowtok[te[k] * 32768 + pos] = tok; tokslot[tok * 4 + k] = te[k] * 32768 + pos; gates[tok * 4 + k] = tg[k]; } }
        __syncthreads();
    }
}

struct CombSlots { int s[4]; float g[4]; };
struct CombData { u32x4 y[2][4]; u32x4 x[2]; };
DI void comb_slots(CArgs& a, int row, CombSlots& cs) {
    const int* tokslot = (const int*)(a.ws + WS_TOKSLOT); const float* gates = (const float*)(a.ws + WS_GATES);
    const int r = row < NTOK ? row : 0;
#pragma unroll
    for (int k = 0; k < 4; ++k) { cs.s[k] = tokslot[r * 4 + k]; cs.g[k] = gates[r * 4 + k]; }
}
DI void comb_data(CArgs& a, int row, const CombSlots& cs, const bf16_t* xmid, const LAS int* tstart, int lane, CombData& d) {
    const bf16_t* YS = (const bf16_t*)(a.ws + WS_R1 + R1_YS); const int r = row < NTOK ? row : 0;
#pragma unroll
    for (int k = 0; k < 4; ++k) { const size_t pr = (size_t)(tstart[cs.s[k] >> 15] * 256 + (cs.s[k] & 32767));
#pragma unroll
        for (int i = 0; i < 2; ++i) d.y[i][k] = *(const u32x4*)(YS + pr * DM + lane * 8 + 512 * i); }
#pragma unroll
    for (int i = 0; i < 2; ++i) d.x[i] = *(const u32x4*)(xmid + (size_t)r * DM + lane * 8 + 512 * i);
}
DI void phase_combine(CArgs& a, int l, const bf16_t* xmid, bf16_t* xnew, LAS unsigned char* lds) {
    const LAS int* tstart = (const LAS int*)(lds + LDS_CTRL + 64);
    const int lane = ltid() & 63, gw = lbid() * 8 + (ltid() >> 6), nw = lgrid() * 8;
    const float* mod = (const float*)(a.ws + WS_MOD);
    if (gw >= NTOK) return;
    CombSlots s0, s1; CombData d0;
    comb_slots(a, gw, s0); comb_slots(a, gw + nw, s1); comb_data(a, gw, s0, xmid, tstart, lane, d0);
    for (int row = gw; row < NTOK; row += nw) {
        CombData d1; CombSlots s2; comb_data(a, row + nw, s1, xmid, tstart, lane, d1); comb_slots(a, row + 2 * nw, s2);
        const int b = row >> 12; const float* mb = mod + ((size_t)l * 8 + b) * 6144;
        float xn[16]; float ss = 0.f;
#pragma unroll
        for (int i = 0; i < 2; ++i) { const int c0 = lane * 8 + 512 * i; float f[8];
#pragma unroll
            for (int j = 0; j < 8; ++j) f[j] = 0.f;
#pragma unroll
            for (int k = 0; k < 4; ++k) { const u32x4 y = d0.y[i][k]; const float g = s0.g[k];
                f[0] += g * bflo(y.x); f[1] += g * bfhi(y.x); f[2] += g * bflo(y.y); f[3] += g * bfhi(y.y); f[4] += g * bflo(y.z); f[5] += g * bfhi(y.z); f[6] += g * bflo(y.w); f[7] += g * bfhi(y.w); }
            const u32x4 xt = d0.x[i]; const float xf[8] = {bflo(xt.x), bfhi(xt.x), bflo(xt.y), bfhi(xt.y), bflo(xt.z), bfhi(xt.z), bflo(xt.w), bfhi(xt.w)};
#pragma unroll
            for (int j = 0; j < 8; ++j) { const float xv = xf[j] + mb[5120 + c0 + j] * f[j]; xn[8 * i + j] = xv; ss += xv * xv; } }
        ss = wave_sum(ss); const float rs = rsqrtf(ss * (1.f / 1024.f) + 1e-6f);
        if (l == 0) {
            const float* mb2 = mod + ((size_t)8 + b) * 6144; const float* g = a.norm_mix + DM;
            float o[16];
#pragma unroll
            for (int i = 0; i < 2; ++i) { const int c0 = lane * 8 + 512 * i;
                *(u32x4*)(xnew + (size_t)row * DM + c0) = (u32x4){pk2(xn[8 * i], xn[8 * i + 1]), pk2(xn[8 * i + 2], xn[8 * i + 3]), pk2(xn[8 * i + 4], xn[8 * i + 5]), pk2(xn[8 * i + 6], xn[8 * i + 7])};
#pragma unroll
                for (int j = 0; j < 8; ++j) o[8 * i + j] = xn[8 * i + j] * rs * g[c0 + j] * (1.f + mb2[1024 + c0 + j]) + mb2[c0 + j]; }
            store_h_row(a, row, lane, o);
        } else {
#pragma unroll
            for (int i = 0; i < 2; ++i) { const int c0 = lane * 8 + 512 * i; float o[8];
#pragma unroll
                for (int j = 0; j < 8; ++j) o[j] = xn[8 * i + j] * rs * a.norm_final[c0 + j];
                *(f32x4*)(a.out + (size_t)row * DM + c0) = (f32x4){o[0], o[1], o[2], o[3]}; *(f32x4*)(a.out + (size_t)row * DM + c0 + 4) = (f32x4){o[4], o[5], o[6], o[7]}; }
        }
        d0 = d1; s0 = s1; s1 = s2;
    }
}

DI float wave_incl_scan(float v, int lane) {
#pragma unroll
    for (int o = 1; o < 64; o <<= 1) { const float y = __shfl_up(v, o); if (lane >= o) v += y; }
    return v;
}
DI void conv8(const bf16_t* p, int pos, const float* w, int chs, const float* bias, float (&out)[8]) {
    float acc[8];
    if (bias) { const f32x4 b0 = *(const f32x4*)bias, b1 = *(const f32x4*)(bias + 4); acc[0] = b0[0]; acc[1] = b0[1]; acc[2] = b0[2]; acc[3] = b0[3]; acc[4] = b1[0]; acc[5] = b1[1]; acc[6] = b1[2]; acc[7] = b1[3]; }
    else {
#pragma unroll
        for (int i = 0; i < 8; ++i) acc[i] = 0.f; }
#pragma unroll
    for (int j = 0; j < 4; ++j) {
        if (pos - 3 + j >= 0) { const u32x4 xv = *(const u32x4*)(p - (ptrdiff_t)(3 - j) * NP); const f32x4 w0 = *(const f32x4*)(w + j * chs), w1 = *(const f32x4*)(w + j * chs + 4);
            acc[0] += w0[0] * bflo(xv.x); acc[1] += w0[1] * bfhi(xv.x); acc[2] += w0[2] * bflo(xv.y); acc[3] += w0[3] * bfhi(xv.y);
            acc[4] += w1[0] * bflo(xv.z); acc[5] += w1[1] * bfhi(xv.z); acc[6] += w1[2] * bflo(xv.w); acc[7] += w1[3] * bfhi(xv.w); } }
#pragma unroll
    for (int i = 0; i < 8; ++i) out[i] = silu_(acc[i]);
}
DI int swz64(int row, int l) { return row * 72 + ((((l >> 3) + (row >> 3)) & 7) << 3) + (l & 7); }
template <int K, bool BSWZ = false> DI f32x4 mm16(const LAS bf16_t* A, int lda, int m0, const LAS bf16_t* Bt, int ldb, int n0, int lane) {
    f32x4 acc = {0.f, 0.f, 0.f, 0.f}; const int r = lane & 15, q = lane >> 4; bf16x8 av[K / 32], bv[K / 32];
#pragma unroll
    for (int s = 0; s < K / 32; ++s) { av[s] = *(const LAS bf16x8*)(A + (m0 + r) * lda + s * 32 + 8 * q);
        bv[s] = BSWZ ? *(const LAS bf16x8*)(Bt + (n0 + r) * ldb + (((s * 4 + q + ((n0 + r) >> 3)) & 7) << 3)) : *(const LAS bf16x8*)(Bt + (n0 + r) * ldb + s * 32 + 8 * q); }
#pragma unroll
    for (int s = 0; s < K / 32; ++s) acc = __builtin_amdgcn_mfma_f32_16x16x32_bf16(av[s], bv[s], acc, 0, 0, 0);
    return acc;
}
DI void frag_store8(char* base, int nkb, int row, int k0, const float (&v)[8]) {
    const int rt = row >> 5, r = row & 31, kb = k0 >> 4, aa = (k0 >> 3) & 1;
    char* p = base + ((size_t)((rt * nkb + kb) * 64 + r)) * 16 + aa * 8;
    *(u32x2*)p = (u32x2){pk2(v[0], v[1]), pk2(v[2], v[3])};
    *(u32x2*)(p + 512) = (u32x2){pk2(v[4], v[5]), pk2(v[6], v[7])};
}
template <bool SWZ, int R, int KK> DI void export_frags(char* dst, const LAS bf16_t* M, int ld, int coloff) {
    constexpr int nkb = KK >> 4, pieces = (R >> 5) * nkb * 64, NP_ = (pieces + NTHREADS - 1) / NTHREADS;
    u32x2 lo[NP_], hi[NP_];
#pragma unroll
    for (int it = 0; it < NP_; ++it) { const int p = ltid() + it * NTHREADS; const int lane = p & 63, f = p >> 6, kb = f % nkb, rt = (f / nkb) % (R >> 5), r = lane & 31, h = lane >> 5, row = rt * 32 + r;
        const LAS bf16_t* s0 = SWZ ? M + swz64(row, kb * 16 + 4 * h) : M + row * ld + coloff + kb * 16 + 4 * h;
        const LAS bf16_t* s1 = SWZ ? M + swz64(row, kb * 16 + 8 + 4 * h) : s0 + 8;
        lo[it] = *(const LAS u32x2*)s0; hi[it] = *(const LAS u32x2*)s1; }
#pragma unroll
    for (int it = 0; it < NP_; ++it) { const int p = ltid() + it * NTHREADS; if (p < pieces) *(u32x4*)(dst + (size_t)p * 16) = (u32x4){lo[it].x, lo[it].y, hi[it].x, hi[it].y}; }
}
DI void export_acc(char* dst, const LAS bf16_t* M, int ld, int nct) {
    const int pieces = nct * 2 * 64;
    for (int p = ltid(); p < pieces; p += NTHREADS) { const int lane = p & 63, tile = p >> 6, rt = tile & 1, ct = tile >> 1, r = lane & 31, h = lane >> 5;
        unsigned w[8]; bf16_t t0[8], t1[8];
#pragma unroll
        for (int i = 0; i < 8; ++i) { const int r0 = rt * 32 + ((2 * i) & 3) + 8 * ((2 * i) >> 2) + 4 * h; t0[i] = M[r0 * ld + ct * 32 + r]; t1[i] = M[(r0 + 1) * ld + ct * 32 + r]; }
        asm volatile("s_waitcnt lgkmcnt(0)" ::: "memory");
#pragma unroll
        for (int i = 0; i < 8; ++i) w[i] = (unsigned)t0[i] | ((unsigned)t1[i] << 16);
        *(u32x4*)(dst + (size_t)p * 32) = (u32x4){w[0], w[1], w[2], w[3]}; *(u32x4*)(dst + (size_t)p * 32 + 16) = (u32x4){w[4], w[5], w[6], w[7]}; }
}

#ifndef PROBE_DUPST
#define PROBE_DUPST 1
#endif
DI u32x4 ldg_or0(const bf16_t* p, bool ok) { return ok ? *(const u32x4*)p : (u32x4){0u, 0u, 0u, 0u}; }
DI void conv8r(const u32x4 (&t)[4], const LAS float* wt, int ws, const LAS float* bias, float (&out)[8]) {
    float acc[8];
#pragma unroll
    for (int i = 0; i < 8; ++i) acc[i] = bias ? bias[i] : 0.f;
#pragma unroll
    for (int j = 0; j < 4; ++j) { const LAS float* w = wt + j * ws; const u32x4 xv = t[j];
        acc[0] += w[0] * bflo(xv.x); acc[1] += w[1] * bfhi(xv.x); acc[2] += w[2] * bflo(xv.y); acc[3] += w[3] * bfhi(xv.y);
        acc[4] += w[4] * bflo(xv.z); acc[5] += w[5] * bfhi(xv.z); acc[6] += w[6] * bflo(xv.w); acc[7] += w[7] * bfhi(xv.w); }
#pragma unroll
    for (int i = 0; i < 8; ++i) out[i] = silu_(acc[i]);
}
struct GlaRaw { f32x4 lr[4]; u32x4 q8, k8, v8[2]; };
DI void gla_load(CArgs& a, int u, GlaRaw& r) {
    const int tid = ltid(); const int n = u & 63, bh = u >> 6, b = bh >> 2, h = bh & 3, T0 = b * SEQ + n * 64;
    const bf16_t* P = (const bf16_t*)(a.ws + WS_R1 + R1_PROJ); const float* small = (const float*)(a.ws + WS_SMALL);
    const int l_ = tid >> 3, d0 = (tid & 7) * 8; const size_t T = (size_t)(T0 + l_);
#pragma unroll
    for (int i = 0; i < 4; ++i) r.lr[i] = *(const f32x4*)(small + T * 32 + 4 * i);
    r.q8 = *(const u32x4*)(P + T * NP + PC_GLA_Q + h * 64 + d0); r.k8 = *(const u32x4*)(P + T * NP + PC_GLA_K + h * 64 + d0);
#pragma unroll
    for (int rep = 0; rep < 2; ++rep) { const int idx = rep * NTHREADS + tid, lr_ = idx >> 4, c0 = (idx & 15) * 8; r.v8[rep] = *(const u32x4*)(P + (size_t)(T0 + lr_) * NP + PC_GLA_V + h * 128 + c0); }
}
DI void gla_table(CArgs& a, int l, int h, LAS float* WT) {
    for (int i = ltid(); i < 17 * 64; i += NTHREADS) { const int j = i >> 6, d = i & 63; WT[i] = j < 16 ? a.gla_w2[(size_t)l * 16 * 256 + j * 256 + h * 64 + d] : a.gla_b2[l * 256 + h * 64 + d]; }
}
template <class F> DI void gla_compute(CArgs& a, int u, const GlaRaw& rw, LAS unsigned char* lds, F&& prefetch) {
    const int tid = ltid(), wid = tid >> 6, lane = tid & 63;
    LAS float* G = (LAS float*)lds; LAS bf16_t* QD = (LAS bf16_t*)(lds + 16640); LAS bf16_t* KI = (LAS bf16_t*)(lds + 25856); LAS bf16_t* KT = (LAS bf16_t*)(lds + 35072);
    LAS bf16_t* PB = (LAS bf16_t*)(lds + 44288); LAS bf16_t* V = (LAS bf16_t*)(lds + 53504); LAS float* SEG = (LAS float*)(lds + 70912); const LAS float* WT = (const LAS float*)(lds + 72960);
    char* ub = a.ws + WS_R1 + R1_SGLA + (size_t)u * GLA_UNIT;
    const int l_ = tid >> 3, d0 = (tid & 7) * 8;
    { float s[8];
#pragma unroll
      for (int i = 0; i < 8; ++i) s[i] = WT[16 * 64 + d0 + i];
#pragma unroll
      for (int j = 0; j < 16; ++j) { const float lv = rw.lr[j >> 2][j & 3];
#pragma unroll
          for (int i = 0; i < 8; ++i) s[i] += lv * WT[j * 64 + d0 + i]; }
#pragma unroll
      for (int i = 0; i < 8; ++i) G[l_ * 65 + d0 + i] = -softplus_(-s[i]) * (1.f / 16.f); }
#pragma unroll
    for (int rep = 0; rep < 2; ++rep) { const int idx = rep * NTHREADS + tid, lr_ = idx >> 4, c0 = (idx & 15) * 8; *(LAS u32x4*)(V + lr_ * 136 + c0) = rw.v8[rep]; }
    const u32x4 q8 = rw.q8, k8 = rw.k8;
    prefetch();
    lds_barrier();
    { const int d = tid & 63, sg = tid >> 6; float run = 0.f, vv[8];
#pragma unroll
      for (int i = 0; i < 8; ++i) { run += G[(sg * 8 + i) * 65 + d]; vv[i] = run; }
      SEG[sg * 64 + d] = run;
      lds_barrier();
      float pre = 0.f;
#pragma unroll
      for (int s2 = 0; s2 < 8; ++s2) pre += (s2 < sg) ? SEG[s2 * 64 + d] : 0.f;
#pragma unroll
      for (int i = 0; i < 8; ++i) G[(sg * 8 + i) * 65 + d] = vv[i] + pre; }
    lds_barrier();
    { const float qf[8] = {bflo(q8.x), bfhi(q8.x), bflo(q8.y), bfhi(q8.y), bflo(q8.z), bfhi(q8.z), bflo(q8.w), bfhi(q8.w)};
      const float kf[8] = {bflo(k8.x), bfhi(k8.x), bflo(k8.y), bfhi(k8.y), bflo(k8.z), bfhi(k8.z), bflo(k8.w), bfhi(k8.w)};
      float qd[8], ki[8];
#pragma unroll
      for (int i = 0; i < 8; ++i) { const float bc = G[l_ * 65 + d0 + i], bl = G[63 * 65 + d0 + i]; qd[i] = qf[i] * 0.125f * __expf(bc); ki[i] = kf[i] * __expf(-bc);
          KT[swz64(d0 + i, l_)] = f2bf(kf[i] * __expf(bl - bc)); }
      *(LAS u32x4*)(QD + l_ * 72 + d0) = (u32x4){pk2(qd[0], qd[1]), pk2(qd[2], qd[3]), pk2(qd[4], qd[5]), pk2(qd[6], qd[7])};
      *(LAS u32x4*)(KI + l_ * 72 + d0) = (u32x4){pk2(ki[0], ki[1]), pk2(ki[2], ki[3]), pk2(ki[4], ki[5]), pk2(ki[6], ki[7])};
      frag_store8(ub + GLA_OQ, 4, l_, d0, qd); }
    if (tid < 64) ((float*)(ub + GLA_OD))[tid] = __expf(G[63 * 65 + tid]);
    lds_barrier();
#pragma unroll
    for (int t2 = 0; t2 < 2; ++t2) { const int t = wid * 2 + t2, mt = t >> 2, nt = t & 3; const f32x4 acc = mm16<64>(QD, 72, mt * 16, KI, 72, nt * 16, lane);
        const int r = lane & 15, q = lane >> 4, m = nt * 16 + r;
#pragma unroll
        for (int j = 0; j < 4; ++j) { const int lrow = mt * 16 + 4 * q + j; PB[lrow * 72 + m] = f2bf(m <= lrow ? acc[j] : 0.f); } }
    lds_barrier();
    for (int dup_ = 0; dup_ < PROBE_DUPST; ++dup_) {
    export_frags<false, 64, 64>(ub + GLA_OP, PB, 72, 0);
    export_frags<true, 64, 64>(ub + GLA_OK, KT, 72, 0);
    export_acc(ub + GLA_OU, V, 136, 4); }
    lds_barrier();
}
struct SsdRaw { u32x4 t[3][4]; float dtr, p0, p1, p2; };
DI void ssd_load(CArgs& a, int u, SsdRaw& r) {
    const int tid = ltid(); const int n = u & 63, bh = u >> 6, b = bh >> 3, hh = bh & 7, g = hh >> 2, T0 = b * SEQ + n * 64;
    const bf16_t* P = (const bf16_t*)(a.ws + WS_R1 + R1_PROJ); const float* small = (const float*)(a.ws + WS_SMALL);
    const int l_ = tid >> 3, c8 = (tid & 7) * 8, pos = n * 64 + l_; const bf16_t* pr = P + (size_t)(T0 + l_) * NP + PC_SSD_XBC + c8;
    const int cb[3] = {hh * 64, 512 + g * 64, 640 + g * 64};
#pragma unroll
    for (int p = 0; p < 3; ++p)
#pragma unroll
        for (int j = 0; j < 4; ++j) r.t[p][j] = ldg_or0(pr + cb[p] - (ptrdiff_t)(3 - j) * NP, pos - 3 + j >= 0);
    r.dtr = tid < 64 ? small[(size_t)(T0 + tid) * 32 + 24 + hh] : 0.f; r.p0 = 0.f; r.p1 = 0.f; r.p2 = 0.f;
}
DI void ssd_table(CArgs& a, int l, int hh, LAS float* WT) {
    const int g = hh >> 2;
    for (int i = ltid(); i < 3 * 5 * 64; i += NTHREADS) { const int p = i / 320, j = (i % 320) >> 6, ch = i & 63; const int col = (p == 0 ? hh * 64 : p == 1 ? 512 + g * 64 : 640 + g * 64) + ch;
        WT[i] = j < 4 ? a.ssd_conv_w[(size_t)l * 4 * 768 + j * 768 + col] : a.ssd_conv_b[l * 768 + col]; }
    if (ltid() == 0) { WT[960] = -__expf(a.ssd_a_log[l * 8 + hh]); WT[961] = a.ssd_dt_bias[l * 8 + hh]; }
}
struct SsdV { float vx[8], vb[8], vc[8]; };
DI void touch(const u32x4& v) { asm volatile("" :: "v"(v)); }
DI void touchf(float v) { asm volatile("" :: "v"(v)); }
DI void ssd_pin(SsdV& v) {
#pragma unroll
    for (int i = 0; i < 8; ++i) { asm volatile("" : "+v"(v.vx[i])); asm volatile("" : "+v"(v.vb[i])); asm volatile("" : "+v"(v.vc[i])); }
    __builtin_amdgcn_sched_barrier(0);
}
DI void ssd_touch(const SsdRaw& r) {
#pragma unroll
    for (int p = 0; p < 3; ++p)
#pragma unroll
        for (int j = 0; j < 4; ++j) touch(r.t[p][j]);
    touchf(r.dtr);
}
DI void ssd_front(const SsdRaw& rw, LAS unsigned char* lds, SsdV& v) {
    const int tid = ltid(), lane = tid & 63;
    LAS float* SDT = (LAS float*)(lds + 46080); LAS float* SCUM = (LAS float*)(lds + 46080 + 256); const LAS float* WT = (const LAS float*)(lds + 47104);
    if (tid < 64) { const float dt = softplus_(rw.dtr + WT[961]); const float cum = wave_incl_scan(dt * WT[960], lane); SDT[tid] = dt; SCUM[tid] = cum; }
    const int c8 = (tid & 7) * 8;
    conv8r(rw.t[0], WT + c8, 64, WT + 4 * 64 + c8, v.vx); conv8r(rw.t[1], WT + 320 + c8, 64, WT + 320 + 4 * 64 + c8, v.vb); conv8r(rw.t[2], WT + 640 + c8, 64, WT + 640 + 4 * 64 + c8, v.vc);
}
template <class F> DI void ssd_back(CArgs& a, int u, SsdV& v, LAS unsigned char* lds, F&& mid) {
    const int tid = ltid(), wid = tid >> 6, lane = tid & 63;
    const int bh = u >> 6, hh = bh & 7;
    LAS bf16_t* CC = (LAS bf16_t*)lds; LAS bf16_t* CBm = (LAS bf16_t*)(lds + 9216); LAS bf16_t* KT = (LAS bf16_t*)(lds + 18432); LAS bf16_t* PB = (LAS bf16_t*)(lds + 27648);
    LAS bf16_t* V = (LAS bf16_t*)(lds + 36864); LAS float* SDT = (LAS float*)(lds + 46080); LAS float* SCUM = (LAS float*)(lds + 46080 + 256);
    char* ub = a.ws + WS_R1 + R1_SSSD + (size_t)u * SSD_UNIT;
    { const int l_ = tid >> 3, c8 = (tid & 7) * 8; const float cl = SCUM[l_], c63 = SCUM[63], dtl = SDT[l_];
      const float (&vx)[8] = v.vx; const float (&vb)[8] = v.vb; const float (&vc)[8] = v.vc;
      *(LAS u32x4*)(V + l_ * 72 + c8) = (u32x4){pk2(vx[0] * dtl, vx[1] * dtl), pk2(vx[2] * dtl, vx[3] * dtl), pk2(vx[4] * dtl, vx[5] * dtl), pk2(vx[6] * dtl, vx[7] * dtl)};
      { const int n_ = u & 63, b_ = u >> 9; *(u32x4*)((bf16_t*)(a.ws + WS_R1 + R1_XCONV) + ((size_t)b_ * SEQ + n_ * 64 + l_) * 512 + hh * 64 + c8) = (u32x4){pk2(vx[0], vx[1]), pk2(vx[2], vx[3]), pk2(vx[4], vx[5]), pk2(vx[6], vx[7])}; }
      *(LAS u32x4*)(CBm + l_ * 72 + c8) = (u32x4){pk2(vb[0], vb[1]), pk2(vb[2], vb[3]), pk2(vb[4], vb[5]), pk2(vb[6], vb[7])};
      const float ek = __expf(c63 - cl);
#pragma unroll
      for (int i = 0; i < 8; ++i) KT[swz64(c8 + i, l_)] = f2bf(vb[i] * ek);
      *(LAS u32x4*)(CC + l_ * 72 + c8) = (u32x4){pk2(vc[0], vc[1]), pk2(vc[2], vc[3]), pk2(vc[4], vc[5]), pk2(vc[6], vc[7])};
      const float eq = __expf(cl); float qd[8];
#pragma unroll
      for (int i = 0; i < 8; ++i) qd[i] = vc[i] * eq;
      frag_store8(ub + SSD_OQ, 4, l_, c8, qd); }
    if (tid < 64) ((float*)(ub + SSD_OD))[tid] = __expf(SCUM[63]);
    lds_barrier();
#pragma unroll
    for (int t2 = 0; t2 < 2; ++t2) { const int t = wid * 2 + t2, mt = t >> 2, nt = t & 3; const f32x4 acc = mm16<64>(CC, 72, mt * 16, CBm, 72, nt * 16, lane);
        const int r = lane & 15, q = lane >> 4, m = nt * 16 + r; const float cm = SCUM[m];
        const f32x4 scl = *(const LAS f32x4*)(SCUM + mt * 16 + 4 * q);
#pragma unroll
        for (int j = 0; j < 4; ++j) { const int lrow = mt * 16 + 4 * q + j; const float e = acc[j] * __expf(scl[j] - cm); PB[lrow * 72 + m] = f2bf(m <= lrow ? e : 0.f); } }
    lds_barrier();
    mid();
    for (int dup_ = 0; dup_ < PROBE_DUPST; ++dup_) {
    export_frags<false, 64, 64>(ub + SSD_OP, PB, 72, 0);
    export_frags<true, 64, 64>(ub + SSD_OK, KT, 72, 0);
    export_acc(ub + SSD_OU, V, 72, 2); }
    lds_barrier();
}
template <int NP_> struct GdnRaw { u32x4 t[NP_][2][4]; u32x4 tb; float ar, br, p0, p1; };
template <int NP_> DI void gdn_load(CArgs& a, int u, GdnRaw<NP_>& r, bool with_t) {
    const int tid = ltid(); const int n = u & 63, bh = u >> 6, b = bh >> 2, h = bh & 3, T0 = b * SEQ + n * 64;
    const bf16_t* P = (const bf16_t*)(a.ws + WS_R1 + R1_PROJ); const float* small = (const float*)(a.ws + WS_SMALL);
#pragma unroll
    for (int rep = 0; rep < 2; ++rep) { const int idx = rep * NTHREADS + tid, l_ = idx >> 4, grp = idx & 15, pos = n * 64 + l_; const bf16_t* pr = P + (size_t)(T0 + l_) * NP + PC_GDN_QKV + h * 128 + grp * 8;
#pragma unroll
        for (int p = 0; p < NP_; ++p) { const int part = NP_ == 1 ? 1 : p;
#pragma unroll
            for (int j = 0; j < 4; ++j) r.t[p][rep][j] = ldg_or0(pr + part * 512 - (ptrdiff_t)(3 - j) * NP, pos - 3 + j >= 0); } }
    r.ar = tid < 64 ? small[(size_t)(T0 + tid) * 32 + 16 + h] : 0.f; r.br = tid < 64 ? small[(size_t)(T0 + tid) * 32 + 20 + h] : 0.f; r.p0 = 0.f; r.p1 = 0.f;
    if (with_t) { const bf16_t* tsrc = (const bf16_t*)(a.ws + WS_TSCR) + (size_t)u * 4096; r.tb = *(const u32x4*)(tsrc + (tid >> 3) * 64 + (tid & 7) * 8); } else r.tb = (u32x4){0u, 0u, 0u, 0u};
}
DI void gdn_table(CArgs& a, int l, int h, LAS float* WT) {
    for (int i = ltid(); i < 3 * 4 * 128; i += NTHREADS) { const int p = i >> 9, j = (i >> 7) & 3, d = i & 127; WT[i] = a.gdn_conv_w[(size_t)l * 4 * 1536 + j * 1536 + p * 512 + h * 128 + d]; }
    if (ltid() == 0) { WT[1536] = -__expf(a.gdn_a_log[l * 4 + h]); WT[1537] = a.gdn_dt_bias[l * 4 + h]; }
}
DI void gdn_scalars_r(const LAS float* hc, float ar, float br, LAS float* SB, LAS float* SC) {
    const int tid = ltid();
    if (tid < 64) { const float beta = sigmoid_(br); const float gg = hc[0] * softplus_(ar + hc[1]);
        const float cum = wave_incl_scan(gg, tid); SB[tid] = beta; SC[tid] = cum; }
}
DI void gdn_norm8(float (&v)[8], float post) {
    float ss = 0.f;
#pragma unroll
    for (int i = 0; i < 8; ++i) ss += v[i] * v[i];
    ss += __shfl_xor(ss, 1); ss += __shfl_xor(ss, 2); ss += __shfl_xor(ss, 4); ss += __shfl_xor(ss, 8);
    const float rn = rsqrtf(ss + 1e-6f) * post;
#pragma unroll
    for (int i = 0; i < 8; ++i) v[i] *= rn;
}
template <class F> DI void gdn_compute1(CArgs& a, int l, int u, const GdnRaw<1>& rw, LAS unsigned char* lds, LAS float* slot, F&& prefetch) {
    const int tid = ltid(), wid = tid >> 6, lane = tid & 63; const int h = (u >> 6) & 3;
    LAS bf16_t* Kb = (LAS bf16_t*)lds; LAS float* SB = (LAS float*)(lds + 17408); LAS float* SC = (LAS float*)(lds + 17408 + 256); const LAS float* WT = (const LAS float*)(lds + 17920);
    gdn_scalars_r(WT + 512, rw.ar, rw.br, SB, SC);
#pragma unroll
    for (int rep = 0; rep < 2; ++rep) { const int idx = rep * NTHREADS + tid, l_ = idx >> 4, grp = idx & 15; float v[8]; conv8r(rw.t[0][rep], WT + grp * 8, 128, nullptr, v); gdn_norm8(v, 1.f);
        *(LAS u32x4*)(Kb + l_ * 136 + grp * 8) = (u32x4){pk2(v[0], v[1]), pk2(v[2], v[3]), pk2(v[4], v[5]), pk2(v[6], v[7])}; }
    prefetch();
    lds_barrier();
#pragma unroll
    for (int t2 = 0; t2 < 2; ++t2) { const int t = wid * 2 + t2, mt = t >> 2, nt = t & 3; const f32x4 acc = mm16<128>(Kb, 136, mt * 16, Kb, 136, nt * 16, lane);
        const int r = lane & 15, q = lane >> 4, m = nt * 16 + r; const float cm = SC[m];
        const f32x4 scl = *(const LAS f32x4*)(SC + mt * 16 + 4 * q), sbl = *(const LAS f32x4*)(SB + mt * 16 + 4 * q);
#pragma unroll
        for (int j = 0; j < 4; ++j) { const int lrow = mt * 16 + 4 * q + j; const float e = sbl[j] * acc[j] * __expf(scl[j] - cm); slot[lrow * 65 + m] = (m < lrow) ? e : 0.f; } }
    lds_barrier();
}
DI float rdl(float v, int l) { return __uint_as_float((unsigned)__builtin_amdgcn_readlane((int)__float_as_uint(v), l)); }
DI void gdn_invert(LAS float* sl, bf16_t* tout, int lane) {
#pragma unroll 1
    for (int I = 0; I < 4; ++I) {
        float ar[16], x[16], tn[16];
#pragma unroll
        for (int r = 0; r < 16; ++r) { ar[r] = sl[(16 * I + r) * 65 + lane]; x[r] = 0.f; }
#pragma unroll 2
        for (int m = 0; m < 16 * I; ++m) { const float t = sl[m * 65 + lane];
#pragma unroll
            for (int r = 0; r < 16; ++r) x[r] += rdl(ar[r], m) * t; }
#pragma unroll
        for (int r = 0; r < 16; ++r) { float acc = ((lane == 16 * I + r) ? 1.f : 0.f) - x[r];
#pragma unroll
            for (int m2 = 0; m2 < r; ++m2) acc -= rdl(ar[r], 16 * I + m2) * tn[m2];
            tn[r] = acc; }
#pragma unroll
        for (int r = 0; r < 16; ++r) sl[(16 * I + r) * 65 + lane] = tn[r];
    }
#pragma unroll 4
    for (int it = 0; it < 32; ++it) { const int rowi = it * 2 + (lane >> 5), cj = (lane & 31) * 2; ((unsigned*)tout)[rowi * 32 + (lane & 31)] = pk2(sl[rowi * 65 + cj], sl[rowi * 65 + cj + 1]); }
}
template <class F> DI void gdn_compute2(CArgs& a, int l, int u, const GdnRaw<3>& rw, LAS unsigned char* lds, F&& prefetch) {
    const int tid = ltid(), wid = tid >> 6, lane = tid & 63; const int h = (u >> 6) & 3;
    LAS bf16_t* Kb = (LAS bf16_t*)lds; LAS bf16_t* Qb = (LAS bf16_t*)(lds + 17408); LAS bf16_t* SOL = (LAS bf16_t*)lds;
    LAS bf16_t* RT = (LAS bf16_t*)(lds + 34816); LAS bf16_t* KT = (LAS bf16_t*)(lds + 71680); LAS bf16_t* Tb = (LAS bf16_t*)(lds + 90112); LAS bf16_t* PB = (LAS bf16_t*)(lds + 99328);
    LAS float* SB = (LAS float*)(lds + 108544); LAS float* SC = (LAS float*)(lds + 108544 + 256); const LAS float* WT = (const LAS float*)(lds + 109056);
    char* ub = a.ws + WS_R1 + R1_SGDN + (size_t)u * GDN_UNIT;
    gdn_scalars_r(WT + 1536, rw.ar, rw.br, SB, SC);
    float vq[2][8], vk[2][8], vv[2][8];
#pragma unroll
    for (int rep = 0; rep < 2; ++rep) { const int grp = (rep * NTHREADS + tid) & 15;
        conv8r(rw.t[0][rep], WT + grp * 8, 128, nullptr, vq[rep]); gdn_norm8(vq[rep], 0.08838834764831845f);
        conv8r(rw.t[1][rep], WT + 512 + grp * 8, 128, nullptr, vk[rep]); gdn_norm8(vk[rep], 1.f);
        conv8r(rw.t[2][rep], WT + 1024 + grp * 8, 128, nullptr, vv[rep]); }
    *(LAS u32x4*)(Tb + (tid >> 3) * 72 + (tid & 7) * 8) = rw.tb;
    prefetch();
    lds_barrier();
#pragma unroll
    for (int rep = 0; rep < 2; ++rep) { const int idx = rep * NTHREADS + tid, l_ = idx >> 4, grp = idx & 15; const float cl = SC[l_], c63 = SC[63], be = SB[l_];
        *(LAS u32x4*)(Qb + l_ * 136 + grp * 8) = (u32x4){pk2(vq[rep][0], vq[rep][1]), pk2(vq[rep][2], vq[rep][3]), pk2(vq[rep][4], vq[rep][5]), pk2(vq[rep][6], vq[rep][7])};
        { const float eq = __expf(cl); float qd[8];
#pragma unroll
          for (int i = 0; i < 8; ++i) qd[i] = vq[rep][i] * eq;
          frag_store8(ub + GDN_OQ, 8, l_, grp * 8, qd); }
        *(LAS u32x4*)(Kb + l_ * 136 + grp * 8) = (u32x4){pk2(vk[rep][0], vk[rep][1]), pk2(vk[rep][2], vk[rep][3]), pk2(vk[rep][4], vk[rep][5]), pk2(vk[rep][6], vk[rep][7])};
        { const float e1 = be * __expf(cl), e2 = __expf(c63 - cl);
#pragma unroll
          for (int i = 0; i < 8; ++i) { RT[swz64(128 + grp * 8 + i, l_)] = f2bf(vk[rep][i] * e1); KT[swz64(grp * 8 + i, l_)] = f2bf(vk[rep][i] * e2); RT[swz64(grp * 8 + i, l_)] = f2bf(vv[rep][i] * be); } } }
    if (tid < 128) ((float*)(ub + GDN_OD))[tid] = __expf(SC[63]);
    lds_barrier();
#pragma unroll
    for (int t2 = 0; t2 < 2; ++t2) { const int t = wid * 2 + t2, mt = t >> 2, nt = t & 3; const f32x4 acc = mm16<128>(Qb, 136, mt * 16, Kb, 136, nt * 16, lane);
        const int r = lane & 15, q = lane >> 4, m = nt * 16 + r; const float cm = SC[m];
        const f32x4 scl = *(const LAS f32x4*)(SC + mt * 16 + 4 * q);
#pragma unroll
        for (int j = 0; j < 4; ++j) { const int lrow = mt * 16 + 4 * q + j; const float e = acc[j] * __expf(scl[j] - cm); PB[lrow * 72 + m] = f2bf(m <= lrow ? e : 0.f); } }
    f32x4 sacc[8];
#pragma unroll
    for (int t2 = 0; t2 < 8; ++t2) { const int t = wid * 8 + t2, mt = t & 3, ntile = t >> 2; sacc[t2] = mm16<64, true>(Tb, 72, mt * 16, RT, 72, ntile * 16, lane); }
    lds_barrier();
#pragma unroll
    for (int t2 = 0; t2 < 8; ++t2) { const int t = wid * 8 + t2, mt = t & 3, ntile = t >> 2; const int r = lane & 15, q = lane >> 4, cc = ntile * 16 + r; const float sg = cc < 128 ? 1.f : -1.f;
#pragma unroll
        for (int j = 0; j < 4; ++j) SOL[(mt * 16 + 4 * q + j) * 264 + cc] = f2bf(sacc[t2][j] * sg); }
    lds_barrier();
    for (int dup_ = 0; dup_ < PROBE_DUPST; ++dup_) {
    export_frags<false, 64, 64>(ub + GDN_OP, PB, 72, 0);
    export_frags<true, 128, 64>(ub + GDN_OK, KT, 72, 0);
    export_frags<false, 64, 128>(ub + GDN_OW, SOL, 264, 128);
    export_acc(ub + GDN_OU, SOL, 264, 4); }
    lds_barrier();
}
DI void phase_prep(CArgs& a, int l, LAS unsigned char* lds) {
    const int wid = ltid() >> 6, lane = ltid() & 63; const int w = lbid(), Gd = lgrid();
#ifndef REP_PGDN
#define REP_PGDN 1
#endif
#ifndef REP_PGLA
#define REP_PGLA 1
#endif
#ifndef REP_PSSD
#define REP_PSSD 1
#endif
    for (int rp_ = 0; rp_ < REP_PGDN; ++rp_)
    { const int upw = (2048 + Gd - 1) / Gd, u0 = w * upw, u1 = (u0 + upw < 2048) ? u0 + upw : 2048;
      LAS float* slots = (LAS float*)(lds + 20480);
      for (int ub = u0; ub < u1; ub += 8) { const int nb = (u1 - ub) < 8 ? (u1 - ub) : 8; int curh = -1;
#ifndef REP_G1
#define REP_G1 1
#endif
#ifndef REP_G2
#define REP_G2 1
#endif
          for (int rg1 = 0; rg1 < REP_G1; ++rg1) { curh = -1;
          GdnRaw<1> r1; gdn_load<1>(a, ub, r1, false);
          for (int j = 0; j < nb; ++j) { const int u = ub + j;
              if ((u >> 6) != curh) { curh = u >> 6; lds_barrier(); LAS float* WT = (LAS float*)(lds + 17920); for (int i = ltid(); i < 512; i += NTHREADS) WT[i] = a.gdn_conv_w[(size_t)l * 4 * 1536 + (i >> 7) * 1536 + 512 + (curh & 3) * 128 + (i & 127)];
                  if (ltid() == 0) { WT[512] = -__expf(a.gdn_a_log[l * 4 + (curh & 3)]); WT[513] = a.gdn_dt_bias[l * 4 + (curh & 3)]; } lds_barrier(); }
              GdnRaw<1> rn = r1;
              gdn_compute1(a, l, u, r1, lds, slots + j * 4160, [&]() { if (j + 1 < nb) gdn_load<1>(a, u + 1, rn, false); }); r1 = rn; }
          if (wid < nb) gdn_invert(slots + wid * 4160, (bf16_t*)(a.ws + WS_TSCR) + (size_t)(ub + wid) * 4096, lane);
          asm volatile("s_waitcnt vmcnt(0)" ::: "memory");
          __syncthreads(); }
          for (int rg2 = 0; rg2 < REP_G2; ++rg2) {
          curh = -1;
          GdnRaw<3> r3; gdn_load<3>(a, ub, r3, true);
          for (int j = 0; j < nb; ++j) { const int u = ub + j;
              if ((u >> 6) != curh) { curh = u >> 6; lds_barrier(); gdn_table(a, l, curh & 3, (LAS float*)(lds + 109056)); lds_barrier(); }
              GdnRaw<3> rn = r3;
              gdn_compute2(a, l, u, r3, lds, [&]() { if (j + 1 < nb) gdn_load<3>(a, u + 1, rn, true); }); r3 = rn; } } } }
    for (int rp_ = 0; rp_ < REP_PGLA; ++rp_)
    { const int upw = (2048 + Gd - 1) / Gd, u0 = w * upw, u1 = (u0 + upw < 2048) ? u0 + upw : 2048; int curh = -1;
      if (u0 < u1) { GlaRaw r; gla_load(a, u0, r);
          for (int u = u0; u < u1; ++u) {
              if ((u >> 6) != curh) { curh = u >> 6; lds_barrier(); gla_table(a, l, curh & 3, (LAS float*)(lds + 72960)); lds_barrier(); }
              GlaRaw rn = r;
              gla_compute(a, u, r, lds, [&]() { if (u + 1 < u1) gla_load(a, u + 1, rn); }); r = rn; } } }
    for (int rp_ = 0; rp_ < REP_PSSD; ++rp_)
    { const int upw = (4096 + Gd - 1) / Gd, u0 = w * upw, u1 = (u0 + upw < 4096) ? u0 + upw : 4096; int curh = -1;
      if (u0 < u1) { SsdRaw r; ssd_load(a, u0, r); SsdV v;
          curh = u0 >> 6; lds_barrier(); ssd_table(a, l, curh & 7, (LAS float*)(lds + 47104)); lds_barrier();
          ssd_front(r, lds, v); if (u0 + 1 < u1) ssd_load(a, u0 + 1, r); lds_barrier();
          for (int u = u0; u < u1; ++u) { const bool more = u + 1 < u1;
              ssd_back(a, u, v, lds, [&]() { ssd_touch(r);
                  if (more) {
                  if (((u + 1) >> 6) != curh) { curh = (u + 1) >> 6; lds_barrier(); ssd_table(a, l, curh & 7, (LAS float*)(lds + 47104)); lds_barrier(); }
                  ssd_front(r, lds, v); ssd_pin(v);
                  if (u + 2 < u1) ssd_load(a, u + 2, r); } }); } } }
}
DI bf16x8 pack16(const f32x16& x, int s) {
    u32x4 p; p.x = pk2(x[8 * s], x[8 * s + 1]); p.y = pk2(x[8 * s + 2], x[8 * s + 3]); p.z = pk2(x[8 * s + 4], x[8 * s + 5]); p.w = pk2(x[8 * s + 6], x[8 * s + 7]);
    return __builtin_bit_cast(bf16x8, p);
}
#define MFMA32(a, b, c) __builtin_amdgcn_mfma_f32_32x32x16_bf16((a), (b), (c), 0, 0, 0)
template <int DK, bool HAS_W, int NH, int NCT, int UNIT, int OQ, int OW, int OP, int OK, int OU, int OD>
DI void scan_wg(const char* ops0, const char* ops1, char* ob0, char* ob1, LAS unsigned char* lds, unsigned* prog = nullptr) {
    constexpr int NKB = DK / 16, NDT = DK / 32, BUF = NH * UNIT, OUNIT = NCT * 2 * 2048;
    static_assert(2 * BUF <= LDS_CTRL, "scan LDS");
    const int tid = ltid(), wid = __builtin_amdgcn_readfirstlane(tid >> 6), lane = tid & 63, h = lane >> 5;
    const int hd = (NH == 2) ? (wid >> 1) & 1 : 0, ct = (NH == 2) ? (wid & 1) : (wid & 3); const bool computes = (NH == 2) || wid < NCT;
    static_assert(UNIT % 1024 == 0, "unit = whole 1 KiB chunks");
    if (wid >= 4) {
        constexpr int NCH = UNIT / 1024, NL = (NCH + 3) / 4;
        const int lw = wid - 4;
        u32x4 R0[NH][NL], R1[NH][NL];
        auto issue = [&](int n, u32x4 (&R)[NH][NL]) {
#pragma unroll
            for (int k = 0; k < NH; ++k) { const char* src = (k == 0 ? ops0 : ops1) + (size_t)n * UNIT + lane * 16;
#pragma unroll
                for (int j = 0; j < NL; ++j) { const int ch = j * 4 + lw; const char* pp = src + (size_t)(ch < NCH ? ch : 0) * 1024;
                    asm volatile("global_load_dwordx4 %0, %1, off" : "=&v"(R[k][j]) : "v"(pp) : "memory"); } } };
        auto put = [&](int buf, u32x4 (&R)[NH][NL], bool newer_in_flight) {
            if (newer_in_flight) asm volatile("s_waitcnt vmcnt(%0)" :: "n"(NH * NL) : "memory"); else asm volatile("s_waitcnt vmcnt(0)" ::: "memory");
#pragma unroll
            for (int k = 0; k < NH; ++k) { LAS unsigned char* dst = lds + buf * BUF + k * UNIT + lane * 16;
#pragma unroll
                for (int j = 0; j < NL; ++j) { const int ch = j * 4 + lw; asm volatile("" : "+v"(R[k][j])); if (ch < NCH) *(LAS u32x4*)(dst + ch * 1024) = R[k][j]; } } };
        issue(0, R0); issue(1, R1);
        put(0, R0, true); issue(2, R0);
        lds_barrier();
#pragma unroll
        for (int n = 0; n < 64; n += 2) {
            put(1, R1, n + 2 < 64); if (n + 3 < 64) issue(n + 3, R1);
            if (prog && tid == 256) __hip_atomic_store(prog, (unsigned)(n + 1), __ATOMIC_RELAXED, __HIP_MEMORY_SCOPE_AGENT);
            lds_barrier();
            if (n + 2 < 64) put(0, R0, n + 3 < 64); if (n + 4 < 64) issue(n + 4, R0);
            if (prog && tid == 256) __hip_atomic_store(prog, (unsigned)(n + 2), __ATOMIC_RELAXED, __HIP_MEMORY_SCOPE_AGENT);
            lds_barrier();
        }
        return;
    }
    f32x16 S[NDT]; bf16x8 Sb[NKB];
#pragma unroll
    for (int d = 0; d < NDT; ++d)
#pragma unroll
        for (int i = 0; i < 16; ++i) S[d][i] = 0.f;
#pragma unroll
    for (int k = 0; k < NKB; ++k) Sb[k] = (bf16x8){0, 0, 0, 0, 0, 0, 0, 0};
    lds_barrier();
    char* ob = (hd == 0 ? ob0 : ob1);
#pragma unroll 1
    for (int n = 0; n < 64; ++n) {
        if (computes) {
            const LAS unsigned char* lb = lds + (n & 1) * BUF + hd * UNIT;
            const unsigned fbase = (unsigned)(size_t)(lb) + (unsigned)lane * 16u;
#ifdef PROBE_LDS2
#define SC_LDG(f, OFF) do { _Pragma("unroll") for (int kb_ = 0; kb_ < 4; ++kb_) { asm volatile("ds_read_b128 %0, %1 offset:%2" : "=&v"(f[kb_]) : "v"(fbase), "n"((OFF) + kb_ * 1024) : "memory"); asm volatile("ds_read_b128 %0, %1 offset:%2" : "+v"(f[kb_]) : "v"(fbase), "n"((OFF) + kb_ * 1024) : "memory"); } } while (0)
#define SC_WAIT(f, N) asm volatile("s_waitcnt lgkmcnt(%4)" : "+v"(f[0]), "+v"(f[1]), "+v"(f[2]), "+v"(f[3]) : "n"(2 * (N)) : "memory")
#else
#define SC_LDG(f, OFF) do { _Pragma("unroll") for (int kb_ = 0; kb_ < 4; ++kb_) asm volatile("ds_read_b128 %0, %1 offset:%2" : "=&v"(f[kb_]) : "v"(fbase), "n"((OFF) + kb_ * 1024) : "memory"); } while (0)
#define SC_WAIT(f, N) asm volatile("s_waitcnt lgkmcnt(" #N ")" : "+v"(f[0]), "+v"(f[1]), "+v"(f[2]), "+v"(f[3]) :: "memory")
#endif
            f32x16 U[2], O[2];
#pragma unroll
            for (int rt = 0; rt < 2; ++rt) { const LAS unsigned char* up = lb + OU + ((ct * 2 + rt) * 64 + lane) * 32; const u32x4 w0 = *(const LAS u32x4*)up, w1 = *(const LAS u32x4*)(up + 16);
                U[rt][0] = bflo(w0.x); U[rt][1] = bfhi(w0.x); U[rt][2] = bflo(w0.y); U[rt][3] = bfhi(w0.y); U[rt][4] = bflo(w0.z); U[rt][5] = bfhi(w0.z); U[rt][6] = bflo(w0.w); U[rt][7] = bfhi(w0.w);
                U[rt][8] = bflo(w1.x); U[rt][9] = bfhi(w1.x); U[rt][10] = bflo(w1.y); U[rt][11] = bfhi(w1.y); U[rt][12] = bflo(w1.z); U[rt][13] = bfhi(w1.z); U[rt][14] = bflo(w1.w); U[rt][15] = bfhi(w1.w);
#pragma unroll
                for (int i = 0; i < 16; ++i) O[rt][i] = 0.f; }
            asm volatile("s_waitcnt lgkmcnt(0)" ::: "memory");
            constexpr int GW = HAS_W ? 2 * (NKB / 4) : 0, GQ = 2 * (NKB / 4), GP = 2, GK = NDT, GT = GW + GQ + GP + GK;
            bf16x8 fa[4], fb[4], Ub[4];
            if constexpr (HAS_W) SC_LDG(fa, OW); else SC_LDG(fa, OQ);
#pragma unroll
            for (int g = 0; g < GT; ++g) {
                bf16x8 (&fc)[4] = (g & 1) ? fb : fa; bf16x8 (&fn)[4] = (g & 1) ? fa : fb;
                { constexpr int dummy = 0; (void)dummy; const int g1 = g + 1;
                  if (g1 < GW) SC_LDG(fn, OW + g1 * 4096);
                  else if (g1 < GW + GQ) SC_LDG(fn, OQ + (g1 - GW) * 4096);
                  else if (g1 < GW + GQ + GP) SC_LDG(fn, OP + (g1 - GW - GQ) * 4096);
                  else if (g1 < GT) SC_LDG(fn, OK + (g1 - GW - GQ - GP) * 4096);
                  if (g1 < GT) SC_WAIT(fc, 4); else SC_WAIT(fc, 0); }
                if (g < GW) { const int rt = g / (NKB / 4), k4 = (g % (NKB / 4)) * 4;
#pragma unroll
                    for (int kb = 0; kb < 4; ++kb) U[rt] = MFMA32(fc[kb], Sb[k4 + kb], U[rt]); }
                else if (g < GW + GQ) { const int gg = g - GW, rt = gg / (NKB / 4), k4 = (gg % (NKB / 4)) * 4;
#pragma unroll
                    for (int kb = 0; kb < 4; ++kb) O[rt] = MFMA32(fc[kb], Sb[k4 + kb], O[rt]);
                    if (gg == GQ - 1) { Ub[0] = pack16(U[0], 0); Ub[1] = pack16(U[0], 1); Ub[2] = pack16(U[1], 0); Ub[3] = pack16(U[1], 1); } }
                else if (g < GW + GQ + GP) { const int rt = g - GW - GQ;
#pragma unroll
                    for (int kb = 0; kb < 4; ++kb) O[rt] = MFMA32(fc[kb], Ub[kb], O[rt]);
                    char* op = ob + (size_t)n * OUNIT + ((ct * 2 + rt) * 64 + lane) * 32;
                    *(u32x4*)op = (u32x4){pk2(O[rt][0], O[rt][1]), pk2(O[rt][2], O[rt][3]), pk2(O[rt][4], O[rt][5]), pk2(O[rt][6], O[rt][7])};
                    *(u32x4*)(op + 16) = (u32x4){pk2(O[rt][8], O[rt][9]), pk2(O[rt][10], O[rt][11]), pk2(O[rt][12], O[rt][13]), pk2(O[rt][14], O[rt][15])}; }
                else { const int d = g - GW - GQ - GP;
#pragma unroll
                    for (int gq = 0; gq < 4; ++gq) { const f32x4 dv = *(const LAS f32x4*)(lb + OD + (d * 32 + 8 * gq + 4 * h) * 4);
                        S[d][4 * gq] *= dv[0]; S[d][4 * gq + 1] *= dv[1]; S[d][4 * gq + 2] *= dv[2]; S[d][4 * gq + 3] *= dv[3]; }
#pragma unroll
                    for (int kb = 0; kb < 4; ++kb) S[d] = MFMA32(fc[kb], Ub[kb], S[d]);
                    Sb[2 * d] = pack16(S[d], 0); Sb[2 * d + 1] = pack16(S[d], 1); }
            }
#undef SC_LDG
#undef SC_WAIT
        }
        lds_barrier();
    }
}
#ifndef WARM_LEAD
#define WARM_LEAD 5
#endif
DI void scan_warm(const char* ops, int k, int kstride, int unit, const unsigned* prog) {
    const int tid = ltid();
    for (int n = k; n < 64; n += kstride) {
        for (int sp = 0; sp < 4000; ++sp) { const unsigned pv = __hip_atomic_load(prog, __ATOMIC_RELAXED, __HIP_MEMORY_SCOPE_AGENT); if ((int)pv + WARM_LEAD >= n) break; __builtin_amdgcn_s_sleep(8); }
        const char* src = ops + (size_t)n * unit; const int np = unit / 16;
#pragma unroll 1
        for (int i = tid; i < np; i += NTHREADS * 4) { u32x4 t0, t1, t2, t3;
            asm volatile("global_load_dwordx4 %0, %1, off" : "=&v"(t0) : "v"(src + (size_t)i * 16) : "memory");
            asm volatile("global_load_dwordx4 %0, %1, off" : "=&v"(t1) : "v"(src + (size_t)((i + NTHREADS) < np ? i + NTHREADS : i) * 16) : "memory");
            asm volatile("global_load_dwordx4 %0, %1, off" : "=&v"(t2) : "v"(src + (size_t)((i + 2 * NTHREADS) < np ? i + 2 * NTHREADS : i) * 16) : "memory");
            asm volatile("global_load_dwordx4 %0, %1, off" : "=&v"(t3) : "v"(src + (size_t)((i + 3 * NTHREADS) < np ? i + 3 * NTHREADS : i) * 16) : "memory");
            asm volatile("s_waitcnt vmcnt(0)" : "+v"(t0), "+v"(t1), "+v"(t2), "+v"(t3) :: "memory"); }
    }
}
DI void phase_scan(CArgs& a, int l, LAS unsigned char* lds) {
    char* r1 = a.ws + WS_R1; char* obuf = r1 + R1_OBUF; const int Gd = lgrid();
    unsigned* prog = (unsigned*)(a.ws + WS_CTL + 32768) + l * 64 * 16;
    for (int it = lbid(); it < 256; it += Gd) {
        if (it < 32) { const char* ops = r1 + R1_SGDN + (size_t)it * 64 * GDN_UNIT; char* ob = obuf + OB_GDN + (size_t)it * 64 * 16384;
#ifndef REP_SGDN
#define REP_SGDN 1
#endif
            for (int rq = 0; rq < REP_SGDN; ++rq)
            scan_wg<128, true, 1, 4, GDN_UNIT, GDN_OQ, GDN_OW, GDN_OP, GDN_OK, GDN_OU, GDN_OD>(ops, ops, ob, ob, lds, Gd >= 256 ? prog + it * 16 : nullptr); }
        else if (it < 64) { const int i2 = it - 32; const char* ops = r1 + R1_SGLA + (size_t)i2 * 64 * GLA_UNIT; char* ob = obuf + OB_GLA + (size_t)i2 * 64 * 16384;
#ifndef REP_SGLA
#define REP_SGLA 1
#endif
            for (int rq = 0; rq < REP_SGLA; ++rq)
            scan_wg<64, false, 1, 4, GLA_UNIT, GLA_OQ, 0, GLA_OP, GLA_OK, GLA_OU, GLA_OD>(ops, ops, ob, ob, lds, Gd >= 256 ? prog + it * 16 : nullptr); }
        else if (it < 128) { const int i2 = it - 64; const char* ops = r1 + R1_SSSD + (size_t)i2 * 64 * SSD_UNIT; char* ob = obuf + OB_SSD + (size_t)i2 * 64 * 8192;
#ifndef REP_SSSD
#define REP_SSSD 1
#endif
            for (int rq = 0; rq < REP_SSSD; ++rq)
            scan_wg<64, false, 1, 2, SSD_UNIT, SSD_OQ, 0, SSD_OP, SSD_OK, SSD_OU, SSD_OD>(ops, ops, ob, ob, lds); }
        else if (Gd >= 256) { const int j = it - 128;
            if (j < 96) { const int c = j & 31, k = j >> 5; scan_warm(r1 + R1_SGDN + (size_t)c * 64 * GDN_UNIT, k, 3, GDN_UNIT, prog + c * 16); }
            else { const int g = j - 96; scan_warm(r1 + R1_SGLA + (size_t)g * 64 * GLA_UNIT, 0, 1, GLA_UNIT, prog + (32 + g) * 16); } }
    }
}

DI float otile_ld(const LAS unsigned char* tl, int l_, int e) {
    const int ct = e >> 5, r = e & 31, rt = l_ >> 5, lr = l_ & 31, h = (lr >> 2) & 1, i = (lr & 3) + 4 * (lr >> 3);
    return bf2f(*(const LAS bf16_t*)(tl + ((ct * 2 + rt) * 64 + h * 32 + r) * 32 + i * 2));
}
struct PostRaw { u32x4 ot[2], g0, g1; };
DI void post_load(CArgs& a, int u, PostRaw& r) {
    const int tid = ltid(); const int ty = u >> 11, uu = u & 2047, n = uu & 63, bh = uu >> 6, b = bh >> 2, h = bh & 3; const int l_ = tid >> 3, sub = tid & 7; const size_t T = (size_t)b * SEQ + n * 64 + l_;
    const char* src = a.ws + WS_R1 + R1_OBUF + (ty ? OB_GDN : OB_GLA) + (size_t)uu * 16384;
    r.ot[0] = *(const u32x4*)(src + (size_t)tid * 16); r.ot[1] = *(const u32x4*)(src + (size_t)(NTHREADS + tid) * 16);
    const bf16_t* gp = (const bf16_t*)(a.ws + WS_R1 + R1_PROJ) + T * NP + (ty ? PC_GDN_G : PC_GLA_R) + h * 128 + sub * 16;
    r.g0 = *(const u32x4*)gp; r.g1 = *(const u32x4*)(gp + 8);
}
struct PostRawS { u32x4 ot[4], z[4], xc[4]; };
DI void post_load_s(CArgs& a, int uu, PostRawS& r) {
    const int tid = ltid(); const int n = uu & 63, bg = uu >> 6, b = bg >> 1, g = bg & 1; const int l_ = tid >> 3, sub = tid & 7; const size_t T = (size_t)b * SEQ + n * 64 + l_;
    const char* obuf = a.ws + WS_R1 + R1_OBUF;
#pragma unroll
    for (int rep = 0; rep < 4; ++rep) r.ot[rep] = *(const u32x4*)(obuf + OB_SSD + ((size_t)((b * 8 + g * 4 + rep) * 64 + n)) * 8192 + (size_t)tid * 16);
    const int hh = g * 4 + (sub >> 1), p0 = (sub & 1) * 32;
    const bf16_t* zp = (const bf16_t*)(a.ws + WS_R1 + R1_PROJ) + T * NP + PC_SSD_Z + hh * 64 + p0; const bf16_t* xp = (const bf16_t*)(a.ws + WS_R1 + R1_XCONV) + T * 512 + hh * 64 + p0;
#pragma unroll
    for (int c8 = 0; c8 < 4; ++c8) { r.z[c8] = *(const u32x4*)(zp + c8 * 8); r.xc[c8] = *(const u32x4*)(xp + c8 * 8); }
}
DI void phase_post(CArgs& a, int l, LAS unsigned char* lds) {
    const int tid = ltid(); bf16_t* Y = (bf16_t*)(a.ws + WS_R1 + R1_YMIX); unsigned char* Y8 = (unsigned char*)Y; (void)Y8;
    const int l_ = tid >> 3, sub = tid & 7; const int w = lbid(), Gd = lgrid();
    { const int upw = (4096 + Gd - 1) / Gd, u0 = w * upw, u1 = (u0 + upw < 4096) ? u0 + upw : 4096;
      auto unit = [&](int u, const LAS unsigned char* tl, const u32x4& g0, const u32x4& g1) {
            const int ty = u >> 11, uu = u & 2047, n = uu & 63, bh = uu >> 6, b = bh >> 2, h = bh & 3; const size_t T = (size_t)b * SEQ + n * 64 + l_;
            float o[16]; float ss = 0.f;
#pragma unroll
            for (int j = 0; j < 16; ++j) { o[j] = otile_ld(tl, l_, sub * 16 + j); ss += o[j] * o[j]; }
            ss += __shfl_xor(ss, 1); ss += __shfl_xor(ss, 2); ss += __shfl_xor(ss, 4);
            const float rs = rsqrtf(ss * (1.f / 128.f) + 1e-6f);
            const float* ng = (ty ? a.gdn_norm : a.gla_norm) + l * 128 + sub * 16;
            const float gv[16] = {bflo(g0.x), bfhi(g0.x), bflo(g0.y), bfhi(g0.y), bflo(g0.z), bfhi(g0.z), bflo(g0.w), bfhi(g0.w), bflo(g1.x), bfhi(g1.x), bflo(g1.y), bfhi(g1.y), bflo(g1.z), bfhi(g1.z), bflo(g1.w), bfhi(g1.w)};
            float y[16];
#pragma unroll
            for (int j = 0; j < 16; ++j) y[j] = o[j] * rs * ng[j] * silu_(gv[j]);
#if BRANCH_FP8
            *(u32x4*)(Y8 + ((size_t)ty * NTOK + T) * 512 + h * 128 + sub * 16) = (u32x4){pk4_fp8(y[0], y[1], y[2], y[3]), pk4_fp8(y[4], y[5], y[6], y[7]), pk4_fp8(y[8], y[9], y[10], y[11]), pk4_fp8(y[12], y[13], y[14], y[15])};
#else
            bf16_t* yp = Y + ((size_t)ty * NTOK + T) * 512 + h * 128 + sub * 16;
            *(u32x4*)yp = (u32x4){pk2(y[0], y[1]), pk2(y[2], y[3]), pk2(y[4], y[5]), pk2(y[6], y[7])};
            *(u32x4*)(yp + 8) = (u32x4){pk2(y[8], y[9]), pk2(y[10], y[11]), pk2(y[12], y[13]), pk2(y[14], y[15])};
#endif
      };
      if (u0 < u1) { PostRaw ra, rb; post_load(a, u0, ra); rb = ra; if (u0 + 1 < u1) post_load(a, u0 + 1, rb);
        for (int u = u0; u < u1; u += 2) { const bool hasb = u + 1 < u1; PostRaw na = ra, nb = rb;
            *(LAS u32x4*)(lds + tid * 16) = ra.ot[0]; *(LAS u32x4*)(lds + (NTHREADS + tid) * 16) = ra.ot[1];
            *(LAS u32x4*)(lds + 16384 + tid * 16) = rb.ot[0]; *(LAS u32x4*)(lds + 16384 + (NTHREADS + tid) * 16) = rb.ot[1];
            const u32x4 ga0 = ra.g0, ga1 = ra.g1, gb0 = rb.g0, gb1 = rb.g1;
            if (u + 2 < u1) post_load(a, u + 2, na);
            if (u + 3 < u1) post_load(a, u + 3, nb);
            lds_barrier();
            unit(u, lds, ga0, ga1);
            if (hasb) unit(u + 1, lds + 16384, gb0, gb1);
            lds_barrier();
            ra = na; rb = nb; } } }
    { const int upw = (1024 + Gd - 1) / Gd, u0 = w * upw, u1 = (u0 + upw < 1024) ? u0 + upw : 1024;
      if (u0 < u1) { PostRawS rw; post_load_s(a, u0, rw);
        for (int uu = u0; uu < u1; ++uu) { PostRawS rn = rw;
            const int n = uu & 63, bg = uu >> 6, b = bg >> 1, g = bg & 1; const size_t T = (size_t)b * SEQ + n * 64 + l_;
#pragma unroll
            for (int rep = 0; rep < 4; ++rep) *(LAS u32x4*)(lds + (rep * NTHREADS + tid) * 16) = rw.ot[rep];
            u32x4 z8[4], x8[4];
#pragma unroll
            for (int c8 = 0; c8 < 4; ++c8) { z8[c8] = rw.z[c8]; x8[c8] = rw.xc[c8]; }
            if (uu + 1 < u1) post_load_s(a, uu + 1, rn);
            lds_barrier();
            const int hq = sub >> 1, hh = g * 4 + hq, p0 = (sub & 1) * 32; const float dsk = a.ssd_d[l * 8 + hh];
            float y[32]; float ss = 0.f;
#pragma unroll
            for (int c8 = 0; c8 < 4; ++c8) {
                const float zf[8] = {bflo(z8[c8].x), bfhi(z8[c8].x), bflo(z8[c8].y), bfhi(z8[c8].y), bflo(z8[c8].z), bfhi(z8[c8].z), bflo(z8[c8].w), bfhi(z8[c8].w)};
                const float xf[8] = {bflo(x8[c8].x), bfhi(x8[c8].x), bflo(x8[c8].y), bfhi(x8[c8].y), bflo(x8[c8].z), bfhi(x8[c8].z), bflo(x8[c8].w), bfhi(x8[c8].w)};
#pragma unroll
                for (int j = 0; j < 8; ++j) { const float ov = otile_ld(lds + hq * 8192, l_, p0 + c8 * 8 + j); const float yv = (ov + dsk * xf[j]) * silu_(zf[j]); y[c8 * 8 + j] = yv; ss += yv * yv; } }
            ss += __shfl_xor(ss, 1); ss += __shfl_xor(ss, 2); ss += __shfl_xor(ss, 4);
            const float rs = rsqrtf(ss * (1.f / 256.f) + 1e-6f);
            const float* ng = a.ssd_norm + l * 512 + hh * 64 + p0;
            bf16_t* yp = Y + ((size_t)2 * NTOK + T) * 512 + hh * 64 + p0; (void)yp;
#pragma unroll
            for (int c8 = 0; c8 < 4; ++c8) { float t[8];
#pragma unroll
                for (int j = 0; j < 8; ++j) t[j] = y[c8 * 8 + j] * rs * ng[c8 * 8 + j];
#if BRANCH_FP8
                *(u32x2*)(Y8 + ((size_t)2 * NTOK + T) * 512 + hh * 64 + p0 + c8 * 8) = (u32x2){pk4_fp8(t[0], t[1], t[2], t[3]), pk4_fp8(t[4], t[5], t[6], t[7])};
#else
                *(u32x4*)(yp + c8 * 8) = (u32x4){pk2(t[0], t[1]), pk2(t[2], t[3]), pk2(t[4], t[5]), pk2(t[6], t[7])};
#endif
            }
            lds_barrier();
            rw = rn; } } }
}
DI CArgs& load_args() { CArgs* p = (CArgs*)__builtin_amdgcn_kernarg_segment_ptr(); asm volatile("" : "+s"(p)); return *p; }
DI void grid_sync(LAS unsigned char* lds) {
    CArgs& a = load_args(); XcdBarrier b; b.bar = (unsigned*)(a.ws + WS_CTL); b.x = xb_xcc_id(); b.st = (volatile LAS unsigned*)(lds + LDS_CTRL); xcd_barrier(b); }
__global__ void __launch_bounds__(NTHREADS, 2) fwd_kernel(Args a_unused) {
    extern __shared__ __attribute__((aligned(16))) unsigned char lds_raw[];
    LAS unsigned char* lds = (LAS unsigned char*)lds_raw;
    const int tid = ltid();
    if (tid < 256) ((LAS unsigned*)(lds + LDS_CTRL))[tid] = (tid == (LDS_VID_OFF - LDS_CTRL) / 4) ? (unsigned)blockIdx.x : 0u;
    __syncthreads();
    { CArgs& a = load_args(); (void)xcd_barrier_post((unsigned*)(a.ws + WS_CTL), (volatile LAS unsigned*)(lds + LDS_CTRL)); }
    const int G = lgrid();
#ifndef REP_CVT
#define REP_CVT 1
#endif
#ifndef REP_INPROJ
#define REP_INPROJ 1
#endif
#ifndef REP_PREP
#define REP_PREP 1
#endif
#ifndef REP_SCAN
#define REP_SCAN 1
#endif
#ifndef REP_POST
#define REP_POST 1
#endif
#ifndef REP_BR
#define REP_BR 1
#endif
#ifndef REP_OUT
#define REP_OUT 1
#endif
#ifndef REP_GU
#define REP_GU 1
#endif
#ifndef REP_DN
#define REP_DN 1
#endif
#ifndef REP_COMB
#define REP_COMB 1
#endif
#define REPEAT(n) for (int rep_ = 0; rep_ < (n); ++rep_)
    { CArgs& a = load_args(); phase_mod(a, lds); }
    REPEAT(REP_CVT) { CArgs& a = load_args(); phase_cvt(a, lds); }
    grid_sync(lds);
    { CArgs& a = load_args();
      if (threadIdx.x == 0) { unsigned* bar = (unsigned*)(a.ws + WS_CTL); bool ok = (gridDim.x == 256u);
#pragma unroll 1
          for (unsigned j = 0; j < 16; ++j) ok = ok && (xb_ld(&bar[XB_XCNT(j)]) == (j < 8u ? 32u : 0u));
          const unsigned x = xb_xcc_id(), rank = ((volatile LAS unsigned*)(lds + LDS_CTRL))[8];
          if (ok && x < 8u && rank < 32u) *(volatile LAS int*)(lds + LDS_VID_OFF) = (int)(rank * 8u + x); }
      __syncthreads(); }
    const int c = lbid();
    { CArgs& a = load_args(); phase_norm0(a); }
#ifdef PROBE_BARS
    for (int pb = 0; pb < PROBE_BARS; ++pb) grid_sync(lds);
#endif
#if INPROJ_I8
    { CArgs& a = load_args(); phase_cvt_win_i8(a, lds); }
#endif
    grid_sync(lds);
    for (int l = 0; l < 2; ++l) {
        REPEAT(REP_INPROJ) {
        { CArgs& a = load_args(); char* r1 = a.ws + WS_R1;
#if INPROJ_I8
#ifdef PROBE_DUPK
          pg8::DupOrder S;
#else
          pg8::StaticOrder S;
#endif
          S.init(NTOK, NP, DM / 2, G, c, a.ws + WS_H, a.ws + WS_WIN + (size_t)l * NP * DM);
          EpiProj E{(bf16_t*)(r1 + R1_PROJ), (float*)(a.ws + WS_SMALL), (const float*)(a.ws + WS_SA), (const float*)(a.ws + WS_COLMAX) + l * NP, (unsigned char*)(r1 + R1_MG8)};
#ifdef PROBE_DUPK
          pg8::gemm_phase<EpiProj, pg8::DupOrder, 2>(lds, DM / 2, S, E);
#else
          pg8::gemm_phase<EpiProj, pg8::StaticOrder, 2>(lds, DM / 2, S, E);
#endif
#else
          pg8::StaticOrder S; S.init(NTOK, NP, DM, G, c, a.ws + WS_H, a.ws + WS_WIN + (size_t)l * NP * DM * 2);
          EpiProj E{(bf16_t*)(r1 + R1_PROJ), (float*)(a.ws + WS_SMALL), nullptr, nullptr, (unsigned char*)(r1 + R1_MG8)};
          pg8::gemm_phase<EpiProj, pg8::StaticOrder>(lds, DM, S, E);
#endif
        }
        grid_sync(lds); }
        REPEAT(REP_PREP) { { CArgs& a = load_args(); phase_prep(a, l, lds); }
        grid_sync(lds); }
        REPEAT(REP_SCAN) { { CArgs& a = load_args(); phase_scan(a, l, lds); }
        grid_sync(lds); }
        REPEAT(REP_POST) { { CArgs& a = load_args(); phase_post(a, l, lds); }
        grid_sync(lds); }
        REPEAT(REP_BR) {
        { CArgs& a = load_args(); char* r1 = a.ws + WS_R1;
          EpiGate E{(const unsigned char*)(r1 + R1_MG8), a.b_merge + l * 3072, (bf16_t*)(r1 + R1_MERGED)};
#if BRANCH_FP8
          pg8::BranchOrder S; S.init(NTOK, DM, 256, G, c, r1 + R1_YMIX, a.ws + WS_WBR + (size_t)l * 3 * DM * 512); S.pn_per_a = 4; S.a_pnstride = (size_t)NTOK * 512;
          pg8::gemm_phase<EpiGate, pg8::BranchOrder, 1>(lds, 256, S, E);
#else
          pg8::BranchOrder S; S.init(NTOK, DM, 512, G, c, r1 + R1_YMIX, a.ws + WS_WBR + (size_t)l * 3 * DM * 512 * 2); S.pn_per_a = 4; S.a_pnstride = (size_t)NTOK * 512 * 2;
          pg8::gemm_phase<EpiGate, pg8::BranchOrder>(lds, 512, S, E);
#endif
        }
        grid_sync(lds); }
        REPEAT(REP_OUT) {
        { CArgs& a = load_args(); char* r1 = a.ws + WS_R1;
          pg8::StaticOrder S; S.init(NTOK, DM, DM, G, c, r1 + R1_MERGED, a.ws + WS_WOUT + (size_t)l * DM * DM * 2);
          EpiResid E{(const bf16_t*)(a.ws + WS_XB), (bf16_t*)(a.ws + WS_XA), (const float*)(a.ws + WS_MOD) + (size_t)l * 8 * 6144 + 2048};
          pg8::gemm_phase<EpiResid, pg8::StaticOrder>(lds, DM, S, E); }
        grid_sync(lds); }
        { CArgs& a = load_args(); phase_router(a, l, (const bf16_t*)(a.ws + WS_XA), lds); }
        grid_sync(lds);
        REPEAT(REP_GU) {
        { CArgs& a = load_args(); char* r1 = a.ws + WS_R1;
          moe_tables((const int*)(a.ws + WS_CNT) + l * 32 * 64, lds);
          MoeOrder<true> S{8, G, c, (const LAS int*)(lds + LDS_CTRL + 64), (const LAS int*)(lds + LDS_CTRL + 256), (const char*)(a.ws + WS_H), a.ws + WS_WGU + (size_t)l * NEXP * 2048 * DM,
                           (size_t)2048 * DM, (size_t)256 * DM, (const int*)(a.ws + WS_ROWTOK)};
          EpiSwiglu E{(unsigned char*)(r1 + R1_ACT), a.b_gu + (size_t)l * NEXP * 2048};
          pg8::gemm_phase<EpiSwiglu, MoeOrder<true>, 1, GEMM_ALIGN, false, MOE_TILED != 0>(lds, DM / 2, S, E); }
        grid_sync(lds); }
        REPEAT(REP_DN) {
        { CArgs& a = load_args(); char* r1 = a.ws + WS_R1;
          MoeOrder<false> S{4, G, c, (const LAS int*)(lds + LDS_CTRL + 64), (const LAS int*)(lds + LDS_CTRL + 256), (const char*)(r1 + R1_ACT), a.ws + WS_WDN + (size_t)l * NEXP * DM * DM,
                            (size_t)DM * DM, (size_t)256 * DM, nullptr};
          EpiDown E{(bf16_t*)(r1 + R1_YS), a.b_dn + (size_t)l * NEXP * DM};
          pg8::gemm_phase<EpiDown, MoeOrder<false>, 1, GEMM_ALIGN, MOE_TILED != 0, MOE_TILED != 0>(lds, DM / 2, S, E); }
        grid_sync(lds); }
        REPEAT(REP_COMB) { { CArgs& a = load_args(); phase_combine(a, l, (const bf16_t*)(a.ws + WS_XA), (bf16_t*)(a.ws + WS_XB), lds); }
        if (l == 0 || REP_COMB > 1) grid_sync(lds); }
    }
}

extern "C" void kernel_launch(void* const* d_in, const int* in_sizes, int n_in, void* d_out, int out_size, void* d_ws, size_t ws_size, hipStream_t stream) {
    static int grid = 0;
    if (grid == 0) {
        if (n_in != 32 || ws_size < WS_END) { fprintf(stderr, "kernel_launch: unexpected inputs (n_in %d, ws %zu, need %zu)\n", n_in, ws_size, (size_t)WS_END); grid = -1; return; }
        int dev = 0, cus = 0, per_cu = 0;
        if (hipGetDevice(&dev) != hipSuccess || hipDeviceGetAttribute(&cus, hipDeviceAttributeMultiprocessorCount, dev) != hipSuccess) { grid = -1; return; }
        if (hipFuncSetAttribute((const void*)fwd_kernel, hipFuncAttributeMaxDynamicSharedMemorySize, LDS_BYTES) != hipSuccess) { fprintf(stderr, "kernel_launch: hipFuncSetAttribute failed\n"); grid = -1; return; }
        if (hipOccupancyMaxActiveBlocksPerMultiprocessor(&per_cu, (const void*)fwd_kernel, NTHREADS, LDS_BYTES) != hipSuccess || per_cu < 1) { fprintf(stderr, "kernel_launch: occupancy query says %d\n", per_cu); grid = -1; return; }
        grid = cus;
    }
    if (grid < 0) return;
    (void)hipMemsetAsync((char*)d_ws + WS_CTL, 0, 131072, stream);
    Args a{};
    const float** pp = (const float**)&a;
    for (int i = 0; i < 32; ++i) pp[i] = (const float*)d_in[i];
    a.out = (float*)d_out; a.ws = (char*)d_ws;
    hipLaunchKernelGGL(fwd_kernel, dim3(grid), dim3(NTHREADS), LDS_BYTES, stream, a);
}
```

```cpp
#include <hip/hip_runtime.h>
#include <cstdio>
#include <cstdint>
#define DI __device__ __forceinline__
#define LAS __attribute__((address_space(3)))
typedef unsigned short bf16_t;
typedef short bf16x8 __attribute__((ext_vector_type(8)));
typedef float f32x4 __attribute__((ext_vector_type(4)));
typedef float f32x2 __attribute__((ext_vector_type(2)));
typedef float f32x16 __attribute__((ext_vector_type(16)));
typedef unsigned u32x4 __attribute__((ext_vector_type(4)));
typedef unsigned u32x2 __attribute__((ext_vector_type(2)));
typedef __bf16 hbf16x2 __attribute__((ext_vector_type(2)));

DI int ltid() { int t = threadIdx.x; asm volatile("" : "+v"(t)); return t; }
constexpr int LDS_VID_OFF = 155648 - 1024 + 896;
DI int lbid() { extern __shared__ __attribute__((aligned(16))) unsigned char lds_vid_[]; int t = *(const volatile LAS int*)((LAS unsigned char*)lds_vid_ + LDS_VID_OFF); t = __builtin_amdgcn_readfirstlane(t); asm volatile("" : "+s"(t)); return t; }
DI int lgrid() { int t = gridDim.x; asm volatile("" : "+s"(t)); return t; }
DI void lds_barrier() { asm volatile("s_waitcnt lgkmcnt(0)" ::: "memory"); __builtin_amdgcn_s_barrier(); asm volatile("" ::: "memory"); }
DI unsigned pk2(float a, float b) { f32x2 v = {a, b}; hbf16x2 r = __builtin_convertvector(v, hbf16x2); return __builtin_bit_cast(unsigned, r); }
DI float bflo(unsigned w) { return __uint_as_float(w << 16); }
DI float bfhi(unsigned w) { return __uint_as_float(w & 0xffff0000u); }
DI float bf2f(bf16_t v) { return __uint_as_float(((unsigned)v) << 16); }
DI bf16_t f2bf(float a) { return (bf16_t)(pk2(a, 0.f) & 0xffffu); }
DI float sigmoid_(float x) { return __builtin_amdgcn_rcpf(1.f + __expf(-x)); }
DI float silu_(float x) { return x * __builtin_amdgcn_rcpf(1.f + __expf(-x)); }
DI float softplus_(float x) { return fmaxf(x, 0.f) + log1pf(__expf(-fabsf(x))); }

#ifndef GEMM_ALIGN
#define GEMM_ALIGN true
#endif
#ifndef PG8_WGM
#define PG8_WGM 4
#endif
namespace pg8 {
constexpr int BM = 256, BK = 64, HALF = 128, HTB = HALF * BK * 2, STAGE_BYTES = 8 * HTB, NXCD = 8, WGM = PG8_WGM;
__host__ __device__ __forceinline__ int lds_byte(int r, int c) { const int st = (r >> 4) * 2 + (c >> 5), rr = r & 15, cc = c & 31, ob = rr * 64 + cc * 2; return st * 1024 + (ob ^ (((ob >> 9) & 1) << 5)); }
__host__ __device__ __forceinline__ void stage_rc(int b, int& R, int& C) { const int st = b / 1024, sb = b % 1024, swz = sb ^ (((sb >> 9) & 1) << 5); R = (st >> 1) * 16 + swz / 64; C = (st & 1) * 32 + (swz % 64) / 2; }
__host__ __device__ __forceinline__ int perm32(int rho) { const int n = rho >> 4, i = rho & 15; return 8 * (i >> 2) + 4 * n + (i & 3); }

struct Unit { int pm, pn, e, cnt, skip; };

struct StaticOrder {
    static constexpr bool GATHER = false;
    int nM, nN, nwg, G, c;
    const char* A; const char* Bt; size_t a_tstep, b_tstep, a_pnstride; int pn_per_a;
    DI void init(int M, int N, int K, int G_, int c_, const void* A_, const void* Bt_) { nM = M / BM; nN = N / BM; nwg = nM * nN; G = G_; c = c_; A = (const char*)A_; Bt = (const char*)Bt_; a_tstep = (size_t)BM * K * 2; b_tstep = (size_t)BM * K * 2; a_pnstride = 0; pn_per_a = 1 << 30; }
    DI bool next(int i, Unit& u) const {
        const long L = (long)i * G + c; if (L >= nwg) return false;
        int wgid = (int)L; { const int q = nwg / NXCD, r = nwg % NXCD, xcd = wgid % NXCD, off = wgid / NXCD; wgid = (xcd < r ? xcd * (q + 1) : r * (q + 1) + (xcd - r) * q) + off; }
        const int nig = WGM * nN, gid = wgid / nig, fm = gid * WGM, gsz = (nM - fm) < WGM ? (nM - fm) : WGM;
        u.pm = fm + ((wgid % nig) % gsz); u.pn = (wgid % nig) / gsz; u.e = 0; u.cnt = 256; u.skip = 0; return true;
    }
    DI const char* a_ptr(const Unit& u) const { return A + (size_t)(u.pn / pn_per_a) * a_pnstride + (size_t)u.pm * a_tstep; }
    DI const char* b_ptr(const Unit& u) const { return Bt + (size_t)u.pn * b_tstep; }
    DI int a_row(const Unit&, int) const { return 0; }
    DI const char* a_rowsrc(const Unit&) const { return A; }
};

typedef int i32x4 __attribute__((ext_vector_type(4)));
typedef int i32x8 __attribute__((ext_vector_type(8)));
struct DupOrder : StaticOrder {
    DI bool next(int i, Unit& u) const { if (!StaticOrder::next(i / 2, u)) return false; u.skip = (i & 1) == 0; return true; }
};
struct BranchOrder : StaticOrder {
    DI bool next(int i, Unit& u) const { if (!StaticOrder::next(i / 3, u)) return false; u.pn += 4 * (i % 3); return true; }
};
template <class Epi, class Sched, int MODE = 0  , bool ALIGN_EPI = GEMM_ALIGN, bool TA = false, bool TB = false>
DI void gemm_phase(LAS unsigned char* lds, const int K, const Sched& S, const Epi& E) {
    constexpr bool GATHER = Sched::GATHER; constexpr bool FP8 = (MODE == 1);
#ifndef GEMM_RELAX
#define GEMM_RELAX 0
#endif
    const bool RELAX = GEMM_RELAX && (K / BK >= 4);
    const int tid = ltid(), wid = __builtin_amdgcn_readfirstlane(tid >> 6), lane = tid & 63, wr = wid >> 2, wc = wid & 3, fr = lane & 15, fq = lane >> 4;
    const int nt = K / BK;
    unsigned voffA[2], voffB[2]; int RA[2], CA[2];
#pragma unroll
    for (int i = 0; i < 2; ++i) { int R, C; stage_rc(tid * 16 + i * 8192, R, C); const int Rb = Epi::PERM ? ((R & ~31) + perm32(R & 31)) : R; RA[i] = R; CA[i] = C;
        voffA[i] = TA ? (unsigned)(R * 128 + C * 2) : (unsigned)(R * K + C) * 2u; voffB[i] = TB ? (unsigned)(Rb * 128 + C * 2) : (unsigned)(Rb * K + C) * 2u; }
    const size_t kstepA = TA ? (size_t)32768 : (size_t)(BK * 2), kstepB = TB ? (size_t)32768 : (size_t)(BK * 2);
    const size_t hstepB = TB ? (size_t)HALF * 128 : (size_t)HALF * K * 2;
    const size_t hstepA = GATHER ? 0 : (TA ? (size_t)HALF * 128 : (size_t)HALF * K * 2);
    const unsigned ldsw = (unsigned)wid * 1024u;
    const int aoff = lds_byte(wr * 64 + fr, fq * 8), boff = lds_byte(wc * 32 + fr, fq * 8);
#define PG8_SA(b, h) (((b) * 2 + (h)) * HTB)
#define PG8_SB(b, h) ((4 + (b) * 2 + (h)) * HTB)
#define PG8_STAGE(bufoff, gbase, voff) do { _Pragma("unroll") for (int _i = 0; _i < 2; ++_i) \
        __builtin_amdgcn_global_load_lds((const unsigned*)((const char*)(gbase) + (voff)[_i]), (LAS unsigned*)(lds + (bufoff) + ldsw + _i * 8192), 16, 0, 0); } while (0)
#define PG8_CAT(x, y) __builtin_shufflevector(__builtin_bit_cast(i32x4, x), __builtin_bit_cast(i32x4, y), 0, 1, 2, 3, 4, 5, 6, 7)
#define PG8_LDA8(dst, b, h) do { _Pragma("unroll") for (int m = 0; m < 4; ++m) dst[m] = PG8_CAT(*(const LAS bf16x8*)(lds + PG8_SA(b, h) + aoff + m * 2048), *(const LAS bf16x8*)(lds + PG8_SA(b, h) + aoff + m * 2048 + 1024)); } while (0)
#define PG8_LDB8(dst, b, h) do { _Pragma("unroll") for (int n = 0; n < 2; ++n) dst[n] = PG8_CAT(*(const LAS bf16x8*)(lds + PG8_SB(b, h) + boff + n * 2048), *(const LAS bf16x8*)(lds + PG8_SB(b, h) + boff + n * 2048 + 1024)); } while (0)
#define PG8_MMA8(ai, bj, At, Bt) do { __builtin_amdgcn_s_setprio(1); _Pragma("unroll") for (int m = 0; m < 4; ++m) _Pragma("unroll") for (int n = 0; n < 2; ++n) \
        asm volatile("v_mfma_scale_f32_16x16x128_f8f6f4 %0, %1, %2, %0, %3, %3 op_sel_hi:[0,0,0]" : "+v"(acc[ai][bj][m][n]) : "v"(Bt[n]), "v"(At[m]), "v"(one_scale)); __builtin_amdgcn_s_setprio(0); } while (0)
#define PG8_LDA(dst, b, h) do { _Pragma("unroll") for (int m = 0; m < 4; ++m) _Pragma("unroll") for (int k = 0; k < 2; ++k) dst[m][k] = *(const LAS bf16x8*)(lds + PG8_SA(b, h) + aoff + m * 2048 + k * 1024); } while (0)
#define PG8_LDB(dst, b, h) do { _Pragma("unroll") for (int n = 0; n < 2; ++n) _Pragma("unroll") for (int k = 0; k < 2; ++k) dst[n][k] = *(const LAS bf16x8*)(lds + PG8_SB(b, h) + boff + n * 2048 + k * 1024); } while (0)
#define PG8_MMA(ai, bj, At, Bt) do { __builtin_amdgcn_s_setprio(1); _Pragma("unroll") for (int m = 0; m < 4; ++m) _Pragma("unroll") for (int n = 0; n < 2; ++n) _Pragma("unroll") for (int k = 0; k < 2; ++k) { \
        if constexpr (MODE == 2) acc[ai][bj][m][n] = __builtin_bit_cast(f32x4, __builtin_amdgcn_mfma_i32_16x16x64_i8(__builtin_bit_cast(i32x4, Bt[n][k]), __builtin_bit_cast(i32x4, At[m][k]), __builtin_bit_cast(i32x4, acc[ai][bj][m][n]), 0, 0, 0)); \
        else acc[ai][bj][m][n] = __builtin_amdgcn_mfma_f32_16x16x32_bf16(Bt[n][k], At[m][k], acc[ai][bj][m][n], 0, 0, 0); } __builtin_amdgcn_s_setprio(0); } while (0)
#define PG8_WAIT_V(n) asm volatile("s_waitcnt vmcnt(" #n ")" ::: "memory")
#define PG8_WAIT_VI(N) asm volatile("s_waitcnt vmcnt(%0)" :: "n"(N) : "memory")
#define PG8_WAIT_SEL(N) do { if (first) PG8_WAIT_VI(N); else PG8_WAIT_V(8); } while (0)
#define PG8_WAIT_L(n) asm volatile("s_waitcnt lgkmcnt(" #n ")" ::: "memory")
#define PG8_BAR __builtin_amdgcn_s_barrier()
#define PG8_SCHED __builtin_amdgcn_sched_barrier(0)
    Unit cur, nxt; int ui = 0;
    if (!S.next(0, cur)) return;
#ifndef STAGGER_CYC
#define STAGGER_CYC 0
#endif
    if (STAGGER_CYC > 0) { const long long t0 = clock64(); const long long dl = (long long)((lbid() >> 3) & 7) * STAGGER_CYC;
        while (clock64() - t0 < dl) __builtin_amdgcn_s_sleep(4); }
    f32x4 acc[2][2][4][2];
#pragma unroll
    for (int a = 0; a < 2; ++a)
#pragma unroll
        for (int b = 0; b < 2; ++b)
#pragma unroll
            for (int m = 0; m < 4; ++m)
#pragma unroll
                for (int n = 0; n < 2; ++n) acc[a][b][m][n] = (f32x4){0.f, 0.f, 0.f, 0.f};
    bf16x8 At[4][2], B0[2][2], B1[2][2]; i32x8 Ct[4], C0[2], C1[2]; const int one_scale = 0x7f7f7f7f;
    const char* cA = S.a_ptr(cur); const char* cB = S.b_ptr(cur);
    unsigned vC0[2], vC1[2], vN0[2], vN1[2];
    if constexpr (GATHER) {
#pragma unroll
        for (int i = 0; i < 2; ++i) { vC0[i] = (unsigned)(S.a_row(cur, RA[i]) * K + CA[i]) * 2u; vC1[i] = (unsigned)(S.a_row(cur, HALF + RA[i]) * K + CA[i]) * 2u; vN0[i] = vC0[i]; vN1[i] = vC1[i]; }
    } else {
#pragma unroll
        for (int i = 0; i < 2; ++i) { vC0[i] = voffA[i]; vC1[i] = voffA[i]; vN0[i] = voffA[i]; vN1[i] = voffA[i]; }
    }
    PG8_STAGE(PG8_SB(0, 0), cB, voffB); PG8_STAGE(PG8_SB(0, 1), cB + hstepB, voffB); PG8_STAGE(PG8_SA(0, 0), cA, vC0); PG8_STAGE(PG8_SA(0, 1), cA + hstepA, vC1);
    if (wr == 1) PG8_BAR;
    PG8_WAIT_V(2); PG8_BAR;
    PG8_STAGE(PG8_SB(1, 0), cB + kstepB, voffB); PG8_STAGE(PG8_SA(1, 0), cA + kstepA, vC0); PG8_STAGE(PG8_SB(1, 1), cB + hstepB + kstepB, voffB);
    PG8_WAIT_V(6); PG8_BAR;
    for (;;) {
        const bool has_next = S.next(ui + 1, nxt);
        const char* nA = has_next ? S.a_ptr(nxt) : cA; const char* nB = has_next ? S.b_ptr(nxt) : cB;
#pragma unroll 1
        for (int t = 0; t < nt; t += 2) {
            const bool last = (t == nt - 2);
            const char* a1 = cA + (size_t)(t + 1) * kstepA;
            const char* a2 = last ? nA : cA + (size_t)(t + 2) * kstepA; const char* b2 = last ? nB : cB + (size_t)(t + 2) * kstepB;
            const char* a3 = a2 + kstepA; const char* b3 = b2 + kstepB;
            if constexpr (GATHER) { if (last && has_next) { const LAS int* tab = (const LAS int*)(lds + STAGE_BYTES + 4096 + ((ui + 1) & 1) * 1024);
#pragma unroll
                    for (int i = 0; i < 2; ++i) { const int r0 = RA[i] < nxt.cnt ? tab[RA[i]] : 0, r1 = (HALF + RA[i]) < nxt.cnt ? tab[HALF + RA[i]] : 0; vN0[i] = (unsigned)(r0 * K + CA[i]) * 2u; vN1[i] = (unsigned)(r1 * K + CA[i]) * 2u; } } }
            unsigned w0[2], w1[2];
            if constexpr (GATHER) { w0[0] = last ? vN0[0] : vC0[0]; w0[1] = last ? vN0[1] : vC0[1]; w1[0] = last ? vN1[0] : vC1[0]; w1[1] = last ? vN1[1] : vC1[1]; }
            else { w0[0] = voffA[0]; w0[1] = voffA[1]; w1[0] = voffA[0]; w1[1] = voffA[1]; }
            if constexpr (GATHER) { if (t == 0 && has_next && wid == 2) __builtin_amdgcn_global_load_lds((const unsigned*)(S.a_rowsrc(nxt) + lane * 16), (LAS unsigned*)(lds + STAGE_BYTES + 4096 + ((ui + 1) & 1) * 1024), 16, 0, 0);
}
            if (t == 0) { if (wid == 0) __builtin_amdgcn_global_load_lds((const unsigned*)(E.cvec(cur, 0) + lane * 16), (LAS unsigned*)(lds + STAGE_BYTES + (ui & 1) * 2048), 16, 0, 0);
                if (Epi::NC > 1 && wid == 1) __builtin_amdgcn_global_load_lds((const unsigned*)(E.cvec(cur, 1) + lane * 16), (LAS unsigned*)(lds + STAGE_BYTES + (ui & 1) * 2048 + 1024), 16, 0, 0); }
            const bool first = RELAX && (t == 0) && (ui > 0);
            if constexpr (FP8) {
            PG8_LDB8(C0, 0, 0); PG8_LDB8(C1, 0, 1); PG8_SCHED; PG8_LDA8(Ct, 0, 0); if (!first) PG8_STAGE(PG8_SA(1, 1), a1 + hstepA, vC1);
            PG8_WAIT_SEL(Epi::NST + 2); PG8_WAIT_L(0); PG8_BAR; PG8_MMA8(0, 0, Ct, C0); PG8_MMA8(0, 1, Ct, C1); PG8_BAR; PG8_SCHED;
            PG8_LDA8(Ct, 0, 1); PG8_STAGE(PG8_SB(0, 0), b2, voffB); PG8_STAGE(PG8_SB(0, 1), b2 + hstepB, voffB); PG8_STAGE(PG8_SA(0, 0), a2, w0);
            PG8_WAIT_SEL(Epi::NST + 8); PG8_WAIT_L(0); PG8_BAR; PG8_MMA8(1, 0, Ct, C0); PG8_MMA8(1, 1, Ct, C1); PG8_BAR; PG8_SCHED;
            PG8_LDB8(C0, 1, 0); PG8_LDB8(C1, 1, 1); PG8_SCHED; PG8_LDA8(Ct, 1, 0); PG8_STAGE(PG8_SA(0, 1), a2 + hstepA, w1);
            PG8_WAIT_SEL(Epi::NST + 8); PG8_WAIT_L(0); PG8_BAR; PG8_MMA8(0, 0, Ct, C0); PG8_MMA8(0, 1, Ct, C1); PG8_BAR; PG8_SCHED;
            PG8_LDA8(Ct, 1, 1); PG8_STAGE(PG8_SB(1, 0), b3, voffB); PG8_STAGE(PG8_SB(1, 1), b3 + hstepB, voffB); PG8_STAGE(PG8_SA(1, 0), a3, w0);
            PG8_WAIT_V(8); PG8_WAIT_L(0); PG8_BAR; PG8_MMA8(1, 0, Ct, C0); PG8_MMA8(1, 1, Ct, C1); PG8_BAR; PG8_SCHED;
                    } else {
            PG8_LDB(B0, 0, 0); PG8_LDB(B1, 0, 1); PG8_SCHED; PG8_LDA(At, 0, 0); if (!first) PG8_STAGE(PG8_SA(1, 1), a1 + hstepA, vC1);
            PG8_WAIT_SEL(Epi::NST + 2); PG8_WAIT_L(0); PG8_BAR; PG8_MMA(0, 0, At, B0); PG8_MMA(0, 1, At, B1); PG8_BAR; PG8_SCHED;
            PG8_LDA(At, 0, 1); PG8_STAGE(PG8_SB(0, 0), b2, voffB); PG8_STAGE(PG8_SB(0, 1), b2 + hstepB, voffB); PG8_STAGE(PG8_SA(0, 0), a2, w0);
            PG8_WAIT_SEL(Epi::NST + 8); PG8_WAIT_L(0); PG8_BAR; PG8_MMA(1, 0, At, B0); PG8_MMA(1, 1, At, B1); PG8_BAR; PG8_SCHED;
            PG8_LDB(B0, 1, 0); PG8_LDB(B1, 1, 1); PG8_SCHED; PG8_LDA(At, 1, 0); PG8_STAGE(PG8_SA(0, 1), a2 + hstepA, w1);
            PG8_WAIT_SEL(Epi::NST + 8); PG8_WAIT_L(0); PG8_BAR; PG8_MMA(0, 0, At, B0); PG8_MMA(0, 1, At, B1); PG8_BAR; PG8_SCHED;
            PG8_LDA(At, 1, 1); PG8_STAGE(PG8_SB(1, 0), b3, voffB); PG8_STAGE(PG8_SB(1, 1), b3 + hstepB, voffB); PG8_STAGE(PG8_SA(1, 0), a3, w0);
            PG8_WAIT_V(8); PG8_WAIT_L(0); PG8_BAR; PG8_MMA(1, 0, At, B0); PG8_MMA(1, 1, At, B1); PG8_BAR; PG8_SCHED;
                    }
            if (RELAX && last && has_next) PG8_STAGE(PG8_SA(1, 1), a3 + hstepA, w1);
        }
        if constexpr (FP8) asm volatile("s_nop 15\n\ts_nop 15" ::: "memory");
        if constexpr (ALIGN_EPI) { if (wr == 0) PG8_BAR; }
        if (!cur.skip) E(acc, cur, wr, wc, fr, fq, (const LAS float*)(lds + STAGE_BYTES + (ui & 1) * 2048));
#ifdef PROBE_EPI2
        E(acc, cur, wr, wc, fr, fq, (const LAS float*)(lds + STAGE_BYTES + (ui & 1) * 2048));
#endif
        if (!has_next) break;
        if (!Epi::keep(cur)) {
#pragma unroll
        for (int a = 0; a < 2; ++a)
#pragma unroll
            for (int b = 0; b < 2; ++b)
#pragma unroll
                for (int m = 0; m < 4; ++m)
#pragma unroll
                    for (int n = 0; n < 2; ++n) acc[a][b][m][n] = (f32x4){0.f, 0.f, 0.f, 0.f}; }
        cur = nxt; cA = nA; cB = nB; ++ui;
        if constexpr (GATHER) { vC0[0] = vN0[0]; vC0[1] = vN0[1]; vC1[0] = vN1[0]; vC1[1] = vN1[1]; }
        if constexpr (ALIGN_EPI) { if (wr == 1) PG8_BAR; }
    }
    PG8_WAIT_V(0);
    if constexpr (!ALIGN_EPI) { if (wr == 0) PG8_BAR; }
    PG8_BAR;
#undef PG8_SA
#undef PG8_SB
#undef PG8_STAGE
#undef PG8_LDA
#undef PG8_LDA8
#undef PG8_LDB8
#undef PG8_MMA8
#undef PG8_CAT
#undef PG8_LDB
#undef PG8_MMA
#undef PG8_WAIT_V
#undef PG8_WAIT_VI
#undef PG8_WAIT_SEL
#undef PG8_WAIT_L
#undef PG8_BAR
#undef PG8_SCHED
}
}
using pg8::Unit;

#define XB_TMO      128
#define XB_XCNT(j)  (256  + 64 * (j))
#define XB_XSUB(j)  (1280 + 64 * (j))
#define XB_XGEN(j)  (2304 + 64 * (j))
#define XB_TOP      3328
#define XB_TOPGEN   3392
#define XCD_BAR_WORDS 3456
#define XB_SPIN_CAP (1u << 18)
DI unsigned xb_ld(unsigned* p)              { return __hip_atomic_load(p, __ATOMIC_RELAXED, __HIP_MEMORY_SCOPE_AGENT); }
DI unsigned xb_add(unsigned* p, unsigned v) { return __hip_atomic_fetch_add(p, v, __ATOMIC_RELAXED, __HIP_MEMORY_SCOPE_AGENT); }
DI unsigned xb_xcc_id() { return (unsigned)__builtin_amdgcn_s_getreg((3 << 11) | 20) & 0xFu; }
#define XB_SPIN(cond, bar) do { unsigned _sp = 0; while (cond) { __builtin_amdgcn_s_sleep(1); \
    if ((++_sp & 255u) == 0u) { if (xb_ld(&(bar)[XB_TMO])) break; if (_sp > XB_SPIN_CAP) { atomicAdd(&(bar)[XB_TMO], 1u); break; } } } } while (0)
struct XcdBarrier { unsigned* bar; unsigned x; volatile LAS unsigned* st; };
DI XcdBarrier xcd_barrier_post(unsigned* bar, volatile LAS unsigned* st) {
    XcdBarrier b; b.bar = bar; b.x = xb_xcc_id(); b.st = st;
    if (threadIdx.x == 0) st[8] = xb_add(&bar[XB_XCNT(b.x)], 1u);
    return b;
}
DI void xcd_barrier_complete(unsigned* bar, unsigned x, unsigned& nloc, unsigned& nx) {
    const unsigned G = gridDim.x * gridDim.y * gridDim.z;
    unsigned sum, cnt, mine, sp = 0u;
    for (;;) {
        sum = 0u; cnt = 0u; mine = 0u;
#pragma unroll
        for (unsigned j = 0; j < 16; ++j) { const unsigned c = xb_ld(&bar[XB_XCNT(j)]); sum += c; cnt += (c > 0u) ? 1u : 0u; mine = (j == x) ? c : mine; }
        if (sum == G) break;
        __builtin_amdgcn_s_sleep(1);
        if ((++sp & 255u) == 0u) { if (xb_ld(&bar[XB_TMO])) break; if (sp > XB_SPIN_CAP) { atomicAdd(&bar[XB_TMO], 1u); break; } }
    }
    nloc = mine > 0u ? mine : 1u; nx = cnt > 0u ? cnt : 1u;
}
DI void xcd_barrier(const XcdBarrier& b) {
    asm volatile("s_waitcnt vmcnt(0)" ::: "memory");
    __syncthreads();
    if (threadIdx.x == 0) {
        unsigned* bar = b.bar;
        __builtin_amdgcn_s_waitcnt(0);
        unsigned nloc = b.st[0], nx = b.st[1];
        if (nloc == 0u) { xcd_barrier_complete(bar, b.x, nloc, nx); b.st[0] = nloc; b.st[1] = nx; }
        const unsigned old = xb_add(&bar[XB_XSUB(b.x)], 1u);
        const unsigned gen = old / nloc;
        if (old + 1u == (gen + 1u) * nloc) {
            __builtin_amdgcn_fence(__ATOMIC_RELEASE, "agent");
            asm volatile("s_waitcnt vmcnt(0)" ::: "memory");
            const unsigned og = xb_add(&bar[XB_TOP], 1u);
            const unsigned tg = og / nx;
            if (og + 1u == (tg + 1u) * nx) xb_add(&bar[XB_TOPGEN], 1u);
            else XB_SPIN(xb_ld(&bar[XB_TOPGEN]) == tg, bar);
            __builtin_amdgcn_fence(__ATOMIC_ACQUIRE, "agent");
            xb_add(&bar[XB_XGEN(b.x)], 1u);
            asm volatile("s_waitcnt vmcnt(0)" ::: "memory");
        } else {
            XB_SPIN(xb_ld(&bar[XB_XGEN(b.x)]) == gen, bar);
            __builtin_amdgcn_fence(__ATOMIC_ACQUIRE, "agent");
            asm volatile("s_waitcnt vmcnt(0)" ::: "memory");
        }
    }
    __syncthreads();
}
constexpr int DM = 1024, NB = 8, SEQ = 4096, NTOK = NB * SEQ, NCHUNK = 64, NP = 8192, NEXP = 32;
constexpr int PC_GLA_Q = 0, PC_GLA_K = 256, PC_GLA_V = 512, PC_GLA_R = 1024, PC_GDN_QKV = 1536, PC_GDN_G = 3072, PC_SSD_Z = 3584, PC_SSD_XBC = 4096, PC_MERGE = 4864, PC_SMALL = 7936;
constexpr int IN_COLS = 7968;
constexpr int NTHREADS = 512;
#ifndef INPROJ_I8
#define INPROJ_I8 1
#endif
#ifndef BRANCH_FP8
#define BRANCH_FP8 1
#endif
constexpr int LDS_BYTES = 155648;
constexpr int LDS_CTRL = LDS_BYTES - 1024;
static_assert(LDS_VID_OFF == LDS_CTRL + 896, "virtual workgroup id word");
constexpr int GLA_UNIT = 41984, GDN_UNIT = 74752, SSD_UNIT = 33792;
constexpr int GLA_OQ = 0, GLA_OP = 8192, GLA_OK = 16384, GLA_OU = 24576, GLA_OD = 40960;
constexpr int GDN_OQ = 0, GDN_OW = 16384, GDN_OP = 32768, GDN_OK = 40960, GDN_OU = 57344, GDN_OD = 73728;
constexpr int SSD_OQ = 0, SSD_OP = 8192, SSD_OK = 16384, SSD_OU = 24576, SSD_OD = 32768;
constexpr size_t WS_CTL = 0, WS_CNT = 16384, WS_COLMAX = 65536, WS_MOD = 131072;
constexpr size_t WS_WIN = 524288, WS_WBR = WS_WIN + 33554432ull, WS_WOUT = WS_WBR + 6291456ull, WS_WGU = WS_WOUT + 12582912ull, WS_WDN = WS_WGU + 268435456ull;
constexpr size_t WS_H = WS_WDN + 134217728ull, WS_SMALL = WS_H + 67108864ull, WS_XA = WS_SMALL + 4194304ull, WS_XB = WS_XA + 134217728ull;
constexpr size_t WS_ROWTOK = WS_XB + 134217728ull, WS_TOKSLOT = WS_ROWTOK + 4194304ull, WS_GATES = WS_TOKSLOT + 524288ull, WS_TSCR = WS_GATES + 524288ull, WS_R1 = WS_TSCR + 16777216ull;
constexpr size_t R1_PROJ = 0, R1_SGLA = 536870912ull, R1_SGDN = R1_SGLA + 2048ull * GLA_UNIT, R1_SSSD = R1_SGDN + 2048ull * GDN_UNIT, R1_OBUF = R1_SSSD + 4096ull * SSD_UNIT;
constexpr size_t R1_YMIX = R1_OBUF + 100663296ull, R1_MERGED = R1_YMIX + 100663296ull, R1_XCONV = R1_MERGED + 67108864ull, R1_MG8 = R1_XCONV + 33554432ull, R1_END = R1_MG8 + 100663296ull,
 R1_GATED = R1_SGLA, R1_ACT = 0, R1_YS = 285212672ull;
constexpr size_t WS_SA = WS_R1 + R1_END, WS_END = WS_SA + 131072;
constexpr size_t OB_GLA = 0, OB_GDN = 33554432ull, OB_SSD = 67108864ull;

struct Args {
    const float *x, *c, *w_mod, *b_mod, *norm_mix, *norm_ffn, *norm_final, *w_in, *gla_w2, *gla_b2, *gla_norm, *gdn_conv_w, *gdn_a_log, *gdn_dt_bias, *gdn_norm,
        *ssd_conv_w, *ssd_conv_b, *ssd_a_log, *ssd_dt_bias, *ssd_d, *ssd_norm, *w_br_gla, *w_br_gdn, *w_br_ssd, *b_merge, *w_out, *w_router, *b_router, *w_gu, *b_gu, *w_dn, *b_dn;
    float* out; char* ws;
};
typedef const Args __attribute__((address_space(4))) CArgs;

DI void phase_mod(CArgs& a, LAS unsigned char* lds) {
    LAS float* cact = (LAS float*)lds;
    LAS float* red = (LAS float*)(lds + 32768);
    const int tid = ltid();
    for (int i = tid; i < 8192; i += NTHREADS) cact[i] = silu_(a.c[i]);
    __syncthreads();
    float* mod = (float*)(a.ws + WS_MOD);
    for (int blk = lbid(); blk < 256; blk += lgrid()) {
        const int jj = tid & 63, ks = tid >> 6, col = blk * 48 + jj;
        float s[8];
#pragma unroll
        for (int b = 0; b < 8; ++b) s[b] = 0.f;
        if (jj < 48) {
            const int l = col / 6144, j = col % 6144;
            const float* w = a.w_mod + (size_t)l * DM * 6144 + j;
#pragma unroll 1
            for (int k0 = ks * 128; k0 < ks * 128 + 128; k0 += 16) { float wv[16];
#pragma unroll
                for (int i = 0; i < 16; ++i) wv[i] = w[(size_t)(k0 + i) * 6144];
#pragma unroll
                for (int i = 0; i < 16; ++i)
#pragma unroll
                    for (int b = 0; b < 8; ++b) s[b] += cact[b * 1024 + k0 + i] * wv[i]; }
        }
#pragma unroll
        for (int b = 0; b < 8; ++b) red[(ks * 64 + jj) * 8 + b] = s[b];
        __syncthreads();
        if (tid < 48 * 8) { const int j2 = tid >> 3, b = tid & 7, col2 = blk * 48 + j2, l = col2 / 6144, j = col2 % 6144; float t = 0.f;
#pragma unroll
            for (int k2 = 0; k2 < 8; ++k2) t += red[(k2 * 64 + j2) * 8 + b];
            mod[((size_t)l * 8 + b) * 6144 + j] = t + a.b_mod[l * 6144 + j]; }
        __syncthreads();
    }
}
DI int win_dst(int c) {
    if (c < 1024) return c;
    if (c < 1040) return PC_SMALL + (c - 1024);
    if (c < 1552) return PC_GLA_R + (c - 1040);
    if (c < 3088) return PC_GDN_QKV + (c - 1552);
    if (c < 3092) return PC_SMALL + 16 + (c - 3088);
    if (c < 3096) return PC_SMALL + 20 + (c - 3092);
    if (c < 3608) return PC_GDN_G + (c - 3096);
    if (c < 4120) return PC_SSD_Z + (c - 3608);
    if (c < 4888) return PC_SSD_XBC + (c - 4120);
    if (c < 4896) return PC_SMALL + 24 + (c - 4888);
    return PC_MERGE + (c - 4896);
}
DI unsigned pk4_fp8(float a, float b, float c, float d) { int w = 0; w = __builtin_amdgcn_cvt_pk_fp8_f32(a, b, w, false); w = __builtin_amdgcn_cvt_pk_fp8_f32(c, d, w, true); return (unsigned)w; }
DI unsigned pk4_i8(float a, float b, float c, float d) { const int x = (int)__builtin_rintf(a), y = (int)__builtin_rintf(b), z = (int)__builtin_rintf(c), w = (int)__builtin_rintf(d);
    return (unsigned)(x & 255) | ((unsigned)(y & 255) << 8) | ((unsigned)(z & 255) << 16) | ((unsigned)w << 24); }
DI float wave_max(float v) {
#pragma unroll
    for (int o = 32; o > 0; o >>= 1) v = fmaxf(v, __shfl_xor(v, o));
    return v;
}
DI void unpk4_fp8(unsigned w, float (&o)[4]) { const f32x2 a = __builtin_amdgcn_cvt_pk_f32_fp8((int)w, false), b = __builtin_amdgcn_cvt_pk_f32_fp8((int)w, true); o[0] = a.x; o[1] = a.y; o[2] = b.x; o[3] = b.y; }
constexpr float W8_SCALE = 32.f, W8_INV = 1.f / 32.f;
#ifndef MOE_TILED
#define MOE_TILED 1
#endif
constexpr int CVT_KT = 128;
template <int KIND, int OUT, bool TILED = false> DI void cvt_tile(const float* src, int ld_src, int ncols, int k0, int n0, unsigned char* dst, int ld_dst, int kd0, LAS float* T, float* cmax = nullptr) {
    const int tid = ltid(); constexpr int HK = CVT_KT / 2;
    { const int jj = tid & 255, kk = tid >> 8; const bool ok = (n0 + jj) < ncols;
#pragma unroll
      for (int i = 0; i < HK; ++i) { const int k = kk + 2 * i; const float v = src[(size_t)(k0 + k) * ld_src + (ok ? n0 + jj : 0)]; T[k * 257 + jj] = ok ? v : 0.f; } }
    __syncthreads();
    { const int j = tid >> 1, kq = tid & 1, c = n0 + j;
      if (c < ncols) {
        const int drow = KIND == 0 ? c : KIND == 1 ? (c & ~255) + (c & 1) * 128 + ((c & 255) >> 1) : win_dst(c);
        float v[HK];
#pragma unroll
        for (int i = 0; i < HK; ++i) v[i] = T[(kq * HK + i) * 257 + j];
        if constexpr (OUT == 2) { float mx = 0.f;
#pragma unroll
            for (int i = 0; i < HK; ++i) mx = fmaxf(mx, fabsf(v[i]));
            atomicMax((unsigned*)cmax + drow, __float_as_uint(mx)); }
        else if constexpr (OUT == 0) { bf16_t* d = (bf16_t*)dst + (size_t)drow * ld_dst + kd0 + k0 + kq * HK;
#pragma unroll
            for (int h = 0; h < HK / 8; ++h) *(u32x4*)(d + 8 * h) = (u32x4){pk2(v[8 * h], v[8 * h + 1]), pk2(v[8 * h + 2], v[8 * h + 3]), pk2(v[8 * h + 4], v[8 * h + 5]), pk2(v[8 * h + 6], v[8 * h + 7])}; }
        else { unsigned char* d8 = TILED ? dst + (size_t)(drow >> 8) * 256 * ld_dst + (size_t)((k0 + kq * HK) >> 7) * 32768 + (drow & 255) * 128 + ((k0 + kq * HK) & 127)
                                         : dst + (size_t)drow * ld_dst + kd0 + k0 + kq * HK; float sc = W8_SCALE;
            if constexpr (OUT == 3) { const float cm = cmax[drow]; sc = cm > 0.f ? 127.f / cm : 0.f; }
#pragma unroll
            for (int h = 0; h < HK / 16; ++h) { u32x4 w;
                if constexpr (OUT == 1) w = (u32x4){pk4_fp8(v[16 * h] * sc, v[16 * h + 1] * sc, v[16 * h + 2] * sc, v[16 * h + 3] * sc), pk4_fp8(v[16 * h + 4] * sc, v[16 * h + 5] * sc, v[16 * h + 6] * sc, v[16 * h + 7] * sc),
                                                  pk4_fp8(v[16 * h + 8] * sc, v[16 * h + 9] * sc, v[16 * h + 10] * sc, v[16 * h + 11] * sc), pk4_fp8(v[16 * h + 12] * sc, v[16 * h + 13] * sc, v[16 * h + 14] * sc, v[16 * h + 15] * sc)};
                else w = (u32x4){pk4_i8(v[16 * h] * sc, v[16 * h + 1] * sc, v[16 * h + 2] * sc, v[16 * h + 3] * sc), pk4_i8(v[16 * h + 4] * sc, v[16 * h + 5] * sc, v[16 * h + 6] * sc, v[16 * h + 7] * sc),
                                 pk4_i8(v[16 * h + 8] * sc, v[16 * h + 9] * sc, v[16 * h + 10] * sc, v[16 * h + 11] * sc), pk4_i8(v[16 * h + 12] * sc, v[16 * h + 13] * sc, v[16 * h + 14] * sc, v[16 * h + 15] * sc)};
                *(u32x4*)(d8 + 16 * h) = w; } } } }
    __syncthreads();
}
constexpr int KT1 = DM / CVT_KT, KT5 = 512 / CVT_KT;
constexpr int T_IN = KT1 * 32, T_BR = 3 * KT5 * 4, T_OUT = KT1 * 4, T_GU = 32 * KT1 * 8, T_DN = 32 * KT1 * 4, T_L = T_IN + T_BR + T_OUT + T_GU + T_DN;
DI void cvt_range(CArgs& a, LAS unsigned char* lds, int l, int rbeg, int first, int stride) {
    LAS float* T = (LAS float*)lds;
    for (int r0 = rbeg + first; r0 < T_L; r0 += stride) { int r = r0;
        if (r < T_IN) { const int kt = r % KT1, ntile = r / KT1;
            cvt_tile<2, INPROJ_I8 ? 2 : 0>(a.w_in + (size_t)l * DM * IN_COLS, IN_COLS, IN_COLS, kt * CVT_KT, ntile * 256, (unsigned char*)(a.ws + WS_WIN + (size_t)l * NP * DM * (INPROJ_I8 ? 1 : 2)), DM, 0, T, (float*)(a.ws + WS_COLMAX) + l * NP); continue; }
        r -= T_IN;
        if (r < T_BR) { const int br = r / (KT5 * 4), kt = (r % (KT5 * 4)) % KT5, ntile = (r % (KT5 * 4)) / KT5; const float* src = (br == 0 ? a.w_br_gla : br == 1 ? a.w_br_gdn : a.w_br_ssd) + (size_t)l * 512 * DM;
            cvt_tile<0, BRANCH_FP8 ? 1 : 0>(src, DM, DM, kt * CVT_KT, ntile * 256, (unsigned char*)(a.ws + WS_WBR + ((size_t)l * 3 + br) * DM * 512 * (BRANCH_FP8 ? 1 : 2)), 512, 0, T); continue; }
        r -= T_BR;
        if (r < T_OUT) { const int kt = r % KT1, ntile = r / KT1;
            cvt_tile<0, 0>(a.w_out + (size_t)l * DM * DM, DM, DM, kt * CVT_KT, ntile * 256, (unsigned char*)(a.ws + WS_WOUT + (size_t)l * DM * DM * 2), DM, 0, T); continue; }
        r -= T_OUT;
        if (r < T_GU) { const int e = r / (KT1 * 8), kt = (r % (KT1 * 8)) % KT1, ntile = (r % (KT1 * 8)) / KT1;
            cvt_tile<1, 1, MOE_TILED != 0>(a.w_gu + ((size_t)l * NEXP + e) * DM * 2048, 2048, 2048, kt * CVT_KT, ntile * 256, (unsigned char*)(a.ws + WS_WGU + ((size_t)l * NEXP + e) * 2048 * DM), DM, 0, T); continue; }
        r -= T_GU;
        { const int e = r / (KT1 * 4), kt = (r % (KT1 * 4)) % KT1, ntile = (r % (KT1 * 4)) / KT1;
            cvt_tile<0, 1, MOE_TILED != 0>(a.w_dn + ((size_t)l * NEXP + e) * DM * DM, DM, DM, kt * CVT_KT, ntile * 256, (unsigned char*)(a.ws + WS_WDN + ((size_t)l * NEXP + e) * DM * DM), DM, 0, T); }
    }
}
DI void phase_cvt(CArgs& a, LAS unsigned char* lds) {
    const int w = lbid(), Gd = lgrid();
    cvt_range(a, lds, 0, 0, w, Gd); cvt_range(a, lds, 1, 0, w, Gd);
    { constexpr size_t RB = (size_t)DM * (INPROJ_I8 ? 1 : 2), NV = 224 * RB / 16;
      for (size_t i = (size_t)lbid() * NTHREADS + ltid(); i < 2 * NV; i += (size_t)lgrid() * NTHREADS) { const size_t l = i / NV, rr = i % NV;
          *(u32x4*)(a.ws + WS_WIN + (l * NP + IN_COLS) * RB + rr * 16) = (u32x4){0u, 0u, 0u, 0u}; } }
}

DI void phase_cvt_win_i8(CArgs& a, LAS unsigned char* lds) {
    LAS float* T = (LAS float*)lds;
    for (int g = lbid(); g < 2 * T_IN; g += lgrid()) { const int l = g / T_IN, r = g % T_IN, kt = r % KT1, ntile = r / KT1;
        cvt_tile<2, 3>(a.w_in + (size_t)l * DM * IN_COLS, IN_COLS, IN_COLS, kt * CVT_KT, ntile * 256, (unsigned char*)(a.ws + WS_WIN + (size_t)l * NP * DM), DM, 0, T, (float*)(a.ws + WS_COLMAX) + l * NP); }
}
DI float wave_sum(float v) {
#pragma unroll
    for (int o = 32; o > 0; o >>= 1) v += __shfl_xor(v, o);
    return v;
}
DI void store_h_row(CArgs& a, int row, int lane, const float (&o)[16]) {
#if INPROJ_I8
    float mx = 0.f;
#pragma unroll
    for (int j = 0; j < 16; ++j) mx = fmaxf(mx, fabsf(o[j]));
    mx = wave_max(mx); const float inv = mx > 0.f ? 127.f / mx : 0.f;
    if (lane == 0) ((float*)(a.ws + WS_SA))[row] = mx * (1.f / 127.f);
#pragma unroll
    for (int i = 0; i < 2; ++i) *(u32x2*)((unsigned char*)(a.ws + WS_H) + (size_t)row * DM + lane * 8 + 512 * i) =
        (u32x2){pk4_i8(o[8 * i] * inv, o[8 * i + 1] * inv, o[8 * i + 2] * inv, o[8 * i + 3] * inv), pk4_i8(o[8 * i + 4] * inv, o[8 * i + 5] * inv, o[8 * i + 6] * inv, o[8 * i + 7] * inv)};
#else
#pragma unroll
    for (int i = 0; i < 2; ++i) { u32x4 w; w.x = pk2(o[8 * i], o[8 * i + 1]); w.y = pk2(o[8 * i + 2], o[8 * i + 3]); w.z = pk2(o[8 * i + 4], o[8 * i + 5]); w.w = pk2(o[8 * i + 6], o[8 * i + 7]);
        *(u32x4*)((bf16_t*)(a.ws + WS_H) + (size_t)row * DM + lane * 8 + 512 * i) = w; }
#endif
}
DI void phase_norm0(CArgs& a) {
    const int lane = ltid() & 63, gw = lbid() * 8 + (ltid() >> 6), nw = lgrid() * 8;
    const float* mod = (const float*)(a.ws + WS_MOD);
    bf16_t* H = (bf16_t*)(a.ws + WS_H);
    f32x4 vn[4];
    { const float* xr = a.x + (size_t)(gw < NTOK ? gw : 0) * DM;
#pragma unroll
      for (int i = 0; i < 2; ++i) { vn[2 * i] = *(const f32x4*)(xr + lane * 8 + 512 * i); vn[2 * i + 1] = *(const f32x4*)(xr + lane * 8 + 512 * i + 4); } }
    for (int row = gw; row < NTOK; row += nw) {
        const int b = row >> 12; const float* mb = mod + (size_t)b * 6144;
        f32x4 v[4]; float ss = 0.f;
#pragma unroll
        for (int i = 0; i < 4; ++i) v[i] = vn[i];
        { const int rn = row + nw < NTOK ? row + nw : row; const float* xr = a.x + (size_t)rn * DM;
#pragma unroll
          for (int i = 0; i < 2; ++i) { vn[2 * i] = *(const f32x4*)(xr + lane * 8 + 512 * i); vn[2 * i + 1] = *(const f32x4*)(xr + lane * 8 + 512 * i + 4); } }
#pragma unroll
        for (int i = 0; i < 4; ++i) ss += v[i][0] * v[i][0] + v[i][1] * v[i][1] + v[i][2] * v[i][2] + v[i][3] * v[i][3];
        ss = wave_sum(ss); const float rs = rsqrtf(ss * (1.f / 1024.f) + 1e-6f);
        float o[16];
#pragma unroll
        for (int i = 0; i < 2; ++i) { const int c0 = lane * 8 + 512 * i;
#pragma unroll
            for (int j = 0; j < 8; ++j) { const float xv = v[2 * i + (j >> 2)][j & 3]; o[8 * i + j] = xv * rs * a.norm_mix[c0 + j] * (1.f + mb[1024 + c0 + j]) + mb[c0 + j]; } }
        store_h_row(a, row, lane, o);
#pragma unroll
        for (int i = 0; i < 2; ++i) *(u32x4*)((bf16_t*)(a.ws + WS_XB) + (size_t)row * DM + lane * 8 + 512 * i) =
            (u32x4){pk2(v[2 * i][0], v[2 * i][1]), pk2(v[2 * i][2], v[2 * i][3]), pk2(v[2 * i + 1][0], v[2 * i + 1][1]), pk2(v[2 * i + 1][2], v[2 * i + 1][3])};
    }
}

#ifndef NT_EPI
#define NT_EPI 0
#endif
template <class T> DI void stg(T* p, T v) { if (NT_EPI) __builtin_nontemporal_store(v, p); else *p = v; }
struct EpiProj { static DI bool keep(const Unit&) { return false; } static constexpr int NC = 2;
    static constexpr bool PERM = true; static constexpr int NST = 16; bf16_t* P; float* small; const float* sa; const float* cmax; unsigned char* mg8;
    DI const char* cvec(const Unit& u, int i) const { if (!INPROJ_I8) return (const char*)P; return i == 0 ? (const char*)(cmax + u.pn * 256) : (const char*)(sa + u.pm * 256); }
    template <int KIND  > DI void body(const f32x4 (&acc)[2][2][4][2], const Unit& u, int wr, int wc, int fr, int fq, const LAS float* cl) const {
        const int row0 = u.pm * 256 + wr * 64 + fr, col0 = u.pn * 256 + wc * 32 + 8 * fq;
        f32x4 sw[2][2];
#pragma unroll
        for (int bj = 0; bj < 2; ++bj) { sw[bj][0] = *(const LAS f32x4*)(cl + wc * 32 + 8 * fq + bj * 128) * (1.f / 127.f); sw[bj][1] = *(const LAS f32x4*)(cl + wc * 32 + 8 * fq + bj * 128 + 4) * (1.f / 127.f); }
        float srv[8];
#pragma unroll
        for (int i = 0; i < 8; ++i) srv[i] = cl[256 + wr * 64 + fr + (i >> 2) * 128 + (i & 3) * 16];
#pragma unroll
        for (int ai = 0; ai < 2; ++ai)
#pragma unroll
            for (int m = 0; m < 4; ++m) { const int row = row0 + ai * 128 + m * 16; const float sr = srv[ai * 4 + m];
                float v[2][8];
#pragma unroll
                for (int bj = 0; bj < 2; ++bj)
#pragma unroll
                    for (int j = 0; j < 8; ++j) { const f32x4 t = acc[ai][bj][m][j >> 2];
                        if constexpr (INPROJ_I8 != 0) v[bj][j] = (float)__builtin_bit_cast(pg8::i32x4, t)[j & 3] * sr * sw[bj][j >> 2][j & 3]; else v[bj][j] = t[j & 3]; }
                if constexpr (KIND == 1) {
                    unsigned char* gp = mg8 + ((size_t)(u.pm * 12 + (u.pn - 19)) * 512 + ((wr * 4 + wc) * 64 + fq * 16 + fr)) * 128 + (ai * 4 + m) * 16;
                    stg((u32x4*)gp, (u32x4){pk4_fp8(v[0][0], v[0][1], v[0][2], v[0][3]), pk4_fp8(v[0][4], v[0][5], v[0][6], v[0][7]), pk4_fp8(v[1][0], v[1][1], v[1][2], v[1][3]), pk4_fp8(v[1][4], v[1][5], v[1][6], v[1][7])}); }
                else {
#pragma unroll
                for (int bj = 0; bj < 2; ++bj) stg((u32x4*)(P + (size_t)row * NP + col0 + bj * 128), (u32x4){pk2(v[bj][0], v[bj][1]), pk2(v[bj][2], v[bj][3]), pk2(v[bj][4], v[bj][5]), pk2(v[bj][6], v[bj][7])}); }
                if constexpr (KIND == 2) { if (wc == 0) { float* sp = small + (size_t)row * 32 + 8 * fq; *(f32x4*)sp = (f32x4){v[0][0], v[0][1], v[0][2], v[0][3]}; *(f32x4*)(sp + 4) = (f32x4){v[0][4], v[0][5], v[0][6], v[0][7]}; } } }
    }
    DI void operator()(const f32x4 (&acc)[2][2][4][2], const Unit& u, int wr, int wc, int fr, int fq, const LAS float* cl) const {
        if (u.pn < 19) body<0>(acc, u, wr, wc, fr, fq, cl); else if (u.pn < 31) body<1>(acc, u, wr, wc, fr, fq, cl); else body<2>(acc, u, wr, wc, fr, fq, cl);
    } };
struct EpiGate { static constexpr int NC = 2; static constexpr bool PERM = true; static constexpr int NST = 16; const unsigned char* P; const float* bmerge; bf16_t* M;
    static DI bool keep(const Unit& u) { return u.pn < 8; }
    DI const char* cvec(const Unit& u, int i) const { return (const char*)(bmerge + (u.pn + ((i && u.pn < 8) ? 4 : 0)) * 256); }
    DI void operator()(f32x4 (&acc)[2][2][4][2], const Unit& u, int wr, int wc, int fr, int fq, const LAS float* cl) const {
        const int row0 = u.pm * 256 + wr * 64 + fr, col0 = u.pn * 256 + wc * 32 + 8 * fq; const bool fin = u.pn >= 8;
        const unsigned char* g0 = P + ((size_t)(u.pm * 12 + u.pn) * 512 + ((wr * 4 + wc) * 64 + fq * 16 + fr)) * 128;
        const unsigned char* g1 = g0 + (fin ? (size_t)0 : (size_t)4 * 512 * 128);
        const float fsel = fin ? 1.f : 0.f, fmul = fin ? (BRANCH_FP8 ? W8_INV : 1.f) : 0.f;
#pragma unroll
        for (int ai = 0; ai < 2; ++ai) { u32x4 ga[4], gb[4];
#pragma unroll
            for (int m = 0; m < 4; ++m) { ga[m] = *(const u32x4*)(g0 + (ai * 4 + m) * 16); gb[m] = *(const u32x4*)(g1 + (ai * 4 + m) * 16); }
#pragma unroll
            for (int bj = 0; bj < 2; ++bj) { f32x2 bv[4], bn[4];
                { const f32x4 t0 = *(const LAS f32x4*)(cl + wc * 32 + 8 * fq + bj * 128), t1 = *(const LAS f32x4*)(cl + wc * 32 + 8 * fq + bj * 128 + 4);
                  bv[0] = (f32x2){t0[0], t0[1]}; bv[1] = (f32x2){t0[2], t0[3]}; bv[2] = (f32x2){t1[0], t1[1]}; bv[3] = (f32x2){t1[2], t1[3]}; }
                { const f32x4 n0 = *(const LAS f32x4*)(cl + 256 + wc * 32 + 8 * fq + bj * 128), n1 = *(const LAS f32x4*)(cl + 256 + wc * 32 + 8 * fq + bj * 128 + 4);
                  bn[0] = (f32x2){n0[0], n0[1]}; bn[1] = (f32x2){n0[2], n0[3]}; bn[2] = (f32x2){n1[0], n1[1]}; bn[3] = (f32x2){n1[2], n1[3]}; }
#pragma unroll
                for (int m = 0; m < 4; ++m) { const size_t row = row0 + ai * 128 + m * 16;
                    const u32x2 mr8 = bj ? (u32x2){ga[m].z, ga[m].w} : (u32x2){ga[m].x, ga[m].y}; const u32x2 nx8 = bj ? (u32x2){gb[m].z, gb[m].w} : (u32x2){gb[m].x, gb[m].y};
                    f32x2 o[4];
#pragma unroll
                    for (int jp = 0; jp < 4; ++jp) { const unsigned w = jp < 2 ? mr8.x : mr8.y; const f32x2 mg = (jp & 1) ? __builtin_amdgcn_cvt_pk_f32_fp8((int)w, true) : __builtin_amdgcn_cvt_pk_f32_fp8((int)w, false);
                        const f32x4 av = acc[ai][bj][m][jp >> 1]; const int e0 = 2 * (jp & 1);
                        f32x2 xa = mg + bv[jp]; xa.x = __builtin_amdgcn_fmed3f(xa.x, -60.f, 60.f); xa.y = __builtin_amdgcn_fmed3f(xa.y, -60.f, 60.f);
                        const f32x2 t = xa * (-1.4426950408889634f); f32x2 d; d.x = __builtin_amdgcn_exp2f(t.x); d.y = __builtin_amdgcn_exp2f(t.y); d = d + 1.f;
                        f32x2 r; r.x = __builtin_amdgcn_rcpf(d.x); r.y = __builtin_amdgcn_rcpf(d.y);
                        const unsigned wn = jp < 2 ? nx8.x : nx8.y; const f32x2 mn = (jp & 1) ? __builtin_amdgcn_cvt_pk_f32_fp8((int)wn, true) : __builtin_amdgcn_cvt_pk_f32_fp8((int)wn, false);
                        f32x2 xb = mn + bn[jp]; xb.x = __builtin_amdgcn_fmed3f(xb.x, -60.f, 60.f); xb.y = __builtin_amdgcn_fmed3f(xb.y, -60.f, 60.f);
                        const f32x2 tb = xb * (-1.4426950408889634f); f32x2 db; db.x = __builtin_amdgcn_exp2f(tb.x); db.y = __builtin_amdgcn_exp2f(tb.y); db = db + 1.f;
                        db = db * (1.f - fsel) + fmul;
                        o[jp] = ((f32x2){av[e0], av[e0 + 1]} * r) * db; }
                    if (fin) stg((u32x4*)(M + row * DM + col0 - 2048 + bj * 128), (u32x4){pk2(o[0].x, o[0].y), pk2(o[1].x, o[1].y), pk2(o[2].x, o[2].y), pk2(o[3].x, o[3].y)});
                    acc[ai][bj][m][0] = (f32x4){o[0].x, o[0].y, o[1].x, o[1].y}; acc[ai][bj][m][1] = (f32x4){o[2].x, o[2].y, o[3].x, o[3].y}; } }
            __builtin_amdgcn_sched_barrier(0); }
    } };
struct EpiResid { static DI bool keep(const Unit&) { return false; } static constexpr int NC = 1; static constexpr bool PERM = true; static constexpr int NST = 16; const bf16_t* xin; bf16_t* xout; const float* gm;
    DI const char* cvec(const Unit& u, int) const { return (const char*)(gm + (size_t)((u.pm * 256) >> 12) * 6144 + u.pn * 256); }
    DI void operator()(const f32x4 (&acc)[2][2][4][2], const Unit& u, int wr, int wc, int fr, int fq, const LAS float* cl) const {
        const int row0 = u.pm * 256 + wr * 64 + fr, col0 = u.pn * 256 + wc * 32 + 8 * fq;
        f32x4 gv[2][2];
#pragma unroll
        for (int bj = 0; bj < 2; ++bj) { gv[bj][0] = *(const LAS f32x4*)(cl + wc * 32 + 8 * fq + bj * 128); gv[bj][1] = *(const LAS f32x4*)(cl + wc * 32 + 8 * fq + bj * 128 + 4); }
#pragma unroll
        for (int ai = 0; ai < 2; ++ai) { u32x4 xt[4][2];
#pragma unroll
            for (int m = 0; m < 4; ++m)
#pragma unroll
                for (int bj = 0; bj < 2; ++bj) xt[m][bj] = *(const u32x4*)(xin + (size_t)(row0 + ai * 128 + m * 16) * DM + col0 + bj * 128);
#pragma unroll
            for (int m = 0; m < 4; ++m) { const size_t off = (size_t)(row0 + ai * 128 + m * 16) * DM + col0;
#pragma unroll
                for (int bj = 0; bj < 2; ++bj) { const u32x4 t = xt[m][bj]; const f32x4 x0 = (f32x4){bflo(t.x), bfhi(t.x), bflo(t.y), bfhi(t.y)}, x1 = (f32x4){bflo(t.z), bfhi(t.z), bflo(t.w), bfhi(t.w)};
                    const f32x4 v0 = x0 + gv[bj][0] * acc[ai][bj][m][0], v1 = x1 + gv[bj][1] * acc[ai][bj][m][1];
                    stg((u32x4*)(xout + off + bj * 128), (u32x4){pk2(v0[0], v0[1]), pk2(v0[2], v0[3]), pk2(v1[0], v1[1]), pk2(v1[2], v1[3])}); } }
            __builtin_amdgcn_sched_barrier(0); }
    } };
struct EpiSwiglu { static DI bool keep(const Unit&) { return false; } static constexpr int NC = 1; static constexpr bool PERM = true; static constexpr int NST = 8; unsigned char* act; const float* bgu;
    DI const char* cvec(const Unit& u, int) const { return (const char*)(bgu + (size_t)u.e * 2048 + u.pn * 256); }
    DI void operator()(const f32x4 (&acc)[2][2][4][2], const Unit& u, int wr, int wc, int fr, int fq, const LAS float* cl) const {
        const int row0 = u.pm * 256 + wr * 64 + fr, x0 = u.pn * 128 + wc * 32 + 8 * fq;
        const LAS float* bb = cl + 2 * (wc * 32 + 8 * fq);
        f32x2 bg[4], bu[4];
#pragma unroll
        for (int i = 0; i < 4; ++i) { const f32x4 t = *(const LAS f32x4*)(bb + 4 * i); bg[i] = (f32x2){t[0], t[2]}; bu[i] = (f32x2){t[1] + 1.f, t[3] + 1.f}; }
#pragma unroll
        for (int ai = 0; ai < 2; ++ai)
#pragma unroll
            for (int m = 0; m < 4; ++m) { const size_t row = row0 + ai * 128 + m * 16; f32x2 o[4];
#pragma unroll
                for (int jp = 0; jp < 4; ++jp) { const f32x4 ag = acc[ai][0][m][jp >> 1], au = acc[ai][1][m][jp >> 1]; const int e0 = 2 * (jp & 1);
                    f32x2 g = (f32x2){ag[e0], ag[e0 + 1]} * W8_INV + bg[jp], u1 = (f32x2){au[e0], au[e0 + 1]} * W8_INV + bu[jp];
                    g.x = fminf(g.x, 7.f); g.y = fminf(g.y, 7.f); u1.x = __builtin_amdgcn_fmed3f(u1.x, -6.f, 8.f); u1.y = __builtin_amdgcn_fmed3f(u1.y, -6.f, 8.f);
                    const f32x2 t = g * (-1.702f * 1.4426950408889634f); f32x2 d; d.x = __builtin_amdgcn_exp2f(t.x); d.y = __builtin_amdgcn_exp2f(t.y); d = d + 1.f;
                    f32x2 r; r.x = __builtin_amdgcn_rcpf(d.x); r.y = __builtin_amdgcn_rcpf(d.y);
                    o[jp] = (u1 * g) * r; }
                unsigned char* dp = MOE_TILED ? act + (size_t)u.pm * 262144 + (size_t)u.pn * 32768 + (row & 255) * 128 + (wc * 32 + 8 * fq) : act + row * DM + x0;
                stg((u32x2*)dp, (u32x2){pk4_fp8(o[0].x, o[0].y, o[1].x, o[1].y), pk4_fp8(o[2].x, o[2].y, o[3].x, o[3].y)}); }
    } };
struct EpiDown { static DI bool keep(const Unit&) { return false; } static constexpr int NC = 1; static constexpr bool PERM = true; static constexpr int NST = 16; bf16_t* ys; const float* bdn;
    DI const char* cvec(const Unit& u, int) const { return (const char*)(bdn + (size_t)u.e * DM + u.pn * 256); }
    DI void operator()(const f32x4 (&acc)[2][2][4][2], const Unit& u, int wr, int wc, int fr, int fq, const LAS float* cl) const {
        const int row0 = u.pm * 256 + wr * 64 + fr, col0 = u.pn * 256 + wc * 32 + 8 * fq;
        f32x4 bv[2][2];
#pragma unroll
        for (int bj = 0; bj < 2; ++bj) { bv[bj][0] = *(const LAS f32x4*)(cl + wc * 32 + 8 * fq + bj * 128); bv[bj][1] = *(const LAS f32x4*)(cl + wc * 32 + 8 * fq + bj * 128 + 4); }
#pragma unroll
        for (int ai = 0; ai < 2; ++ai)
#pragma unroll
            for (int m = 0; m < 4; ++m) { const size_t row = row0 + ai * 128 + m * 16;
#pragma unroll
                for (int bj = 0; bj < 2; ++bj) { const f32x4 v0 = acc[ai][bj][m][0] * W8_INV + bv[bj][0], v1 = acc[ai][bj][m][1] * W8_INV + bv[bj][1];
                    u32x4 w; w.x = pk2(v0[0], v0[1]); w.y = pk2(v0[2], v0[3]); w.z = pk2(v1[0], v1[1]); w.w = pk2(v1[2], v1[3]);
                    stg((u32x4*)(ys + row * DM + col0 + bj * 128), w); } }
    } };

DI void moe_tables(const int* cnt  , LAS unsigned char* lds) {
    LAS int* tstart = (LAS int*)(lds + LDS_CTRL + 64); LAS int* lcnt = (LAS int*)(lds + LDS_CTRL + 256);
    if (ltid() < 64) { const int t = ltid(); const int c = t < 32 ? cnt[t * 64] : 0; int v = (c + 255) >> 8;
#pragma unroll
        for (int o = 1; o < 32; o <<= 1) { const int y = __shfl_up(v, o); if ((t & 31) >= o) v += y; }
        if (t < 32) { tstart[t + 1] = v; lcnt[t] = c; } if (t == 0) tstart[0] = 0; }
    __syncthreads();
}
#ifndef MOE_DEAL
#define MOE_DEAL 1
#endif
template <bool G_> struct MoeOrder {
    static constexpr bool GATHER = G_;
    int nN, G, c; const LAS int* tstart; const LAS int* lcnt; const char* A; const char* Bt; size_t b_estride, tstep; const int* rowtok;
    DI bool next(int i, Unit& u) const {
#ifdef PROBE_DUPK_MOE
        int dupskip = 0; if (GATHER == (PROBE_DUPK_MOE == 1)) { dupskip = (i & 1) == 0; i >>= 1; }
#endif
        int rt, ct;
#if MOE_DEAL == 1
        if ((G & 7) == 0) { const int x = c & 7, j = i * (G >> 3) + (c >> 3), T = __builtin_amdgcn_readfirstlane(tstart[32]); rt = ((x * T) >> 3) + j / nN; ct = j % nN; if (rt >= (((x + 1) * T) >> 3)) return false; }
        else { const int L = i * G + c; rt = L / nN; ct = L % nN; if (rt >= tstart[32]) return false; }
#else
        if ((G & 7) == 0) { const int x = c & 7, j = i * (G >> 3) + (c >> 3); rt = (j / nN) * 8 + x; ct = j % nN; } else { const int L = i * G + c; rt = L / nN; ct = L % nN; }
        if (rt >= tstart[32]) return false;
#endif
        int e = 0;
#pragma unroll
        for (int s = 16; s >= 1; s >>= 1) { if (tstart[e + s] <= rt) e += s; }
        e = __builtin_amdgcn_readfirstlane(e);
        u.pm = rt; u.pn = ct; u.e = e; u.skip = 0;
#ifdef PROBE_DUPK_MOE
        u.skip = dupskip;
#endif
        const int rem = lcnt[e] - (rt - tstart[e]) * 256; u.cnt = rem < 256 ? rem : 256; return true; }
    DI const char* a_ptr(const Unit& u) const { return GATHER ? A : A + (size_t)u.pm * tstep; }
    DI const char* b_ptr(const Unit& u) const { return Bt + (size_t)u.e * b_estride + (size_t)u.pn * tstep; }
    DI int a_row(const Unit& u, int R) const { return R < u.cnt ? rowtok[u.e * 32768 + (u.pm - tstart[u.e]) * 256 + R] : 0; }
    DI const char* a_rowsrc(const Unit& u) const { return (const char*)(rowtok + u.e * 32768 + (u.pm - tstart[u.e]) * 256); }
};
DI void phase_router(CArgs& a, int l, const bf16_t* xmid, LAS unsigned char* lds) {
    const int tid = ltid(), wid = tid >> 6, lane = tid & 63, r = lane & 15, q = lane >> 4;
    LAS bf16_t* Whi = (LAS bf16_t*)lds; LAS bf16_t* Wlo = (LAS bf16_t*)(lds + 66048);
    LAS float* scr = (LAS float*)(lds + 132096 + wid * 2112);
    LAS int* hist = (LAS int*)(lds + 148992); LAS int* basep = (LAS int*)(lds + 148992 + 128);
    const float* wr_ = a.w_router + (size_t)l * DM * NEXP;
    { f32x4 wv[16];
#pragma unroll
      for (int j = 0; j < 16; ++j) wv[j] = *(const f32x4*)(wr_ + (size_t)(tid + NTHREADS * j) * 4);
#pragma unroll
      for (int j = 0; j < 16; ++j) { const int i = (tid + NTHREADS * j) * 4, k = i >> 5, e0 = i & 31;
#pragma unroll
          for (int t = 0; t < 4; ++t) { const float v = wv[j][t]; const bf16_t hi = f2bf(v); Whi[(e0 + t) * 1032 + k] = hi; Wlo[(e0 + t) * 1032 + k] = f2bf(v - bf2f(hi)); } } }
    __syncthreads();
    const float* mod = (const float*)(a.ws + WS_MOD) + (size_t)l * 8 * 6144;
    const float* nf = a.norm_ffn + l * DM;
    bf16_t* H = (bf16_t*)(a.ws + WS_H);
    int* cntg = (int*)(a.ws + WS_CNT) + l * 32 * 64;
    int* rowtok = (int*)(a.ws + WS_ROWTOK); int* tokslot = (int*)(a.ws + WS_TOKSLOT); float* gates = (float*)(a.ws + WS_GATES);
    for (int blk = lbid(); blk < NTOK / 128; blk += lgrid()) {
        if (tid < 32) hist[tid] = 0;
        const int row = blk * 128 + wid * 16 + r, b = row >> 12;
        const bf16_t* xr = xmid + (size_t)row * DM; const float* mb = mod + (size_t)b * 6144;
        float ss = 0.f;
#pragma unroll 1
        for (int kc = 0; kc < 2; ++kc) { u32x4 xa[16];
#pragma unroll
            for (int s = 0; s < 16; ++s) xa[s] = *(const u32x4*)(xr + (kc * 16 + s) * 32 + 8 * q);
#pragma unroll
            for (int s = 0; s < 16; ++s) { const u32x4 t = xa[s]; ss += bflo(t.x) * bflo(t.x) + bfhi(t.x) * bfhi(t.x) + bflo(t.y) * bflo(t.y) + bfhi(t.y) * bfhi(t.y) + bflo(t.z) * bflo(t.z) + bfhi(t.z) * bfhi(t.z) + bflo(t.w) * bflo(t.w) + bfhi(t.w) * bfhi(t.w); } }
        ss += __shfl_xor(ss, 16); ss += __shfl_xor(ss, 32);
        const float rs = rsqrtf(ss * (1.f / 1024.f) + 1e-6f);
        f32x4 acc0 = {0.f, 0.f, 0.f, 0.f}, acc1 = {0.f, 0.f, 0.f, 0.f};
#pragma unroll 1
        for (int kc = 0; kc < 8; ++kc) { u32x4 xb[4]; f32x4 ga[8], ca[8], ha[8];
#pragma unroll
            for (int s = 0; s < 4; ++s) { const int k0 = (kc * 4 + s) * 32 + 8 * q;
                xb[s] = *(const u32x4*)(xr + k0); ga[2 * s] = *(const f32x4*)(nf + k0); ga[2 * s + 1] = *(const f32x4*)(nf + k0 + 4);
                ca[2 * s] = *(const f32x4*)(mb + 4096 + k0); ca[2 * s + 1] = *(const f32x4*)(mb + 4096 + k0 + 4); ha[2 * s] = *(const f32x4*)(mb + 3072 + k0); ha[2 * s + 1] = *(const f32x4*)(mb + 3072 + k0 + 4); }
#pragma unroll
            for (int s = 0; s < 4; ++s) { const int k0 = (kc * 4 + s) * 32 + 8 * q;
                float hv[8]; const u32x4 xt = xb[s]; const float xf[8] = {bflo(xt.x), bfhi(xt.x), bflo(xt.y), bfhi(xt.y), bflo(xt.z), bfhi(xt.z), bflo(xt.w), bfhi(xt.w)};
#pragma unroll
                for (int j = 0; j < 8; ++j) { const int v2 = 2 * s + (j >> 2), e2 = j & 3; hv[j] = xf[j] * rs * ga[v2][e2] * (1.f + ca[v2][e2]) + ha[v2][e2]; }
                u32x4 hi; hi.x = pk2(hv[0], hv[1]); hi.y = pk2(hv[2], hv[3]); hi.z = pk2(hv[4], hv[5]); hi.w = pk2(hv[6], hv[7]);
                *(u32x2*)((unsigned char*)H + (size_t)row * DM + k0) = (u32x2){pk4_fp8(hv[0], hv[1], hv[2], hv[3]), pk4_fp8(hv[4], hv[5], hv[6], hv[7])};
                u32x4 lo; lo.x = pk2(hv[0] - bflo(hi.x), hv[1] - bfhi(hi.x)); lo.y = pk2(hv[2] - bflo(hi.y), hv[3] - bfhi(hi.y)); lo.z = pk2(hv[4] - bflo(hi.z), hv[5] - bfhi(hi.z)); lo.w = pk2(hv[6] - bflo(hi.w), hv[7] - bfhi(hi.w));
                const bf16x8 ah = __builtin_bit_cast(bf16x8, hi), al = __builtin_bit_cast(bf16x8, lo);
                const bf16x8 b0h = *(const LAS bf16x8*)(Whi + r * 1032 + k0), b0l = *(const LAS bf16x8*)(Wlo + r * 1032 + k0);
                const bf16x8 b1h = *(const LAS bf16x8*)(Whi + (16 + r) * 1032 + k0), b1l = *(const LAS bf16x8*)(Wlo + (16 + r) * 1032 + k0);
                acc0 = __builtin_amdgcn_mfma_f32_16x16x32_bf16(ah, b0h, acc0, 0, 0, 0); acc0 = __builtin_amdgcn_mfma_f32_16x16x32_bf16(ah, b0l, acc0, 0, 0, 0); acc0 = __builtin_amdgcn_mfma_f32_16x16x32_bf16(al, b0h, acc0, 0, 0, 0);
                acc1 = __builtin_amdgcn_mfma_f32_16x16x32_bf16(ah, b1h, acc1, 0, 0, 0); acc1 = __builtin_amdgcn_mfma_f32_16x16x32_bf16(ah, b1l, acc1, 0, 0, 0); acc1 = __builtin_amdgcn_mfma_f32_16x16x32_bf16(al, b1h, acc1, 0, 0, 0); } }
        const float br0 = a.b_router[l * 32 + r], br1 = a.b_router[l * 32 + 16 + r];
#pragma unroll
        for (int j = 0; j < 4; ++j) { scr[(4 * q + j) * 33 + r] = acc0[j] + br0; scr[(4 * q + j) * 33 + 16 + r] = acc1[j] + br1; }
        __syncthreads();
        int te[4] = {0, 0, 0, 0}; float tg[4] = {0.f, 0.f, 0.f, 0.f}; int rk[4] = {0, 0, 0, 0};
        if (lane < 16) {
            float v[32];
#pragma unroll
            for (int e = 0; e < 32; ++e) v[e] = scr[lane * 33 + e];
            float tv[4];
#pragma unroll
            for (int k = 0; k < 4; ++k) { float best = -3.0e38f; int bi = 0;
#pragma unroll
                for (int e = 0; e < 32; ++e) { if (v[e] > best) { best = v[e]; bi = e; } }
                tv[k] = best; te[k] = bi;
#pragma unroll
                for (int e = 0; e < 32; ++e) v[e] = (e == bi) ? -3.0e38f : v[e]; }
            const float e1 = __expf(tv[1] - tv[0]), e2 = __expf(tv[2] - tv[0]), e3 = __expf(tv[3] - tv[0]); const float inv = 1.f / (1.f + e1 + e2 + e3);
            tg[0] = inv; tg[1] = e1 * inv; tg[2] = e2 * inv; tg[3] = e3 * inv;
#pragma unroll
            for (int k = 0; k < 4; ++k) rk[k] = atomicAdd((int*)&hist[te[k]], 1);
        }
        __syncthreads();
        if (tid < 32) basep[tid] = atomicAdd(&cntg[tid * 64], hist[tid]);
        __syncthreads();
        if (lane < 16) { const int tok = blk * 128 + wid * 16 + lane;
#pragma unroll
            for (int k = 0; k < 4; ++k) { const int pos = basep[te[k]] + rk[k]; rowtok[te[k] * 32768 + pos] = tok; tokslot[tok * 4 + k] = te[k] * 32768 + pos; gates[tok * 4 + k] = tg[k]; } }
        __syncthreads();
    }
}

struct CombSlots { int s[4]; float g[4]; };
struct CombData { u32x4 y[2][4]; u32x4 x[2]; };
DI void comb_slots(CArgs& a, int row, CombSlots& cs) {
    const int* tokslot = (const int*)(a.ws + WS_TOKSLOT); const float* gates = (const float*)(a.ws + WS_GATES);
    const int r = row < NTOK ? row : 0;
#pragma unroll
    for (int k = 0; k < 4; ++k) { cs.s[k] = tokslot[r * 4 + k]; cs.g[k] = gates[r * 4 + k]; }
}
DI void comb_data(CArgs& a, int row, const CombSlots& cs, const bf16_t* xmid, const LAS int* tstart, int lane, CombData& d) {
    const bf16_t* YS = (const bf16_t*)(a.ws + WS_R1 + R1_YS); const int r = row < NTOK ? row : 0;
#pragma unroll
    for (int k = 0; k < 4; ++k) { const size_t pr = (size_t)(tstart[cs.s[k] >> 15] * 256 + (cs.s[k] & 32767));
#pragma unroll
        for (int i = 0; i < 2; ++i) d.y[i][k] = *(const u32x4*)(YS + pr * DM + lane * 8 + 512 * i); }
#pragma unroll
    for (int i = 0; i < 2; ++i) d.x[i] = *(const u32x4*)(xmid + (size_t)r * DM + lane * 8 + 512 * i);
}
DI void phase_combine(CArgs& a, int l, const bf16_t* xmid, bf16_t* xnew, LAS unsigned char* lds) {
    const LAS int* tstart = (const LAS int*)(lds + LDS_CTRL + 64);
    const int lane = ltid() & 63, gw = lbid() * 8 + (ltid() >> 6), nw = lgrid() * 8;
    const float* mod = (const float*)(a.ws + WS_MOD);
    if (gw >= NTOK) return;
    CombSlots s0, s1; CombData d0;
    comb_slots(a, gw, s0); comb_slots(a, gw + nw, s1); comb_data(a, gw, s0, xmid, tstart, lane, d0);
    for (int row = gw; row < NTOK; row += nw) {
        CombData d1; CombSlots s2; comb_data(a, row + nw, s1, xmid, tstart, lane, d1); comb_slots(a, row + 2 * nw, s2);
        const int b = row >> 12; const float* mb = mod + ((size_t)l * 8 + b) * 6144;
        float xn[16]; float ss = 0.f;
#pragma unroll
        for (int i = 0; i < 2; ++i) { const int c0 = lane * 8 + 512 * i; float f[8];
#pragma unroll
            for (int j = 0; j < 8; ++j) f[j] = 0.f;
#pragma unroll
            for (int k = 0; k < 4; ++k) { const u32x4 y = d0.y[i][k]; const float g = s0.g[k];
                f[0] += g * bflo(y.x); f[1] += g * bfhi(y.x); f[2] += g * bflo(y.y); f[3] += g * bfhi(y.y); f[4] += g * bflo(y.z); f[5] += g * bfhi(y.z); f[6] += g * bflo(y.w); f[7] += g * bfhi(y.w); }
            const u32x4 xt = d0.x[i]; const float xf[8] = {bflo(xt.x), bfhi(xt.x), bflo(xt.y), bfhi(xt.y), bflo(xt.z), bfhi(xt.z), bflo(xt.w), bfhi(xt.w)};
#pragma unroll
            for (int j = 0; j < 8; ++j) { const float xv = xf[j] + mb[5120 + c0 + j] * f[j]; xn[8 * i + j] = xv; ss += xv * xv; } }
        ss = wave_sum(ss); const float rs = rsqrtf(ss * (1.f / 1024.f) + 1e-6f);
        if (l == 0) {
            const float* mb2 = mod + ((size_t)8 + b) * 6144; const float* g = a.norm_mix + DM;
            float o[16];
#pragma unroll
            for (int i = 0; i < 2; ++i) { const int c0 = lane * 8 + 512 * i;
                *(u32x4*)(xnew + (size_t)row * DM + c0) = (u32x4){pk2(xn[8 * i], xn[8 * i + 1]), pk2(xn[8 * i + 2], xn[8 * i + 3]), pk2(xn[8 * i + 4], xn[8 * i + 5]), pk2(xn[8 * i + 6], xn[8 * i + 7])};
#pragma unroll
                for (int j = 0; j < 8; ++j) o[8 * i + j] = xn[8 * i + j] * rs * g[c0 + j] * (1.f + mb2[1024 + c0 + j]) + mb2[c0 + j]; }
            store_h_row(a, row, lane, o);
        } else {
#pragma unroll
            for (int i = 0; i < 2; ++i) { const int c0 = lane * 8 + 512 * i; float o[8];
#pragma unroll
                for (int j = 0; j < 8; ++j) o[j] = xn[8 * i + j] * rs * a.norm_final[c0 + j];
                *(f32x4*)(a.out + (size_t)row * DM + c0) = (f32x4){o[0], o[1], o[2], o[3]}; *(f32x4*)(a.out + (size_t)row * DM + c0 + 4) = (f32x4){o[4], o[5], o[6], o[7]}; }
        }
        d0 = d1; s0 = s1; s1 = s2;
    }
}

DI float wave_incl_scan(float v, int lane) {
#pragma unroll
    for (int o = 1; o < 64; o <<= 1) { const float y = __shfl_up(v, o); if (lane >= o) v += y; }
    return v;
}
DI void conv8(const bf16_t* p, int pos, const float* w, int chs, const float* bias, float (&out)[8]) {
    float acc[8];
    if (bias) { const f32x4 b0 = *(const f32x4*)bias, b1 = *(const f32x4*)(bias + 4); acc[0] = b0[0]; acc[1] = b0[1]; acc[2] = b0[2]; acc[3] = b0[3]; acc[4] = b1[0]; acc[5] = b1[1]; acc[6] = b1[2]; acc[7] = b1[3]; }
    else {
#pragma unroll
        for (int i = 0; i < 8; ++i) acc[i] = 0.f; }
#pragma unroll
    for (int j = 0; j < 4; ++j) {
        if (pos - 3 + j >= 0) { const u32x4 xv = *(const u32x4*)(p - (ptrdiff_t)(3 - j) * NP); const f32x4 w0 = *(const f32x4*)(w + j * chs), w1 = *(const f32x4*)(w + j * chs + 4);
            acc[0] += w0[0] * bflo(xv.x); acc[1] += w0[1] * bfhi(xv.x); acc[2] += w0[2] * bflo(xv.y); acc[3] += w0[3] * bfhi(xv.y);
            acc[4] += w1[0] * bflo(xv.z); acc[5] += w1[1] * bfhi(xv.z); acc[6] += w1[2] * bflo(xv.w); acc[7] += w1[3] * bfhi(xv.w); } }
#pragma unroll
    for (int i = 0; i < 8; ++i) out[i] = silu_(acc[i]);
}
DI int swz64(int row, int l) { return row * 72 + ((((l >> 3) + (row >> 3)) & 7) << 3) + (l & 7); }
template <int K, bool BSWZ = false> DI f32x4 mm16(const LAS bf16_t* A, int lda, int m0, const LAS bf16_t* Bt, int ldb, int n0, int lane) {
    f32x4 acc = {0.f, 0.f, 0.f, 0.f}; const int r = lane & 15, q = lane >> 4; bf16x8 av[K / 32], bv[K / 32];
#pragma unroll
    for (int s = 0; s < K / 32; ++s) { av[s] = *(const LAS bf16x8*)(A + (m0 + r) * lda + s * 32 + 8 * q);
        bv[s] = BSWZ ? *(const LAS bf16x8*)(Bt + (n0 + r) * ldb + (((s * 4 + q + ((n0 + r) >> 3)) & 7) << 3)) : *(const LAS bf16x8*)(Bt + (n0 + r) * ldb + s * 32 + 8 * q); }
#pragma unroll
    for (int s = 0; s < K / 32; ++s) acc = __builtin_amdgcn_mfma_f32_16x16x32_bf16(av[s], bv[s], acc, 0, 0, 0);
    return acc;
}
DI void frag_store8(char* base, int nkb, int row, int k0, const float (&v)[8]) {
    const int rt = row >> 5, r = row & 31, kb = k0 >> 4, aa = (k0 >> 3) & 1;
    char* p = base + ((size_t)((rt * nkb + kb) * 64 + r)) * 16 + aa * 8;
    *(u32x2*)p = (u32x2){pk2(v[0], v[1]), pk2(v[2], v[3])};
    *(u32x2*)(p + 512) = (u32x2){pk2(v[4], v[5]), pk2(v[6], v[7])};
}
template <bool SWZ, int R, int KK> DI void export_frags(char* dst, const LAS bf16_t* M, int ld, int coloff) {
    constexpr int nkb = KK >> 4, pieces = (R >> 5) * nkb * 64, NP_ = (pieces + NTHREADS - 1) / NTHREADS;
    u32x2 lo[NP_], hi[NP_];
#pragma unroll
    for (int it = 0; it < NP_; ++it) { const int p = ltid() + it * NTHREADS; const int lane = p & 63, f = p >> 6, kb = f % nkb, rt = (f / nkb) % (R >> 5), r = lane & 31, h = lane >> 5, row = rt * 32 + r;
        const LAS bf16_t* s0 = SWZ ? M + swz64(row, kb * 16 + 4 * h) : M + row * ld + coloff + kb * 16 + 4 * h;
        const LAS bf16_t* s1 = SWZ ? M + swz64(row, kb * 16 + 8 + 4 * h) : s0 + 8;
        lo[it] = *(const LAS u32x2*)s0; hi[it] = *(const LAS u32x2*)s1; }
#pragma unroll
    for (int it = 0; it < NP_; ++it) { const int p = ltid() + it * NTHREADS; if (p < pieces) *(u32x4*)(dst + (size_t)p * 16) = (u32x4){lo[it].x, lo[it].y, hi[it].x, hi[it].y}; }
}
DI void export_acc(char* dst, const LAS bf16_t* M, int ld, int nct) {
    const int pieces = nct * 2 * 64;
    for (int p = ltid(); p < pieces; p += NTHREADS) { const int lane = p & 63, tile = p >> 6, rt = tile & 1, ct = tile >> 1, r = lane & 31, h = lane >> 5;
        unsigned w[8]; bf16_t t0[8], t1[8];
#pragma unroll
        for (int i = 0; i < 8; ++i) { const int r0 = rt * 32 + ((2 * i) & 3) + 8 * ((2 * i) >> 2) + 4 * h; t0[i] = M[r0 * ld + ct * 32 + r]; t1[i] = M[(r0 + 1) * ld + ct * 32 + r]; }
        asm volatile("s_waitcnt lgkmcnt(0)" ::: "memory");
#pragma unroll
        for (int i = 0; i < 8; ++i) w[i] = (unsigned)t0[i] | ((unsigned)t1[i] << 16);
        *(u32x4*)(dst + (size_t)p * 32) = (u32x4){w[0], w[1], w[2], w[3]}; *(u32x4*)(dst + (size_t)p * 32 + 16) = (u32x4){w[4], w[5], w[6], w[7]}; }
}

#ifndef PROBE_DUPST
#define PROBE_DUPST 1
#endif
DI u32x4 ldg_or0(const bf16_t* p, bool ok) { return ok ? *(const u32x4*)p : (u32x4){0u, 0u, 0u, 0u}; }
DI void conv8r(const u32x4 (&t)[4], const LAS float* wt, int ws, const LAS float* bias, float (&out)[8]) {
    float acc[8];
#pragma unroll
    for (int i = 0; i < 8; ++i) acc[i] = bias ? bias[i] : 0.f;
#pragma unroll
    for (int j = 0; j < 4; ++j) { const LAS float* w = wt + j * ws; const u32x4 xv = t[j];
        acc[0] += w[0] * bflo(xv.x); acc[1] += w[1] * bfhi(xv.x); acc[2] += w[2] * bflo(xv.y); acc[3] += w[3] * bfhi(xv.y);
        acc[4] += w[4] * bflo(xv.z); acc[5] += w[5] * bfhi(xv.z); acc[6] += w[6] * bflo(xv.w); acc[7] += w[7] * bfhi(xv.w); }
#pragma unroll
    for (int i = 0; i < 8; ++i) out[i] = silu_(acc[i]);
}
struct GlaRaw { f32x4 lr[4]; u32x4 q8, k8, v8[2]; };
DI void gla_load(CArgs& a, int u, GlaRaw& r) {
    const int tid = ltid(); const int n = u & 63, bh = u >> 6, b = bh >> 2, h = bh & 3, T0 = b * SEQ + n * 64;
    const bf16_t* P = (const bf16_t*)(a.ws + WS_R1 + R1_PROJ); const float* small = (const float*)(a.ws + WS_SMALL);
    const int l_ = tid >> 3, d0 = (tid & 7) * 8; const size_t T = (size_t)(T0 + l_);
#pragma unroll
    for (int i = 0; i < 4; ++i) r.lr[i] = *(const f32x4*)(small + T * 32 + 4 * i);
    r.q8 = *(const u32x4*)(P + T * NP + PC_GLA_Q + h * 64 + d0); r.k8 = *(const u32x4*)(P + T * NP + PC_GLA_K + h * 64 + d0);
#pragma unroll
    for (int rep = 0; rep < 2; ++rep) { const int idx = rep * NTHREADS + tid, lr_ = idx >> 4, c0 = (idx & 15) * 8; r.v8[rep] = *(const u32x4*)(P + (size_t)(T0 + lr_) * NP + PC_GLA_V + h * 128 + c0); }
}
DI void gla_table(CArgs& a, int l, int h, LAS float* WT) {
    for (int i = ltid(); i < 17 * 64; i += NTHREADS) { const int j = i >> 6, d = i & 63; WT[i] = j < 16 ? a.gla_w2[(size_t)l * 16 * 256 + j * 256 + h * 64 + d] : a.gla_b2[l * 256 + h * 64 + d]; }
}
template <class F> DI void gla_compute(CArgs& a, int u, const GlaRaw& rw, LAS unsigned char* lds, F&& prefetch) {
    const int tid = ltid(), wid = tid >> 6, lane = tid & 63;
    LAS float* G = (LAS float*)lds; LAS bf16_t* QD = (LAS bf16_t*)(lds + 16640); LAS bf16_t* KI = (LAS bf16_t*)(lds + 25856); LAS bf16_t* KT = (LAS bf16_t*)(lds + 35072);
    LAS bf16_t* PB = (LAS bf16_t*)(lds + 44288); LAS bf16_t* V = (LAS bf16_t*)(lds + 53504); LAS float* SEG = (LAS float*)(lds + 70912); const LAS float* WT = (const LAS float*)(lds + 72960);
    char* ub = a.ws + WS_R1 + R1_SGLA + (size_t)u * GLA_UNIT;
    const int l_ = tid >> 3, d0 = (tid & 7) * 8;
    { float s[8];
#pragma unroll
      for (int i = 0; i < 8; ++i) s[i] = WT[16 * 64 + d0 + i];
#pragma unroll
      for (int j = 0; j < 16; ++j) { const float lv = rw.lr[j >> 2][j & 3];
#pragma unroll
          for (int i = 0; i < 8; ++i) s[i] += lv * WT[j * 64 + d0 + i]; }
#pragma unroll
      for (int i = 0; i < 8; ++i) G[l_ * 65 + d0 + i] = -softplus_(-s[i]) * (1.f / 16.f); }
#pragma unroll
    for (int rep = 0; rep < 2; ++rep) { const int idx = rep * NTHREADS + tid, lr_ = idx >> 4, c0 = (idx & 15) * 8; *(LAS u32x4*)(V + lr_ * 136 + c0) = rw.v8[rep]; }
    const u32x4 q8 = rw.q8, k8 = rw.k8;
    prefetch();
    lds_barrier();
    { const int d = tid & 63, sg = tid >> 6; float run = 0.f, vv[8];
#pragma unroll
      for (int i = 0; i < 8; ++i) { run += G[(sg * 8 + i) * 65 + d]; vv[i] = run; }
      SEG[sg * 64 + d] = run;
      lds_barrier();
      float pre = 0.f;
#pragma unroll
      for (int s2 = 0; s2 < 8; ++s2) pre += (s2 < sg) ? SEG[s2 * 64 + d] : 0.f;
#pragma unroll
      for (int i = 0; i < 8; ++i) G[(sg * 8 + i) * 65 + d] = vv[i] + pre; }
    lds_barrier();
    { const float qf[8] = {bflo(q8.x), bfhi(q8.x), bflo(q8.y), bfhi(q8.y), bflo(q8.z), bfhi(q8.z), bflo(q8.w), bfhi(q8.w)};
      const float kf[8] = {bflo(k8.x), bfhi(k8.x), bflo(k8.y), bfhi(k8.y), bflo(k8.z), bfhi(k8.z), bflo(k8.w), bfhi(k8.w)};
      float qd[8], ki[8];
#pragma unroll
      for (int i = 0; i < 8; ++i) { const float bc = G[l_ * 65 + d0 + i], bl = G[63 * 65 + d0 + i]; qd[i] = qf[i] * 0.125f * __expf(bc); ki[i] = kf[i] * __expf(-bc);
          KT[swz64(d0 + i, l_)] = f2bf(kf[i] * __expf(bl - bc)); }
      *(LAS u32x4*)(QD + l_ * 72 + d0) = (u32x4){pk2(qd[0], qd[1]), pk2(qd[2], qd[3]), pk2(qd[4], qd[5]), pk2(qd[6], qd[7])};
      *(LAS u32x4*)(KI + l_ * 72 + d0) = (u32x4){pk2(ki[0], ki[1]), pk2(ki[2], ki[3]), pk2(ki[4], ki[5]), pk2(ki[6], ki[7])};
      frag_store8(ub + GLA_OQ, 4, l_, d0, qd); }
    if (tid < 64) ((float*)(ub + GLA_OD))[tid] = __expf(G[63 * 65 + tid]);
    lds_barrier();
#pragma unroll
    for (int t2 = 0; t2 < 2; ++t2) { const int t = wid * 2 + t2, mt = t >> 2, nt = t & 3; const f32x4 acc = mm16<64>(QD, 72, mt * 16, KI, 72, nt * 16, lane);
        const int r = lane & 15, q = lane >> 4, m = nt * 16 + r;
#pragma unroll
        for (int j = 0; j < 4; ++j) { const int lrow = mt * 16 + 4 * q + j; PB[lrow * 72 + m] = f2bf(m <= lrow ? acc[j] : 0.f); } }
    lds_barrier();
    for (int dup_ = 0; dup_ < PROBE_DUPST; ++dup_) {
    export_frags<false, 64, 64>(ub + GLA_OP, PB, 72, 0);
    export_frags<true, 64, 64>(ub + GLA_OK, KT, 72, 0);
    export_acc(ub + GLA_OU, V, 136, 4); }
    lds_barrier();
}
struct SsdRaw { u32x4 t[3][4]; float dtr, p0, p1, p2; };
DI void ssd_load(CArgs& a, int u, SsdRaw& r) {
    const int tid = ltid(); const int n = u & 63, bh = u >> 6, b = bh >> 3, hh = bh & 7, g = hh >> 2, T0 = b * SEQ + n * 64;
    const bf16_t* P = (const bf16_t*)(a.ws + WS_R1 + R1_PROJ); const float* small = (const float*)(a.ws + WS_SMALL);
    const int l_ = tid >> 3, c8 = (tid & 7) * 8, pos = n * 64 + l_; const bf16_t* pr = P + (size_t)(T0 + l_) * NP + PC_SSD_XBC + c8;
    const int cb[3] = {hh * 64, 512 + g * 64, 640 + g * 64};
#pragma unroll
    for (int p = 0; p < 3; ++p)
#pragma unroll
        for (int j = 0; j < 4; ++j) r.t[p][j] = ldg_or0(pr + cb[p] - (ptrdiff_t)(3 - j) * NP, pos - 3 + j >= 0);
    r.dtr = tid < 64 ? small[(size_t)(T0 + tid) * 32 + 24 + hh] : 0.f; r.p0 = 0.f; r.p1 = 0.f; r.p2 = 0.f;
}
DI void ssd_table(CArgs& a, int l, int hh, LAS float* WT) {
    const int g = hh >> 2;
    for (int i = ltid(); i < 3 * 5 * 64; i += NTHREADS) { const int p = i / 320, j = (i % 320) >> 6, ch = i & 63; const int col = (p == 0 ? hh * 64 : p == 1 ? 512 + g * 64 : 640 + g * 64) + ch;
        WT[i] = j < 4 ? a.ssd_conv_w[(size_t)l * 4 * 768 + j * 768 + col] : a.ssd_conv_b[l * 768 + col]; }
    if (ltid() == 0) { WT[960] = -__expf(a.ssd_a_log[l * 8 + hh]); WT[961] = a.ssd_dt_bias[l * 8 + hh]; }
}
struct SsdV { float vx[8], vb[8], vc[8]; };
DI void touch(const u32x4& v) { asm volatile("" :: "v"(v)); }
DI void touchf(float v) { asm volatile("" :: "v"(v)); }
DI void ssd_pin(SsdV& v) {
#pragma unroll
    for (int i = 0; i < 8; ++i) { asm volatile("" : "+v"(v.vx[i])); asm volatile("" : "+v"(v.vb[i])); asm volatile("" : "+v"(v.vc[i])); }
    __builtin_amdgcn_sched_barrier(0);
}
DI void ssd_touch(const SsdRaw& r) {
#pragma unroll
    for (int p = 0; p < 3; ++p)
#pragma unroll
        for (int j = 0; j < 4; ++j) touch(r.t[p][j]);
    touchf(r.dtr);
}
DI void ssd_front(const SsdRaw& rw, LAS unsigned char* lds, SsdV& v) {
    const int tid = ltid(), lane = tid & 63;
    LAS float* SDT = (LAS float*)(lds + 46080); LAS float* SCUM = (LAS float*)(lds + 46080 + 256); const LAS float* WT = (const LAS float*)(lds + 47104);
    if (tid < 64) { const float dt = softplus_(rw.dtr + WT[961]); const float cum = wave_incl_scan(dt * WT[960], lane); SDT[tid] = dt; SCUM[tid] = cum; }
    const int c8 = (tid & 7) * 8;
    conv8r(rw.t[0], WT + c8, 64, WT + 4 * 64 + c8, v.vx); conv8r(rw.t[1], WT + 320 + c8, 64, WT + 320 + 4 * 64 + c8, v.vb); conv8r(rw.t[2], WT + 640 + c8, 64, WT + 640 + 4 * 64 + c8, v.vc);
}
template <class F> DI void ssd_back(CArgs& a, int u, SsdV& v, LAS unsigned char* lds, F&& mid) {
    const int tid = ltid(), wid = tid >> 6, lane = tid & 63;
    const int bh = u >> 6, hh = bh & 7;
    LAS bf16_t* CC = (LAS bf16_t*)lds; LAS bf16_t* CBm = (LAS bf16_t*)(lds + 9216); LAS bf16_t* KT = (LAS bf16_t*)(lds + 18432); LAS bf16_t* PB = (LAS bf16_t*)(lds + 27648);
    LAS bf16_t* V = (LAS bf16_t*)(lds + 36864); LAS float* SDT = (LAS float*)(lds + 46080); LAS float* SCUM = (LAS float*)(lds + 46080 + 256);
    char* ub = a.ws + WS_R1 + R1_SSSD + (size_t)u * SSD_UNIT;
    { const int l_ = tid >> 3, c8 = (tid & 7) * 8; const float cl = SCUM[l_], c63 = SCUM[63], dtl = SDT[l_];
      const float (&vx)[8] = v.vx; const float (&vb)[8] = v.vb; const float (&vc)[8] = v.vc;
      *(LAS u32x4*)(V + l_ * 72 + c8) = (u32x4){pk2(vx[0] * dtl, vx[1] * dtl), pk2(vx[2] * dtl, vx[3] * dtl), pk2(vx[4] * dtl, vx[5] * dtl), pk2(vx[6] * dtl, vx[7] * dtl)};
      { const int n_ = u & 63, b_ = u >> 9; *(u32x4*)((bf16_t*)(a.ws + WS_R1 + R1_XCONV) + ((size_t)b_ * SEQ + n_ * 64 + l_) * 512 + hh * 64 + c8) = (u32x4){pk2(vx[0], vx[1]), pk2(vx[2], vx[3]), pk2(vx[4], vx[5]), pk2(vx[6], vx[7])}; }
      *(LAS u32x4*)(CBm + l_ * 72 + c8) = (u32x4){pk2(vb[0], vb[1]), pk2(vb[2], vb[3]), pk2(vb[4], vb[5]), pk2(vb[6], vb[7])};
      const float ek = __expf(c63 - cl);
#pragma unroll
      for (int i = 0; i < 8; ++i) KT[swz64(c8 + i, l_)] = f2bf(vb[i] * ek);
      *(LAS u32x4*)(CC + l_ * 72 + c8) = (u32x4){pk2(vc[0], vc[1]), pk2(vc[2], vc[3]), pk2(vc[4], vc[5]), pk2(vc[6], vc[7])};
      const float eq = __expf(cl); float qd[8];
#pragma unroll
      for (int i = 0; i < 8; ++i) qd[i] = vc[i] * eq;
      frag_store8(ub + SSD_OQ, 4, l_, c8, qd); }
    if (tid < 64) ((float*)(ub + SSD_OD))[tid] = __expf(SCUM[63]);
    lds_barrier();
#pragma unroll
    for (int t2 = 0; t2 < 2; ++t2) { const int t = wid * 2 + t2, mt = t >> 2, nt = t & 3; const f32x4 acc = mm16<64>(CC, 72, mt * 16, CBm, 72, nt * 16, lane);
        const int r = lane & 15, q = lane >> 4, m = nt * 16 + r; const float cm = SCUM[m];
#pragma unroll
        for (int j = 0; j < 4; ++j) { const int lrow = mt * 16 + 4 * q + j; PB[lrow * 72 + m] = f2bf(m <= lrow ? acc[j] * __expf(SCUM[lrow] - cm) : 0.f); } }
    lds_barrier();
    mid();
    for (int dup_ = 0; dup_ < PROBE_DUPST; ++dup_) {
    export_frags<false, 64, 64>(ub + SSD_OP, PB, 72, 0);
    export_frags<true, 64, 64>(ub + SSD_OK, KT, 72, 0);
    export_acc(ub + SSD_OU, V, 72, 2); }
    lds_barrier();
}

constexpr int S4_CC = 0, S4_CB = 9216, S4_KT = 18432, S4_PB = 55296, S4_V = 92160, S4_SDT = 129024, S4_SCUM = 130048, S4_WT = 131072;
struct Ssd4Raw { u32x4 tx[4][4], tb[4], tc[4]; float dtr, p0, p1, p2; };
DI void ssd4_load(CArgs& a, int uu, Ssd4Raw& r) {
    const int tid = ltid(), wid = tid >> 6, lane = tid & 63; const int n = uu & 63, bg = uu >> 6, b = bg >> 1, g = bg & 1, T0 = b * SEQ + n * 64;
    const bf16_t* P = (const bf16_t*)(a.ws + WS_R1 + R1_PROJ); const float* small = (const float*)(a.ws + WS_SMALL);
    const int l_ = tid >> 3, c8 = (tid & 7) * 8, pos = n * 64 + l_; const bf16_t* pr = P + (size_t)(T0 + l_) * NP + PC_SSD_XBC + c8;
#pragma unroll
    for (int j = 0; j < 4; ++j) { const bool ok = pos - 3 + j >= 0; const ptrdiff_t ro = -(ptrdiff_t)(3 - j) * NP;
#pragma unroll
        for (int h4 = 0; h4 < 4; ++h4) r.tx[h4][j] = ldg_or0(pr + (g * 4 + h4) * 64 + ro, ok);
        r.tb[j] = ldg_or0(pr + 512 + g * 64 + ro, ok); r.tc[j] = ldg_or0(pr + 640 + g * 64 + ro, ok); }
    r.dtr = wid < 4 ? small[(size_t)(T0 + lane) * 32 + 24 + g * 4 + wid] : 0.f; r.p0 = 0.f; r.p1 = 0.f; r.p2 = 0.f;
}
DI void ssd4_table(CArgs& a, int l, int g, LAS float* WT) {
    for (int i = ltid(); i < 6 * 320; i += NTHREADS) { const int p = i / 320, j = (i % 320) >> 6, ch = i & 63; const int col = (p < 4 ? (g * 4 + p) * 64 : p == 4 ? 512 + g * 64 : 640 + g * 64) + ch;
        WT[i] = j < 4 ? a.ssd_conv_w[(size_t)l * 4 * 768 + j * 768 + col] : a.ssd_conv_b[l * 768 + col]; }
    if (ltid() < 4) { const int hh = g * 4 + ltid(); WT[1920 + 2 * ltid()] = -__expf(a.ssd_a_log[l * 8 + hh]); WT[1921 + 2 * ltid()] = a.ssd_dt_bias[l * 8 + hh]; }
}
struct Ssd4V { float vx[4][8], vb[8], vc[8]; };
DI void ssd4_pin(Ssd4V& v) {
#pragma unroll
    for (int i = 0; i < 8; ++i) { asm volatile("" : "+v"(v.vb[i])); asm volatile("" : "+v"(v.vc[i]));
#pragma unroll
        for (int h4 = 0; h4 < 4; ++h4) asm volatile("" : "+v"(v.vx[h4][i])); }
    __builtin_amdgcn_sched_barrier(0);
}
DI void ssd4_touch(const Ssd4Raw& r) {
#pragma unroll
    for (int j = 0; j < 4; ++j) { touch(r.tb[j]); touch(r.tc[j]);
#pragma unroll
        for (int h4 = 0; h4 < 4; ++h4) touch(r.tx[h4][j]); }
    touchf(r.dtr);
}
DI void ssd4_front(const Ssd4Raw& rw, LAS unsigned char* lds, Ssd4V& v) {
    const int tid = ltid(), wid = tid >> 6, lane = tid & 63;
    LAS float* SDT = (LAS float*)(lds + S4_SDT); LAS float* SCUM = (LAS float*)(lds + S4_SCUM); const LAS float* WT = (const LAS float*)(lds + S4_WT);
    if (wid < 4) { const float dt = softplus_(rw.dtr + WT[1921 + 2 * wid]); const float cum = wave_incl_scan(dt * WT[1920 + 2 * wid], lane); SDT[wid * 64 + lane] = dt; SCUM[wid * 64 + lane] = cum; }
    const int c8 = (tid & 7) * 8;
#pragma unroll
    for (int h4 = 0; h4 < 4; ++h4) conv8r(rw.tx[h4], WT + h4 * 320 + c8, 64, WT + h4 * 320 + 256 + c8, v.vx[h4]);
    conv8r(rw.tb, WT + 4 * 320 + c8, 64, WT + 4 * 320 + 256 + c8, v.vb); conv8r(rw.tc, WT + 5 * 320 + c8, 64, WT + 5 * 320 + 256 + c8, v.vc);
}
template <class F> DI void ssd4_back(CArgs& a, int uu, Ssd4V& v, LAS unsigned char* lds, F&& mid) {
    const int tid = ltid(), wid = tid >> 6, lane = tid & 63;
    const int n = uu & 63, bg = uu >> 6, b = bg >> 1, g = bg & 1;
    LAS bf16_t* CC = (LAS bf16_t*)(lds + S4_CC); LAS bf16_t* CBm = (LAS bf16_t*)(lds + S4_CB);
    const LAS float* SDT = (const LAS float*)(lds + S4_SDT); const LAS float* SCUM = (const LAS float*)(lds + S4_SCUM);
    char* ub0 = a.ws + WS_R1 + R1_SSSD + ((size_t)((b * 8 + g * 4) * 64 + n)) * SSD_UNIT;
    { const int l_ = tid >> 3, c8 = (tid & 7) * 8;
      const float (&vb)[8] = v.vb; const float (&vc)[8] = v.vc;
      *(LAS u32x4*)(CBm + l_ * 72 + c8) = (u32x4){pk2(vb[0], vb[1]), pk2(vb[2], vb[3]), pk2(vb[4], vb[5]), pk2(vb[6], vb[7])};
      *(LAS u32x4*)(CC + l_ * 72 + c8) = (u32x4){pk2(vc[0], vc[1]), pk2(vc[2], vc[3]), pk2(vc[4], vc[5]), pk2(vc[6], vc[7])};
#pragma unroll
      for (int h4 = 0; h4 < 4; ++h4) { const float (&vx)[8] = v.vx[h4]; char* ub = ub0 + (size_t)h4 * 64 * SSD_UNIT;
          LAS bf16_t* KT = (LAS bf16_t*)(lds + S4_KT + h4 * 9216); LAS bf16_t* V = (LAS bf16_t*)(lds + S4_V + h4 * 9216);
          const float cl = SCUM[h4 * 64 + l_], c63 = SCUM[h4 * 64 + 63], dtl = SDT[h4 * 64 + l_];
          *(LAS u32x4*)(V + l_ * 72 + c8) = (u32x4){pk2(vx[0] * dtl, vx[1] * dtl), pk2(vx[2] * dtl, vx[3] * dtl), pk2(vx[4] * dtl, vx[5] * dtl), pk2(vx[6] * dtl, vx[7] * dtl)};
          *(u32x4*)((bf16_t*)(a.ws + WS_R1 + R1_XCONV) + ((size_t)b * SEQ + n * 64 + l_) * 512 + (g * 4 + h4) * 64 + c8) = (u32x4){pk2(vx[0], vx[1]), pk2(vx[2], vx[3]), pk2(vx[4], vx[5]), pk2(vx[6], vx[7])};
          const float ek = __expf(c63 - cl);
#pragma unroll
          for (int i = 0; i < 8; ++i) KT[swz64(c8 + i, l_)] = f2bf(vb[i] * ek);
          const float eq = __expf(cl); float qd[8];
#pragma unroll
          for (int i = 0; i < 8; ++i) qd[i] = vc[i] * eq;
          frag_store8(ub + SSD_OQ, 4, l_, c8, qd); } }
    if (wid < 4) ((float*)(ub0 + (size_t)wid * 64 * SSD_UNIT + SSD_OD))[lane] = __expf(SCUM[wid * 64 + 63]);
    lds_barrier();
#pragma unroll
    for (int t2 = 0; t2 < 2; ++t2) { const int t = wid * 2 + t2, mt = t >> 2, nt = t & 3; const f32x4 acc = mm16<64>(CC, 72, mt * 16, CBm, 72, nt * 16, lane);
        const int r = lane & 15, q = lane >> 4, m = nt * 16 + r;
#pragma unroll
        for (int h4 = 0; h4 < 4; ++h4) { LAS bf16_t* PB = (LAS bf16_t*)(lds + S4_PB + h4 * 9216); const float cm = SCUM[h4 * 64 + m]; const f32x4 scl = *(const LAS f32x4*)(SCUM + h4 * 64 + mt * 16 + 4 * q);
#pragma unroll
            for (int j = 0; j < 4; ++j) { const int lrow = mt * 16 + 4 * q + j; const float e = acc[j] * __expf(scl[j] - cm); PB[lrow * 72 + m] = f2bf(m <= lrow ? e : 0.f); } } }
    lds_barrier();
    mid();
#pragma unroll 1
    for (int h4 = 0; h4 < 4; ++h4) { char* ub = ub0 + (size_t)h4 * 64 * SSD_UNIT;
        export_frags<false, 64, 64>(ub + SSD_OP, (const LAS bf16_t*)(lds + S4_PB + h4 * 9216), 72, 0);
        export_frags<true, 64, 64>(ub + SSD_OK, (const LAS bf16_t*)(lds + S4_KT + h4 * 9216), 72, 0);
        export_acc(ub + SSD_OU, (const LAS bf16_t*)(lds + S4_V + h4 * 9216), 72, 2); }
    lds_barrier();
}
template <int NP_> struct GdnRaw { u32x4 t[NP_][2][4]; u32x4 tb; float ar, br, p0, p1; };
template <int NP_> DI void gdn_load(CArgs& a, int u, GdnRaw<NP_>& r, bool with_t) {
    const int tid = ltid(); const int n = u & 63, bh = u >> 6, b = bh >> 2, h = bh & 3, T0 = b * SEQ + n * 64;
    const bf16_t* P = (const bf16_t*)(a.ws + WS_R1 + R1_PROJ); const float* small = (const float*)(a.ws + WS_SMALL);
#pragma unroll
    for (int rep = 0; rep < 2; ++rep) { const int idx = rep * NTHREADS + tid, l_ = idx >> 4, grp = idx & 15, pos = n * 64 + l_; const bf16_t* pr = P + (size_t)(T0 + l_) * NP + PC_GDN_QKV + h * 128 + grp * 8;
#pragma unroll
        for (int p = 0; p < NP_; ++p) { const int part = NP_ == 1 ? 1 : p;
#pragma unroll
            for (int j = 0; j < 4; ++j) r.t[p][rep][j] = ldg_or0(pr + part * 512 - (ptrdiff_t)(3 - j) * NP, pos - 3 + j >= 0); } }
    r.ar = tid < 64 ? small[(size_t)(T0 + tid) * 32 + 16 + h] : 0.f; r.br = tid < 64 ? small[(size_t)(T0 + tid) * 32 + 20 + h] : 0.f; r.p0 = 0.f; r.p1 = 0.f;
    if (with_t) { const bf16_t* tsrc = (const bf16_t*)(a.ws + WS_TSCR) + (size_t)u * 4096; r.tb = *(const u32x4*)(tsrc + (tid >> 3) * 64 + (tid & 7) * 8); } else r.tb = (u32x4){0u, 0u, 0u, 0u};
}
DI void gdn_table(CArgs& a, int l, int h, LAS float* WT) {
    for (int i = ltid(); i < 3 * 4 * 128; i += NTHREADS) { const int p = i >> 9, j = (i >> 7) & 3, d = i & 127; WT[i] = a.gdn_conv_w[(size_t)l * 4 * 1536 + j * 1536 + p * 512 + h * 128 + d]; }
    if (ltid() == 0) { WT[1536] = -__expf(a.gdn_a_log[l * 4 + h]); WT[1537] = a.gdn_dt_bias[l * 4 + h]; }
}
DI void gdn_scalars_r(const LAS float* hc, float ar, float br, LAS float* SB, LAS float* SC) {
    const int tid = ltid();
    if (tid < 64) { const float beta = sigmoid_(br); const float gg = hc[0] * softplus_(ar + hc[1]);
        const float cum = wave_incl_scan(gg, tid); SB[tid] = beta; SC[tid] = cum; }
}
DI void gdn_norm8(float (&v)[8], float post) {
    float ss = 0.f;
#pragma unroll
    for (int i = 0; i < 8; ++i) ss += v[i] * v[i];
    ss += __shfl_xor(ss, 1); ss += __shfl_xor(ss, 2); ss += __shfl_xor(ss, 4); ss += __shfl_xor(ss, 8);
    const float rn = rsqrtf(ss + 1e-6f) * post;
#pragma unroll
    for (int i = 0; i < 8; ++i) v[i] *= rn;
}
template <class F> DI void gdn_compute1(CArgs& a, int l, int u, const GdnRaw<1>& rw, LAS unsigned char* lds, LAS float* slot, F&& prefetch) {
    const int tid = ltid(), wid = tid >> 6, lane = tid & 63; const int h = (u >> 6) & 3;
    LAS bf16_t* Kb = (LAS bf16_t*)lds; LAS float* SB = (LAS float*)(lds + 17408); LAS float* SC = (LAS float*)(lds + 17408 + 256); const LAS float* WT = (const LAS float*)(lds + 17920);
    gdn_scalars_r(WT + 512, rw.ar, rw.br, SB, SC);
#pragma unroll
    for (int rep = 0; rep < 2; ++rep) { const int idx = rep * NTHREADS + tid, l_ = idx >> 4, grp = idx & 15; float v[8]; conv8r(rw.t[0][rep], WT + grp * 8, 128, nullptr, v); gdn_norm8(v, 1.f);
        *(LAS u32x4*)(Kb + l_ * 136 + grp * 8) = (u32x4){pk2(v[0], v[1]), pk2(v[2], v[3]), pk2(v[4], v[5]), pk2(v[6], v[7])}; }
    prefetch();
    lds_barrier();
#pragma unroll
    for (int t2 = 0; t2 < 2; ++t2) { const int t = wid * 2 + t2, mt = t >> 2, nt = t & 3; const f32x4 acc = mm16<128>(Kb, 136, mt * 16, Kb, 136, nt * 16, lane);
        const int r = lane & 15, q = lane >> 4, m = nt * 16 + r; const float cm = SC[m];
#pragma unroll
        for (int j = 0; j < 4; ++j) { const int lrow = mt * 16 + 4 * q + j; slot[lrow * 65 + m] = (m < lrow) ? SB[lrow] * acc[j] * __expf(SC[lrow] - cm) : 0.f; } }
    lds_barrier();
}
DI float rdl(float v, int l) { return __uint_as_float((unsigned)__builtin_amdgcn_readlane((int)__float_as_uint(v), l)); }
DI void gdn_invert(LAS float* sl, bf16_t* tout, int lane) {
#pragma unroll 1
    for (int I = 0; I < 4; ++I) {
        float ar[16], x[16], tn[16];
#pragma unroll
        for (int r = 0; r < 16; ++r) { ar[r] = sl[(16 * I + r) * 65 + lane]; x[r] = 0.f; }
#pragma unroll 2
        for (int m = 0; m < 16 * I; ++m) { const float t = sl[m * 65 + lane];
#pragma unroll
            for (int r = 0; r < 16; ++r) x[r] += rdl(ar[r], m) * t; }
#pragma unroll
        for (int r = 0; r < 16; ++r) { float acc = ((lane == 16 * I + r) ? 1.f : 0.f) - x[r];
#pragma unroll
            for (int m2 = 0; m2 < r; ++m2) acc -= rdl(ar[r], 16 * I + m2) * tn[m2];
            tn[r] = acc; }
#pragma unroll
        for (int r = 0; r < 16; ++r) sl[(16 * I + r) * 65 + lane] = tn[r];
    }
#pragma unroll 4
    for (int it = 0; it < 32; ++it) { const int rowi = it * 2 + (lane >> 5), cj = (lane & 31) * 2; ((unsigned*)tout)[rowi * 32 + (lane & 31)] = pk2(sl[rowi * 65 + cj], sl[rowi * 65 + cj + 1]); }
}
template <class F> DI void gdn_compute2(CArgs& a, int l, int u, const GdnRaw<3>& rw, LAS unsigned char* lds, F&& prefetch) {
    const int tid = ltid(), wid = tid >> 6, lane = tid & 63; const int h = (u >> 6) & 3;
    LAS bf16_t* Kb = (LAS bf16_t*)lds; LAS bf16_t* Qb = (LAS bf16_t*)(lds + 17408); LAS bf16_t* SOL = (LAS bf16_t*)(lds + 116736);
    LAS bf16_t* RT = (LAS bf16_t*)(lds + 34816); LAS bf16_t* KT = (LAS bf16_t*)(lds + 71680); LAS bf16_t* Tb = (LAS bf16_t*)(lds + 90112); LAS bf16_t* PB = (LAS bf16_t*)(lds + 99328);
    LAS float* SB = (LAS float*)(lds + 108544); LAS float* SC = (LAS float*)(lds + 108544 + 256); const LAS float* WT = (const LAS float*)(lds + 109056);
    char* ub = a.ws + WS_R1 + R1_SGDN + (size_t)u * GDN_UNIT;
    gdn_scalars_r(WT + 1536, rw.ar, rw.br, SB, SC);
    float vq[2][8], vk[2][8], vv[2][8];
#pragma unroll
    for (int rep = 0; rep < 2; ++rep) { const int grp = (rep * NTHREADS + tid) & 15;
        conv8r(rw.t[0][rep], WT + grp * 8, 128, nullptr, vq[rep]); gdn_norm8(vq[rep], 0.08838834764831845f);
        conv8r(rw.t[1][rep], WT + 512 + grp * 8, 128, nullptr, vk[rep]); gdn_norm8(vk[rep], 1.f);
        conv8r(rw.t[2][rep], WT + 1024 + grp * 8, 128, nullptr, vv[rep]); }
    *(LAS u32x4*)(Tb + (tid >> 3) * 72 + (tid & 7) * 8) = rw.tb;
    prefetch();
    lds_barrier();
#pragma unroll
    for (int rep = 0; rep < 2; ++rep) { const int idx = rep * NTHREADS + tid, l_ = idx >> 4, grp = idx & 15; const float cl = SC[l_], c63 = SC[63], be = SB[l_];
        *(LAS u32x4*)(Qb + l_ * 136 + grp * 8) = (u32x4){pk2(vq[rep][0], vq[rep][1]), pk2(vq[rep][2], vq[rep][3]), pk2(vq[rep][4], vq[rep][5]), pk2(vq[rep][6], vq[rep][7])};
        { const float eq = __expf(cl); float qd[8];
#pragma unroll
          for (int i = 0; i < 8; ++i) qd[i] = vq[rep][i] * eq;
          frag_store8(ub + GDN_OQ, 8, l_, grp * 8, qd); }
        *(LAS u32x4*)(Kb + l_ * 136 + grp * 8) = (u32x4){pk2(vk[rep][0], vk[rep][1]), pk2(vk[rep][2], vk[rep][3]), pk2(vk[rep][4], vk[rep][5]), pk2(vk[rep][6], vk[rep][7])};
        { const float e1 = be * __expf(cl), e2 = __expf(c63 - cl);
#pragma unroll
          for (int i = 0; i < 8; ++i) { RT[swz64(128 + grp * 8 + i, l_)] = f2bf(vk[rep][i] * e1); KT[swz64(grp * 8 + i, l_)] = f2bf(vk[rep][i] * e2); RT[swz64(grp * 8 + i, l_)] = f2bf(vv[rep][i] * be); } } }
    if (tid < 128) ((float*)(ub + GDN_OD))[tid] = __expf(SC[63]);
    lds_barrier();
#pragma unroll
    for (int t2 = 0; t2 < 2; ++t2) { const int t = wid * 2 + t2, mt = t >> 2, nt = t & 3; const f32x4 acc = mm16<128>(Qb, 136, mt * 16, Kb, 136, nt * 16, lane);
        const int r = lane & 15, q = lane >> 4, m = nt * 16 + r; const float cm = SC[m];
#pragma unroll
        for (int j = 0; j < 4; ++j) { const int lrow = mt * 16 + 4 * q + j; PB[lrow * 72 + m] = f2bf(m <= lrow ? acc[j] * __expf(SC[lrow] - cm) : 0.f); } }
    f32x4 sacc[8];
#pragma unroll
    for (int t2 = 0; t2 < 8; ++t2) { const int t = wid * 8 + t2, mt = t & 3, ntile = t >> 2; sacc[t2] = mm16<64, true>(Tb, 72, mt * 16, RT, 72, ntile * 16, lane); }
#pragma unroll
    for (int t2 = 0; t2 < 8; ++t2) { const int t = wid * 8 + t2, mt = t & 3, ntile = t >> 2; const int r = lane & 15, q = lane >> 4, cc = ntile * 16 + r; const float sg = cc < 128 ? 1.f : -1.f;
#pragma unroll
        for (int j = 0; j < 4; ++j) SOL[(mt * 16 + 4 * q + j) * 264 + cc] = f2bf(sacc[t2][j] * sg); }
    lds_barrier();
    for (int dup_ = 0; dup_ < PROBE_DUPST; ++dup_) {
    export_frags<false, 64, 64>(ub + GDN_OP, PB, 72, 0);
    export_frags<true, 128, 64>(ub + GDN_OK, KT, 72, 0);
    export_frags<false, 64, 128>(ub + GDN_OW, SOL, 264, 128);
    export_acc(ub + GDN_OU, SOL, 264, 4); }
}
DI void phase_prep(CArgs& a, int l, LAS unsigned char* lds) {
    const int wid = ltid() >> 6, lane = ltid() & 63; const int w = lbid(), Gd = lgrid();
#ifndef REP_PGDN
#define REP_PGDN 1
#endif
#ifndef REP_PGLA
#define REP_PGLA 1
#endif
#ifndef REP_PSSD
#define REP_PSSD 1
#endif
    for (int rp_ = 0; rp_ < REP_PGDN; ++rp_)
    { const int upw = (2048 + Gd - 1) / Gd, u0 = w * upw, u1 = (u0 + upw < 2048) ? u0 + upw : 2048;
      LAS float* slots = (LAS float*)(lds + 20480);
      for (int ub = u0; ub < u1; ub += 8) { const int nb = (u1 - ub) < 8 ? (u1 - ub) : 8; int curh = -1;
#ifndef REP_G1
#define REP_G1 1
#endif
#ifndef REP_G2
#define REP_G2 1
#endif
          for (int rg1 = 0; rg1 < REP_G1; ++rg1) { curh = -1;
          GdnRaw<1> r1; gdn_load<1>(a, ub, r1, false);
          for (int j = 0; j < nb; ++j) { const int u = ub + j;
              if ((u >> 6) != curh) { curh = u >> 6; lds_barrier(); LAS float* WT = (LAS float*)(lds + 17920); for (int i = ltid(); i < 512; i += NTHREADS) WT[i] = a.gdn_conv_w[(size_t)l * 4 * 1536 + (i >> 7) * 1536 + 512 + (curh & 3) * 128 + (i & 127)];
                  if (ltid() == 0) { WT[512] = -__expf(a.gdn_a_log[l * 4 + (curh & 3)]); WT[513] = a.gdn_dt_bias[l * 4 + (curh & 3)]; } lds_barrier(); }
              GdnRaw<1> rn = r1;
              gdn_compute1(a, l, u, r1, lds, slots + j * 4160, [&]() { if (j + 1 < nb) gdn_load<1>(a, u + 1, rn, false); }); r1 = rn; }
          if (wid < nb) gdn_invert(slots + wid * 4160, (bf16_t*)(a.ws + WS_TSCR) + (size_t)(ub + wid) * 4096, lane);
          asm volatile("s_waitcnt vmcnt(0)" ::: "memory");
          __syncthreads(); }
          for (int rg2 = 0; rg2 < REP_G2; ++rg2) {
          curh = -1;
          GdnRaw<3> r3; gdn_load<3>(a, ub, r3, true);
          for (int j = 0; j < nb; ++j) { const int u = ub + j;
              if ((u >> 6) != curh) { curh = u >> 6; lds_barrier(); gdn_table(a, l, curh & 3, (LAS float*)(lds + 109056)); lds_barrier(); }
              GdnRaw<3> rn = r3;
              gdn_compute2(a, l, u, r3, lds, [&]() { if (j + 1 < nb) gdn_load<3>(a, u + 1, rn, true); }); r3 = rn; } } } }
    for (int rp_ = 0; rp_ < REP_PGLA; ++rp_)
    { const int upw = (2048 + Gd - 1) / Gd, u0 = w * upw, u1 = (u0 + upw < 2048) ? u0 + upw : 2048; int curh = -1;
      if (u0 < u1) { GlaRaw r; gla_load(a, u0, r);
          for (int u = u0; u < u1; ++u) {
              if ((u >> 6) != curh) { curh = u >> 6; lds_barrier(); gla_table(a, l, curh & 3, (LAS float*)(lds + 72960)); lds_barrier(); }
              GlaRaw rn = r;
              gla_compute(a, u, r, lds, [&]() { if (u + 1 < u1) gla_load(a, u + 1, rn); }); r = rn; } } }
    for (int rp_ = 0; rp_ < REP_PSSD; ++rp_)
    { const int upw = (1024 + Gd - 1) / Gd, u0 = w * upw, u1 = (u0 + upw < 1024) ? u0 + upw : 1024; int curg = -1;
      if (u0 < u1) { Ssd4Raw r; ssd4_load(a, u0, r); Ssd4V v;
          curg = u0 >> 6; lds_barrier(); ssd4_table(a, l, curg & 1, (LAS float*)(lds + S4_WT)); lds_barrier();
          ssd4_front(r, lds, v); ssd4_pin(v); ssd4_load(a, u0 + 1 < u1 ? u0 + 1 : u0, r); lds_barrier();
          for (int u = u0; u < u1; ++u) {
              ssd4_back(a, u, v, lds, [&]() {
                  const int un = u + 1 < u1 ? u + 1 : u;
                  if ((un >> 6) != curg) { curg = un >> 6; lds_barrier(); ssd4_table(a, l, curg & 1, (LAS float*)(lds + S4_WT)); lds_barrier(); }
                  ssd4_front(r, lds, v); ssd4_pin(v);
                  ssd4_load(a, u + 2 < u1 ? u + 2 : u1 - 1, r); }); } } }
}
DI bf16x8 pack16(const f32x16& x, int s) {
    u32x4 p; p.x = pk2(x[8 * s], x[8 * s + 1]); p.y = pk2(x[8 * s + 2], x[8 * s + 3]); p.z = pk2(x[8 * s + 4], x[8 * s + 5]); p.w = pk2(x[8 * s + 6], x[8 * s + 7]);
    return __builtin_bit_cast(bf16x8, p);
}
#define MFMA32(a, b, c) __builtin_amdgcn_mfma_f32_32x32x16_bf16((a), (b), (c), 0, 0, 0)
template <int DK, bool HAS_W, int NH, int NCT, int UNIT, int OQ, int OW, int OP, int OK, int OU, int OD, int NCTT = NCT  , bool SDEC = false  >
DI void scan_wg(const char* ops0, const char* ops1, char* ob0, char* ob1, LAS unsigned char* lds, unsigned* prog = nullptr, const int ct0 = 0) {
    constexpr int NKB = DK / 16, NDT = DK / 32, BUF = NH * UNIT, OUNIT = NCTT * 2 * 2048;
    static_assert(2 * BUF <= LDS_CTRL, "scan LDS");
    const int tid = ltid(), wid = __builtin_amdgcn_readfirstlane(tid >> 6), lane = tid & 63, h = lane >> 5;
    const int hd = (NH == 2) ? (wid >> 1) & 1 : 0, ct = ct0 + ((NH == 2) ? (wid & 1) : (wid & 3)); const bool computes = (NH == 2) || wid < NCT;
    static_assert(UNIT % 1024 == 0, "unit = whole 1 KiB chunks");
    if (wid >= 4) {
        constexpr int NCH = UNIT / 1024, NL = (NCH + 3) / 4;
        const int lw = wid - 4;
        u32x4 R0[NH][NL], R1[NH][NL];
        auto issue = [&](int n, u32x4 (&R)[NH][NL]) {
#pragma unroll
            for (int k = 0; k < NH; ++k) { const char* src = (k == 0 ? ops0 : ops1) + (size_t)n * UNIT + lane * 16;
#pragma unroll
                for (int j = 0; j < NL; ++j) { const int ch = j * 4 + lw; const char* pp = src + (size_t)(ch < NCH ? ch : 0) * 1024;
                    asm volatile("global_load_dwordx4 %0, %1, off" : "=&v"(R[k][j]) : "v"(pp) : "memory"); } } };
        auto put = [&](int buf, u32x4 (&R)[NH][NL], bool newer_in_flight) {
            if (newer_in_flight) asm volatile("s_waitcnt vmcnt(%0)" :: "n"(NH * NL) : "memory"); else asm volatile("s_waitcnt vmcnt(0)" ::: "memory");
#pragma unroll
            for (int k = 0; k < NH; ++k) { LAS unsigned char* dst = lds + buf * BUF + k * UNIT + lane * 16;
#pragma unroll
                for (int j = 0; j < NL; ++j) { const int ch = j * 4 + lw; asm volatile("" : "+v"(R[k][j])); if (ch < NCH) *(LAS u32x4*)(dst + ch * 1024) = R[k][j]; } } };
        issue(0, R0); issue(1, R1);
        put(0, R0, true); issue(2, R0);
        lds_barrier();
#pragma unroll
        for (int n = 0; n < 64; n += 2) {
            put(1, R1, n + 2 < 64); if (n + 3 < 64) issue(n + 3, R1);
            if (prog && tid == 256) __hip_atomic_store(prog, (unsigned)(n + 1), __ATOMIC_RELAXED, __HIP_MEMORY_SCOPE_AGENT);
            lds_barrier();
            if (n + 2 < 64) put(0, R0, n + 3 < 64); if (n + 4 < 64) issue(n + 4, R0);
            if (prog && tid == 256) __hip_atomic_store(prog, (unsigned)(n + 2), __ATOMIC_RELAXED, __HIP_MEMORY_SCOPE_AGENT);
            lds_barrier();
        }
        return;
    }
    f32x16 S[NDT]; bf16x8 Sb[NKB];
#pragma unroll
    for (int d = 0; d < NDT; ++d)
#pragma unroll
        for (int i = 0; i < 16; ++i) S[d][i] = 0.f;
#pragma unroll
    for (int k = 0; k < NKB; ++k) Sb[k] = (bf16x8){0, 0, 0, 0, 0, 0, 0, 0};
    lds_barrier();
    char* ob = (hd == 0 ? ob0 : ob1);
#pragma unroll 1
    for (int n = 0; n < 64; ++n) {
        if (computes) {
            const LAS unsigned char* lb = lds + (n & 1) * BUF + hd * UNIT;
            const unsigned fbase = (unsigned)(size_t)(lb) + (unsigned)lane * 16u;
#ifdef PROBE_LDS2
#define SC_LDG(f, OFF) do { _Pragma("unroll") for (int kb_ = 0; kb_ < 4; ++kb_) { asm volatile("ds_read_b128 %0, %1 offset:%2" : "=&v"(f[kb_]) : "v"(fbase), "n"((OFF) + kb_ * 1024) : "memory"); asm volatile("ds_read_b128 %0, %1 offset:%2" : "+v"(f[kb_]) : "v"(fbase), "n"((OFF) + kb_ * 1024) : "memory"); } } while (0)
#define SC_WAIT(f, N) asm volatile("s_waitcnt lgkmcnt(%4)" : "+v"(f[0]), "+v"(f[1]), "+v"(f[2]), "+v"(f[3]) : "n"(2 * (N)) : "memory")
#else
#define SC_LDG(f, OFF) do { _Pragma("unroll") for (int kb_ = 0; kb_ < 4; ++kb_) asm volatile("ds_read_b128 %0, %1 offset:%2" : "=&v"(f[kb_]) : "v"(fbase), "n"((OFF) + kb_ * 1024) : "memory"); } while (0)
#define SC_WAIT(f, N) asm volatile("s_waitcnt lgkmcnt(" #N ")" : "+v"(f[0]), "+v"(f[1]), "+v"(f[2]), "+v"(f[3]) :: "memory")
#endif
            f32x16 U[2], O[2]; float sdec = 1.f; if constexpr (SDEC) sdec = *(const LAS float*)(lb + OD);
#pragma unroll
            for (int rt = 0; rt < 2; ++rt) { const LAS unsigned char* up = lb + OU + ((ct * 2 + rt) * 64 + lane) * 32; const u32x4 w0 = *(const LAS u32x4*)up, w1 = *(const LAS u32x4*)(up + 16);
                U[rt][0] = bflo(w0.x); U[rt][1] = bfhi(w0.x); U[rt][2] = bflo(w0.y); U[rt][3] = bfhi(w0.y); U[rt][4] = bflo(w0.z); U[rt][5] = bfhi(w0.z); U[rt][6] = bflo(w0.w); U[rt][7] = bfhi(w0.w);
                U[rt][8] = bflo(w1.x); U[rt][9] = bfhi(w1.x); U[rt][10] = bflo(w1.y); U[rt][11] = bfhi(w1.y); U[rt][12] = bflo(w1.z); U[rt][13] = bfhi(w1.z); U[rt][14] = bflo(w1.w); U[rt][15] = bfhi(w1.w);
#pragma unroll
                for (int i = 0; i < 16; ++i) O[rt][i] = 0.f; }
            asm volatile("s_waitcnt lgkmcnt(0)" ::: "memory");
            constexpr int GW = HAS_W ? 2 * (NKB / 4) : 0, GQ = 2 * (NKB / 4), GP = 2, GK = NDT, GT = GW + GQ + GP + GK;
            bf16x8 fa[4], fb[4], Ub[4];
            if constexpr (HAS_W) SC_LDG(fa, OW); else SC_LDG(fa, OQ);
#pragma unroll
            for (int g = 0; g < GT; ++g) {
                bf16x8 (&fc)[4] = (g & 1) ? fb : fa; bf16x8 (&fn)[4] = (g & 1) ? fa : fb;
                { constexpr int dummy = 0; (void)dummy; const int g1 = g + 1;
                  if (g1 < GW) SC_LDG(fn, OW + g1 * 4096);
                  else if (g1 < GW + GQ) SC_LDG(fn, OQ + (g1 - GW) * 4096);
                  else if (g1 < GW + GQ + GP) SC_LDG(fn, OP + (g1 - GW - GQ) * 4096);
                  else if (g1 < GT) SC_LDG(fn, OK + (g1 - GW - GQ - GP) * 4096);
                  if (g1 < GT) SC_WAIT(fc, 4); else SC_WAIT(fc, 0); }
                if (g < GW) { const int rt = g / (NKB / 4), k4 = (g % (NKB / 4)) * 4;
#pragma unroll
                    for (int kb = 0; kb < 4; ++kb) U[rt] = MFMA32(fc[kb], Sb[k4 + kb], U[rt]); }
                else if (g < GW + GQ) { const int gg = g - GW, rt = gg / (NKB / 4), k4 = (gg % (NKB / 4)) * 4;
#pragma unroll
                    for (int kb = 0; kb < 4; ++kb) O[rt] = MFMA32(fc[kb], Sb[k4 + kb], O[rt]);
                    if (gg == GQ - 1) { Ub[0] = pack16(U[0], 0); Ub[1] = pack16(U[0], 1); Ub[2] = pack16(U[1], 0); Ub[3] = pack16(U[1], 1); } }
                else if (g < GW + GQ + GP) { const int rt = g - GW - GQ;
#pragma unroll
                    for (int kb = 0; kb < 4; ++kb) O[rt] = MFMA32(fc[kb], Ub[kb], O[rt]);
                    char* op = ob + (size_t)n * OUNIT + ((ct * 2 + rt) * 64 + lane) * 32;
                    *(u32x4*)op = (u32x4){pk2(O[rt][0], O[rt][1]), pk2(O[rt][2], O[rt][3]), pk2(O[rt][4], O[rt][5]), pk2(O[rt][6], O[rt][7])};
                    *(u32x4*)(op + 16) = (u32x4){pk2(O[rt][8], O[rt][9]), pk2(O[rt][10], O[rt][11]), pk2(O[rt][12], O[rt][13]), pk2(O[rt][14], O[rt][15])}; }
                else { const int d = g - GW - GQ - GP;
                    if constexpr (SDEC) {
#pragma unroll
                        for (int i = 0; i < 16; ++i) S[d][i] *= sdec; }
                    else
#pragma unroll
                    for (int gq = 0; gq < 4; ++gq) { const f32x4 dv = *(const LAS f32x4*)(lb + OD + (d * 32 + 8 * gq + 4 * h) * 4);
                        S[d][4 * gq] *= dv[0]; S[d][4 * gq + 1] *= dv[1]; S[d][4 * gq + 2] *= dv[2]; S[d][4 * gq + 3] *= dv[3]; }
#pragma unroll
                    for (int kb = 0; kb < 4; ++kb) S[d] = MFMA32(fc[kb], Ub[kb], S[d]);
                    Sb[2 * d] = pack16(S[d], 0); Sb[2 * d + 1] = pack16(S[d], 1); }
            }
#undef SC_LDG
#undef SC_WAIT
        }
        lds_barrier();
    }
}
#ifndef WARM_LEAD
#define WARM_LEAD 5
#endif
DI void scan_warm(const char* ops, int k, int kstride, int unit, const unsigned* prog) {
    const int tid = ltid();
    for (int n = k; n < 64; n += kstride) {
        for (int sp = 0; sp < 4000; ++sp) { const unsigned pv = __hip_atomic_load(prog, __ATOMIC_RELAXED, __HIP_MEMORY_SCOPE_AGENT); if ((int)pv + WARM_LEAD >= n) break; __builtin_amdgcn_s_sleep(8); }
        const char* src = ops + (size_t)n * unit; const int np = unit / 16;
#pragma unroll 1
        for (int i = tid; i < np; i += NTHREADS * 4) { u32x4 t0, t1, t2, t3;
            asm volatile("global_load_dwordx4 %0, %1, off" : "=&v"(t0) : "v"(src + (size_t)i * 16) : "memory");
            asm volatile("global_load_dwordx4 %0, %1, off" : "=&v"(t1) : "v"(src + (size_t)((i + NTHREADS) < np ? i + NTHREADS : i) * 16) : "memory");
            asm volatile("global_load_dwordx4 %0, %1, off" : "=&v"(t2) : "v"(src + (size_t)((i + 2 * NTHREADS) < np ? i + 2 * NTHREADS : i) * 16) : "memory");
            asm volatile("global_load_dwordx4 %0, %1, off" : "=&v"(t3) : "v"(src + (size_t)((i + 3 * NTHREADS) < np ? i + 3 * NTHREADS : i) * 16) : "memory");
            asm volatile("s_waitcnt vmcnt(0)" : "+v"(t0), "+v"(t1), "+v"(t2), "+v"(t3) :: "memory"); }
    }
}
DI void phase_scan(CArgs& a, int l, LAS unsigned char* lds) {
    char* r1 = a.ws + WS_R1; char* obuf = r1 + R1_OBUF; const int Gd = lgrid();
    unsigned* prog = (unsigned*)(a.ws + WS_CTL + 32768) + l * 64 * 16;
    for (int it = lbid(); it < 256; it += Gd) {
        if (it < 64) { const int c = it & 31, hf = it >> 5; const char* ops = r1 + R1_SGDN + (size_t)c * 64 * GDN_UNIT; char* ob = obuf + OB_GDN + (size_t)c * 64 * 16384;
            scan_wg<128, true, 1, 2, GDN_UNIT, GDN_OQ, GDN_OW, GDN_OP, GDN_OK, GDN_OU, GDN_OD, 4, true>(ops, ops, ob, ob, lds, (Gd >= 256 && hf == 0) ? prog + c * 16 : nullptr, hf * 2); }
        else if (it < 128) { const int c = (it - 64) & 31, hf = (it - 64) >> 5; const char* ops = r1 + R1_SGLA + (size_t)c * 64 * GLA_UNIT; char* ob = obuf + OB_GLA + (size_t)c * 64 * 16384;
            scan_wg<64, false, 1, 2, GLA_UNIT, GLA_OQ, 0, GLA_OP, GLA_OK, GLA_OU, GLA_OD, 4>(ops, ops, ob, ob, lds, nullptr, hf * 2); }
        else if (it < 192) { const int i2 = it - 128; const char* ops = r1 + R1_SSSD + (size_t)i2 * 64 * SSD_UNIT; char* ob = obuf + OB_SSD + (size_t)i2 * 64 * 8192;
            scan_wg<64, false, 1, 2, SSD_UNIT, SSD_OQ, 0, SSD_OP, SSD_OK, SSD_OU, SSD_OD, 2, true>(ops, ops, ob, ob, lds); }
        else if (Gd >= 256) { const int j = it - 192, c = j & 31, k = j >> 5; scan_warm(r1 + R1_SGDN + (size_t)c * 64 * GDN_UNIT, k, 2, GDN_UNIT, prog + c * 16); }
    }
}

DI float otile_ld(const LAS unsigned char* tl, int l_, int e) {
    const int ct = e >> 5, r = e & 31, rt = l_ >> 5, lr = l_ & 31, h = (lr >> 2) & 1, i = (lr & 3) + 4 * (lr >> 3);
    return bf2f(*(const LAS bf16_t*)(tl + ((ct * 2 + rt) * 64 + h * 32 + r) * 32 + i * 2));
}
struct PostRaw { u32x4 ot[2], g0, g1; };
DI void post_load(CArgs& a, int u, PostRaw& r) {
    const int tid = ltid(); const int ty = u >> 11, uu = u & 2047, n = uu & 63, bh = uu >> 6, b = bh >> 2, h = bh & 3; const int l_ = tid >> 3, sub = tid & 7; const size_t T = (size_t)b * SEQ + n * 64 + l_;
    const char* src = a.ws + WS_R1 + R1_OBUF + (ty ? OB_GDN : OB_GLA) + (size_t)uu * 16384;
    r.ot[0] = *(const u32x4*)(src + (size_t)tid * 16); r.ot[1] = *(const u32x4*)(src + (size_t)(NTHREADS + tid) * 16);
    const bf16_t* gp = (const bf16_t*)(a.ws + WS_R1 + R1_PROJ) + T * NP + (ty ? PC_GDN_G : PC_GLA_R) + h * 128 + sub * 16;
    r.g0 = *(const u32x4*)gp; r.g1 = *(const u32x4*)(gp + 8);
}
struct PostRawS { u32x4 ot[4], z[4], xc[4]; };
DI void post_load_s(CArgs& a, int uu, PostRawS& r) {
    const int tid = ltid(); const int n = uu & 63, bg = uu >> 6, b = bg >> 1, g = bg & 1; const int l_ = tid >> 3, sub = tid & 7; const size_t T = (size_t)b * SEQ + n * 64 + l_;
    const char* obuf = a.ws + WS_R1 + R1_OBUF;
#pragma unroll
    for (int rep = 0; rep < 4; ++rep) r.ot[rep] = *(const u32x4*)(obuf + OB_SSD + ((size_t)((b * 8 + g * 4 + rep) * 64 + n)) * 8192 + (size_t)tid * 16);
    const int hh = g * 4 + (sub >> 1), p0 = (sub & 1) * 32;
    const bf16_t* zp = (const bf16_t*)(a.ws + WS_R1 + R1_PROJ) + T * NP + PC_SSD_Z + hh * 64 + p0; const bf16_t* xp = (const bf16_t*)(a.ws + WS_R1 + R1_XCONV) + T * 512 + hh * 64 + p0;
#pragma unroll
    for (int c8 = 0; c8 < 4; ++c8) { r.z[c8] = *(const u32x4*)(zp + c8 * 8); r.xc[c8] = *(const u32x4*)(xp + c8 * 8); }
}
DI void phase_post(CArgs& a, int l, LAS unsigned char* lds) {
    const int tid = ltid(); bf16_t* Y = (bf16_t*)(a.ws + WS_R1 + R1_YMIX); unsigned char* Y8 = (unsigned char*)Y; (void)Y8;
    const int l_ = tid >> 3, sub = tid & 7; const int w = lbid(), Gd = lgrid();
    { const int upw = (4096 + Gd - 1) / Gd, u0 = w * upw, u1 = (u0 + upw < 4096) ? u0 + upw : 4096;
      auto unit = [&](int u, const LAS unsigned char* tl, const u32x4& g0, const u32x4& g1) {
            const int ty = u >> 11, uu = u & 2047, n = uu & 63, bh = uu >> 6, b = bh >> 2, h = bh & 3; const size_t T = (size_t)b * SEQ + n * 64 + l_;
            float o[16]; float ss = 0.f;
#pragma unroll
            for (int j = 0; j < 16; ++j) { o[j] = otile_ld(tl, l_, sub * 16 + j); ss += o[j] * o[j]; }
            ss += __shfl_xor(ss, 1); ss += __shfl_xor(ss, 2); ss += __shfl_xor(ss, 4);
            const float rs = rsqrtf(ss * (1.f / 128.f) + 1e-6f);
            const float* ng = (ty ? a.gdn_norm : a.gla_norm) + l * 128 + sub * 16;
            const float gv[16] = {bflo(g0.x), bfhi(g0.x), bflo(g0.y), bfhi(g0.y), bflo(g0.z), bfhi(g0.z), bflo(g0.w), bfhi(g0.w), bflo(g1.x), bfhi(g1.x), bflo(g1.y), bfhi(g1.y), bflo(g1.z), bfhi(g1.z), bflo(g1.w), bfhi(g1.w)};
            float y[16];
#pragma unroll
            for (int j = 0; j < 16; ++j) y[j] = o[j] * rs * ng[j] * silu_(gv[j]);
#if BRANCH_FP8
            *(u32x4*)(Y8 + ((size_t)ty * NTOK + T) * 512 + h * 128 + sub * 16) = (u32x4){pk4_fp8(y[0], y[1], y[2], y[3]), pk4_fp8(y[4], y[5], y[6], y[7]), pk4_fp8(y[8], y[9], y[10], y[11]), pk4_fp8(y[12], y[13], y[14], y[15])};
#else
            bf16_t* yp = Y + ((size_t)ty * NTOK + T) * 512 + h * 128 + sub * 16;
            *(u32x4*)yp = (u32x4){pk2(y[0], y[1]), pk2(y[2], y[3]), pk2(y[4], y[5]), pk2(y[6], y[7])};
            *(u32x4*)(yp + 8) = (u32x4){pk2(y[8], y[9]), pk2(y[10], y[11]), pk2(y[12], y[13]), pk2(y[14], y[15])};
#endif
      };
      if (u0 < u1) { PostRaw ra, rb; post_load(a, u0, ra); rb = ra; if (u0 + 1 < u1) post_load(a, u0 + 1, rb);
        for (int u = u0; u < u1; u += 2) { const bool hasb = u + 1 < u1; PostRaw na = ra, nb = rb;
            *(LAS u32x4*)(lds + tid * 16) = ra.ot[0]; *(LAS u32x4*)(lds + (NTHREADS + tid) * 16) = ra.ot[1];
            *(LAS u32x4*)(lds + 16384 + tid * 16) = rb.ot[0]; *(LAS u32x4*)(lds + 16384 + (NTHREADS + tid) * 16) = rb.ot[1];
            const u32x4 ga0 = ra.g0, ga1 = ra.g1, gb0 = rb.g0, gb1 = rb.g1;
            if (u + 2 < u1) post_load(a, u + 2, na);
            if (u + 3 < u1) post_load(a, u + 3, nb);
            lds_barrier();
            unit(u, lds, ga0, ga1);
            if (hasb) unit(u + 1, lds + 16384, gb0, gb1);
            lds_barrier();
            ra = na; rb = nb; } } }
    { const int upw = (1024 + Gd - 1) / Gd, u0 = w * upw, u1 = (u0 + upw < 1024) ? u0 + upw : 1024;
      if (u0 < u1) { PostRawS rw; post_load_s(a, u0, rw);
        for (int uu = u0; uu < u1; ++uu) { PostRawS rn = rw;
            const int n = uu & 63, bg = uu >> 6, b = bg >> 1, g = bg & 1; const size_t T = (size_t)b * SEQ + n * 64 + l_;
#pragma unroll
            for (int rep = 0; rep < 4; ++rep) *(LAS u32x4*)(lds + (rep * NTHREADS + tid) * 16) = rw.ot[rep];
            u32x4 z8[4], x8[4];
#pragma unroll
            for (int c8 = 0; c8 < 4; ++c8) { z8[c8] = rw.z[c8]; x8[c8] = rw.xc[c8]; }
            if (uu + 1 < u1) post_load_s(a, uu + 1, rn);
            lds_barrier();
            const int hq = sub >> 1, hh = g * 4 + hq, p0 = (sub & 1) * 32; const float dsk = a.ssd_d[l * 8 + hh];
            float y[32]; float ss = 0.f;
#pragma unroll
            for (int c8 = 0; c8 < 4; ++c8) {
                const float zf[8] = {bflo(z8[c8].x), bfhi(z8[c8].x), bflo(z8[c8].y), bfhi(z8[c8].y), bflo(z8[c8].z), bfhi(z8[c8].z), bflo(z8[c8].w), bfhi(z8[c8].w)};
                const float xf[8] = {bflo(x8[c8].x), bfhi(x8[c8].x), bflo(x8[c8].y), bfhi(x8[c8].y), bflo(x8[c8].z), bfhi(x8[c8].z), bflo(x8[c8].w), bfhi(x8[c8].w)};
#pragma unroll
                for (int j = 0; j < 8; ++j) { const float ov = otile_ld(lds + hq * 8192, l_, p0 + c8 * 8 + j); const float yv = (ov + dsk * xf[j]) * silu_(zf[j]); y[c8 * 8 + j] = yv; ss += yv * yv; } }
            ss += __shfl_xor(ss, 1); ss += __shfl_xor(ss, 2); ss += __shfl_xor(ss, 4);
            const float rs = rsqrtf(ss * (1.f / 256.f) + 1e-6f);
            const float* ng = a.ssd_norm + l * 512 + hh * 64 + p0;
            bf16_t* yp = Y + ((size_t)2 * NTOK + T) * 512 + hh * 64 + p0; (void)yp;
#pragma unroll
            for (int c8 = 0; c8 < 4; ++c8) { float t[8];
#pragma unroll
                for (int j = 0; j < 8; ++j) t[j] = y[c8 * 8 + j] * rs * ng[c8 * 8 + j];
#if BRANCH_FP8
                *(u32x2*)(Y8 + ((size_t)2 * NTOK + T) * 512 + hh * 64 + p0 + c8 * 8) = (u32x2){pk4_fp8(t[0], t[1], t[2], t[3]), pk4_fp8(t[4], t[5], t[6], t[7])};
#else
                *(u32x4*)(yp + c8 * 8) = (u32x4){pk2(t[0], t[1]), pk2(t[2], t[3]), pk2(t[4], t[5]), pk2(t[6], t[7])};
#endif
            }
            lds_barrier();
            rw = rn; } } }
}
DI CArgs& load_args() { CArgs* p = (CArgs*)__builtin_amdgcn_kernarg_segment_ptr(); asm volatile("" : "+s"(p)); return *p; }
DI void grid_sync(LAS unsigned char* lds) {
    CArgs& a = load_args(); XcdBarrier b; b.bar = (unsigned*)(a.ws + WS_CTL); b.x = xb_xcc_id(); b.st = (volatile LAS unsigned*)(lds + LDS_CTRL); xcd_barrier(b); }
__global__ void __launch_bounds__(NTHREADS, 2) fwd_kernel(Args a_unused) {
    extern __shared__ __attribute__((aligned(16))) unsigned char lds_raw[];
    LAS unsigned char* lds = (LAS unsigned char*)lds_raw;
    const int tid = ltid();
    if (tid < 256) ((LAS unsigned*)(lds + LDS_CTRL))[tid] = (tid == (LDS_VID_OFF - LDS_CTRL) / 4) ? (unsigned)blockIdx.x : 0u;
    __syncthreads();
    { CArgs& a = load_args(); (void)xcd_barrier_post((unsigned*)(a.ws + WS_CTL), (volatile LAS unsigned*)(lds + LDS_CTRL)); }
    const int G = lgrid();
#ifndef REP_CVT
#define REP_CVT 1
#endif
#ifndef REP_INPROJ
#define REP_INPROJ 1
#endif
#ifndef REP_PREP
#define REP_PREP 1
#endif
#ifndef REP_SCAN
#define REP_SCAN 1
#endif
#ifndef REP_POST
#define REP_POST 1
#endif
#ifndef REP_BR
#define REP_BR 1
#endif
#ifndef REP_OUT
#define REP_OUT 1
#endif
#ifndef REP_GU
#define REP_GU 1
#endif
#ifndef REP_DN
#define REP_DN 1
#endif
#ifndef REP_COMB
#define REP_COMB 1
#endif
#define REPEAT(n) for (int rep_ = 0; rep_ < (n); ++rep_)
    { CArgs& a = load_args(); phase_mod(a, lds); }
    REPEAT(REP_CVT) { CArgs& a = load_args(); phase_cvt(a, lds); }
    grid_sync(lds);
    { CArgs& a = load_args();
      if (threadIdx.x == 0) { unsigned* bar = (unsigned*)(a.ws + WS_CTL); bool ok = (gridDim.x == 256u);
#pragma unroll 1
          for (unsigned j = 0; j < 16; ++j) ok = ok && (xb_ld(&bar[XB_XCNT(j)]) == (j < 8u ? 32u : 0u));
          const unsigned x = xb_xcc_id(), rank = ((volatile LAS unsigned*)(lds + LDS_CTRL))[8];
          if (ok && x < 8u && rank < 32u) *(volatile LAS int*)(lds + LDS_VID_OFF) = (int)(rank * 8u + x); }
      __syncthreads(); }
    const int c = lbid();
    { CArgs& a = load_args(); phase_norm0(a); }
#ifdef PROBE_BARS
    for (int pb = 0; pb < PROBE_BARS; ++pb) grid_sync(lds);
#endif
#if INPROJ_I8
    { CArgs& a = load_args(); phase_cvt_win_i8(a, lds); }
#endif
    grid_sync(lds);
    for (int l = 0; l < 2; ++l) {
        REPEAT(REP_INPROJ) {
        { CArgs& a = load_args(); char* r1 = a.ws + WS_R1;
#if INPROJ_I8
#ifdef PROBE_DUPK
          pg8::DupOrder S;
#else
          pg8::StaticOrder S;
#endif
          S.init(NTOK, NP, DM / 2, G, c, a.ws + WS_H, a.ws + WS_WIN + (size_t)l * NP * DM);
          EpiProj E{(bf16_t*)(r1 + R1_PROJ), (float*)(a.ws + WS_SMALL), (const float*)(a.ws + WS_SA), (const float*)(a.ws + WS_COLMAX) + l * NP, (unsigned char*)(r1 + R1_MG8)};
#ifdef PROBE_DUPK
          pg8::gemm_phase<EpiProj, pg8::DupOrder, 2>(lds, DM / 2, S, E);
#else
          pg8::gemm_phase<EpiProj, pg8::StaticOrder, 2>(lds, DM / 2, S, E);
#endif
#else
          pg8::StaticOrder S; S.init(NTOK, NP, DM, G, c, a.ws + WS_H, a.ws + WS_WIN + (size_t)l * NP * DM * 2);
          EpiProj E{(bf16_t*)(r1 + R1_PROJ), (float*)(a.ws + WS_SMALL), nullptr, nullptr, (unsigned char*)(r1 + R1_MG8)};
          pg8::gemm_phase<EpiProj, pg8::StaticOrder>(lds, DM, S, E);
#endif
        }
        grid_sync(lds); }
        REPEAT(REP_PREP) { { CArgs& a = load_args(); phase_prep(a, l, lds); }
        grid_sync(lds); }
        REPEAT(REP_SCAN) { { CArgs& a = load_args(); phase_scan(a, l, lds); }
        grid_sync(lds); }
        REPEAT(REP_POST) { { CArgs& a = load_args(); phase_post(a, l, lds); }
        grid_sync(lds); }
        REPEAT(REP_BR) {
        { CArgs& a = load_args(); char* r1 = a.ws + WS_R1;
          EpiGate E{(const unsigned char*)(r1 + R1_MG8), a.b_merge + l * 3072, (bf16_t*)(r1 + R1_MERGED)};
#if BRANCH_FP8
          pg8::BranchOrder S; S.init(NTOK, DM, 256, G, c, r1 + R1_YMIX, a.ws + WS_WBR + (size_t)l * 3 * DM * 512); S.pn_per_a = 4; S.a_pnstride = (size_t)NTOK * 512;
          pg8::gemm_phase<EpiGate, pg8::BranchOrder, 1>(lds, 256, S, E);
#else
          pg8::BranchOrder S; S.init(NTOK, DM, 512, G, c, r1 + R1_YMIX, a.ws + WS_WBR + (size_t)l * 3 * DM * 512 * 2); S.pn_per_a = 4; S.a_pnstride = (size_t)NTOK * 512 * 2;
          pg8::gemm_phase<EpiGate, pg8::BranchOrder>(lds, 512, S, E);
#endif
        }
        grid_sync(lds); }
        REPEAT(REP_OUT) {
        { CArgs& a = load_args(); char* r1 = a.ws + WS_R1;
          pg8::StaticOrder S; S.init(NTOK, DM, DM, G, c, r1 + R1_MERGED, a.ws + WS_WOUT + (size_t)l * DM * DM * 2);
          EpiResid E{(const bf16_t*)(a.ws + WS_XB), (bf16_t*)(a.ws + WS_XA), (const float*)(a.ws + WS_MOD) + (size_t)l * 8 * 6144 + 2048};
          pg8::gemm_phase<EpiResid, pg8::StaticOrder>(lds, DM, S, E); }
        grid_sync(lds); }
        { CArgs& a = load_args(); phase_router(a, l, (const bf16_t*)(a.ws + WS_XA), lds); }
        grid_sync(lds);
        REPEAT(REP_GU) {
        { CArgs& a = load_args(); char* r1 = a.ws + WS_R1;
          moe_tables((const int*)(a.ws + WS_CNT) + l * 32 * 64, lds);
          MoeOrder<true> S{8, G, c, (const LAS int*)(lds + LDS_CTRL + 64), (const LAS int*)(lds + LDS_CTRL + 256), (const char*)(a.ws + WS_H), a.ws + WS_WGU + (size_t)l * NEXP * 2048 * DM,
                           (size_t)2048 * DM, (size_t)256 * DM, (const int*)(a.ws + WS_ROWTOK)};
          EpiSwiglu E{(unsigned char*)(r1 + R1_ACT), a.b_gu + (size_t)l * NEXP * 2048};
          pg8::gemm_phase<EpiSwiglu, MoeOrder<true>, 1, GEMM_ALIGN, false, MOE_TILED != 0>(lds, DM / 2, S, E); }
        grid_sync(lds); }
        REPEAT(REP_DN) {
        { CArgs& a = load_args(); char* r1 = a.ws + WS_R1;
          MoeOrder<false> S{4, G, c, (const LAS int*)(lds + LDS_CTRL + 64), (const LAS int*)(lds + LDS_CTRL + 256), (const char*)(r1 + R1_ACT), a.ws + WS_WDN + (size_t)l * NEXP * DM * DM,
                            (size_t)DM * DM, (size_t)256 * DM, nullptr};
          EpiDown E{(bf16_t*)(r1 + R1_YS), a.b_dn + (size_t)l * NEXP * DM};
          pg8::gemm_phase<EpiDown, MoeOrder<false>, 1, GEMM_ALIGN, MOE_TILED != 0, MOE_TILED != 0>(lds, DM / 2, S, E); }
        grid_sync(lds); }
        REPEAT(REP_COMB) { { CArgs& a = load_args(); phase_combine(a, l, (const bf16_t*)(a.ws + WS_XA), (bf16_t*)(a.ws + WS_XB), lds); }
        if (l == 0 || REP_COMB > 1) grid_sync(lds); }
    }
}

extern "C" void kernel_launch(void* const* d_in, const int* in_sizes, int n_in, void* d_out, int out_size, void* d_ws, size_t ws_size, hipStream_t stream) {
    static int grid = 0;
    if (grid == 0) {
        if (n_in != 32 || ws_size < WS_END) { fprintf(stderr, "kernel_launch: unexpected inputs (n_in %d, ws %zu, need %zu)\n", n_in, ws_size, (size_t)WS_END); grid = -1; return; }
        int dev = 0, cus = 0, per_cu = 0;
        if (hipGetDevice(&dev) != hipSuccess || hipDeviceGetAttribute(&cus, hipDeviceAttributeMultiprocessorCount, dev) != hipSuccess) { grid = -1; return; }
        if (hipFuncSetAttribute((const void*)fwd_kernel, hipFuncAttributeMaxDynamicSharedMemorySize, LDS_BYTES) != hipSuccess) { fprintf(stderr, "kernel_launch: hipFuncSetAttribute failed\n"); grid = -1; return; }
        if (hipOccupancyMaxActiveBlocksPerMultiprocessor(&per_cu, (const void*)fwd_kernel, NTHREADS, LDS_BYTES) != hipSuccess || per_cu < 1) { fprintf(stderr, "kernel_launch: occupancy query says %d\n", per_cu); grid = -1; return; }
        grid = cus;
    }
    if (grid < 0) return;
    (void)hipMemsetAsync((char*)d_ws + WS_CTL, 0, 131072, stream);
    Args a{};
    const float** pp = (const float**)&a;
    for (int i = 0; i < 32; ++i) pp[i] = (const float*)d_in[i];
    a.out = (float*)d_out; a.ws = (char*)d_ws;
    hipLaunchKernelGGL(fwd_kernel, dim3(grid), dim3(NTHREADS), LDS_BYTES, stream, a);
}
```
